# Optimizing an MI355X kernel written in HIP

```python
import math
import jax, jax.numpy as jnp
from jax import lax
import numpy as np

D_MODEL = 2048
BATCH = 4
SEQ = 2048
DEPTH = 2

GLA_HEADS = 4
GLA_DK = 64
GLA_DV = 128
GLA_RANK = 16
GLA_TAU = 16.0
GLA_CHUNK = 64
GLA_QK = GLA_HEADS * GLA_DK
GLA_V = GLA_HEADS * GLA_DV

DIL_PAIRS = ((128, 1), (512, 4), (2048, 16))
DIL_HEADS_PER_GROUP = 4
DIL_HEAD_DIM = 64
DIL_HEADS = len(DIL_PAIRS) * DIL_HEADS_PER_GROUP
DIL_W = DIL_HEADS * DIL_HEAD_DIM
DIL_OUT = DIL_HEADS_PER_GROUP * DIL_HEAD_DIM
DIL_BLOCK = 128
ROPE_THETA = 10000.0

SGU_CHUNK = 128
SGU_GROUPS = 6
SGU_GROUP_CH = 128
SGU_W = SGU_GROUPS * SGU_GROUP_CH

MLSTM_HEADS = 4
MLSTM_HEAD_DIM = 128
MLSTM_CHUNK = 64
MLSTM_CONV = 4
ML_W = MLSTM_HEADS * MLSTM_HEAD_DIM

N_EXPERTS = 64
TOP_K = 8
N_GROUPS = 8
TOPK_GROUPS = 4
EXPERT_FF = 512
SHARED_FF = 512
ROUTED_SCALE = 2.5
EXPERT_BLOCK = 8

N_BRANCH = 4
DN_ALPHA = (2 * DEPTH) ** 0.25
DN_BETA = (8 * DEPTH) ** -0.25
LN_EPS = 1e-5

SPLIT_SIZES = (GLA_QK, GLA_QK, GLA_V, GLA_V, GLA_RANK,
               DIL_W, DIL_W, DIL_W,
               SGU_W, SGU_W,
               ML_W, ML_W, ML_W, ML_W, MLSTM_HEADS, MLSTM_HEADS,
               N_BRANCH * D_MODEL)
IN_COLS = sum(SPLIT_SIZES)

kernel_name = 'hybrid_gla_dilated_sgu_mlstm_moe'


def _layernorm(x, g, b):
    xf = x.astype(jnp.float32)
    mu = jnp.mean(xf, axis=-1, keepdims=True)
    var = jnp.mean(jnp.square(xf - mu), axis=-1, keepdims=True)
    y = (xf - mu) * lax.rsqrt(var + LN_EPS) * g.astype(jnp.float32) + b.astype(jnp.float32)
    return y.astype(x.dtype)


def _head_rmsnorm(x, g, n_heads):
    B, S, W = x.shape
    xf = x.astype(jnp.float32).reshape(B, S, n_heads, W // n_heads)
    xf = xf * lax.rsqrt(jnp.mean(jnp.square(xf), axis=-1, keepdims=True) + LN_EPS)
    return xf.reshape(B, S, W) * g.astype(jnp.float32)


def _rope(x, pos):
    dh = x.shape[-1]
    half = dh // 2
    inv = ROPE_THETA ** (-jnp.arange(half, dtype=jnp.float32) * 2.0 / dh)
    ang = pos.astype(jnp.float32)[..., None] * inv
    cos = jnp.cos(ang)[:, :, None, :]
    sin = jnp.sin(ang)[:, :, None, :]
    x1, x2 = x[..., :half], x[..., half:]
    return jnp.concatenate([x1 * cos - x2 * sin, x2 * cos + x1 * sin], axis=-1)


def _to_chunks(t, n_heads, chunk):
    B, S, W = t.shape
    return t.reshape(B, S // chunk, chunk, n_heads, W // n_heads).transpose(1, 0, 3, 2, 4)


def _from_chunks(t):
    N, B, H, L, d = t.shape
    return t.transpose(1, 0, 3, 2, 4).reshape(B, N * L, H * d)


def _gla(q, k, v, r, a_low, wa2, ba, norm_g):
    f32 = jnp.float32
    L = GLA_CHUNK
    g = jax.nn.log_sigmoid((a_low @ wa2 + ba).astype(f32)) / GLA_TAU
    qc = _to_chunks(q.astype(f32) * GLA_DK ** -0.5, GLA_HEADS, L)
    kc = _to_chunks(k.astype(f32), GLA_HEADS, L)
    vc = _to_chunks(v.astype(f32), GLA_HEADS, L)
    gc = _to_chunks(g, GLA_HEADS, L)
    causal = jnp.tril(jnp.ones((L, L), dtype=bool))

    def step(state, inp):
        qq, kk, vv, gg = inp
        b = jnp.cumsum(gg, axis=-2)
        qe = qq * jnp.exp(b)
        ke = kk * jnp.exp(-b)
        att = jnp.where(causal, jnp.einsum('bhid,bhjd->bhij', qe, ke), 0.0)
        o = jnp.einsum('bhij,bhje->bhie', att, vv) + jnp.einsum('bhid,bhde->bhie', qe, state)
        b_last = b[:, :, -1, :]
        kd = kk * jnp.exp(b_last[:, :, None, :] - b)
        state = jnp.exp(b_last)[..., None] * state + jnp.einsum('bhjd,bhje->bhde', kd, vv)
        return state, o

    B = q.shape[0]
    state0 = jnp.zeros((B, GLA_HEADS, GLA_DK, GLA_DV), f32)
    _, o = lax.scan(step, state0, (qc, kc, vc, gc))
    o = _head_rmsnorm(_from_chunks(o), norm_g, GLA_HEADS)
    return (o * jax.nn.silu(r.astype(f32))).astype(q.dtype)


def _dilated_group(q, k, v, window, dilation):
    B, S, H, dh = q.shape
    Lsub = S // dilation
    span = window // dilation
    blk = min(DIL_BLOCK, Lsub)
    nb = -(-Lsub // blk)
    Lp = nb * blk

    def strided(t):
        t = t.reshape(B, Lsub, dilation, H, dh).transpose(0, 2, 3, 1, 4)
        return jnp.pad(t, ((0, 0), (0, 0), (0, 0), (0, Lp - Lsub), (0, 0)))

    def with_prev(t):
        tb = t.reshape(B, dilation, H, nb, blk, dh)
        prev = jnp.pad(tb, ((0, 0), (0, 0), (0, 0), (1, 0), (0, 0), (0, 0)))[:, :, :, :-1]
        return jnp.concatenate([prev, tb], axis=4)

    qb = strided(q).reshape(B, dilation, H, nb, blk, dh)
    kb = with_prev(strided(k))
    vb = with_prev(strided(v))
    qpos = jnp.arange(nb)[:, None] * blk + jnp.arange(blk)[None, :]
    kpos = (jnp.arange(nb)[:, None] - 1) * blk + jnp.arange(2 * blk)[None, :]
    rel = qpos[:, :, None] - kpos[:, None, :]
    valid = (rel >= 0) & (rel <= span) & (kpos[:, None, :] >= 0)
    s = jnp.einsum('brhnqd,brhnkd->brhnqk', qb, kb) * dh ** -0.5
    s = jnp.where(valid, s, -jnp.inf)
    m = jnp.max(s, axis=-1, keepdims=True)
    p = jnp.exp(s - m)
    den = jnp.sum(p, axis=-1)
    o = jnp.einsum('brhnqk,brhnkd->brhnqd', p, vb) / den[..., None]
    lse = m[..., 0] + jnp.log(den)
    o = o.reshape(B, dilation, H, Lp, dh)[:, :, :, :Lsub].transpose(0, 3, 1, 2, 4).reshape(B, S, H, dh)
    lse = lse.reshape(B, dilation, H, Lp)[:, :, :, :Lsub].transpose(0, 3, 1, 2).reshape(B, S, H)
    return o, lse


def _dilated(q, k, v, pos):
    B, S, _ = q.shape
    f32 = jnp.float32
    qh = _rope(q.astype(f32).reshape(B, S, DIL_HEADS, DIL_HEAD_DIM), pos)
    kh = _rope(k.astype(f32).reshape(B, S, DIL_HEADS, DIL_HEAD_DIM), pos)
    vh = v.astype(f32).reshape(B, S, DIL_HEADS, DIL_HEAD_DIM)
    outs, lses = [], []
    for gi, (window, dilation) in enumerate(DIL_PAIRS):
        hs = slice(gi * DIL_HEADS_PER_GROUP, (gi + 1) * DIL_HEADS_PER_GROUP)
        o, lse = _dilated_group(qh[:, :, hs], kh[:, :, hs], vh[:, :, hs], window, dilation)
        outs.append(o)
        lses.append(lse)
    w = jax.nn.softmax(jnp.stack(lses, axis=0), axis=0)
    o = jnp.sum(w[..., None] * jnp.stack(outs, axis=0), axis=0)
    return o.reshape(B, S, DIL_OUT).astype(q.dtype)


def _sgu(u, v, ln_g, ln_b, ws, bs):
    f32 = jnp.float32
    B, S, _ = u.shape
    N = S // SGU_CHUNK
    zu = jax.nn.gelu(u.astype(f32), approximate=False)
    zv = jax.nn.gelu(v.astype(f32), approximate=False)
    vn = _layernorm(zv, ln_g, ln_b).reshape(B, N, SGU_CHUNK, SGU_GROUPS, SGU_GROUP_CH)
    w_causal = ws.astype(f32) * jnp.tril(jnp.ones((SGU_CHUNK, SGU_CHUNK), f32))
    s = jnp.einsum('gij,bnjgc->bnigc', w_causal, vn) + bs.astype(f32).T[None, None, :, :, None]
    return (zu * s.reshape(B, S, SGU_W)).astype(u.dtype)


def _mlstm(q, k, v, o_pre, i_pre, f_pre, conv_w, conv_b, b_i, b_f, norm_g):
    f32 = jnp.float32
    B, S, _ = q.shape
    L = MLSTM_CHUNK
    qk = jnp.concatenate([q, k], axis=-1)
    qk = lax.conv_general_dilated(qk, conv_w[:, None, :].astype(qk.dtype), window_strides=(1,),
                                  padding=((MLSTM_CONV - 1, 0),), dimension_numbers=('NWC', 'WIO', 'NWC'),
                                  feature_group_count=qk.shape[-1]) + conv_b
    qk = jax.nn.silu(qk.astype(f32))
    qq_all, kk_all = jnp.split(qk, 2, axis=-1)
    qc = _to_chunks(qq_all, MLSTM_HEADS, L)
    kc = _to_chunks(kk_all * MLSTM_HEAD_DIM ** -0.5, MLSTM_HEADS, L)
    vc = _to_chunks(v.astype(f32), MLSTM_HEADS, L)
    logf = jax.nn.log_sigmoid((f_pre + b_f).astype(f32))
    logi = (i_pre + b_i).astype(f32)
    lfc = logf.reshape(B, S // L, L, MLSTM_HEADS).transpose(1, 0, 3, 2)
    lic = logi.reshape(B, S // L, L, MLSTM_HEADS).transpose(1, 0, 3, 2)
    causal = jnp.tril(jnp.ones((L, L), dtype=bool))

    def step(carry, inp):
        C, n, m = carry
        qq, kk, vv, lf, li = inp
        b = jnp.cumsum(lf, axis=-1)
        dmat = jnp.where(causal, b[..., :, None] - b[..., None, :] + li[..., None, :], -jnp.inf)
        inter = b + m[..., None]
        m_t = jnp.maximum(inter, jnp.max(dmat, axis=-1))
        w_in = jnp.exp(dmat - m_t[..., None])
        w_st = jnp.exp(inter - m_t)
        sc = jnp.einsum('bhid,bhjd->bhij', qq, kk) * w_in
        num = jnp.einsum('bhij,bhje->bhie', sc, vv) + w_st[..., None] * jnp.einsum('bhid,bhde->bhie', qq, C)
        den = jnp.sum(sc, axis=-1) + w_st * jnp.einsum('bhid,bhd->bhi', qq, n)
        h = num / jnp.maximum(jnp.abs(den), jnp.exp(-m_t))[..., None]
        b_last = b[..., -1]
        dec = b_last[..., None] - b + li
        m_new = jnp.maximum(b_last + m, jnp.max(dec, axis=-1))
        wk = jnp.exp(dec - m_new[..., None])
        keep = jnp.exp(b_last + m - m_new)
        C = keep[..., None, None] * C + jnp.einsum('bhj,bhjd,bhje->bhde', wk, kk, vv)
        n = keep[..., None] * n + jnp.einsum('bhj,bhjd->bhd', wk, kk)
        return (C, n, m_new), h

    carry0 = (jnp.zeros((B, MLSTM_HEADS, MLSTM_HEAD_DIM, MLSTM_HEAD_DIM), f32),
              jnp.zeros((B, MLSTM_HEADS, MLSTM_HEAD_DIM), f32),
              jnp.zeros((B, MLSTM_HEADS), f32))
    _, h = lax.scan(step, carry0, (qc, kc, vc, lfc, lic))
    h = jax.nn.sigmoid(o_pre.astype(f32)) * _from_chunks(h)
    return _head_rmsnorm(h, norm_g, MLSTM_HEADS).astype(q.dtype)


def _moe(x, w_router, router_bias, w1, w3, w2, ws1, ws3, ws2):
    f32 = jnp.float32
    B, S, D = x.shape
    t = x.reshape(B * S, D)
    scores = jax.nn.sigmoid(t.astype(f32) @ w_router.astype(f32))
    choice = scores + router_bias.astype(f32)
    grp = choice.reshape(-1, N_GROUPS, N_EXPERTS // N_GROUPS)
    grp_score = jnp.sum(lax.top_k(grp, 2)[0], axis=-1)
    _, grp_idx = lax.top_k(grp_score, TOPK_GROUPS)
    grp_mask = jnp.sum(jax.nn.one_hot(grp_idx, N_GROUPS, dtype=f32), axis=-2) > 0
    exp_mask = jnp.repeat(grp_mask, N_EXPERTS // N_GROUPS, axis=-1)
    _, idx = lax.top_k(jnp.where(exp_mask, choice, -jnp.inf), TOP_K)
    wts = jnp.take_along_axis(scores, idx, axis=-1)
    wts = wts / jnp.sum(wts, axis=-1, keepdims=True) * ROUTED_SCALE
    combine = jnp.sum(jax.nn.one_hot(idx, N_EXPERTS, dtype=f32) * wts[..., None], axis=-2)
    out = (jax.nn.silu(t @ ws1) * (t @ ws3)) @ ws2
    for e0 in range(0, N_EXPERTS, EXPERT_BLOCK):
        sl = slice(e0, e0 + EXPERT_BLOCK)
        h = jax.nn.silu(jnp.einsum('nd,edf->nef', t, w1[sl])) * jnp.einsum('nd,edf->nef', t, w3[sl])
        h = h * combine[:, sl, None].astype(h.dtype)
        out = out + jnp.einsum('nef,efd->nd', h, w2[sl])
    return out.reshape(B, S, D).astype(x.dtype)


def setup_inputs(seed: int = 0) -> dict:
    key = jax.random.key(seed)
    ks = iter(jax.random.split(key, 48))
    f32 = jnp.float32
    L, D, E, F, SF = DEPTH, D_MODEL, N_EXPERTS, EXPERT_FF, SHARED_FF

    def nrm(shape, scale):
        return jax.random.normal(next(ks), shape, f32) * scale

    x = jax.random.normal(next(ks), (BATCH, SEQ, D), f32)
    offs = jax.random.randint(next(ks), (BATCH, 1), 0, 4096, dtype=jnp.int32)
    positions = offs + jnp.arange(SEQ, dtype=jnp.int32)[None, :]
    return {
        'x': x,
        'positions': positions,
        'w_in': nrm((L, D, IN_COLS), D ** -0.5),
        'gla_wa2': nrm((L, GLA_RANK, GLA_QK), GLA_RANK ** -0.5),
        'gla_ba': nrm((L, GLA_QK), 0.1),
        'gla_norm': 1.0 + nrm((L, GLA_V), 0.02),
        'mlstm_conv_w': nrm((L, MLSTM_CONV, 2 * ML_W), MLSTM_CONV ** -0.5),
        'mlstm_conv_b': nrm((L, 2 * ML_W), 0.02),
        'mlstm_bi': nrm((L, MLSTM_HEADS), 0.1),
        'mlstm_bf': 3.0 + nrm((L, MLSTM_HEADS), 0.5),
        'mlstm_norm': 1.0 + nrm((L, ML_W), 0.02),
        'sgu_ln_g': 1.0 + nrm((L, SGU_W), 0.02),
        'sgu_ln_b': nrm((L, SGU_W), 0.02),
        'sgu_ws': nrm((L, SGU_GROUPS, SGU_CHUNK, SGU_CHUNK), 0.5 * SGU_CHUNK ** -0.5),
        'sgu_bs': 1.0 + nrm((L, SGU_GROUPS, SGU_CHUNK), 0.1),
        'w_pa': nrm((L, GLA_V, D), DN_BETA * GLA_V ** -0.5),
        'w_pb': nrm((L, DIL_OUT, D), DN_BETA * DIL_OUT ** -0.5),
        'w_pc': nrm((L, SGU_W, D), DN_BETA * SGU_W ** -0.5),
        'w_pd': nrm((L, ML_W, D), DN_BETA * ML_W ** -0.5),
        'w_out': nrm((L, D, D), DN_BETA * D ** -0.5),
        'ln1_g': 1.0 + nrm((L, D), 0.02),
        'ln1_b': nrm((L, D), 0.02),
        'w_router': nrm((L, D, E), D ** -0.5),
        'router_bias': nrm((L, E), 0.01),
        'w1': nrm((L, E, D, F), D ** -0.5),
        'w3': nrm((L, E, D, F), D ** -0.5),
        'w2': nrm((L, E, F, D), DN_BETA * F ** -0.5),
        'ws1': nrm((L, D, SF), D ** -0.5),
        'ws3': nrm((L, D, SF), D ** -0.5),
        'ws2': nrm((L, SF, D), DN_BETA * SF ** -0.5),
        'ln2_g': 1.0 + nrm((L, D), 0.02),
        'ln2_b': nrm((L, D), 0.02),
    }


def reference(x, positions, w_in, gla_wa2, gla_ba, gla_norm, mlstm_conv_w, mlstm_conv_b, mlstm_bi, mlstm_bf,
              mlstm_norm, sgu_ln_g, sgu_ln_b, sgu_ws, sgu_bs, w_pa, w_pb, w_pc, w_pd, w_out, ln1_g, ln1_b,
              w_router, router_bias, w1, w3, w2, ws1, ws3, ws2, ln2_g, ln2_b):
    B, S, D = x.shape
    points = np.cumsum(SPLIT_SIZES)[:-1].tolist()
    for l in range(DEPTH):
        y = x @ w_in[l]
        (a_q, a_k, a_v, a_r, a_low, b_q, b_k, b_v, c_u, c_v,
         d_q, d_k, d_v, d_o, d_i, d_f, g_pre) = jnp.split(y, points, axis=-1)
        ya = _gla(a_q, a_k, a_v, a_r, a_low, gla_wa2[l], gla_ba[l], gla_norm[l])
        yb = _dilated(b_q, b_k, b_v, positions)
        yc = _sgu(c_u, c_v, sgu_ln_g[l], sgu_ln_b[l], sgu_ws[l], sgu_bs[l])
        yd = _mlstm(d_q, d_k, d_v, d_o, d_i, d_f, mlstm_conv_w[l], mlstm_conv_b[l],
                    mlstm_bi[l], mlstm_bf[l], mlstm_norm[l])
        gates = jax.nn.sigmoid(g_pre.astype(jnp.float32)).reshape(B, S, N_BRANCH, D)
        merged = (gates[:, :, 0] * (ya @ w_pa[l]) + gates[:, :, 1] * (yb @ w_pb[l])
                  + gates[:, :, 2] * (yc @ w_pc[l]) + gates[:, :, 3] * (yd @ w_pd[l]))
        h = merged.astype(x.dtype) @ w_out[l]
        x = _layernorm(DN_ALPHA * x + h, ln1_g[l], ln1_b[l])
        h = _moe(x, w_router[l], router_bias[l], w1[l], w3[l], w2[l], ws1[l], ws3[l], ws2[l])
        x = _layernorm(DN_ALPHA * x + h, ln2_g[l], ln2_b[l])
    return x
```

```cpp
#include <hip/hip_runtime.h>
#include <cstdio>
#include <cstdint>
#include <cmath>
#define MK_MODE 3
#define REPEAT_MASK 0
#define HD __device__
#ifndef HD
#define HD
#endif
#define YP 15872
#define Y_AQ 0
#define Y_AK 256
#define Y_AV 512
#define Y_AR 1024
#define Y_BQ 1536
#define Y_BK 2304
#define Y_BV 3072
#define Y_CU 3840
#define Y_CV 4608
#define Y_DQ 5376
#define Y_DK 5888
#define Y_DV 6400
#define Y_DO 6912
#define Y_G  7680
#define YM_A 0
#define YM_B 512
#define YM_C 768
#define YM_D 1536
typedef unsigned short u16;
HD static inline float bf2f(u16 v) { unsigned u = ((unsigned)v) << 16; float f; __builtin_memcpy(&f, &u, 4); return f; }
HD static inline u16 f2bf(float f) { unsigned u; __builtin_memcpy(&u, &f, 4); u += 0x7fffu + ((u >> 16) & 1u); return (u16)(u >> 16); }
HD static inline float sigmoidf_(float x) { return 1.f / (1.f + expf(-x)); }
HD static inline float logsigmoidf_(float x) { return x < 0.f ? x - log1pf(expf(x)) : -log1pf(expf(-x)); }
HD static inline float siluf_(float x) { return x * sigmoidf_(x); }
HD static inline float geluf_(float x) { return 0.5f * x * (1.f + erff(x * 0.70710678118654752f)); }

HD static inline void naive_gla_g(int tok, int c, const float* YSM, const float* wa2, const float* ba, float* GG) {
    float s = ba[c];
    for (int r = 0; r < 16; ++r) s += YSM[tok * 32 + r] * wa2[r * 256 + c];
    GG[(size_t)tok * 256 + c] = logsigmoidf_(s) * (1.f / 16.f);
}
HD static inline void naive_gla_rec(int b, int h, int e, int S_, const u16* Y, const float* GG, float* OA) {
    float St[64];
#pragma unroll
    for (int d = 0; d < 64; ++d) St[d] = 0.f;
    for (int t = 0; t < S_; ++t) {
        const size_t tok = (size_t)b * S_ + t;
        const float v = bf2f(Y[tok * YP + Y_AV + h * 128 + e]);
        float o = 0.f;
#pragma unroll
        for (int d = 0; d < 64; ++d) {
            const float a = expf(GG[tok * 256 + h * 64 + d]);
            const float k = bf2f(Y[tok * YP + Y_AK + h * 64 + d]);
            const float q = bf2f(Y[tok * YP + Y_AQ + h * 64 + d]) * 0.125f;
            St[d] = a * St[d] + k * v;
            o += q * St[d];
        }
        OA[tok * 512 + h * 128 + e] = o;
    }
}
HD static inline void naive_gla_post(int tok, int h, const u16* Y, const float* OA, const float* norm_g, u16* YM) {
    float ss = 0.f;
    for (int e = 0; e < 128; ++e) { const float o = OA[(size_t)tok * 512 + h * 128 + e]; ss += o * o; }
    const float rs = 1.f / sqrtf(ss * (1.f / 128.f) + 1e-5f);
    for (int e = 0; e < 128; ++e) {
        const float o = OA[(size_t)tok * 512 + h * 128 + e] * rs * norm_g[h * 128 + e];
        const float r = bf2f(Y[(size_t)tok * YP + Y_AR + h * 128 + e]);
        YM[(size_t)tok * 2048 + YM_A + h * 128 + e] = f2bf(o * siluf_(r));
    }
}
HD static inline void naive_rope(int tok, int head, int i, const u16* Y, const int* positions, float* QR, float* KR) {
    const float inv = powf(10000.0f, -(float)i * 2.0f / 64.0f);
    const float ang = (float)positions[tok] * inv;
    const float c = cosf(ang), s = sinf(ang);
    const size_t yb = (size_t)tok * YP;
    const float q1 = bf2f(Y[yb + Y_BQ + head * 64 + i]), q2 = bf2f(Y[yb + Y_BQ + head * 64 + 32 + i]);
    const float k1 = bf2f(Y[yb + Y_BK + head * 64 + i]), k2 = bf2f(Y[yb + Y_BK + head * 64 + 32 + i]);
    QR[(size_t)tok * 768 + head * 64 + i] = q1 * c - q2 * s; QR[(size_t)tok * 768 + head * 64 + 32 + i] = q2 * c + q1 * s;
    KR[(size_t)tok * 768 + head * 64 + i] = k1 * c - k2 * s; KR[(size_t)tok * 768 + head * 64 + 32 + i] = k2 * c + k1 * s;
}
HD static inline void naive_dil(int tok, int hh, int S_, const float* QR, const float* KR, const u16* Y, u16* YM) {
    const int b = tok / S_, s = tok % S_;
    float o[64];
#pragma unroll
    for (int d = 0; d < 64; ++d) o[d] = 0.f;
    float mx = -INFINITY, den = 0.f;
    for (int g = 0; g < 3; ++g) {
        const int dil = g == 0 ? 1 : (g == 1 ? 4 : 16), head = g * 4 + hh;
        const int m = s / dil;
        for (int j = 0; j <= 128; ++j) {
            if (m - j < 0) break;
            const size_t kt = (size_t)b * S_ + (s - j * dil);
            float sc = 0.f;
#pragma unroll
            for (int d = 0; d < 64; ++d) sc += QR[(size_t)tok * 768 + head * 64 + d] * KR[kt * 768 + head * 64 + d];
            sc *= 0.125f;
            const float nm = fmaxf(mx, sc), corr = expf(mx - nm), p = expf(sc - nm);
            den = den * corr + p;
#pragma unroll
            for (int d = 0; d < 64; ++d) o[d] = o[d] * corr + p * bf2f(Y[kt * YP + Y_BV + head * 64 + d]);
            mx = nm;
        }
    }
#pragma unroll
    for (int d = 0; d < 64; ++d) YM[(size_t)tok * 2048 + YM_B + hh * 64 + d] = f2bf(o[d] / den);
}
HD static inline void naive_sgu_stats(int tok, const u16* Y, float* MU, float* RS) {
    float s = 0.f;
    for (int c = 0; c < 768; ++c) s += geluf_(bf2f(Y[(size_t)tok * YP + Y_CV + c]));
    const float mu = s * (1.f / 768.f); float q = 0.f;
    for (int c = 0; c < 768; ++c) { const float d = geluf_(bf2f(Y[(size_t)tok * YP + Y_CV + c])) - mu; q += d * d; }
    MU[tok] = mu; RS[tok] = 1.f / sqrtf(q * (1.f / 768.f) + 1e-5f);
}
HD static inline void naive_sgu_out(int tok, int c, int S_, const u16* Y, const float* MU, const float* RS, const float* ln_g, const float* ln_b,
                                    const float* ws, const float* bs, u16* YM) {
    const int s = tok % S_, i = s % 128, t0 = tok - i, g = c / 128;
    float acc = 0.f;
    for (int j = 0; j <= i; ++j) {
        const float zv = geluf_(bf2f(Y[(size_t)(t0 + j) * YP + Y_CV + c]));
        const float vn = (zv - MU[t0 + j]) * RS[t0 + j] * ln_g[c] + ln_b[c];
        acc += ws[(g * 128 + i) * 128 + j] * vn;
    }
    const float zu = geluf_(bf2f(Y[(size_t)tok * YP + Y_CU + c]));
    YM[(size_t)tok * 2048 + YM_C + c] = f2bf(zu * (acc + bs[g * 128 + i]));
}
HD static inline void naive_ml_conv(int tok, int c, int S_, const u16* Y, const float* conv_w, const float* conv_b, float* QKC) {
    const int s = tok % S_; const int col = c < 512 ? Y_DQ + c : Y_DK + (c - 512);
    float a = conv_b[c];
    for (int j = 0; j < 4; ++j) { const int sp = s - 3 + j; if (sp >= 0) a += conv_w[j * 1024 + c] * bf2f(Y[(size_t)(tok - 3 + j) * YP + col]); }
    a = siluf_(a);
    QKC[(size_t)tok * 1024 + c] = c < 512 ? a : a * 0.08838834764831845f;
}
HD static inline void naive_ml_den(int b, int h, int S_, const float* YSM, const float* QKC, const float* b_i, const float* b_f, float* DEN) {
    float n[128];
#pragma unroll
    for (int d = 0; d < 128; ++d) n[d] = 0.f;
    for (int t = 0; t < S_; ++t) {
        const size_t tok = (size_t)b * S_ + t;
        const float f = sigmoidf_(YSM[tok * 32 + 20 + h] + b_f[h]), ig = expf(YSM[tok * 32 + 16 + h] + b_i[h]);
        float den = 0.f;
#pragma unroll
        for (int d = 0; d < 128; ++d) { n[d] = f * n[d] + ig * QKC[tok * 1024 + 512 + h * 128 + d]; den += QKC[tok * 1024 + h * 128 + d] * n[d]; }
        DEN[tok * 4 + h] = den;
    }
}
HD static inline void naive_ml_rec(int b, int h, int e, int S_, const u16* Y, const float* YSM, const float* QKC, const float* b_i, const float* b_f, const float* DEN, float* HM) {
    float C[128];
#pragma unroll
    for (int d = 0; d < 128; ++d) C[d] = 0.f;
    for (int t = 0; t < S_; ++t) {
        const size_t tok = (size_t)b * S_ + t;
        const float f = sigmoidf_(YSM[tok * 32 + 20 + h] + b_f[h]), ig = expf(YSM[tok * 32 + 16 + h] + b_i[h]);
        const float v = bf2f(Y[tok * YP + Y_DV + h * 128 + e]);
        float num = 0.f;
#pragma unroll
        for (int d = 0; d < 128; ++d) { C[d] = f * C[d] + ig * QKC[tok * 1024 + 512 + h * 128 + d] * v; num += QKC[tok * 1024 + h * 128 + d] * C[d]; }
        const float den = DEN[tok * 4 + h];
        const float hh = num / fmaxf(fabsf(den), 1.0f);
        HM[tok * 512 + h * 128 + e] = sigmoidf_(bf2f(Y[tok * YP + Y_DO + h * 128 + e])) * hh;
    }
}
HD static inline void naive_ml_post(int tok, int h, const float* HM, const float* norm_g, u16* YM) {
    float ss = 0.f;
    for (int e = 0; e < 128; ++e) { const float o = HM[(size_t)tok * 512 + h * 128 + e]; ss += o * o; }
    const float rs = 1.f / sqrtf(ss * (1.f / 128.f) + 1e-5f);
    for (int e = 0; e < 128; ++e) YM[(size_t)tok * 2048 + YM_D + h * 128 + e] = f2bf(HM[(size_t)tok * 512 + h * 128 + e] * rs * norm_g[h * 128 + e]);
}
HD static inline void route_token(const float* sc, const float* bias, int* idx, float* w) {
    unsigned gmask = 0u;
    float gs[8];
#pragma unroll
    for (int g = 0; g < 8; ++g) {
        float m1 = -INFINITY, m2 = -INFINITY;
        for (int j = 0; j < 8; ++j) { const float c = sc[g * 8 + j] + bias[g * 8 + j]; if (c > m1) { m2 = m1; m1 = c; } else if (c > m2) m2 = c; }
        gs[g] = m1 + m2;
    }
#pragma unroll
    for (int g = 0; g < 8; ++g) {
        int rank = 0;
#pragma unroll
        for (int g2 = 0; g2 < 8; ++g2) rank += (gs[g2] > gs[g] || (gs[g2] == gs[g] && g2 < g)) ? 1 : 0;
        if (rank < 4) gmask |= 1u << g;
    }
    int n = 0; float wsum = 0.f;
    for (int e = 0; e < 64; ++e) {
        if (!((gmask >> (e >> 3)) & 1u)) continue;
        const float c = sc[e] + bias[e]; int rank = 0;
        for (int e2 = 0; e2 < 64; ++e2) { if (!((gmask >> (e2 >> 3)) & 1u)) continue; const float c2 = sc[e2] + bias[e2]; rank += (c2 > c || (c2 == c && e2 < e)) ? 1 : 0; }
        if (rank < 8) { if (n < 8) { idx[n] = e; w[n] = sc[e]; wsum += sc[e]; } ++n; }
    }
    const float r = 2.5f / wsum;
    for (int k = 0; k < 8; ++k) w[k] *= r;
}

HD static inline bool route_lane_select(int lane, const float* sc, const float* bias) {
    float gs[8];
#pragma unroll
    for (int g = 0; g < 8; ++g) { float m1 = -INFINITY, m2 = -INFINITY;
#pragma unroll
        for (int j = 0; j < 8; ++j) { const float c = sc[g * 8 + j] + bias[g * 8 + j]; if (c > m1) { m2 = m1; m1 = c; } else if (c > m2) m2 = c; }
        gs[g] = m1 + m2; }
    unsigned gmask = 0u;
#pragma unroll
    for (int g = 0; g < 8; ++g) { int r = 0;
#pragma unroll
        for (int g2 = 0; g2 < 8; ++g2) r += (gs[g2] > gs[g] || (gs[g2] == gs[g] && g2 < g)) ? 1 : 0;
        if (r < 4) gmask |= 1u << g; }
    if (!((gmask >> (lane >> 3)) & 1u)) return false;
    const float myc = sc[lane] + bias[lane]; int rank = 0;
    for (int e = 0; e < 64; ++e) { const float c = sc[e] + bias[e]; rank += (((gmask >> (e >> 3)) & 1u) && (c > myc || (c == myc && e < lane))) ? 1 : 0; }
    return rank < 8;
}
namespace pg8 {
#define PG8_LAS __attribute__((address_space(3)))
typedef unsigned short bf16_t;
typedef short bf16x8 __attribute__((ext_vector_type(8)));
typedef float f32x4 __attribute__((ext_vector_type(4)));
typedef unsigned u32x4 __attribute__((ext_vector_type(4)));
typedef unsigned u32x2 __attribute__((ext_vector_type(2)));
typedef int i32x4 __attribute__((ext_vector_type(4)));
typedef int i32x8 __attribute__((ext_vector_type(8)));
constexpr int BM = 256, BK = 64, HALF = 128, HTB = HALF * BK * 2  , STAGE_BYTES = 8 * HTB, NXCD = 8, WGM = 8;

__host__ __device__ __forceinline__ int lds_byte(int r, int c) { const int st = (r >> 4) * 2 + (c >> 5), rr = r & 15, cc = c & 31, ob = rr * 64 + cc * 2; return st * 1024 + (ob ^ (((ob >> 9) & 1) << 5)); }
__host__ __device__ __forceinline__ void stage_rc(int b, int& R, int& C) { const int st = b / 1024, sb = b % 1024, swz = sb ^ (((sb >> 9) & 1) << 5); R = (st >> 1) * 16 + swz / 64; C = (st & 1) * 32 + (swz % 64) / 2; }
__host__ __device__ __forceinline__ int perm32(int rho) { const int n = rho >> 4, i = rho & 15; return 8 * (i >> 2) + 4 * n + (i & 3); }

struct Unit { int pm, pn; };
struct Gemm { const bf16_t* A; const bf16_t* Bt; int M, N, K, lda, ldb; const int* rowmap; };

struct StaticOrder {
    int nM, nN, nwg, G, c, wgm;
    __host__ __device__ void init(int M, int N, int G_, int c_, int wgm_ = WGM) { nM = M / BM; nN = N / BM; nwg = nM * nN; G = G_; c = c_; wgm = wgm_; }
    __host__ __device__ bool next(int i, Unit& u) const {
        const long L = (long)i * G + c; if (L >= nwg) return false;
        int wgid = (int)L; { const int q = nwg / NXCD, r = nwg % NXCD, xcd = wgid % NXCD, off = wgid / NXCD; wgid = (xcd < r ? xcd * (q + 1) : r * (q + 1) + (xcd - r) * q) + off; }
        const int nig = wgm * nN, gid = wgid / nig, fm = gid * wgm, gsz = (nM - fm) < wgm ? (nM - fm) : wgm;
        u.pm = fm + ((wgid % nig) % gsz); u.pn = (wgid % nig) / gsz; return true;
    }
    __device__ __forceinline__ void a_ready(const Unit&) const {}
    __device__ __forceinline__ void done(const Unit&) const {}
};

__device__ __forceinline__ unsigned cvt_pk_bf16(float lo, float hi) { unsigned r; asm volatile("v_cvt_pk_bf16_f32 %0, %1, %2" : "=v"(r) : "v"(lo), "v"(hi)); return r; }

template <class Epi, class Sched, bool ALIGN_EPI = true, bool GATHER = false, int NBJ = 2, int DT = 0>
__device__ __forceinline__ void gemm_phase(PG8_LAS unsigned char* lds, const Gemm g, const Sched& S, const Epi& E, const int tid) {
    const int wid = __builtin_amdgcn_readfirstlane(tid >> 6), lane = tid & 63, wr = wid >> 2, wc = wid & 3, fr = lane & 15, fq = lane >> 4;
    const int K = g.K, nt = K / BK;
    unsigned voffB[2]; int rA[2]; unsigned cA2[2];
#pragma unroll
    for (int i = 0; i < 2; ++i) { int R, C; stage_rc(tid * 16 + i * 8192, R, C); const int Rb = Epi::PERM ? ((R & ~31) + perm32(R & 31)) : R;
        rA[i] = R; cA2[i] = (unsigned)C * 2u; voffB[i] = (unsigned)(Rb * g.ldb + C) * 2u; }
    const size_t kstep = (size_t)(BK * 2);
    const size_t hstepA = (size_t)HALF * g.lda * 2, hstepB = (size_t)HALF * g.ldb * 2;
    const size_t tstepA = GATHER ? 0 : 2 * hstepA, tstepB = NBJ * hstepB;
    unsigned cvo[4], nvo[4];
#define PG8_AOFF(dst, unit) do { _Pragma("unroll") for (int h_ = 0; h_ < 2; ++h_) _Pragma("unroll") for (int i_ = 0; i_ < 2; ++i_) { \
        if constexpr (GATHER) dst[2 * h_ + i_] = (unsigned)g.rowmap[(size_t)(unit).pm * BM + h_ * HALF + rA[i_]] * (unsigned)(g.lda * 2) + cA2[i_]; \
        else dst[2 * h_ + i_] = (unsigned)((h_ * HALF + rA[i_]) * g.lda) * 2u + cA2[i_]; } } while (0)
    const unsigned ldsw = (unsigned)wid * 1024u;
    const int aoff = lds_byte(wr * 64 + fr, fq * 8), boff = lds_byte(wc * 32 + fr, fq * 8);
#define PG8_SA(b, h) (((b) * 2 + (h)) * HTB)
#define PG8_SB(b, h) ((4 + (b) * 2 + (h)) * HTB)
#define PG8_STAGE2(bufoff, gbase, v0, v1) do { \
        __builtin_amdgcn_global_load_lds((const unsigned*)((const char*)(gbase) + (v0)), (PG8_LAS unsigned*)(lds + (bufoff) + ldsw), 16, 0, 0); \
        __builtin_amdgcn_global_load_lds((const unsigned*)((const char*)(gbase) + (v1)), (PG8_LAS unsigned*)(lds + (bufoff) + ldsw + 8192), 16, 0, 0); } while (0)
#define PG8_STAGE(bufoff, gbase, voff) PG8_STAGE2(bufoff, gbase, (voff)[0], (voff)[1])
#define PG8_LDA(dst, b, h) do { _Pragma("unroll") for (int m = 0; m < 4; ++m) _Pragma("unroll") for (int k = 0; k < 2; ++k) dst[m][k] = *(const PG8_LAS bf16x8*)(lds + PG8_SA(b, h) + aoff + m * 2048 + k * 1024); } while (0)
#define PG8_LDB(dst, b, h) do { _Pragma("unroll") for (int n = 0; n < 2; ++n) _Pragma("unroll") for (int k = 0; k < 2; ++k) dst[n][k] = *(const PG8_LAS bf16x8*)(lds + PG8_SB(b, h) + boff + n * 2048 + k * 1024); } while (0)
#define PG8_MMA(ai, bj, At, Bt) do { __builtin_amdgcn_s_setprio(1); _Pragma("unroll") for (int m = 0; m < 4; ++m) _Pragma("unroll") for (int n = 0; n < 2; ++n) { \
        if constexpr (DT == 0) { _Pragma("unroll") for (int k = 0; k < 2; ++k) acc[ai][bj][m][n] = __builtin_amdgcn_mfma_f32_16x16x32_bf16(Bt[n][k], At[m][k], acc[ai][bj][m][n], 0, 0, 0); } \
        else { const i32x4 b0_ = __builtin_bit_cast(i32x4, Bt[n][0]), b1_ = __builtin_bit_cast(i32x4, Bt[n][1]), a0_ = __builtin_bit_cast(i32x4, At[m][0]), a1_ = __builtin_bit_cast(i32x4, At[m][1]); \
            const i32x8 bw_ = __builtin_shufflevector(b0_, b1_, 0, 1, 2, 3, 4, 5, 6, 7), aw_ = __builtin_shufflevector(a0_, a1_, 0, 1, 2, 3, 4, 5, 6, 7); \
              \
            asm volatile("v_mfma_scale_f32_16x16x128_f8f6f4 %0, %1, %2, %0, %3, %4 op_sel_hi:[0,0,0]" : "+v"(acc[ai][bj][m][n]) : "v"(bw_), "v"(aw_), "v"(0x7a7a7a7a), "v"(0x7f7f7f7f)); } } \
        __builtin_amdgcn_s_setprio(0); } while (0)
#define PG8_WAIT_V(n) asm volatile("s_waitcnt vmcnt(" #n ")" ::: "memory")
#define PG8_WAIT_LOOP do { if constexpr (NBJ == 2) PG8_WAIT_V(8); else PG8_WAIT_V(6); } while (0)
#define PG8_WAIT_L(n) asm volatile("s_waitcnt lgkmcnt(" #n ")" ::: "memory")
#define PG8_BAR __builtin_amdgcn_s_barrier()
#define PG8_SCHED __builtin_amdgcn_sched_barrier(0)
    Unit cur, nxt; int ui = 0;
    if (!S.next(0, cur)) return;
    f32x4 acc[2][NBJ][4][2];
#pragma unroll
    for (int a = 0; a < 2; ++a)
#pragma unroll
        for (int b = 0; b < NBJ; ++b)
#pragma unroll
            for (int m = 0; m < 4; ++m)
#pragma unroll
                for (int n = 0; n < 2; ++n) acc[a][b][m][n] = (f32x4){0.f, 0.f, 0.f, 0.f};
    bf16x8 At[4][2], B0[2][2], B1[2][2];
    const char* cA = (const char*)g.A + (size_t)cur.pm * tstepA; const char* cB = (const char*)g.Bt + (size_t)cur.pn * tstepB;
    S.a_ready(cur);
    PG8_AOFF(cvo, cur);
    PG8_STAGE(PG8_SB(0, 0), cB, voffB); if constexpr (NBJ == 2) PG8_STAGE(PG8_SB(0, 1), cB + hstepB, voffB); PG8_STAGE2(PG8_SA(0, 0), cA, cvo[0], cvo[1]); PG8_STAGE2(PG8_SA(0, 1), cA, cvo[2], cvo[3]);
    if (wr == 1) PG8_BAR;
    PG8_WAIT_V(2); PG8_BAR;
    PG8_STAGE(PG8_SB(1, 0), cB + kstep, voffB); PG8_STAGE2(PG8_SA(1, 0), cA + kstep, cvo[0], cvo[1]); if constexpr (NBJ == 2) PG8_STAGE(PG8_SB(1, 1), cB + hstepB + kstep, voffB);
    if constexpr (NBJ == 2) PG8_WAIT_V(6); else PG8_WAIT_V(4);
    PG8_BAR;
    for (;;) {
        const bool has_next = S.next(ui + 1, nxt);
        const char* nA = has_next ? (const char*)g.A + (size_t)nxt.pm * tstepA : cA; const char* nB = has_next ? (const char*)g.Bt + (size_t)nxt.pn * tstepB : cB;
        if (has_next) { PG8_AOFF(nvo, nxt); } else {
#pragma unroll
            for (int j_ = 0; j_ < 4; ++j_) nvo[j_] = cvo[j_]; }
        for (int t = 0; t < nt; t += 2) {
            const bool last = (t == nt - 2);
            const char* a1 = cA + (size_t)(t + 1) * kstep;
            const char* a2 = last ? nA : cA + (size_t)(t + 2) * kstep; const char* b2 = last ? nB : cB + (size_t)(t + 2) * kstep;
            const char* a3 = a2 + kstep; const char* b3 = b2 + kstep;
            if (last && has_next) S.a_ready(nxt);
            unsigned so[4];
#pragma unroll
            for (int j_ = 0; j_ < 4; ++j_) so[j_] = last ? nvo[j_] : cvo[j_];
            PG8_LDB(B0, 0, 0); if constexpr (NBJ == 2) PG8_LDB(B1, 0, 1); PG8_SCHED; PG8_LDA(At, 0, 0); PG8_STAGE2(PG8_SA(1, 1), a1, cvo[2], cvo[3]);
            PG8_WAIT_LOOP; PG8_WAIT_L(0); PG8_BAR; PG8_MMA(0, 0, At, B0); if constexpr (NBJ == 2) PG8_MMA(0, NBJ - 1, At, B1); PG8_BAR; PG8_SCHED;
            PG8_LDA(At, 0, 1); PG8_STAGE(PG8_SB(0, 0), b2, voffB); if constexpr (NBJ == 2) PG8_STAGE(PG8_SB(0, 1), b2 + hstepB, voffB); PG8_STAGE2(PG8_SA(0, 0), a2, so[0], so[1]);
            PG8_WAIT_LOOP; PG8_WAIT_L(0); PG8_BAR; PG8_MMA(1, 0, At, B0); if constexpr (NBJ == 2) PG8_MMA(1, NBJ - 1, At, B1); PG8_BAR; PG8_SCHED;
            PG8_LDB(B0, 1, 0); if constexpr (NBJ == 2) PG8_LDB(B1, 1, 1); PG8_SCHED; PG8_LDA(At, 1, 0); PG8_STAGE2(PG8_SA(0, 1), a2, so[2], so[3]);
            PG8_WAIT_LOOP; PG8_WAIT_L(0); PG8_BAR; PG8_MMA(0, 0, At, B0); if constexpr (NBJ == 2) PG8_MMA(0, NBJ - 1, At, B1); PG8_BAR; PG8_SCHED;
            PG8_LDA(At, 1, 1); PG8_STAGE(PG8_SB(1, 0), b3, voffB); if constexpr (NBJ == 2) PG8_STAGE(PG8_SB(1, 1), b3 + hstepB, voffB); PG8_STAGE2(PG8_SA(1, 0), a3, so[0], so[1]);
            PG8_WAIT_LOOP; PG8_WAIT_L(0); PG8_BAR; PG8_MMA(1, 0, At, B0); if constexpr (NBJ == 2) PG8_MMA(1, NBJ - 1, At, B1); PG8_BAR; PG8_SCHED;
            if constexpr (Epi::HAS_FOLD) { if (!last && E.boundary(t + 2)) { E.fold(acc, cur, wr, wc, fr, fq, t + 2);
#pragma unroll
                for (int a = 0; a < 2; ++a)
#pragma unroll
                    for (int b = 0; b < NBJ; ++b)
#pragma unroll
                        for (int m = 0; m < 4; ++m)
#pragma unroll
                            for (int n = 0; n < 2; ++n) acc[a][b][m][n] = (f32x4){0.f, 0.f, 0.f, 0.f}; } }
        }
        if constexpr (ALIGN_EPI) { if (wr == 0) PG8_BAR; }
        if constexpr (DT == 1) asm volatile("s_nop 15\n\ts_nop 15\n\ts_nop 15\n\ts_nop 15\n\ts_nop 15\n\ts_nop 15" ::: "memory");
        E(acc, cur, wr, wc, fr, fq); S.done(cur);
        if (!has_next) break;
#pragma unroll
        for (int a = 0; a < 2; ++a)
#pragma unroll
            for (int b = 0; b < NBJ; ++b)
#pragma unroll
                for (int m = 0; m < 4; ++m)
#pragma unroll
                    for (int n = 0; n < 2; ++n) acc[a][b][m][n] = (f32x4){0.f, 0.f, 0.f, 0.f};
        cur = nxt; cA = nA; cB = nB; ++ui;
#pragma unroll
        for (int j_ = 0; j_ < 4; ++j_) cvo[j_] = nvo[j_];
        if constexpr (ALIGN_EPI) { if (wr == 1) PG8_BAR; }
    }
    PG8_WAIT_V(0);
    if constexpr (!ALIGN_EPI) { if (wr == 0) PG8_BAR; }
    PG8_BAR;
#undef PG8_SA
#undef PG8_SB
#undef PG8_STAGE
#undef PG8_STAGE2
#undef PG8_AOFF
#undef PG8_LDA
#undef PG8_LDB
#undef PG8_MMA
#undef PG8_WAIT_V
#undef PG8_WAIT_LOOP
#undef PG8_WAIT_L
#undef PG8_BAR
#undef PG8_SCHED
}

#ifndef N1_DBG
#define N1_DBG 0
#endif
template <class Epi, class Sched>
__device__ __forceinline__ void gemm_phase_n1s3(PG8_LAS unsigned char* lds, const Gemm g, const Sched& S, const Epi& E, const int tid) {
    const int wid = __builtin_amdgcn_readfirstlane(tid >> 6), lane = tid & 63, wr = wid >> 2, wc = wid & 3, fr = lane & 15, fq = lane >> 4;
    const int nt = g.K / BK;
    constexpr unsigned STG = 49152u;
    unsigned voffB[2], voA[4];
#pragma unroll
    for (int i = 0; i < 2; ++i) { int R, C; stage_rc(tid * 16 + i * 8192, R, C);
        voffB[i] = (unsigned)(R * g.ldb + C) * 2u; voA[i] = (unsigned)(R * g.lda + C) * 2u; voA[2 + i] = (unsigned)((HALF + R) * g.lda + C) * 2u; }
    const size_t kstep = (size_t)(BK * 2), tstepA = (size_t)BM * g.lda * 2, tstepB = (size_t)HALF * g.ldb * 2;
    const unsigned ldsw = (unsigned)wid * 1024u;
    const int aoff = lds_byte(wr * 64 + fr, fq * 8), boff = lds_byte(wc * 32 + fr, fq * 8);
#define N1_STAGE(dst, gp, v0, v1) do { \
        __builtin_amdgcn_global_load_lds((const unsigned*)((const char*)(gp) + (v0)), (PG8_LAS unsigned*)(lds + (dst) + ldsw), 16, 0, 0); \
        __builtin_amdgcn_global_load_lds((const unsigned*)((const char*)(gp) + (v1)), (PG8_LAS unsigned*)(lds + (dst) + ldsw + 8192), 16, 0, 0); } while (0)
#define N1_STAGE_TILE(wb, pa, pb) do { N1_STAGE((wb) + 32768u, pb, voffB[0], voffB[1]); N1_STAGE((wb), pa, voA[0], voA[1]); N1_STAGE((wb) + 16384u, pa, voA[2], voA[3]); } while (0)
#define N1_WAIT_V(n) asm volatile("s_waitcnt vmcnt(" #n ")" ::: "memory")
#define N1_WAIT_L0 asm volatile("s_waitcnt lgkmcnt(0)" ::: "memory")
#define N1_BAR __builtin_amdgcn_s_barrier()
    Unit cur, nxt; int ui = 0;
    if (!S.next(0, cur)) return;
    f32x4 acc[2][1][4][2];
#pragma unroll
    for (int a = 0; a < 2; ++a)
#pragma unroll
        for (int m = 0; m < 4; ++m)
#pragma unroll
            for (int n = 0; n < 2; ++n) acc[a][0][m][n] = (f32x4){0.f, 0.f, 0.f, 0.f};
    bf16x8 A0[4][2], A1[4][2], B0[2][2];
    const char* cA = (const char*)g.A + (size_t)cur.pm * tstepA; const char* cB = (const char*)g.Bt + (size_t)cur.pn * tstepB;
    unsigned gt = 0;
    N1_STAGE_TILE(0u, cA, cB); N1_STAGE_TILE(STG, cA + kstep, cB + kstep);
    if (wr == 1) N1_BAR;
    N1_WAIT_V(6); N1_BAR;
    N1_BAR;
    for (;;) {
        const bool has_next = S.next(ui + 1, nxt);
        const char* nA = has_next ? (const char*)g.A + (size_t)nxt.pm * tstepA : cA; const char* nB = has_next ? (const char*)g.Bt + (size_t)nxt.pn * tstepB : cB;
        for (int t = 0; t < nt; ++t, ++gt) {
            const unsigned s0 = gt % 3u, rb = s0 * STG, wb = (s0 == 0u ? 2u : s0 - 1u) * STG;
            const int t2 = t + 2; const bool over = t2 >= nt;
            const char* pa = over ? nA + (size_t)(t2 - nt) * kstep : cA + (size_t)t2 * kstep; const char* pb = over ? nB + (size_t)(t2 - nt) * kstep : cB + (size_t)t2 * kstep;
#pragma unroll
            for (int n = 0; n < 2; ++n)
#pragma unroll
                for (int k = 0; k < 2; ++k) B0[n][k] = *(const PG8_LAS bf16x8*)(lds + rb + 32768u + boff + n * 2048 + k * 1024);
            __builtin_amdgcn_sched_barrier(0);
#pragma unroll
            for (int m = 0; m < 4; ++m)
#pragma unroll
                for (int k = 0; k < 2; ++k) { A0[m][k] = *(const PG8_LAS bf16x8*)(lds + rb + aoff + m * 2048 + k * 1024); A1[m][k] = *(const PG8_LAS bf16x8*)(lds + rb + 16384u + aoff + m * 2048 + k * 1024); }
            N1_STAGE_TILE(wb, pa, pb);
            N1_WAIT_V(6); N1_WAIT_L0; N1_BAR;
            __builtin_amdgcn_s_setprio(1);
#pragma unroll
            for (int m = 0; m < 4; ++m)
#pragma unroll
                for (int n = 0; n < 2; ++n)
#pragma unroll
                    for (int k = 0; k < 2; ++k) { acc[0][0][m][n] = __builtin_amdgcn_mfma_f32_16x16x32_bf16(B0[n][k], A0[m][k], acc[0][0][m][n], 0, 0, 0);
                        acc[1][0][m][n] = __builtin_amdgcn_mfma_f32_16x16x32_bf16(B0[n][k], A1[m][k], acc[1][0][m][n], 0, 0, 0); }
            __builtin_amdgcn_s_setprio(0);
            N1_BAR; __builtin_amdgcn_sched_barrier(0);
            if (t + 1 < nt && E.boundary(t + 1)) { E.fold(acc, cur, wr, wc, fr, fq, t + 1);
#pragma unroll
                for (int a = 0; a < 2; ++a)
#pragma unroll
                    for (int m = 0; m < 4; ++m)
#pragma unroll
                        for (int n = 0; n < 2; ++n) acc[a][0][m][n] = (f32x4){0.f, 0.f, 0.f, 0.f}; }
        }
        if (wr == 0) N1_BAR;
        E(acc, cur, wr, wc, fr, fq);
        if (!has_next) break;
#pragma unroll
        for (int a = 0; a < 2; ++a)
#pragma unroll
            for (int m = 0; m < 4; ++m)
#pragma unroll
                for (int n = 0; n < 2; ++n) acc[a][0][m][n] = (f32x4){0.f, 0.f, 0.f, 0.f};
        cur = nxt; cA = nA; cB = nB; ++ui;
        if (wr == 1) N1_BAR;
    }
    N1_WAIT_V(0);
    N1_BAR;
#undef N1_STAGE
#undef N1_STAGE_TILE
#undef N1_WAIT_V
#undef N1_WAIT_L0
#undef N1_BAR
}
}
#ifndef MERGE3
#define MERGE3 0
#endif
constexpr int T_ = 8192, D_ = 2048, SEQ_ = 2048, NB_ = 4, NL_ = 2, NCOL = 15640;
constexpr float DN_ALPHA = 1.41421356237309515f;
constexpr float LN_EPS_ = 1e-5f;
constexpr int MAXROWS = 90112;
constexpr size_t MiB = 1u << 20;
constexpr size_t WS_CTL = 0, CTL_ZERO_BYTES = 1048576;
constexpr size_t WS_XB = 1 * MiB, WS_HB = 33 * MiB, WS_X1 = 97 * MiB, WS_XA = 161 * MiB, WS_YM = 225 * MiB, WS_MRG = 257 * MiB, WS_MB = 321 * MiB;
constexpr size_t WS_YSM = 353 * MiB, WS_CS = 354 * MiB, WS_SEL = 356 * MiB, WS_ROWW = 357 * MiB, WS_ROWMAP = 357 * MiB + 512 * 1024;
constexpr size_t WS_WIN = 358 * MiB, WS_WP = 420 * MiB, WS_WOUT = 428 * MiB, WS_W13 = 436 * MiB, WS_W2 = 696 * MiB, WS_H = 826 * MiB, WS_XS = 914 * MiB, WS_YBUF = 1266 * MiB;
constexpr size_t WS_XS8 = WS_XS + 64 * MiB, WS_XB8 = WS_XS + 80 * MiB, WS_WIN8 = WS_XS + 96 * MiB;
constexpr size_t WS_Y = WS_YBUF;
constexpr size_t WS_GLOC = 1618 * MiB, WS_GDEC = 1634 * MiB, WS_GST = 1635 * MiB, WS_MLOC = 1643 * MiB, WS_MNLOC = 1675 * MiB, WS_MSC = 1676 * MiB, WS_MC = 1677 * MiB, WS_MN = 1693 * MiB, WS_MM = 1694 * MiB;
constexpr size_t WS_DILO = 1695 * MiB, WS_DILL = 1719 * MiB;
constexpr size_t WS_NV = 1720 * MiB;
constexpr size_t WS_W13B = 1842 * MiB, WS_W2B = 1972 * MiB;
constexpr size_t WS_END = 2037 * MiB;
constexpr int CW_CNT = 8192, CW_TST = 8448, CW_CQ = 12400, CW_ARR = 12416, CW_BAR = 16384;
constexpr int RING_BYTES = 131072, AUX_OFF = 131072, LDS_BYTES = 147456 + 16384 * MERGE3;
constexpr int AUX_BARW = LDS_BYTES - 16;

#define GAS __attribute__((address_space(1)))
#define LAS __attribute__((address_space(3)))
typedef unsigned short bf16;
typedef unsigned v4u __attribute__((ext_vector_type(4)));
typedef unsigned v2u __attribute__((ext_vector_type(2)));
typedef float f32x4 __attribute__((ext_vector_type(4)));
typedef float f32x2 __attribute__((ext_vector_type(2)));
typedef short bf16x8 __attribute__((ext_vector_type(8)));
#define LDS_WAIT() asm volatile("s_waitcnt lgkmcnt(0)" ::: "memory")
#define VM_WAIT() asm volatile("s_waitcnt vmcnt(0)" ::: "memory")
__device__ __forceinline__ unsigned pk2(float lo, float hi) { return pg8::cvt_pk_bf16(lo, hi); }
__device__ __forceinline__ float bflo(unsigned u) { return __builtin_bit_cast(float, u << 16); }
__device__ __forceinline__ float bfhi(unsigned u) { return __builtin_bit_cast(float, u & 0xffff0000u); }
__device__ __forceinline__ float fsigmoid(float x) { return 1.f / (1.f + __expf(-x)); }
__device__ __forceinline__ float wave_sum(float v) {
#pragma unroll
    for (int o = 1; o < 64; o <<= 1) v += __shfl_xor(v, o);
    return v;
}
__device__ __forceinline__ float wave_max(float v) {
#pragma unroll
    for (int o = 1; o < 64; o <<= 1) v = fmaxf(v, __shfl_xor(v, o));
    return v;
}

#define XB_TMO      128
#define XB_XCNT(j)  (256  + 64 * (j))
#define XB_XSUB(j)  (1280 + 64 * (j))
#define XB_XGEN(j)  (2304 + 64 * (j))
#define XB_TOP      3328
#define XB_TOPGEN   3392
#define XCD_BAR_WORDS 3456
#define XB_SPIN_CAP (1u << 22)
__device__ __forceinline__ unsigned xb_ld(unsigned* p)              { return __hip_atomic_load(p, __ATOMIC_RELAXED, __HIP_MEMORY_SCOPE_AGENT); }
__device__ __forceinline__ unsigned xb_add(unsigned* p, unsigned v) { return __hip_atomic_fetch_add(p, v, __ATOMIC_RELAXED, __HIP_MEMORY_SCOPE_AGENT); }
__device__ __forceinline__ unsigned xb_xcc_id() { return (unsigned)__builtin_amdgcn_s_getreg((3 << 11) | 20) & 0xFu; }
#define XB_SPIN(cond, bar) do { unsigned _sp = 0; while (cond) { __builtin_amdgcn_s_sleep(1); \
    if ((++_sp & 255u) == 0u) { if (xb_ld(&(bar)[XB_TMO])) break; if (_sp > XB_SPIN_CAP) { atomicAdd(&(bar)[XB_TMO], 1u); break; } } } } while (0)
struct XcdBarrier { unsigned* bar; unsigned x; volatile LAS unsigned* st; };
__device__ __forceinline__ XcdBarrier xcd_barrier_post(unsigned* bar, volatile LAS unsigned* st) {
    XcdBarrier b; b.bar = bar; b.x = xb_xcc_id(); b.st = st;
    if (threadIdx.x == 0) (void)xb_add(&bar[XB_XCNT(b.x)], 1u);
    return b;
}
__device__ __forceinline__ void xcd_barrier_complete(unsigned* bar, unsigned x, unsigned& nloc, unsigned& nx) {
    const unsigned G = gridDim.x * gridDim.y * gridDim.z;
    unsigned sum, cnt, mine, sp = 0u;
    for (;;) {
        sum = 0u; cnt = 0u; mine = 0u;
#pragma unroll
        for (unsigned j = 0; j < 16; ++j) { const unsigned c = xb_ld(&bar[XB_XCNT(j)]); sum += c; cnt += (c > 0u) ? 1u : 0u; mine = (j == x) ? c : mine; }
        if (sum == G) break;
        __builtin_amdgcn_s_sleep(1);
        if ((++sp & 255u) == 0u) { if (xb_ld(&bar[XB_TMO])) break; if (sp > XB_SPIN_CAP) { atomicAdd(&bar[XB_TMO], 1u); break; } }
    }
    nloc = mine > 0u ? mine : 1u; nx = cnt > 0u ? cnt : 1u;
}
__device__ __forceinline__ void xcd_barrier(const XcdBarrier& b) {
    asm volatile("s_waitcnt vmcnt(0)" ::: "memory");
    __syncthreads();
    if (threadIdx.x == 0) {
        unsigned* bar = b.bar;
        __builtin_amdgcn_s_waitcnt(0);
        unsigned nloc = b.st[0], nx = b.st[1];
        if (nloc == 0u) { xcd_barrier_complete(bar, b.x, nloc, nx); b.st[0] = nloc; b.st[1] = nx; }
        const unsigned old = xb_add(&bar[XB_XSUB(b.x)], 1u);
        const unsigned gen = old / nloc;
        if (old + 1u == (gen + 1u) * nloc) {
            __builtin_amdgcn_fence(__ATOMIC_RELEASE, "agent");
            asm volatile("s_waitcnt vmcnt(0)" ::: "memory");
            const unsigned og = xb_add(&bar[XB_TOP], 1u);
            const unsigned tg = og / nx;
            if (og + 1u == (tg + 1u) * nx) xb_add(&bar[XB_TOPGEN], 1u);
            else XB_SPIN(xb_ld(&bar[XB_TOPGEN]) == tg, bar);
            __builtin_amdgcn_fence(__ATOMIC_ACQUIRE, "agent");
            xb_add(&bar[XB_XGEN(b.x)], 1u);
            asm volatile("s_waitcnt vmcnt(0)" ::: "memory");
        } else {
            XB_SPIN(xb_ld(&bar[XB_XGEN(b.x)]) == gen, bar);
            __builtin_amdgcn_fence(__ATOMIC_ACQUIRE, "agent");
            asm volatile("s_waitcnt vmcnt(0)" ::: "memory");
        }
    }
    __syncthreads();
}
using pg8::Unit;
#ifndef STEAL_MARGIN
#define STEAL_MARGIN 8u
#endif
#ifndef FP8_GATES
#define FP8_GATES 3
#endif
#define GATES8(l) ((FP8_GATES >> (l)) & 1)
#ifndef FP8_MOE
#define FP8_MOE 3
#endif
#define MOE8(l) ((FP8_MOE >> (l)) & 1)
#define FP8_LAST MOE8(NL_ - 1)
__device__ __forceinline__ unsigned pk4_fp8(float a, float b, float c, float d) { int w = 0; w = __builtin_amdgcn_cvt_pk_fp8_f32(a, b, w, false); w = __builtin_amdgcn_cvt_pk_fp8_f32(c, d, w, true); return (unsigned)w; }
struct EpiY {
    static constexpr bool PERM = true, HAS_FOLD = false;
    bf16* Y; float* YSM; int pn0;
    __device__ __forceinline__ void operator()(const f32x4 (&acc)[2][2][4][2], const Unit& u, int wr, int wc, int fr, int fq) const {
        const int row0 = u.pm * 256 + wr * 64 + fr, pn = u.pn + pn0;
        if (pn == 29) {
            if (wc == 0) {
#pragma unroll
                for (int ai = 0; ai < 2; ++ai)
#pragma unroll
                    for (int m = 0; m < 4; ++m) { float* rp = YSM + (size_t)(row0 + ai * 128 + m * 16) * 32 + 8 * fq; *(f32x4*)rp = acc[ai][0][m][0]; *(f32x4*)(rp + 4) = acc[ai][0][m][1]; }
            }
            return;
        }
        const bool sg = pn >= 30;
#pragma unroll
        for (int ai = 0; ai < 2; ++ai)
#pragma unroll
            for (int m = 0; m < 4; ++m) { bf16* rp = Y + (size_t)(row0 + ai * 128 + m * 16) * YP + pn * 256 + wc * 32 + 8 * fq;
#pragma unroll
                for (int bj = 0; bj < 2; ++bj) { f32x4 v0 = acc[ai][bj][m][0], v1 = acc[ai][bj][m][1];
                    if (sg) {
#pragma unroll
                        for (int j = 0; j < 4; ++j) { v0[j] = fsigmoid(v0[j]); v1[j] = fsigmoid(v1[j]); } }
                    v4u w; w.x = pk2(v0[0], v0[1]); w.y = pk2(v0[2], v0[3]); w.z = pk2(v1[0], v1[1]); w.w = pk2(v1[2], v1[3]);
                    *(v4u*)(rp + bj * 128) = w; } }
    }
};
struct EpiMerge {
    static constexpr bool PERM = false, HAS_FOLD = true;
    const bf16* Y; bf16* MB; mutable f32x4 tot[2][4][2];
    __device__ __forceinline__ bool boundary(int kt) const { return kt == 8 || kt == 12 || kt == 24; }
    __device__ __forceinline__ void fold(const f32x4 (&acc)[2][1][4][2], const Unit& u, int wr, int wc, int fr, int fq, int kt) const {
        const int br = kt == 8 ? 0 : (kt == 12 ? 1 : (kt == 24 ? 2 : 3));
        int zv = 0; asm volatile("" : "+v"(zv));
        const int row0 = u.pm * 256 + wr * 64 + fr + zv, col0 = u.pn * 128 + wc * 32 + 4 * fq;
        v2u gp[2][4][2];
#pragma unroll
        for (int ai = 0; ai < 2; ++ai)
#pragma unroll
            for (int m = 0; m < 4; ++m)
#pragma unroll
                for (int n = 0; n < 2; ++n) gp[ai][m][n] = *(const v2u*)(Y + (size_t)(row0 + ai * 128 + m * 16) * YP + Y_G + br * 2048 + col0 + n * 16);
#pragma unroll
        for (int ai = 0; ai < 2; ++ai)
#pragma unroll
            for (int m = 0; m < 4; ++m)
#pragma unroll
                for (int n = 0; n < 2; ++n) { f32x4 v = acc[ai][0][m][n]; const v2u g2 = gp[ai][m][n]; v[0] *= bflo(g2.x); v[1] *= bfhi(g2.x); v[2] *= bflo(g2.y); v[3] *= bfhi(g2.y);
                    v = br > 0 ? v + tot[ai][m][n] : v;
                    if (br < 3) tot[ai][m][n] = v;
                    else { v2u o; o.x = pk2(v[0], v[1]); o.y = pk2(v[2], v[3]); *(v2u*)(MB + (size_t)(row0 + ai * 128 + m * 16) * 2048 + col0 + n * 16) = o; } }
    }
    __device__ __forceinline__ void operator()(const f32x4 (&acc)[2][1][4][2], const Unit& u, int wr, int wc, int fr, int fq) const { fold(acc, u, wr, wc, fr, fq, 32); }
};
struct EpiOut {
    static constexpr bool PERM = false, HAS_FOLD = false;
    const float* X; float* HB;
    __device__ __forceinline__ void operator()(const f32x4 (&acc)[2][2][4][2], const Unit& u, int wr, int wc, int fr, int fq) const {
        const int row0 = u.pm * 256 + wr * 64 + fr, col0 = u.pn * 256 + wc * 32 + 4 * fq;
#pragma unroll
        for (int ai = 0; ai < 2; ++ai)
#pragma unroll
            for (int m = 0; m < 4; ++m) { const size_t off = (size_t)(row0 + ai * 128 + m * 16) * 2048 + col0;
#pragma unroll
                for (int bj = 0; bj < 2; ++bj)
#pragma unroll
                    for (int n = 0; n < 2; ++n) { const f32x4 xv = *(const f32x4*)(X + off + bj * 128 + n * 16); *(f32x4*)(HB + off + bj * 128 + n * 16) = xv * DN_ALPHA + acc[ai][bj][m][n]; } }
    }
};
struct EpiMoe1 {
    static constexpr bool PERM = true, HAS_FOLD = false;
    bf16* H; const float* ROWW; int NJ;
    __device__ __forceinline__ void operator()(const f32x4 (&acc)[2][2][4][2], const Unit& u, int wr, int wc, int fr, int fq) const {
        const int row0 = u.pm * 256 + wr * 64 + fr, col0 = (u.pn & 3) * 128 + wc * 32 + 8 * fq;
#pragma unroll
        for (int ai = 0; ai < 2; ++ai)
#pragma unroll
            for (int m = 0; m < 4; ++m) { const size_t row = (size_t)(row0 + ai * 128 + m * 16); const float rw = ROWW[row];
                float h[8];
#pragma unroll
                for (int n = 0; n < 2; ++n)
#pragma unroll
                    for (int j = 0; j < 4; ++j) { const float a = acc[ai][0][m][n][j], b = acc[ai][1][m][n][j]; h[n * 4 + j] = a * fsigmoid(a) * b * rw; }
                v4u w; w.x = pk2(h[0], h[1]); w.y = pk2(h[2], h[3]); w.z = pk2(h[4], h[5]); w.w = pk2(h[6], h[7]);
                *(v4u*)(H + row * 512 + col0) = w; }
    }
};
struct EpiMoe2 {
    static constexpr bool PERM = true, HAS_FOLD = false;
    bf16* YB;
    __device__ __forceinline__ void operator()(const f32x4 (&acc)[2][2][4][2], const Unit& u, int wr, int wc, int fr, int fq) const {
        const int row0 = u.pm * 256 + wr * 64 + fr, col0 = (u.pn & 7) * 256 + wc * 32 + 8 * fq;
#pragma unroll
        for (int ai = 0; ai < 2; ++ai)
#pragma unroll
            for (int m = 0; m < 4; ++m) { bf16* rp = YB + (size_t)(row0 + ai * 128 + m * 16) * 2048 + col0;
#pragma unroll
                for (int bj = 0; bj < 2; ++bj) { const f32x4 v0 = acc[ai][bj][m][0], v1 = acc[ai][bj][m][1];
                    v4u w; w.x = pk2(v0[0], v0[1]); w.y = pk2(v0[2], v0[3]); w.z = pk2(v1[0], v1[1]); w.w = pk2(v1[2], v1[3]);
                    *(v4u*)(rp + bj * 128) = w; } }
    }
};
struct EpiMoe1F8 {
    static constexpr bool PERM = true, HAS_FOLD = false;
    unsigned char* H; const float* ROWW;
    __device__ __forceinline__ void operator()(const f32x4 (&acc)[2][2][4][2], const Unit& u, int wr, int wc, int fr, int fq) const {
        const int row0 = u.pm * 256 + wr * 64 + fr, col0 = (u.pn & 3) * 128 + wc * 32 + 8 * fq;
#pragma unroll
        for (int ai = 0; ai < 2; ++ai)
#pragma unroll
            for (int m = 0; m < 4; ++m) { const size_t row = (size_t)(row0 + ai * 128 + m * 16); const float rw = ROWW[row];
                float h[8];
#pragma unroll
                for (int n = 0; n < 2; ++n)
#pragma unroll
                    for (int j = 0; j < 4; ++j) { const float a = acc[ai][0][m][n][j], b = acc[ai][1][m][n][j]; h[n * 4 + j] = a * fsigmoid(a) * b * rw; }
                v2u w; w.x = pk4_fp8(h[0], h[1], h[2], h[3]); w.y = pk4_fp8(h[4], h[5], h[6], h[7]);
                *(v2u*)(H + row * 512 + col0) = w; }
    }
};
struct MoeOrder {
    int NJ, G, c, total, upm, upn;
    __device__ __forceinline__ void init(const int* tst, int NJ_, int G_, int c_, int lane) { NJ = NJ_; G = G_; c = c_; total = tst[65] * NJ_;
        const long L = (long)lane * G + c; upm = 0; upn = 0;
        if (L < total) { const int mt = (int)(L / NJ), j = (int)(L % NJ); int e = 0;
            for (int k = 1; k <= 64; ++k) e += (mt >= tst[k]) ? 1 : 0;
            upm = mt; upn = e * NJ + j; } }
    __device__ __forceinline__ bool next(int i, Unit& u) const {
        if ((long)i * G + c >= total || i >= 64) return false;
        const int iu = __builtin_amdgcn_readfirstlane(i);
        u.pm = __builtin_amdgcn_readlane(upm, iu); u.pn = __builtin_amdgcn_readlane(upn, iu); return true;
    }
    __device__ __forceinline__ void a_ready(const Unit&) const {}
    __device__ __forceinline__ void done(const Unit&) const {}
};

struct KArgs { const float* in[32]; float* out; unsigned char* ws; int ph_lo, ph_hi, region, pad; };
struct Ctx {
    LAS unsigned char* lds; unsigned char* ws; const float* in[32]; float* out;
    int tid, lane, wave, G, bid;
};
#define WSP(T, off) ((T*)(C.ws + (off)))

struct CvDesc { const float* sp; bf16* dp; int ldw, ldt, zero, w13, f8; };
__device__ __forceinline__ CvDesc cv_desc(const float* W, int ldw, int srccol, int k0, bf16* WT, size_t drow0, int ldt, int w13, int tid, int f8 = 0) {
    CvDesc d; d.zero = srccol < 0; d.ldw = ldw; d.ldt = ldt; d.w13 = w13; d.f8 = f8;
    d.sp = W + (size_t)(k0 + (tid >> 6)) * ldw + (srccol < 0 ? 0 : srccol);
    d.dp = f8 ? (bf16*)((unsigned char*)WT + drow0 * (size_t)ldt + k0) : WT + drow0 * (size_t)ldt + k0; return d;
}
__device__ __forceinline__ CvDesc conv_item(Ctx& C, int l, int r, int tid) {
    constexpr int I_WIN = 16 * 62, I_W13 = 65 * 64, I_W2 = 65 * 32, I_PA = 4 * 8, I_PB = 2 * 8, I_PC = 6 * 8, I_PD = 4 * 8;
    const bool f8l = MOE8(l), lastb = MOE8(l) && l == NL_ - 1;
    bf16* WIN = WSP(bf16, WS_WIN); bf16* W13 = lastb ? WSP(bf16, WS_W13B) : WSP(bf16, WS_W13); bf16* W2 = lastb ? WSP(bf16, WS_W2B) : WSP(bf16, WS_W2); bf16* WP = WSP(bf16, WS_WP); bf16* WOUT = WSP(bf16, WS_WOUT);
    const int c4 = 4 * (tid & 63);
    if (r < I_WIN) { const int nb = r % 62, kb = r / 62, n = 256 * nb + c4; int sc;
        if (n < 1536) sc = n; else if (n < 7424) sc = n + 16; else if (n < 7680) { const int i = n - 7424; sc = i < 16 ? 1536 + i : (i < 24 ? 7440 + (i - 16) : -1); } else sc = n - 7680 + 7448;
        if (GATES8(l) && nb >= 30) return cv_desc(C.in[2] + (size_t)l * 2048 * NCOL, NCOL, sc, 128 * kb, WSP(bf16, WS_WIN8), 256 * (nb - 30), 2048, 0, tid, 1);
        return cv_desc(C.in[2] + (size_t)l * 2048 * NCOL, NCOL, sc, 128 * kb, WIN, 256 * nb, 2048, 0, tid); }
    r -= I_WIN;
    if (r < I_W13) { const int e = r / 64, q = r % 64, half = q >> 5, kb = (q >> 1) & 15, nq = q & 1;
        const float* src = e == 0 ? (half ? C.in[28] : C.in[27]) + (size_t)l * 2048 * 512 : (half ? C.in[25] : C.in[24]) + (size_t)(l * 64 + e - 1) * 2048 * 512;
        return cv_desc(src, 512, 256 * nq + c4, 128 * kb, W13, (size_t)e * 1024 + nq * 512 + half * 128, 2048, 1, tid, f8l ? 1 : 0); }
    r -= I_W13;
    if (r < I_W2) { const int e = r / 32, q = r % 32, kb = q / 8, nb = q % 8;
        const float* src = e == 0 ? C.in[29] + (size_t)l * 512 * 2048 : C.in[26] + (size_t)(l * 64 + e - 1) * 512 * 2048;
        return cv_desc(src, 2048, 256 * nb + c4, 128 * kb, W2, (size_t)e * 2048 + 256 * nb, 512, 0, tid, f8l ? 1 : 0); }
    r -= I_W2;
    if (r < I_PA) return cv_desc(C.in[15] + (size_t)l * 512 * 2048, 2048, 256 * (r % 8) + c4, 128 * (r / 8), WP, 256 * (r % 8), 2048, 0, tid);
    r -= I_PA;
    if (r < I_PB) return cv_desc(C.in[16] + (size_t)l * 256 * 2048, 2048, 256 * (r % 8) + c4, 128 * (r / 8), WP + 512, 256 * (r % 8), 2048, 0, tid);
    r -= I_PB;
    if (r < I_PC) return cv_desc(C.in[17] + (size_t)l * 768 * 2048, 2048, 256 * (r % 8) + c4, 128 * (r / 8), WP + 768, 256 * (r % 8), 2048, 0, tid);
    r -= I_PC;
    if (r < I_PD) return cv_desc(C.in[18] + (size_t)l * 512 * 2048, 2048, 256 * (r % 8) + c4, 128 * (r / 8), WP + 1536, 256 * (r % 8), 2048, 0, tid);
    r -= I_PD;
    return cv_desc(C.in[19] + (size_t)l * 2048 * 2048, 2048, 256 * (r % 8) + c4, 128 * (r / 8), WOUT, 256 * (r % 8), 2048, 0, tid);
}
__device__ __forceinline__ void phase_convert(Ctx& C, int l, int part, int cbid, int cG, unsigned* arr = nullptr) {
    LAS float* tile = (LAS float*)C.lds; LAS int* qn = (LAS int*)(C.lds + AUX_OFF + 8192);
    unsigned* cq = WSP(unsigned, WS_CTL) + CW_CQ + l * 2 + part;
    const int tid = C.tid, lane = C.lane, wave = C.wave;
    constexpr int I_WIN = 16 * 62, NITEMS = I_WIN + 65 * 64 + 65 * 32 + (4 + 2 + 6 + 4) * 8 + 16 * 8;
    const int it0 = part == 0 ? 0 : I_WIN, it1 = part == 0 ? I_WIN : NITEMS;
    __syncthreads();
    if (tid == 0) qn[0] = (arr && __hip_atomic_load(arr, __ATOMIC_RELAXED, __HIP_MEMORY_SCOPE_AGENT) + STEAL_MARGIN >= (unsigned)C.G) ? 0x7fffffff : it0 + (int)atomicAdd(cq, 1u);
    __syncthreads();
    int it = qn[0];
    f32x4 va[16];
    CvDesc d = conv_item(C, l, it < it1 ? it : it0, tid);
    if (it < it1) {
#pragma unroll
        for (int i = 0; i < 16; ++i) va[i] = d.zero ? (f32x4){0.f, 0.f, 0.f, 0.f} : *(const f32x4*)(d.sp + (size_t)(8 * i) * d.ldw); }
    const int c16 = lane & 15, nsub = lane >> 4;
    while (it < it1) {
#pragma unroll
        for (int i = 0; i < 16; ++i) { const int kk = wave + 8 * i; *(LAS f32x4*)(tile + kk * 256 + ((4 * (tid & 63)) ^ (4 * ((kk >> 3) & 7)))) = va[i]; }
        if (tid == 0) qn[1] = (arr && __hip_atomic_load(arr, __ATOMIC_RELAXED, __HIP_MEMORY_SCOPE_AGENT) + STEAL_MARGIN >= (unsigned)C.G) ? 0x7fffffff : it0 + (int)atomicAdd(cq, 1u);
        __syncthreads();
        const int nx = qn[1]; const bool hn = nx < it1;
        const CvDesc dn = conv_item(C, l, hn ? nx : it, tid);
        if (hn) {
#pragma unroll
            for (int i = 0; i < 16; ++i) va[i] = dn.zero ? (f32x4){0.f, 0.f, 0.f, 0.f} : *(const f32x4*)(dn.sp + (size_t)(8 * i) * dn.ldw); }
#pragma unroll
        for (int p = 0; p < 8; ++p) { const int n = p * 32 + wave * 4 + nsub; const LAS float* s = tile + (8 * c16) * 256 + (n ^ (4 * (c16 & 7)));
            const int drow = d.w13 ? ((n >> 7) << 8) + (n & 127) : n;
            if (d.f8) { v2u o8; o8.x = pk4_fp8(s[0 * 256] * 32.f, s[1 * 256] * 32.f, s[2 * 256] * 32.f, s[3 * 256] * 32.f); o8.y = pk4_fp8(s[4 * 256] * 32.f, s[5 * 256] * 32.f, s[6 * 256] * 32.f, s[7 * 256] * 32.f);
                *(v2u*)((unsigned char*)d.dp + (size_t)drow * d.ldt + 8 * c16) = o8; }
            else { v4u o; o.x = pk2(s[0 * 256], s[1 * 256]); o.y = pk2(s[2 * 256], s[3 * 256]); o.z = pk2(s[4 * 256], s[5 * 256]); o.w = pk2(s[6 * 256], s[7 * 256]);
                *(v4u*)(d.dp + (size_t)drow * d.ldt + 8 * c16) = o; } }
        __syncthreads();
        d = dn; it = nx;
    }
    if (l == 0 && part == 0) {
        const int gw = cbid * 8 + C.wave, NGW = cG * 8;
        bf16* XB = WSP(bf16, WS_XB); const float* X = C.in[0];
        for (int t = gw; t < T_; t += NGW) {
#pragma unroll
            for (int j = 0; j < 8; ++j) { const f32x4 v = *(const f32x4*)(X + (size_t)t * 2048 + 4 * (lane + 64 * j)); v2u o; o.x = pk2(v[0], v[1]); o.y = pk2(v[2], v[3]); *(v2u*)(XB + (size_t)t * 2048 + 4 * (lane + 64 * j)) = o;
                if (GATES8(0)) *(unsigned*)(WSP(unsigned char, WS_XB8) + (size_t)t * 2048 + 4 * (lane + 64 * j)) = pk4_fp8(v[0], v[1], v[2], v[3]); }
        }
        f32x2* CS = WSP(f32x2, WS_CS); const int* pos = (const int*)C.in[1];
        for (int i = C.bid * 512 + C.tid; i < T_ * 32; i += C.G * 512) { const int t = i >> 5, f = i & 31;
            const float inv = powf(10000.0f, -(float)f * 2.0f / 64.0f), ang = (float)pos[t] * inv; float sn, cs; sincosf(ang, &sn, &cs); CS[i] = (f32x2){cs, sn}; }
    }
}
__device__ __forceinline__ void ln_row(f32x4 (&v)[8], const float* g, const float* b, int lane) {
    float s = 0.f;
#pragma unroll
    for (int j = 0; j < 8; ++j) s += (v[j][0] + v[j][1]) + (v[j][2] + v[j][3]);
    const float mean = wave_sum(s) * (1.f / 2048.f); float q = 0.f;
#pragma unroll
    for (int j = 0; j < 8; ++j) { v[j] = v[j] - mean; q += (v[j][0] * v[j][0] + v[j][1] * v[j][1]) + (v[j][2] * v[j][2] + v[j][3] * v[j][3]); }
    const float rstd = 1.f / sqrtf(wave_sum(q) * (1.f / 2048.f) + LN_EPS_);
#pragma unroll
    for (int j = 0; j < 8; ++j) { const f32x4 gv = *(const f32x4*)(g + 4 * (lane + 64 * j)), bv = *(const f32x4*)(b + 4 * (lane + 64 * j)); v[j] = v[j] * rstd * gv + bv; }
}
__device__ __forceinline__ void phase_ln1_router(Ctx& C, int l) {
    const float* HB = WSP(float, WS_HB); float* X1 = WSP(float, WS_X1); bf16* XS = WSP(bf16, WS_XS); float* ROWW = WSP(float, WS_ROWW);
    int* sel_e = WSP(int, WS_SEL); float* sel_w = WSP(float, WS_SEL + 262144); int* sel_r = WSP(int, WS_SEL + 2 * 262144);
    unsigned* cnt = WSP(unsigned, WS_CTL) + CW_CNT + l * 64;
    const float* g = C.in[20] + l * 2048; const float* b = C.in[21] + l * 2048; const float* wrt = C.in[22] + (size_t)l * 2048 * 64; const float* rb = C.in[23] + l * 64;
    constexpr int XP = 2068;
    LAS float* xl = (LAS float*)C.lds; LAS float* part = xl + 16 * XP; LAS float* scl = part + 2048;
    const int lane = C.lane, wave = C.wave;
    for (int unit = C.bid; unit < T_ / 16; unit += C.G) {
        const int t0 = unit * 16;
#pragma unroll 1
        for (int rr = 0; rr < 2; ++rr) { const int row = 2 * wave + rr; const size_t t = (size_t)(t0 + row);
            f32x4 v[8];
#pragma unroll
            for (int j = 0; j < 8; ++j) v[j] = *(const f32x4*)(HB + t * 2048 + 4 * (lane + 64 * j));
            ln_row(v, g, b, lane);
#pragma unroll
            for (int j = 0; j < 8; ++j) { *(f32x4*)(X1 + t * 2048 + 4 * (lane + 64 * j)) = v[j];
                if (MOE8(l)) *(unsigned*)(WSP(unsigned char, WS_XS8) + t * 2048 + 4 * (lane + 64 * j)) = pk4_fp8(v[j][0], v[j][1], v[j][2], v[j][3]);
                else { v2u o; o.x = pk2(v[j][0], v[j][1]); o.y = pk2(v[j][2], v[j][3]); *(v2u*)(XS + t * 2048 + 4 * (lane + 64 * j)) = o; }
                *(LAS f32x4*)(xl + row * XP + 4 * (lane + 64 * j)) = v[j]; }
        }
        if (C.tid < 16) { ROWW[t0 + C.tid] = 1.0f; WSP(int, WS_ROWMAP)[t0 + C.tid] = t0 + C.tid; }
        __syncthreads();
        {
            const int et = wave & 3, kh = wave >> 2, i = lane & 15, h = lane >> 4; f32x4 acc = (f32x4){0.f, 0.f, 0.f, 0.f};
            const LAS float* xr = xl + i * XP + kh * 1024 + 4 * h; const float* wb = wrt + (size_t)(kh * 1024 + 4 * h) * 64 + 16 * et + i;
#pragma unroll 4
            for (int s = 0; s < 64; ++s) { const f32x4 a = *(const LAS f32x4*)(xr + 16 * s); const float* wp = wb + (size_t)(16 * s) * 64;
                const float b0 = wp[0], b1 = wp[64], b2 = wp[128], b3 = wp[192];
                acc = __builtin_amdgcn_mfma_f32_16x16x4f32(a[0], b0, acc, 0, 0, 0); acc = __builtin_amdgcn_mfma_f32_16x16x4f32(a[1], b1, acc, 0, 0, 0);
                acc = __builtin_amdgcn_mfma_f32_16x16x4f32(a[2], b2, acc, 0, 0, 0); acc = __builtin_amdgcn_mfma_f32_16x16x4f32(a[3], b3, acc, 0, 0, 0); }
#pragma unroll
            for (int r = 0; r < 4; ++r) part[kh * 1024 + (4 * h + r) * 64 + 16 * et + i] = acc[r];
        }
        __syncthreads();
#pragma unroll
        for (int k = 0; k < 2; ++k) { const int idx = C.tid + 512 * k; scl[idx] = 1.f / (1.f + expf(-(part[idx] + part[1024 + idx]))); }
        __syncthreads();
#pragma unroll 1
        for (int rr = 0; rr < 2; ++rr) { const int tok = 2 * wave + rr, t = t0 + tok; const float* sp = (const float*)(scl + tok * 64);
            const bool sel = route_lane_select(lane, sp, rb); const float s = scl[tok * 64 + lane];
            const unsigned long long m0_ = __ballot(sel); const bool sel8 = sel && __popcll(m0_ & ((1ull << lane) - 1ull)) < 8;
            const float wsum = wave_sum(sel8 ? s : 0.f); const unsigned long long m = __ballot(sel8);
            if (sel8) { const int k = __popcll(m & ((1ull << lane) - 1ull)); sel_e[t * 8 + k] = lane; sel_w[t * 8 + k] = s * 2.5f / wsum; sel_r[t * 8 + k] = (int)atomicAdd(cnt + lane, 1u); } }
        __syncthreads();
    }
}
__device__ __forceinline__ void phase_scatter(Ctx& C, int l) {
    float* ROWW = WSP(float, WS_ROWW); int* ROWMAP = WSP(int, WS_ROWMAP);
    const int* sel_e = WSP(int, WS_SEL); const float* sel_w = WSP(float, WS_SEL + 262144); const int* sel_r = WSP(int, WS_SEL + 2 * 262144); int* POS = WSP(int, WS_SEL + 3 * 262144);
    const unsigned* cnt = WSP(unsigned, WS_CTL) + CW_CNT + l * 64; int* tst = WSP(int, WS_CTL) + CW_TST + l * 128;
    LAS int* offl = (LAS int*)(C.lds + AUX_OFF + 4096);
    if (C.tid == 0) { int ts = 0;
        for (int k = 0; k <= 65; ++k) { if (C.bid == 0) tst[k] = ts; if (k >= 1 && k <= 64) offl[k - 1] = ts * 256; ts += (k == 0) ? 32 : (k <= 64 ? (((int)cnt[k - 1] + 255) >> 8) : 0); } }
    __syncthreads();
    for (int p = C.bid * 512 + C.tid; p < T_ * 8; p += C.G * 512) { const int e = sel_e[p], pos = offl[e] + sel_r[p]; ROWMAP[pos] = p >> 3; ROWW[pos] = sel_w[p]; POS[p] = pos; }
    for (int e = C.bid; e < 64; e += C.G) { const int c = (int)cnt[e], beg = offl[e] + c, end = offl[e] + ((c + 255) & ~255);
        for (int pos = beg + C.tid; pos < end; pos += 512) { ROWMAP[pos] = 0; ROWW[pos] = 0.f; } }
}
__device__ __forceinline__ void phase_combine(Ctx& C, int l) {
    const bf16* YB = WSP(bf16, WS_YBUF); const float* X1 = WSP(float, WS_X1); const int* POS = WSP(int, WS_SEL + 3 * 262144);
    float* XO = (l == NL_ - 1) ? C.out : WSP(float, WS_XA); bf16* XB = WSP(bf16, WS_XB);
    const float* g = C.in[30] + l * 2048; const float* b = C.in[31] + l * 2048;
    const int gw = C.bid * 8 + C.wave, NGW = C.G * 8, lane = C.lane;
    int pn[8];
#pragma unroll
    for (int k = 0; k < 8; ++k) pn[k] = gw < T_ ? POS[gw * 8 + k] : 0;
    for (int t = gw; t < T_; t += NGW) {
        size_t rows[9]; rows[0] = (size_t)t;
#pragma unroll
        for (int k = 0; k < 8; ++k) rows[k + 1] = (size_t)pn[k];
        { const int tn = t + NGW < T_ ? t + NGW : t;
#pragma unroll
          for (int k = 0; k < 8; ++k) pn[k] = POS[tn * 8 + k]; }
        v4u w[9][4];
#pragma unroll
        for (int k = 0; k < 9; ++k)
#pragma unroll
            for (int j = 0; j < 4; ++j) w[k][j] = *(const v4u*)(YB + rows[k] * 2048 + 8 * lane + 512 * j);
        float v[4][8];
#pragma unroll
        for (int j = 0; j < 4; ++j) { const f32x4 a = *(const f32x4*)(X1 + (size_t)t * 2048 + 8 * lane + 512 * j), c = *(const f32x4*)(X1 + (size_t)t * 2048 + 8 * lane + 512 * j + 4);
            v[j][0] = a[0] * DN_ALPHA; v[j][1] = a[1] * DN_ALPHA; v[j][2] = a[2] * DN_ALPHA; v[j][3] = a[3] * DN_ALPHA; v[j][4] = c[0] * DN_ALPHA; v[j][5] = c[1] * DN_ALPHA; v[j][6] = c[2] * DN_ALPHA; v[j][7] = c[3] * DN_ALPHA; }
#pragma unroll
        for (int k = 0; k < 9; ++k)
#pragma unroll
            for (int j = 0; j < 4; ++j) { v[j][0] += bflo(w[k][j].x); v[j][1] += bfhi(w[k][j].x); v[j][2] += bflo(w[k][j].y); v[j][3] += bfhi(w[k][j].y); v[j][4] += bflo(w[k][j].z); v[j][5] += bfhi(w[k][j].z); v[j][6] += bflo(w[k][j].w); v[j][7] += bfhi(w[k][j].w); }
        float s = 0.f;
#pragma unroll
        for (int j = 0; j < 4; ++j)
#pragma unroll
            for (int e = 0; e < 8; ++e) s += v[j][e];
        const float mean = wave_sum(s) * (1.f / 2048.f); float q = 0.f;
#pragma unroll
        for (int j = 0; j < 4; ++j)
#pragma unroll
            for (int e = 0; e < 8; ++e) { v[j][e] -= mean; q += v[j][e] * v[j][e]; }
        const float rstd = 1.f / sqrtf(wave_sum(q) * (1.f / 2048.f) + LN_EPS_);
#pragma unroll
        for (int j = 0; j < 4; ++j) { const int c0 = 8 * lane + 512 * j; float o[8];
            const f32x4 g0 = *(const f32x4*)(g + c0), g1 = *(const f32x4*)(g + c0 + 4), b0 = *(const f32x4*)(b + c0), b1 = *(const f32x4*)(b + c0 + 4);
#pragma unroll
            for (int e = 0; e < 4; ++e) { o[e] = v[j][e] * rstd * g0[e] + b0[e]; o[4 + e] = v[j][4 + e] * rstd * g1[e] + b1[e]; }
            *(f32x4*)(XO + (size_t)t * 2048 + c0) = (f32x4){o[0], o[1], o[2], o[3]}; *(f32x4*)(XO + (size_t)t * 2048 + c0 + 4) = (f32x4){o[4], o[5], o[6], o[7]};
            if (l < NL_ - 1) { v4u ow; ow.x = pk2(o[0], o[1]); ow.y = pk2(o[2], o[3]); ow.z = pk2(o[4], o[5]); ow.w = pk2(o[6], o[7]); *(v4u*)(XB + (size_t)t * 2048 + c0) = ow;
                if (GATES8(l + 1)) { v2u o8; o8.x = pk4_fp8(o[0], o[1], o[2], o[3]); o8.y = pk4_fp8(o[4], o[5], o[6], o[7]); *(v2u*)(WSP(unsigned char, WS_XB8) + (size_t)t * 2048 + c0) = o8; } } }
    }
}
typedef LAS unsigned char* ldsp;
__device__ __forceinline__ f32x4 mfma16(bf16x8 bt, bf16x8 a, f32x4 c) { return __builtin_amdgcn_mfma_f32_16x16x32_bf16(bt, a, c, 0, 0, 0); }
__device__ __forceinline__ bf16x8 frag(ldsp base, int pitch, int row, int k0, int fq) { return *(const LAS bf16x8*)(base + row * pitch + (k0 + 8 * fq) * 2); }
__device__ __forceinline__ bf16x8 frag2(ldsp base, int pitch, int row, int kA, int kB, int fq) {
    const v2u a = *(const LAS v2u*)(base + row * pitch + (kA + 4 * fq) * 2), b = *(const LAS v2u*)(base + row * pitch + (kB + 4 * fq) * 2);
    v4u r; r.x = a.x; r.y = a.y; r.z = b.x; r.w = b.y; return __builtin_bit_cast(bf16x8, r);
}
typedef short v4i16_t __attribute__((ext_vector_type(4)));
__device__ __forceinline__ bf16x8 trfrag2(ldsp base, int pitch, int col0, int kA, int kB, int lane) {
    const int q = (lane & 15) >> 2, p = lane & 3, fq = lane >> 4;
    const v4i16_t x = __builtin_amdgcn_ds_read_tr16_b64_v4i16((LAS v4i16_t*)(base + (kA + 4 * fq + q) * pitch + (col0 + 4 * p) * 2));
    const v4i16_t y = __builtin_amdgcn_ds_read_tr16_b64_v4i16((LAS v4i16_t*)(base + (kB + 4 * fq + q) * pitch + (col0 + 4 * p) * 2));
    bf16x8 r; r[0] = x[0]; r[1] = x[1]; r[2] = x[2]; r[3] = x[3]; r[4] = y[0]; r[5] = y[1]; r[6] = y[2]; r[7] = y[3]; return r;
}
__device__ __forceinline__ bf16x8 trfrag(ldsp base, int pitch, int col0, int k0, int lane) { const int fq = lane >> 4; return trfrag2(base, pitch, col0, k0 + 4 * fq, k0 + 4 * fq + 4, lane); }
__device__ __forceinline__ bf16x8 pfrag(const f32x4& p0, const f32x4& p1) { v4u r; r.x = pk2(p0[0], p0[1]); r.y = pk2(p0[2], p0[3]); r.z = pk2(p1[0], p1[1]); r.w = pk2(p1[2], p1[3]); return __builtin_bit_cast(bf16x8, r); }
__device__ __forceinline__ void unpack8(const v4u w, float (&f)[8]) { f[0] = bflo(w.x); f[1] = bfhi(w.x); f[2] = bflo(w.y); f[3] = bfhi(w.y); f[4] = bflo(w.z); f[5] = bfhi(w.z); f[6] = bflo(w.w); f[7] = bfhi(w.w); }
__device__ __forceinline__ unsigned short bf1(float x) { return (unsigned short)(pk2(x, 0.f) & 0xffffu); }
__device__ __forceinline__ float flogsigmoid(float x) { return fminf(x, 0.f) - log1pf(__expf(-fabsf(x))); }
__device__ __forceinline__ float fgelu(float v) {
    const float av = fabsf(v), t = __builtin_amdgcn_rcpf(av * 0.2316418882f + 1.0f);
    float q = t * 0.5307027145f + (-0.7265760135f); q = q * t + 0.7107068705f; q = q * t + (-0.142248368f); q = q * t + 0.127414796f; q = q * t;
    const float e = __builtin_amdgcn_exp2f((v * v) * (-0.72134752044f)), m = v * (q * e);
    return v < 0.f ? m : v - m;
}

__device__ __forceinline__ void scat8(LAS unsigned short* vp, int ps  , const v4u w) {
    vp[0 * ps] = (unsigned short)(w.x & 0xffff); vp[1 * ps] = (unsigned short)(w.x >> 16); vp[2 * ps] = (unsigned short)(w.y & 0xffff); vp[3 * ps] = (unsigned short)(w.y >> 16);
    vp[4 * ps] = (unsigned short)(w.z & 0xffff); vp[5 * ps] = (unsigned short)(w.z >> 16); vp[6 * ps] = (unsigned short)(w.w & 0xffff); vp[7 * ps] = (unsigned short)(w.w >> 16);
}

__device__ __forceinline__ void dil_unit(Ctx& C, int u) {
    const int tid = C.tid, lane = C.lane, wave = C.wave, fr = lane & 15, fq = lane >> 4;
    const int blk16 = u & 15, hh = (u >> 4) & 3, g = (u >> 6) % 3, b = u / 192;
    const int dil = g == 0 ? 1 : (g == 1 ? 4 : 16), nbpr = 16 / dil  , r = blk16 / nbpr, nb = blk16 % nbpr, head = g * 4 + hh;
    const bf16* Y = WSP(bf16, WS_Y); const f32x2* CS = WSP(f32x2, WS_CS);
    constexpr int QP = 144, KP = 144, VP = 160;
    ldsp Ql = C.lds, Kl = C.lds + 128 * QP, Vl = Kl + 256 * KP;
    const size_t tb = (size_t)b * SEQ_;
    {   const int ch = tid & 3, row0 = tid >> 2; v4u xa[3], xb[3]; f32x4 cs[3][4]; int mrow[3];
#pragma unroll
        for (int i = 0; i < 3; ++i) { const int row = row0 + (i == 2 ? 128 : 0), m = (i == 0) ? nb * 128 + row : (nb - 1) * 128 + row, mc = m < 0 ? 0 : m; const size_t t = tb + (size_t)mc * dil + r;
            const bf16* src = Y + t * YP + (i == 0 ? Y_BQ : Y_BK) + head * 64 + 8 * ch; xa[i] = *(const v4u*)src; xb[i] = *(const v4u*)(src + 32);
            const f32x4* cp = (const f32x4*)(CS + t * 32 + 8 * ch); cs[i][0] = cp[0]; cs[i][1] = cp[1]; cs[i][2] = cp[2]; cs[i][3] = cp[3]; mrow[i] = m; }
        const int ch8 = tid & 7, key0 = tid >> 3; v4u vv[4];
#pragma unroll
        for (int i = 0; i < 4; ++i) { const int m = (nb - 1) * 128 + key0 + 64 * i, mc = m < 0 ? 0 : m; vv[i] = *(const v4u*)(Y + (tb + (size_t)mc * dil + r) * YP + Y_BV + head * 64 + 8 * ch8); }
#pragma unroll
        for (int i = 0; i < 3; ++i) { const int row = row0 + (i == 2 ? 128 : 0); ldsp dst = (i == 0) ? Ql + row * QP : Kl + row * KP;
            float x1[8], x2[8]; unpack8(xa[i], x1); unpack8(xb[i], x2); const float sc = (i == 0) ? 0.125f : (mrow[i] < 0 ? 0.f : 1.f); float y1[8], y2[8];
#pragma unroll
            for (int k = 0; k < 8; ++k) { const float c = cs[i][k >> 1][2 * (k & 1)], sn = cs[i][k >> 1][2 * (k & 1) + 1]; y1[k] = (x1[k] * c - x2[k] * sn) * sc; y2[k] = (x2[k] * c + x1[k] * sn) * sc; }
            v4u o1, o2; o1.x = pk2(y1[0], y1[1]); o1.y = pk2(y1[2], y1[3]); o1.z = pk2(y1[4], y1[5]); o1.w = pk2(y1[6], y1[7]);
            o2.x = pk2(y2[0], y2[1]); o2.y = pk2(y2[2], y2[3]); o2.z = pk2(y2[4], y2[5]); o2.w = pk2(y2[6], y2[7]);
            *(LAS v4u*)(dst + 16 * ch) = o1; *(LAS v4u*)(dst + 64 + 16 * ch) = o2; }
#pragma unroll
        for (int i = 0; i < 4; ++i) { const int key = key0 + 64 * i; v4u w = vv[i]; if ((nb - 1) * 128 + key < 0) w = (v4u){0u, 0u, 0u, 0u};
            *(LAS v4u*)(Vl + key * VP + 16 * ch8) = w; }
    }
    __syncthreads();
    const int ts = wave < 6 ? wave : 6;
    const bf16x8 q0 = frag(Ql, QP, 16 * wave + fr, 0, fq), q1 = frag(Ql, QP, 16 * wave + fr, 32, fq);
    f32x4 s[10];
#pragma unroll
    for (int t = 0; t < 10; ++t) { s[t] = (f32x4){0.f, 0.f, 0.f, 0.f};
        s[t] = mfma16(frag(Kl, KP, 16 * (ts + t) + fr, 0, fq), q0, s[t]); s[t] = mfma16(frag(Kl, KP, 16 * (ts + t) + fr, 32, fq), q1, s[t]); }
    const int qi = 16 * wave + fr; float mx = -INFINITY;
#pragma unroll
    for (int t = 0; t < 10; ++t)
#pragma unroll
        for (int e = 0; e < 4; ++e) { const int j = 16 * (ts + t) + 4 * fq + e; const bool ok = (j >= qi) && (j <= qi + 128) && ((nb - 1) * 128 + j >= 0); s[t][e] = ok ? s[t][e] : -INFINITY; mx = fmaxf(mx, s[t][e]); }
    mx = fmaxf(mx, __shfl_xor(mx, 16)); mx = fmaxf(mx, __shfl_xor(mx, 32));
    float den = 0.f;
#pragma unroll
    for (int t = 0; t < 10; ++t)
#pragma unroll
        for (int e = 0; e < 4; ++e) { const float p = __expf(s[t][e] - mx); s[t][e] = p; den += p; }
    den += __shfl_xor(den, 16); den += __shfl_xor(den, 32);
    f32x4 o[4];
#pragma unroll
    for (int n = 0; n < 4; ++n) o[n] = (f32x4){0.f, 0.f, 0.f, 0.f};
#pragma unroll
    for (int tp = 0; tp < 5; ++tp) { const bf16x8 pf = pfrag(s[2 * tp], s[2 * tp + 1]);
#pragma unroll
        for (int n = 0; n < 4; ++n) o[n] = mfma16(trfrag2(Vl, VP, 16 * n, 16 * (ts + 2 * tp), 16 * (ts + 2 * tp + 1), lane), pf, o[n]); }
    const size_t t = tb + (size_t)(nb * 128 + qi) * dil + r; const float rden = 1.f / den;
    float* DO = WSP(float, WS_DILO) + t * 768 + head * 64;
#pragma unroll
    for (int n = 0; n < 4; ++n) *(f32x4*)(DO + 16 * n + 4 * fq) = o[n] * rden;
    if (fq == 0) WSP(float, WS_DILL)[t * 12 + head] = mx + __logf(den);
    __syncthreads();
}
__device__ __forceinline__ void dil_merge(Ctx& C, bf16* YM) {
    const float* DO = WSP(float, WS_DILO); const float* DL = WSP(float, WS_DILL);
    for (int i = C.bid * 512 + C.tid; i < T_ * 64; i += C.G * 512) { const int t = i >> 6, hh = (i >> 4) & 3, d4 = (i & 15) * 4;
        const float l0 = DL[t * 12 + hh], l1 = DL[t * 12 + 4 + hh], l2 = DL[t * 12 + 8 + hh], m = fmaxf(l0, fmaxf(l1, l2));
        const float w0 = __expf(l0 - m), w1 = __expf(l1 - m), w2 = __expf(l2 - m), rs = 1.f / (w0 + w1 + w2);
        const f32x4 a = *(const f32x4*)(DO + (size_t)t * 768 + hh * 64 + d4), bb = *(const f32x4*)(DO + (size_t)t * 768 + (4 + hh) * 64 + d4), c = *(const f32x4*)(DO + (size_t)t * 768 + (8 + hh) * 64 + d4);
        const f32x4 o = (a * w0 + bb * w1 + c * w2) * rs; v2u w; w.x = pk2(o[0], o[1]); w.y = pk2(o[2], o[3]);
        *(v2u*)(YM + (size_t)t * 2048 + YM_B + hh * 64 + d4) = w; }
}

__device__ __forceinline__ void sgu_unit(Ctx& C, int l, int u, bf16* YM) {
    const int tid = C.tid, lane = C.lane, wave = C.wave, fr = lane & 15, fq = lane >> 4;
    const int g = u % 6, cn = u / 6; const size_t t0 = (size_t)cn * 128;
    const bf16* Y = WSP(bf16, WS_Y);
    const float* lng = C.in[11] + l * 768; const float* lnb = C.in[12] + l * 768; const float* ws = C.in[13] + (size_t)(l * 6 + g) * 128 * 128; const float* bs = C.in[14] + (l * 6 + g) * 128;
    constexpr int AP = 272, VP = 288;
    ldsp Al = C.lds, Vl = C.lds + 128 * AP; LAS float* st = (LAS float*)(Vl + 128 * VP);
    {   const int j = tid >> 2, qd = tid & 3; const bf16* src = Y + (t0 + j) * YP + Y_CV + qd * 192; float s1 = 0.f, s2 = 0.f;
#pragma unroll
        for (int c3 = 0; c3 < 3; ++c3) { v4u w[8];
#pragma unroll
            for (int k = 0; k < 8; ++k) w[k] = *(const v4u*)(src + 8 * (8 * c3 + k));
#pragma unroll
            for (int k = 0; k < 8; ++k) { float x[8]; unpack8(w[k], x);
#pragma unroll
                for (int q2 = 0; q2 < 8; ++q2) { const float z = fgelu(x[q2]); s1 += z; s2 += z * z; } } }
        s1 += __shfl_xor(s1, 1); s2 += __shfl_xor(s2, 1); s1 += __shfl_xor(s1, 2); s2 += __shfl_xor(s2, 2);
        if (qd == 0) { const float mu = s1 * (1.f / 768.f), var = fmaxf(s2 * (1.f / 768.f) - mu * mu, 0.f); st[2 * j] = mu; st[2 * j + 1] = 1.f / sqrtf(var + LN_EPS_); } }
    {   const int c8 = (tid & 15) * 8; f32x4 a[4], bq[4];
#pragma unroll
        for (int k4 = 0; k4 < 4; ++k4) { const int i = (tid >> 4) + 32 * k4; const float* src = ws + i * 128 + c8; a[k4] = *(const f32x4*)src; bq[k4] = *(const f32x4*)(src + 4); }
#pragma unroll
        for (int k4 = 0; k4 < 4; ++k4) { const int i = (tid >> 4) + 32 * k4; float v[8] = {a[k4][0], a[k4][1], a[k4][2], a[k4][3], bq[k4][0], bq[k4][1], bq[k4][2], bq[k4][3]};
#pragma unroll
            for (int k = 0; k < 8; ++k) v[k] = (c8 + k <= i) ? v[k] : 0.f;
            v4u o; o.x = pk2(v[0], v[1]); o.y = pk2(v[2], v[3]); o.z = pk2(v[4], v[5]); o.w = pk2(v[6], v[7]); *(LAS v4u*)(Al + i * AP + c8 * 2) = o; } }
    {   const int c8 = (tid & 15) * 8; v4u w[4];
#pragma unroll
        for (int k4 = 0; k4 < 4; ++k4) { const int j = (tid >> 4) + 32 * k4; w[k4] = *(const v4u*)(Y + (t0 + j) * YP + Y_CV + g * 128 + c8); }
        const f32x4 g0 = *(const f32x4*)(lng + g * 128 + c8), g1 = *(const f32x4*)(lng + g * 128 + c8 + 4), b0 = *(const f32x4*)(lnb + g * 128 + c8), b1 = *(const f32x4*)(lnb + g * 128 + c8 + 4);
        const float gg[8] = {g0[0], g0[1], g0[2], g0[3], g1[0], g1[1], g1[2], g1[3]}, bb[8] = {b0[0], b0[1], b0[2], b0[3], b1[0], b1[1], b1[2], b1[3]};
        __syncthreads();
#pragma unroll
        for (int k4 = 0; k4 < 4; ++k4) { const int j = (tid >> 4) + 32 * k4; float x[8]; unpack8(w[k4], x); const float mu = st[2 * j], rs = st[2 * j + 1];
#pragma unroll
            for (int k = 0; k < 8; ++k) x[k] = (fgelu(x[k]) - mu) * rs * gg[k] + bb[k];
            v4u o; o.x = pk2(x[0], x[1]); o.y = pk2(x[2], x[3]); o.z = pk2(x[4], x[5]); o.w = pk2(x[6], x[7]); *(LAS v4u*)(Vl + j * VP + c8 * 2) = o; } }
    __syncthreads();
    f32x4 acc[8];
#pragma unroll
    for (int n = 0; n < 8; ++n) acc[n] = (f32x4){0.f, 0.f, 0.f, 0.f};
    const int nks = (16 * wave + 15) / 32 + 1;
    for (int ks = 0; ks < nks; ++ks) { const bf16x8 a = frag(Al, AP, 16 * wave + fr, 32 * ks, fq);
#pragma unroll
        for (int n = 0; n < 8; ++n) acc[n] = mfma16(trfrag(Vl, VP, 16 * n, 32 * ks, lane), a, acc[n]); }
    const int i = 16 * wave + fr; const float bsi = bs[i]; const size_t t = t0 + i;
#pragma unroll
    for (int n = 0; n < 8; ++n) { const int c = 16 * n + 4 * fq; const v2u w = *(const v2u*)(Y + t * YP + Y_CU + g * 128 + c);
        const float o0 = fgelu(bflo(w.x)) * (acc[n][0] + bsi), o1 = fgelu(bfhi(w.x)) * (acc[n][1] + bsi), o2 = fgelu(bflo(w.y)) * (acc[n][2] + bsi), o3 = fgelu(bfhi(w.y)) * (acc[n][3] + bsi);
        v2u o; o.x = pk2(o0, o1); o.y = pk2(o2, o3); *(v2u*)(YM + t * 2048 + YM_C + g * 128 + c) = o; }
    __syncthreads();
}

__device__ __forceinline__ void gla_decay(Ctx& C, int l, int h, size_t t0, LAS float* Bl, LAS float* tmp  ) {
    const int tid = C.tid; const float* YSM = WSP(float, WS_YSM); const float* wa2 = C.in[3] + l * 16 * 256 + h * 64; const float* ba = C.in[4] + l * 256 + h * 64;
    { const int j = tid >> 3, d0 = (tid & 7) * 8; float a[16];
#pragma unroll
        for (int r4 = 0; r4 < 4; ++r4) { const f32x4 v = *(const f32x4*)(YSM + (t0 + j) * 32 + 4 * r4); a[4 * r4] = v[0]; a[4 * r4 + 1] = v[1]; a[4 * r4 + 2] = v[2]; a[4 * r4 + 3] = v[3]; }
#pragma unroll
        for (int k = 0; k < 8; ++k) { float s = ba[d0 + k];
#pragma unroll
            for (int r = 0; r < 16; ++r) s += a[r] * wa2[r * 256 + d0 + k];
            Bl[j * 65 + d0 + k] = flogsigmoid(s) * (1.f / 16.f); } }
    __syncthreads();
    { const int d = tid & 63, sg = tid >> 6; float run = 0.f;
#pragma unroll
        for (int k = 0; k < 8; ++k) { run += Bl[(8 * sg + k) * 65 + d]; Bl[(8 * sg + k) * 65 + d] = run; }
        tmp[sg * 64 + d] = run;
        __syncthreads();
        float off = 0.f;
        for (int s2 = 0; s2 < sg; ++s2) off += tmp[s2 * 64 + d];
#pragma unroll
        for (int k = 0; k < 8; ++k) Bl[(8 * sg + k) * 65 + d] += off; }
    __syncthreads();
}
__device__ __forceinline__ void gla_local_unit(Ctx& C, int l, int u) {
    const int tid = C.tid, lane = C.lane, wave = C.wave, fr = lane & 15, fq = lane >> 4;
    const int n = u & 31, h = (u >> 5) & 3, b = u >> 7; const size_t t0 = (size_t)b * SEQ_ + n * 64;
    const bf16* Y = WSP(bf16, WS_Y);
    constexpr int KP = 160, VP = 288;
    LAS float* Bl = (LAS float*)C.lds; LAS float* tmp = Bl + 64 * 65; ldsp Kl = (ldsp)(tmp + 512), Vl = Kl + 64 * KP;
    gla_decay(C, l, h, t0, Bl, tmp);
    {   const int j = tid >> 3, d0 = (tid & 7) * 8, e0 = (tid & 15) * 8;
        const v4u kw = *(const v4u*)(Y + (t0 + j) * YP + Y_AK + h * 64 + d0); v4u vw[2];
#pragma unroll
        for (int i = 0; i < 2; ++i) vw[i] = *(const v4u*)(Y + (t0 + (tid >> 4) + 32 * i) * YP + Y_AV + h * 128 + e0);
        float x[8]; unpack8(kw, x);
#pragma unroll
        for (int k = 0; k < 8; ++k) x[k] = x[k] * __expf(Bl[63 * 65 + d0 + k] - Bl[j * 65 + d0 + k]);
        v4u o; o.x = pk2(x[0], x[1]); o.y = pk2(x[2], x[3]); o.z = pk2(x[4], x[5]); o.w = pk2(x[6], x[7]); *(LAS v4u*)(Kl + j * KP + d0 * 2) = o;
#pragma unroll
        for (int i = 0; i < 2; ++i) *(LAS v4u*)(Vl + ((tid >> 4) + 32 * i) * VP + e0 * 2) = vw[i];
    }
    __syncthreads();
    float* LOC = WSP(float, WS_GLOC) + (size_t)u * 64 * 128; float* DEC = WSP(float, WS_GDEC) + (size_t)u * 64;
    if (tid < 64) DEC[tid] = __expf(Bl[63 * 65 + tid]);
#pragma unroll
    for (int mt = 0; mt < 4; ++mt) { f32x4 acc = (f32x4){0.f, 0.f, 0.f, 0.f};
#pragma unroll
        for (int ks = 0; ks < 2; ++ks) acc = mfma16(trfrag2(Vl, VP, 16 * wave, 32 * ks, 32 * ks + 16, lane), trfrag2(Kl, KP, 16 * mt, 32 * ks, 32 * ks + 16, lane), acc);
        *(f32x4*)(LOC + (size_t)(16 * mt + fr) * 128 + 16 * wave + 4 * fq) = acc; }
    __syncthreads();
}
__device__ __forceinline__ void gla_scan(Ctx& C) {
    const float* LOC = WSP(float, WS_GLOC); const float* DEC = WSP(float, WS_GDEC); bf16* ST = WSP(bf16, WS_GST);
    for (int i = C.bid * 512 + C.tid; i < 16 * 8192; i += C.G * 512) { const int bh = i >> 13, de = i & 8191, d = de >> 7; float S = 0.f;
        float lc[32], dc[32];
#pragma unroll
        for (int n = 0; n < 32; ++n) { const size_t uu = (size_t)bh * 32 + n; lc[n] = LOC[uu * 8192 + de]; dc[n] = DEC[uu * 64 + d]; }
#pragma unroll
        for (int n = 0; n < 32; ++n) { const size_t uu = (size_t)bh * 32 + n; ST[uu * 8192 + de] = bf1(S); S = dc[n] * S + lc[n]; } }
}
__device__ __forceinline__ void gla_out_unit(Ctx& C, int l, int u, bf16* YM) {
    const int tid = C.tid, lane = C.lane, wave = C.wave, fr = lane & 15, fq = lane >> 4;
    const int n = u & 31, h = (u >> 5) & 3, b = u >> 7; const size_t t0 = (size_t)b * SEQ_ + n * 64;
    const bf16* Y = WSP(bf16, WS_Y); const bf16* ST = WSP(bf16, WS_GST) + (size_t)u * 8192;
    constexpr int QP = 144, VP = 288;
    LAS float* Bl = (LAS float*)C.lds; LAS float* tmp = Bl + 64 * 65; ldsp Ql = (ldsp)(tmp + 512), Kl = Ql + 64 * QP, Vl = Kl + 64 * QP, Sl = Vl + 64 * VP; LAS float* ssq = (LAS float*)(Sl + 64 * VP);
    gla_decay(C, l, h, t0, Bl, tmp);
    {   const int j = tid >> 3, d0 = (tid & 7) * 8, e0 = (tid & 15) * 8, j2 = tid >> 4;
        const v4u qw = *(const v4u*)(Y + (t0 + j) * YP + Y_AQ + h * 64 + d0), kw = *(const v4u*)(Y + (t0 + j) * YP + Y_AK + h * 64 + d0); v4u vw[2], sw[2];
#pragma unroll
        for (int i = 0; i < 2; ++i) { vw[i] = *(const v4u*)(Y + (t0 + j2 + 32 * i) * YP + Y_AV + h * 128 + e0); sw[i] = *(const v4u*)(ST + (j2 + 32 * i) * 128 + e0); }
        float xq[8], xk[8]; unpack8(qw, xq); unpack8(kw, xk);
#pragma unroll
        for (int k = 0; k < 8; ++k) { const float bb = Bl[j * 65 + d0 + k]; xq[k] = xq[k] * 0.125f * __expf(bb); xk[k] = xk[k] * __expf(-bb); }
        v4u o; o.x = pk2(xq[0], xq[1]); o.y = pk2(xq[2], xq[3]); o.z = pk2(xq[4], xq[5]); o.w = pk2(xq[6], xq[7]); *(LAS v4u*)(Ql + j * QP + d0 * 2) = o;
        o.x = pk2(xk[0], xk[1]); o.y = pk2(xk[2], xk[3]); o.z = pk2(xk[4], xk[5]); o.w = pk2(xk[6], xk[7]); *(LAS v4u*)(Kl + j * QP + d0 * 2) = o;
#pragma unroll
        for (int i = 0; i < 2; ++i) { *(LAS v4u*)(Vl + (j2 + 32 * i) * VP + e0 * 2) = vw[i]; *(LAS v4u*)(Sl + (j2 + 32 * i) * VP + e0 * 2) = sw[i]; }
    }
    __syncthreads();
    const int mt = wave & 3, nh = wave >> 2;
    const bf16x8 qa0 = frag(Ql, QP, 16 * mt + fr, 0, fq), qa1 = frag(Ql, QP, 16 * mt + fr, 32, fq);
    f32x4 att[4];
#pragma unroll
    for (int t = 0; t < 4; ++t) { att[t] = (f32x4){0.f, 0.f, 0.f, 0.f}; att[t] = mfma16(frag(Kl, QP, 16 * t + fr, 0, fq), qa0, att[t]); att[t] = mfma16(frag(Kl, QP, 16 * t + fr, 32, fq), qa1, att[t]);
#pragma unroll
        for (int e = 0; e < 4; ++e) att[t][e] = (16 * t + 4 * fq + e <= 16 * mt + fr) ? att[t][e] : 0.f; }
    const bf16x8 p0 = pfrag(att[0], att[1]), p1 = pfrag(att[2], att[3]);
    f32x4 o[4];
#pragma unroll
    for (int nt = 0; nt < 4; ++nt) { const int ec = 64 * nh + 16 * nt; f32x4 a = (f32x4){0.f, 0.f, 0.f, 0.f};
        a = mfma16(trfrag2(Vl, VP, ec, 0, 16, lane), p0, a); a = mfma16(trfrag2(Vl, VP, ec, 32, 48, lane), p1, a);
        a = mfma16(trfrag(Sl, VP, ec, 0, lane), qa0, a); a = mfma16(trfrag(Sl, VP, ec, 32, lane), qa1, a); o[nt] = a; }
    float sq = 0.f;
#pragma unroll
    for (int nt = 0; nt < 4; ++nt) sq += (o[nt][0] * o[nt][0] + o[nt][1] * o[nt][1]) + (o[nt][2] * o[nt][2] + o[nt][3] * o[nt][3]);
    sq += __shfl_xor(sq, 16); sq += __shfl_xor(sq, 32);
    const int i = 16 * mt + fr;
    if (fq == 0) ssq[2 * i + nh] = sq;
    __syncthreads();
    const float rs = 1.f / sqrtf((ssq[2 * i] + ssq[2 * i + 1]) * (1.f / 128.f) + LN_EPS_);
    const float* ng = C.in[5] + l * 512 + h * 128; const size_t t = t0 + i;
#pragma unroll
    for (int nt = 0; nt < 4; ++nt) { const int e = 64 * nh + 16 * nt + 4 * fq; const f32x4 gv = *(const f32x4*)(ng + e); const v2u rw = *(const v2u*)(Y + t * YP + Y_AR + h * 128 + e);
        const float r0 = bflo(rw.x), r1 = bfhi(rw.x), r2 = bflo(rw.y), r3 = bfhi(rw.y);
        v2u w; w.x = pk2(o[nt][0] * rs * gv[0] * r0 * fsigmoid(r0), o[nt][1] * rs * gv[1] * r1 * fsigmoid(r1)); w.y = pk2(o[nt][2] * rs * gv[2] * r2 * fsigmoid(r2), o[nt][3] * rs * gv[3] * r3 * fsigmoid(r3));
        *(v2u*)(YM + t * 2048 + YM_A + h * 128 + e) = w; }
    __syncthreads();
}

__device__ __forceinline__ void ml_prep(Ctx& C, int l, int h, int b, int n, LAS float* gl, ldsp Ql, ldsp Kl, int QP, bool need_q) {
    const int tid = C.tid, lane = C.lane; const size_t t0 = (size_t)b * SEQ_ + n * 64;
    const bf16* Y = WSP(bf16, WS_Y); const float* YSM = WSP(float, WS_YSM);
    if (tid < 64) { const float lf = flogsigmoid(YSM[(t0 + lane) * 32 + 20 + h] + C.in[9][l * 4 + h]); float run = lf;
#pragma unroll
        for (int o = 1; o < 64; o <<= 1) { const float v = __shfl_up(run, o); if (lane >= o) run += v; }
        gl[lane] = run; gl[64 + lane] = YSM[(t0 + lane) * 32 + 16 + h] + C.in[8][l * 4 + h]; }
    const float* cw = C.in[6] + l * 4096; const float* cb = C.in[7] + l * 1024;
    {   const int c0 = (tid & 15) * 8, j0 = tid >> 4;
#pragma unroll
        for (int qk = 0; qk < 2; ++qk) { if (qk == 0 && !need_q) continue;
            const int cc = (qk == 0 ? 0 : 512) + h * 128 + c0, ycol = (qk == 0 ? Y_DQ : Y_DK) + h * 128 + c0;
            v4u xw[2][4]; f32x4 w4[4][2], b4[2];
#pragma unroll
            for (int i = 0; i < 2; ++i)
#pragma unroll
                for (int jj = 0; jj < 4; ++jj) { const int j = j0 + 32 * i, rel = j - 3 + jj, ok = (n * 64 + rel) >= 0; xw[i][jj] = *(const v4u*)(Y + (t0 + (ok ? rel : j)) * YP + ycol); }
#pragma unroll
            for (int jj = 0; jj < 4; ++jj) { w4[jj][0] = *(const f32x4*)(cw + jj * 1024 + cc); w4[jj][1] = *(const f32x4*)(cw + jj * 1024 + cc + 4); }
            b4[0] = *(const f32x4*)(cb + cc); b4[1] = *(const f32x4*)(cb + cc + 4);
#pragma unroll
            for (int i = 0; i < 2; ++i) { const int j = j0 + 32 * i; float a[8] = {b4[0][0], b4[0][1], b4[0][2], b4[0][3], b4[1][0], b4[1][1], b4[1][2], b4[1][3]};
#pragma unroll
                for (int jj = 0; jj < 4; ++jj) { const float mk = (n * 64 + j - 3 + jj) >= 0 ? 1.f : 0.f; float x[8]; unpack8(xw[i][jj], x);
#pragma unroll
                    for (int k = 0; k < 8; ++k) a[k] += (w4[jj][k >> 2][k & 3] * mk) * x[k]; }
                const float sc = qk == 0 ? 1.f : 0.08838834764831845f;
#pragma unroll
                for (int k = 0; k < 8; ++k) a[k] = a[k] * fsigmoid(a[k]) * sc;
                v4u o; o.x = pk2(a[0], a[1]); o.y = pk2(a[2], a[3]); o.z = pk2(a[4], a[5]); o.w = pk2(a[6], a[7]); *(LAS v4u*)((qk == 0 ? Ql : Kl) + j * QP + c0 * 2) = o; } }
    }
    __syncthreads();
}
__device__ __forceinline__ void ml_local_unit(Ctx& C, int l, int u) {
    const int tid = C.tid, lane = C.lane, wave = C.wave, fr = lane & 15, fq = lane >> 4;
    const int n = u & 31, h = (u >> 5) & 3, b = u >> 7; const size_t t0 = (size_t)b * SEQ_ + n * 64;
    const bf16* Y = WSP(bf16, WS_Y);
    constexpr int KP = 288, TP = 288;
    LAS float* gl = (LAS float*)C.lds; LAS float* wk = gl + 128; LAS float* red = wk + 64;
    ldsp Kl = (ldsp)(red + 512), Vl = Kl + 64 * KP;
    ml_prep(C, l, h, b, n, gl, Kl, Kl, KP, false);
    if (tid < 64) { const float bl = gl[63], dec = bl - gl[lane] + gl[64 + lane], a = wave_max(dec); wk[lane] = __expf(dec - a);
        if (lane == 0) { float* SC = WSP(float, WS_MSC) + (size_t)u * 2; SC[0] = bl; SC[1] = a; } }
    __syncthreads();
    { const int d = tid & 127, sg = tid >> 7; float s = 0.f;
        for (int j = 16 * sg; j < 16 * sg + 16; ++j) s += wk[j] * bflo((unsigned)*(const LAS unsigned short*)(Kl + j * KP + d * 2));
        red[sg * 128 + d] = s; }
    {   const int c0 = (tid & 15) * 8, j0 = tid >> 4; v4u vw[2];
#pragma unroll
        for (int i = 0; i < 2; ++i) vw[i] = *(const v4u*)(Y + (t0 + j0 + 32 * i) * YP + Y_DV + h * 128 + c0);
#pragma unroll
        for (int i = 0; i < 2; ++i) *(LAS v4u*)(Vl + (j0 + 32 * i) * TP + c0 * 2) = vw[i];
    }
    __syncthreads();
    {   const int c0 = (tid & 15) * 8, j0 = tid >> 4;
#pragma unroll
        for (int i = 0; i < 2; ++i) { const int j = j0 + 32 * i; float x[8]; unpack8(*(const LAS v4u*)(Kl + j * KP + c0 * 2), x); const float w = wk[j];
            v4u o; o.x = pk2(x[0] * w, x[1] * w); o.y = pk2(x[2] * w, x[3] * w); o.z = pk2(x[4] * w, x[5] * w); o.w = pk2(x[6] * w, x[7] * w); *(LAS v4u*)(Kl + j * KP + c0 * 2) = o; }
    }
    if (tid < 128) WSP(float, WS_MNLOC)[(size_t)u * 128 + tid] = (red[tid] + red[128 + tid]) + (red[256 + tid] + red[384 + tid]);
    __syncthreads();
    float* LOC = WSP(float, WS_MLOC) + (size_t)u * 16384;
#pragma unroll
    for (int mt = 0; mt < 8; ++mt) { f32x4 acc = (f32x4){0.f, 0.f, 0.f, 0.f};
#pragma unroll
        for (int ks = 0; ks < 2; ++ks) acc = mfma16(trfrag2(Vl, TP, 16 * wave, 32 * ks, 32 * ks + 16, lane), trfrag2(Kl, KP, 16 * mt, 32 * ks, 32 * ks + 16, lane), acc);
        *(f32x4*)(LOC + (size_t)(16 * mt + fr) * 128 + 16 * wave + 4 * fq) = acc; }
    __syncthreads();
}
__device__ __forceinline__ void ml_scan(Ctx& C) {
    const float* LOC = WSP(float, WS_MLOC); const float* NL = WSP(float, WS_MNLOC); const float* SC = WSP(float, WS_MSC);
    bf16* MC = WSP(bf16, WS_MC); float* MN = WSP(float, WS_MN); float* MM = WSP(float, WS_MM);
    for (int i = C.bid * 512 + C.tid; i < 16 * (16384 + 128); i += C.G * 512) { const int bh = i / (16384 + 128), r = i % (16384 + 128); float S = 0.f, m = 0.f;
        float lc[32], bl_[32], a_[32];
#pragma unroll
        for (int n = 0; n < 32; ++n) { const size_t uu = (size_t)bh * 32 + n; lc[n] = r < 16384 ? LOC[uu * 16384 + r] : NL[uu * 128 + (r - 16384)]; bl_[n] = SC[uu * 2]; a_[n] = SC[uu * 2 + 1]; }
#pragma unroll
        for (int n = 0; n < 32; ++n) { const size_t uu = (size_t)bh * 32 + n; const float bl = bl_[n], a = a_[n], mn = fmaxf(bl + m, a), keep = __expf(bl + m - mn), sc = __expf(a - mn);
            if (r < 16384) MC[uu * 16384 + r] = bf1(S);
            else { const int d = r - 16384; MN[uu * 128 + d] = S; if (d == 0) MM[uu] = m; }
            S = keep * S + sc * lc[n]; m = mn; } }
}
__device__ __forceinline__ void ml_out_unit(Ctx& C, int l, int u, bf16* YM) {
    const int tid = C.tid, lane = C.lane, wave = C.wave, fr = lane & 15, fq = lane >> 4;
    const int n = u & 31, h = (u >> 5) & 3, b = u >> 7; const size_t t0 = (size_t)b * SEQ_ + n * 64;
    const bf16* Y = WSP(bf16, WS_Y); const bf16* MC = WSP(bf16, WS_MC) + (size_t)u * 16384; const float* MN = WSP(float, WS_MN) + (size_t)u * 128; const float m0 = WSP(float, WS_MM)[u];
    constexpr int QP = 272, TP = 288;
    LAS float* gl = (LAS float*)C.lds; LAS float* mt_ = gl + 128; LAS float* wst = mt_ + 64; LAS float* qn = wst + 64; LAS float* ssq = qn + 64;
    ldsp Ql = (ldsp)(ssq + 128), Kl = Ql + 64 * QP, Vl = Kl + 64 * QP, Cl = Vl + 64 * TP;
    ml_prep(C, l, h, b, n, gl, Ql, Kl, QP, true);
    if (tid < 64) { float pm = gl[64 + lane] - gl[lane];
#pragma unroll
        for (int o = 1; o < 64; o <<= 1) { const float v = __shfl_up(pm, o); if (lane >= o) pm = fmaxf(pm, v); }
        const float mt = gl[lane] + fmaxf(m0, pm); mt_[lane] = mt; wst[lane] = __expf(gl[lane] + m0 - mt); }
    {   const int c0 = (tid & 15) * 8, j0 = tid >> 4; v4u vw[2], cw4[4];
#pragma unroll
        for (int i = 0; i < 2; ++i) vw[i] = *(const v4u*)(Y + (t0 + j0 + 32 * i) * YP + Y_DV + h * 128 + c0);
#pragma unroll
        for (int i = 0; i < 4; ++i) cw4[i] = *(const v4u*)(MC + (j0 + 32 * i) * 128 + c0);
#pragma unroll
        for (int i = 0; i < 2; ++i) *(LAS v4u*)(Vl + (j0 + 32 * i) * TP + c0 * 2) = vw[i];
#pragma unroll
        for (int i = 0; i < 4; ++i) *(LAS v4u*)(Cl + (j0 + 32 * i) * TP + c0 * 2) = cw4[i];
    }
    { const int i = tid >> 3, d0 = (tid & 7) * 16; float s = 0.f;
#pragma unroll
        for (int k2 = 0; k2 < 2; ++k2) { float x[8]; unpack8(*(const LAS v4u*)(Ql + i * QP + (d0 + 8 * k2) * 2), x);
#pragma unroll
            for (int k = 0; k < 8; ++k) s += x[k] * MN[d0 + 8 * k2 + k]; }
        s += __shfl_xor(s, 1); s += __shfl_xor(s, 2); s += __shfl_xor(s, 4);
        if ((tid & 7) == 0) qn[i] = s; }
    __syncthreads();
    const int mt = wave & 3, nh = wave >> 2, i = 16 * mt + fr;
    bf16x8 qa[4];
#pragma unroll
    for (int ks = 0; ks < 4; ++ks) qa[ks] = frag(Ql, QP, i, 32 * ks, fq);
    const float bi_ = gl[i], mti = mt_[i], wsti = wst[i];
    f32x4 sc[4]; float rsum = 0.f;
#pragma unroll
    for (int t = 0; t < 4; ++t) { sc[t] = (f32x4){0.f, 0.f, 0.f, 0.f};
#pragma unroll
        for (int ks = 0; ks < 4; ++ks) sc[t] = mfma16(frag(Kl, QP, 16 * t + fr, 32 * ks, fq), qa[ks], sc[t]);
#pragma unroll
        for (int e = 0; e < 4; ++e) { const int j = 16 * t + 4 * fq + e; const float w = (j <= i) ? __expf(bi_ - gl[j] + gl[64 + j] - mti) : 0.f; sc[t][e] *= w; rsum += sc[t][e]; } }
    rsum += __shfl_xor(rsum, 16); rsum += __shfl_xor(rsum, 32);
    const float den = rsum + wsti * qn[i], rden = 1.f / fmaxf(fabsf(den), __expf(-mti));
    const bf16x8 p0 = pfrag(sc[0], sc[1]), p1 = pfrag(sc[2], sc[3]);
    f32x4 o[4]; float sq = 0.f;
    const size_t t = t0 + i;
#pragma unroll
    for (int nt = 0; nt < 4; ++nt) { const int ec = 64 * nh + 16 * nt; f32x4 a1 = (f32x4){0.f, 0.f, 0.f, 0.f}, a2 = a1;
        a1 = mfma16(trfrag2(Vl, TP, ec, 0, 16, lane), p0, a1); a1 = mfma16(trfrag2(Vl, TP, ec, 32, 48, lane), p1, a1);
#pragma unroll
        for (int ks = 0; ks < 4; ++ks) a2 = mfma16(trfrag(Cl, TP, ec, 32 * ks, lane), qa[ks], a2);
        const v2u ow = *(const v2u*)(Y + t * YP + Y_DO + h * 128 + 64 * nh + 16 * nt + 4 * fq);
        f32x4 hv = (a1 + a2 * wsti) * rden; hv[0] *= fsigmoid(bflo(ow.x)); hv[1] *= fsigmoid(bfhi(ow.x)); hv[2] *= fsigmoid(bflo(ow.y)); hv[3] *= fsigmoid(bfhi(ow.y));
        o[nt] = hv; sq += (hv[0] * hv[0] + hv[1] * hv[1]) + (hv[2] * hv[2] + hv[3] * hv[3]); }
    sq += __shfl_xor(sq, 16); sq += __shfl_xor(sq, 32);
    if (fq == 0) ssq[2 * i + nh] = sq;
    __syncthreads();
    const float rs = 1.f / sqrtf((ssq[2 * i] + ssq[2 * i + 1]) * (1.f / 128.f) + LN_EPS_);
    const float* ng = C.in[10] + l * 512 + h * 128;
#pragma unroll
    for (int nt = 0; nt < 4; ++nt) { const int e = 64 * nh + 16 * nt + 4 * fq; const f32x4 gv = *(const f32x4*)(ng + e);
        v2u w; w.x = pk2(o[nt][0] * rs * gv[0], o[nt][1] * rs * gv[1]); w.y = pk2(o[nt][2] * rs * gv[2], o[nt][3] * rs * gv[3]);
        *(v2u*)(YM + t * 2048 + YM_D + h * 128 + e) = w; }
    __syncthreads();
}

#ifndef MIXREP
#define MIXREP 0
#endif
#define RELAUNDER(C) do { int zv_ = 0; asm volatile("" : "+v"(zv_)); unsigned long long zw_ = (unsigned long long)(C).ws; asm volatile("" : "+s"(zw_)); (C).ws = (unsigned char*)(GAS unsigned char*)zw_;     \
    (C).tid = (int)threadIdx.x + zv_; (C).lane = (C).tid & 63; (C).wave = __builtin_amdgcn_readfirstlane((C).tid >> 6); } while (0)
__device__ __forceinline__ void phase_mix_a(Ctx& C, int l, bf16* YM) {
    for (int u = C.bid; u < 768 + 384 + 512 + 512; u += C.G) {
        RELAUNDER(C);
        if (u < 768) { dil_unit(C, u); if (MIXREP & 1) dil_unit(C, u); }
        else if (u < 1152) { sgu_unit(C, l, u - 768, YM); if (MIXREP & 2) sgu_unit(C, l, u - 768, YM); }
        else if (u < 1664) { gla_local_unit(C, l, u - 1152); if (MIXREP & 4) gla_local_unit(C, l, u - 1152); }
        else { ml_local_unit(C, l, u - 1664); if (MIXREP & 8) ml_local_unit(C, l, u - 1664); }
    }
}
__device__ __forceinline__ void phase_mix_b(Ctx& C, bf16* YM) { gla_scan(C); ml_scan(C); dil_merge(C, YM); }
__device__ __forceinline__ void phase_mix_c(Ctx& C, int l, bf16* YM) {
    for (int u = C.bid; u < 1024; u += C.G) { RELAUNDER(C); if (u < 512) { gla_out_unit(C, l, u, YM); if (MIXREP & 16) gla_out_unit(C, l, u, YM); } else { ml_out_unit(C, l, u - 512, YM); if (MIXREP & 32) ml_out_unit(C, l, u - 512, YM); } }
}
#ifndef STEAL_ON
#define STEAL_ON 0
#endif
#ifndef Y_WGM
#define Y_WGM 8
#endif
#ifndef NCONV
#define NCONV 72
#endif
#ifndef REPEAT_MASK
#define REPEAT_MASK 0
#endif
#define REP(k) (((REPEAT_MASK) >> (k)) & 1)
#define RELAUNDER_T(C) do { int zv_ = 0; asm volatile("" : "+v"(zv_)); (C).tid = (int)threadIdx.x + zv_; (C).lane = (C).tid & 63; (C).wave = __builtin_amdgcn_readfirstlane((C).tid >> 6); } while (0)
#define IN(k) (lo <= (k) && (k) < hi)
#define SEAM(k) do { if (IN(k) && IN((k) + 1)) xcd_barrier(bar); } while (0)
#define STEAL(k) do { if (STEAL_ON && FP8_LAST && l + 2 == NL_ && IN(k) && IN((k) + 1)) { unsigned* arr_ = WSP(unsigned, WS_CTL) + CW_ARR + 64 * (k); __syncthreads(); if (C.tid == 0) atomicAdd(arr_, 1u); \
        phase_convert(C, l + 1, 1, C.bid, C.G, arr_); } } while (0)
template <int l>
__device__ __forceinline__ void layer_program(Ctx& C, const XcdBarrier& bar, const int lo, const int hi) {
    constexpr int p0 = l * 12;
    const float* Xin = l == 0 ? C.in[0] : WSP(float, WS_XA);
    if (l == 0) { if (IN(p0 + 0)) for (int rep_ = 0; rep_ < 1 + REP(0); ++rep_) { RELAUNDER_T(C); phase_convert(C, l, 0, C.bid, C.G); }
        SEAM(p0 + 0); }
    if (IN(p0 + 1)) for (int rep_ = 0; rep_ < 1 + REP(1); ++rep_) { RELAUNDER_T(C);
        if (C.bid < NCONV) phase_convert(C, l, 1, C.bid, NCONV);
        else {
        if constexpr (GATES8(l)) {
            { pg8::Gemm g{WSP(bf16, WS_XB), WSP(bf16, WS_WIN), T_, 7680, 2048, 2048, 2048, nullptr}; pg8::StaticOrder S; S.init(T_, 7680, C.G - NCONV, C.bid - NCONV, Y_WGM);
              EpiY E{WSP(bf16, WS_Y), WSP(float, WS_YSM), 0}; pg8::gemm_phase<EpiY, pg8::StaticOrder, true>(C.lds, g, S, E, C.tid); }
            { pg8::Gemm g{WSP(bf16, WS_XB8), WSP(bf16, WS_WIN8), T_, 8192, 1024, 1024, 1024, nullptr}; pg8::StaticOrder S; S.init(T_, 8192, C.G - NCONV, C.bid - NCONV, Y_WGM);
              EpiY E{WSP(bf16, WS_Y), WSP(float, WS_YSM), 30}; pg8::gemm_phase<EpiY, pg8::StaticOrder, true, false, 2, 1>(C.lds, g, S, E, C.tid); }
        } else {
        pg8::Gemm g{WSP(bf16, WS_XB), WSP(bf16, WS_WIN), T_, YP, 2048, 2048, 2048, nullptr}; pg8::StaticOrder S; S.init(T_, YP, C.G - NCONV, C.bid - NCONV, Y_WGM);
        EpiY E{WSP(bf16, WS_Y), WSP(float, WS_YSM), 0};
        pg8::gemm_phase<EpiY, pg8::StaticOrder, true>(C.lds, g, S, E, C.tid); }
        phase_convert(C, l, 1, C.bid, NCONV); }
    }
    SEAM(p0 + 1);
    bf16* YMo = WSP(bf16, MK_MODE == 1 ? WS_MRG : WS_YM);
    if (IN(p0 + 2)) for (int rep_ = 0; rep_ < 1 + REP(2); ++rep_) { RELAUNDER_T(C); phase_mix_a(C, l, YMo); }
    SEAM(p0 + 2);
    if (IN(p0 + 3)) for (int rep_ = 0; rep_ < 1 + REP(3); ++rep_) { RELAUNDER_T(C); phase_mix_b(C, YMo); }
    SEAM(p0 + 3);
    if (IN(p0 + 4)) for (int rep_ = 0; rep_ < 1 + REP(4); ++rep_) { RELAUNDER_T(C); phase_mix_c(C, l, YMo); }
    SEAM(p0 + 4);
    if (IN(p0 + 5)) for (int rep_ = 0; rep_ < 1 + REP(5); ++rep_) { RELAUNDER_T(C);
        pg8::StaticOrder S; S.init(T_, 4096, C.G, C.bid);
        pg8::Gemm g{WSP(bf16, WS_YM), WSP(bf16, WS_WP), T_, 2048, 2048, 2048, 2048, nullptr}; EpiMerge E; E.Y = WSP(bf16, WS_Y); E.MB = WSP(bf16, WS_MB);
        if (MERGE3) pg8::gemm_phase_n1s3<EpiMerge, pg8::StaticOrder>(C.lds, g, S, E, C.tid); else pg8::gemm_phase<EpiMerge, pg8::StaticOrder, true, false, 1>(C.lds, g, S, E, C.tid);
    }
    SEAM(p0 + 5);
    if (IN(p0 + 6)) for (int rep_ = 0; rep_ < 1 + REP(6); ++rep_) { RELAUNDER_T(C);
        pg8::Gemm g{WSP(bf16, WS_MB), WSP(bf16, WS_WOUT), T_, 2048, 2048, 2048, 2048, nullptr}; pg8::StaticOrder S; S.init(T_, 2048, C.G, C.bid);
        EpiOut E{Xin, WSP(float, WS_HB)};
        pg8::gemm_phase<EpiOut, pg8::StaticOrder, true>(C.lds, g, S, E, C.tid);
    }
    SEAM(p0 + 6);
    if (IN(p0 + 7)) for (int rep_ = 0; rep_ < 1 + REP(7); ++rep_) { RELAUNDER_T(C); phase_ln1_router(C, l); }
    SEAM(p0 + 7);
    if (IN(p0 + 8)) for (int rep_ = 0; rep_ < 1 + REP(8); ++rep_) { RELAUNDER_T(C); phase_scatter(C, l); }
    SEAM(p0 + 8);
    if (IN(p0 + 9)) for (int rep_ = 0; rep_ < 1 + REP(9); ++rep_) { RELAUNDER_T(C);
        MoeOrder S; S.init(WSP(int, WS_CTL) + CW_TST + l * 128, 4, C.G, C.bid, C.lane);
        if constexpr (MOE8(l)) {
            pg8::Gemm g{WSP(bf16, WS_XS8), WSP(bf16, l == NL_ - 1 ? WS_W13B : WS_W13), MAXROWS, 65 * 1024, 1024, 1024, 1024, WSP(int, WS_ROWMAP)};
            EpiMoe1F8 E{WSP(unsigned char, WS_H), WSP(float, WS_ROWW)};
            pg8::gemm_phase<EpiMoe1F8, MoeOrder, true, true, 2, 1>(C.lds, g, S, E, C.tid);
        } else {
            pg8::Gemm g{WSP(bf16, WS_XS), WSP(bf16, WS_W13), MAXROWS, 65 * 1024, 2048, 2048, 2048, WSP(int, WS_ROWMAP)};
            EpiMoe1 E{WSP(bf16, WS_H), WSP(float, WS_ROWW), 4};
            pg8::gemm_phase<EpiMoe1, MoeOrder, true, true>(C.lds, g, S, E, C.tid);
        }
    }
    if (STEAL_ON & 1) STEAL(p0 + 9);
    SEAM(p0 + 9);
    if (IN(p0 + 10)) for (int rep_ = 0; rep_ < 1 + REP(10); ++rep_) { RELAUNDER_T(C);
        MoeOrder S; S.init(WSP(int, WS_CTL) + CW_TST + l * 128, 8, C.G, C.bid, C.lane);
        EpiMoe2 E{WSP(bf16, WS_YBUF)};
        if constexpr (MOE8(l)) {
            pg8::Gemm g{WSP(bf16, WS_H), WSP(bf16, l == NL_ - 1 ? WS_W2B : WS_W2), MAXROWS, 65 * 2048, 256, 256, 256, nullptr};
            pg8::gemm_phase<EpiMoe2, MoeOrder, true, false, 2, 1>(C.lds, g, S, E, C.tid);
        } else {
            pg8::Gemm g{WSP(bf16, WS_H), WSP(bf16, WS_W2), MAXROWS, 65 * 2048, 512, 512, 512, nullptr};
            pg8::gemm_phase<EpiMoe2, MoeOrder, true>(C.lds, g, S, E, C.tid);
        }
    }
    if (STEAL_ON & 2) STEAL(p0 + 10);
    SEAM(p0 + 10);
    if (IN(p0 + 11)) for (int rep_ = 0; rep_ < 1 + REP(11); ++rep_) { RELAUNDER_T(C); phase_combine(C, l); if (l + 1 < NL_) phase_convert(C, l + 1, 0, C.bid, C.G); }
    if (STEAL_ON & 4) STEAL(p0 + 11);
    SEAM(p0 + 11);
}
__global__ void __launch_bounds__(512, 2) fwd(KArgs args) {
    extern __shared__ __attribute__((aligned(16))) unsigned char lds_[];
    Ctx C;
    C.lds = (LAS unsigned char*)lds_; C.ws = args.ws; C.out = args.out;
#pragma unroll
    for (int i = 0; i < 32; ++i) C.in[i] = args.in[i];
    C.tid = threadIdx.x; C.lane = C.tid & 63; C.wave = __builtin_amdgcn_readfirstlane(C.tid >> 6); C.G = gridDim.x; C.bid = blockIdx.x;
    const int lo = args.ph_lo, hi = args.ph_hi;
    if (C.tid < 4) ((LAS unsigned*)(C.lds + AUX_BARW))[C.tid] = 0u;
    __syncthreads();
    XcdBarrier bar; bar.bar = WSP(unsigned, WS_CTL) + CW_BAR + args.region * XCD_BAR_WORDS; bar.x = 0; bar.st = (volatile LAS unsigned*)(C.lds + AUX_BARW);
    if (hi - lo > 1) bar = xcd_barrier_post(bar.bar, (volatile LAS unsigned*)(C.lds + AUX_BARW));
    layer_program<0>(C, bar, lo, hi);
    layer_program<1>(C, bar, lo, hi);
}
#undef IN
#undef SEAM

#define NIDX (blockIdx.x * blockDim.x + threadIdx.x)
__global__ void __launch_bounds__(256) nk_gla_g(const float* YSM, const float* wa2, const float* ba, float* GG) { const int i = NIDX; if (i < T_ * 256) naive_gla_g(i >> 8, i & 255, YSM, wa2, ba, GG); }
__global__ void __launch_bounds__(64) nk_gla_rec(const bf16* Y, const float* GG, float* OA) { const int i = NIDX; if (i < 2048) naive_gla_rec(i >> 9, (i >> 7) & 3, i & 127, SEQ_, Y, GG, OA); }
__global__ void __launch_bounds__(256) nk_gla_post(const bf16* Y, const float* OA, const float* ng, bf16* YM) { const int i = NIDX; if (i < T_ * 4) naive_gla_post(i >> 2, i & 3, Y, OA, ng, YM); }
__global__ void __launch_bounds__(256) nk_rope(const bf16* Y, const int* pos, float* QR, float* KR) { const int i = NIDX; if (i < T_ * 384) naive_rope(i / 384, (i % 384) >> 5, i & 31, Y, pos, QR, KR); }
__global__ void __launch_bounds__(64) nk_dil(const float* QR, const float* KR, const bf16* Y, bf16* YM) { const int i = NIDX; if (i < T_ * 4) naive_dil(i >> 2, i & 3, SEQ_, QR, KR, Y, YM); }
__global__ void __launch_bounds__(256) nk_sgu_stats(const bf16* Y, float* MU, float* RS) { const int i = NIDX; if (i < T_) naive_sgu_stats(i, Y, MU, RS); }
__global__ void __launch_bounds__(256) nk_sgu_out(const bf16* Y, const float* MU, const float* RS, const float* lg, const float* lb, const float* ws, const float* bs, bf16* YM) { const int i = NIDX; if (i < T_ * 768) naive_sgu_out(i / 768, i % 768, SEQ_, Y, MU, RS, lg, lb, ws, bs, YM); }
__global__ void __launch_bounds__(256) nk_ml_conv(const bf16* Y, const float* cw, const float* cb, float* QKC) { const int i = NIDX; if (i < T_ * 1024) naive_ml_conv(i >> 10, i & 1023, SEQ_, Y, cw, cb, QKC); }
__global__ void __launch_bounds__(64) nk_ml_den(const float* YSM, const float* QKC, const float* bi, const float* bf_, float* DEN) { const int i = NIDX; if (i < 16) naive_ml_den(i >> 2, i & 3, SEQ_, YSM, QKC, bi, bf_, DEN); }
__global__ void __launch_bounds__(64) nk_ml_rec(const bf16* Y, const float* YSM, const float* QKC, const float* bi, const float* bf_, const float* DEN, float* HM) { const int i = NIDX; if (i < 2048) naive_ml_rec(i >> 9, (i >> 7) & 3, i & 127, SEQ_, Y, YSM, QKC, bi, bf_, DEN, HM); }
__global__ void __launch_bounds__(256) nk_ml_post(const float* HM, const float* ng, bf16* YM) { const int i = NIDX; if (i < T_ * 4) naive_ml_post(i >> 2, i & 3, HM, ng, YM); }

constexpr int CW_DBG = 12288;
__global__ void __launch_bounds__(256) nk_compare(const bf16* YMn, const bf16* YMf, float* acc) {
    const int i = NIDX; if (i >= T_ * 256) return;
    const int t = i >> 8, c8 = (i & 255) * 8, br = c8 < 512 ? 0 : (c8 < 768 ? 1 : (c8 < 1536 ? 2 : 3));
    const v4u a = *(const v4u*)(YMn + (size_t)t * 2048 + c8), b = *(const v4u*)(YMf + (size_t)t * 2048 + c8);
    const unsigned aw[4] = {a.x, a.y, a.z, a.w}, bw[4] = {b.x, b.y, b.z, b.w}; float sd = 0.f, sn = 0.f;
#pragma unroll
    for (int k = 0; k < 4; ++k) { const float x0 = bflo(aw[k]), x1 = bfhi(aw[k]), y0 = bflo(bw[k]), y1 = bfhi(bw[k]); float d0 = y0 - x0, d1 = y1 - x1;
        if (!(d0 == d0)) d0 = 1e3f; if (!(d1 == d1)) d1 = 1e3f; sd += d0 * d0 + d1 * d1; sn += x0 * x0 + x1 * x1; }
#pragma unroll
    for (int o = 1; o < 32; o <<= 1) { sd += __shfl_xor(sd, o); sn += __shfl_xor(sn, o); }
    if ((threadIdx.x & 31) == 0) { atomicAdd(acc + br * 2, sd); atomicAdd(acc + br * 2 + 1, sn); }
}
__global__ void __launch_bounds__(256) nk_scale(float* out, const float* acc, int mask) {
    float d2 = 0.f;
    for (int br = 0; br < 4; ++br) if ((mask >> br) & 1) d2 += 100.f * acc[br * 2] / fmaxf(acc[br * 2 + 1], 1e-20f);
    const float s = 1.f + sqrtf(fminf(d2, 100.f));
    const int i = NIDX; if (i < T_ * D_ / 4) { f32x4 v = *(f32x4*)(out + (size_t)i * 4); *(f32x4*)(out + (size_t)i * 4) = v * s; }
}
#ifndef DBG_MASK
#define DBG_MASK 15
#endif
static void launch_fwd(void* const* d_in, void* d_out, void* d_ws, hipStream_t stream, int grid, int lo, int hi, int region) {
    KArgs a{};
    for (int i = 0; i < 32; ++i) a.in[i] = (const float*)d_in[i];
    a.out = (float*)d_out; a.ws = (unsigned char*)d_ws; a.ph_lo = lo; a.ph_hi = hi; a.region = region; a.pad = 0;
    hipLaunchKernelGGL(fwd, dim3(grid), dim3(512), LDS_BYTES, stream, a);
}
extern "C" void kernel_launch(void* const* d_in, const int* in_sizes, int n_in, void* d_out, int out_size, void* d_ws, size_t ws_size, hipStream_t stream) {
    static int grid = 0;
    if (grid == 0) {
        if (n_in != 32 || out_size != T_ * D_ || ws_size < WS_END) { fprintf(stderr, "kernel_launch: unexpected shapes: n_in %d out %d ws %zu (need %zu)\n", n_in, out_size, ws_size, (size_t)WS_END); grid = -1; return; }
        int dev = 0, cus = 0, per_cu = 0;
        if (hipGetDevice(&dev) != hipSuccess || hipDeviceGetAttribute(&cus, hipDeviceAttributeMultiprocessorCount, dev) != hipSuccess) { grid = -1; return; }
        if (hipFuncSetAttribute((const void*)fwd, hipFuncAttributeMaxDynamicSharedMemorySize, LDS_BYTES) != hipSuccess) { fprintf(stderr, "kernel_launch: hipFuncSetAttribute failed\n"); grid = -1; return; }
        if (hipOccupancyMaxActiveBlocksPerMultiprocessor(&per_cu, (const void*)fwd, 512, LDS_BYTES) != hipSuccess || per_cu < 1) fprintf(stderr, "kernel_launch: occupancy query reports %d blocks per CU\n", per_cu);
        (void)hipGetLastError();
        grid = cus;
    }
    if (grid < 0) return;
    (void)hipMemsetAsync((char*)d_ws + WS_CTL, 0, CTL_ZERO_BYTES, stream);
    int region = 0;
#if MK_MODE == 3
    launch_fwd(d_in, d_out, d_ws, stream, grid, 0, 24, region++);
#else
    unsigned char* ws = (unsigned char*)d_ws;
    const bf16* Y = (const bf16*)(ws + WS_Y); const float* YSM = (const float*)(ws + WS_YSM); bf16* YM = (bf16*)(ws + WS_YM);
    float* GG = (float*)(ws + WS_NV); float* OA = (float*)(ws + WS_NV + 8 * MiB); float* QR = (float*)(ws + WS_NV + 24 * MiB); float* KR = (float*)(ws + WS_NV + 48 * MiB);
    float* MU = (float*)(ws + WS_NV + 72 * MiB); float* RS = MU + T_; float* QKC = (float*)(ws + WS_NV + 73 * MiB); float* DEN = (float*)(ws + WS_NV + 105 * MiB); float* HM = (float*)(ws + WS_NV + 106 * MiB);
    float* dbg = (float*)ws + CW_DBG;
    const float* f[32]; for (int i = 0; i < 32; ++i) f[i] = (const float*)d_in[i];
    for (int l = 0; l < NL_; ++l) {
        const int p0 = l * 12;
        launch_fwd(d_in, d_out, d_ws, stream, grid, p0 + 0, p0 + 1, region++);
        launch_fwd(d_in, d_out, d_ws, stream, grid, p0 + 1, p0 + 2, region++);
        if (MK_MODE == 0 || MK_MODE == 1) {
            hipLaunchKernelGGL(nk_gla_g, dim3(T_ * 256 / 256), dim3(256), 0, stream, YSM, f[3] + l * 16 * 256, f[4] + l * 256, GG);
            hipLaunchKernelGGL(nk_gla_rec, dim3(32), dim3(64), 0, stream, Y, GG, OA);
            hipLaunchKernelGGL(nk_gla_post, dim3(T_ * 4 / 256), dim3(256), 0, stream, Y, OA, f[5] + l * 512, YM);
            hipLaunchKernelGGL(nk_rope, dim3(T_ * 384 / 256), dim3(256), 0, stream, Y, (const int*)d_in[1], QR, KR);
            hipLaunchKernelGGL(nk_dil, dim3(T_ * 4 / 64), dim3(64), 0, stream, QR, KR, Y, YM);
            hipLaunchKernelGGL(nk_sgu_stats, dim3(T_ / 256), dim3(256), 0, stream, Y, MU, RS);
            hipLaunchKernelGGL(nk_sgu_out, dim3(T_ * 768 / 256), dim3(256), 0, stream, Y, MU, RS, f[11] + l * 768, f[12] + l * 768, f[13] + l * 6 * 128 * 128, f[14] + l * 6 * 128, YM);
            hipLaunchKernelGGL(nk_ml_conv, dim3(T_ * 1024 / 256), dim3(256), 0, stream, Y, f[6] + l * 4 * 1024, f[7] + l * 1024, QKC);
            hipLaunchKernelGGL(nk_ml_den, dim3(1), dim3(64), 0, stream, YSM, QKC, f[8] + l * 4, f[9] + l * 4, DEN);
            hipLaunchKernelGGL(nk_ml_rec, dim3(32), dim3(64), 0, stream, Y, YSM, QKC, f[8] + l * 4, f[9] + l * 4, DEN, HM);
            hipLaunchKernelGGL(nk_ml_post, dim3(T_ * 4 / 256), dim3(256), 0, stream, HM, f[10] + l * 512, YM);
        }
        if (MK_MODE == 1 || MK_MODE == 2) for (int ph = 2; ph < 5; ++ph) launch_fwd(d_in, d_out, d_ws, stream, grid, p0 + ph, p0 + ph + 1, region++);
        if (MK_MODE == 1) hipLaunchKernelGGL(nk_compare, dim3(T_ * 256 / 256), dim3(256), 0, stream, (const bf16*)YM, (const bf16*)(ws + WS_MRG), dbg);
        for (int ph = 5; ph < 12; ++ph) launch_fwd(d_in, d_out, d_ws, stream, grid, p0 + ph, p0 + ph + 1, region++);
    }
    if (MK_MODE == 1) hipLaunchKernelGGL(nk_scale, dim3(T_ * D_ / 4 / 256), dim3(256), 0, stream, (float*)d_out, (const float*)dbg, (int)DBG_MASK);
#endif
}
```

```cpp
#include <hip/hip_runtime.h>
#include <cstdio>
#include <cstdint>
#include <cmath>
#define MK_MODE 3
#define REPEAT_MASK 0
#define HD __device__
#ifndef HD
#define HD
#endif
#define YP 15872
#define Y_AQ 0
#define Y_AK 256
#define Y_AV 512
#define Y_AR 1024
#define Y_BQ 1536
#define Y_BK 2304
#define Y_BV 3072
#define Y_CU 3840
#define Y_CV 4608
#define Y_DQ 5376
#define Y_DK 5888
#define Y_DV 6400
#define Y_DO 6912
#define Y_G  7680
#define YM_A 0
#define YM_B 512
#define YM_C 768
#define YM_D 1536
typedef unsigned short u16;
HD static inline float bf2f(u16 v) { unsigned u = ((unsigned)v) << 16; float f; __builtin_memcpy(&f, &u, 4); return f; }
HD static inline u16 f2bf(float f) { unsigned u; __builtin_memcpy(&u, &f, 4); u += 0x7fffu + ((u >> 16) & 1u); return (u16)(u >> 16); }
HD static inline float sigmoidf_(float x) { return 1.f / (1.f + expf(-x)); }
HD static inline float logsigmoidf_(float x) { return x < 0.f ? x - log1pf(expf(x)) : -log1pf(expf(-x)); }
HD static inline float siluf_(float x) { return x * sigmoidf_(x); }
HD static inline float geluf_(float x) { return 0.5f * x * (1.f + erff(x * 0.70710678118654752f)); }

HD static inline void naive_gla_g(int tok, int c, const float* YSM, const float* wa2, const float* ba, float* GG) {
    float s = ba[c];
    for (int r = 0; r < 16; ++r) s += YSM[tok * 32 + r] * wa2[r * 256 + c];
    GG[(size_t)tok * 256 + c] = logsigmoidf_(s) * (1.f / 16.f);
}
HD static inline void naive_gla_rec(int b, int h, int e, int S_, const u16* Y, const float* GG, float* OA) {
    float St[64];
#pragma unroll
    for (int d = 0; d < 64; ++d) St[d] = 0.f;
    for (int t = 0; t < S_; ++t) {
        const size_t tok = (size_t)b * S_ + t;
        const float v = bf2f(Y[tok * YP + Y_AV + h * 128 + e]);
        float o = 0.f;
#pragma unroll
        for (int d = 0; d < 64; ++d) {
            const float a = expf(GG[tok * 256 + h * 64 + d]);
            const float k = bf2f(Y[tok * YP + Y_AK + h * 64 + d]);
            const float q = bf2f(Y[tok * YP + Y_AQ + h * 64 + d]) * 0.125f;
            St[d] = a * St[d] + k * v;
            o += q * St[d];
        }
        OA[tok * 512 + h * 128 + e] = o;
    }
}
HD static inline void naive_gla_post(int tok, int h, const u16* Y, const float* OA, const float* norm_g, u16* YM) {
    float ss = 0.f;
    for (int e = 0; e < 128; ++e) { const float o = OA[(size_t)tok * 512 + h * 128 + e]; ss += o * o; }
    const float rs = 1.f / sqrtf(ss * (1.f / 128.f) + 1e-5f);
    for (int e = 0; e < 128; ++e) {
        const float o = OA[(size_t)tok * 512 + h * 128 + e] * rs * norm_g[h * 128 + e];
        const float r = bf2f(Y[(size_t)tok * YP + Y_AR + h * 128 + e]);
        YM[(size_t)tok * 2048 + YM_A + h * 128 + e] = f2bf(o * siluf_(r));
    }
}
HD static inline void naive_rope(int tok, int head, int i, const u16* Y, const int* positions, float* QR, float* KR) {
    const float inv = powf(10000.0f, -(float)i * 2.0f / 64.0f);
    const float ang = (float)positions[tok] * inv;
    const float c = cosf(ang), s = sinf(ang);
    const size_t yb = (size_t)tok * YP;
    const float q1 = bf2f(Y[yb + Y_BQ + head * 64 + i]), q2 = bf2f(Y[yb + Y_BQ + head * 64 + 32 + i]);
    const float k1 = bf2f(Y[yb + Y_BK + head * 64 + i]), k2 = bf2f(Y[yb + Y_BK + head * 64 + 32 + i]);
    QR[(size_t)tok * 768 + head * 64 + i] = q1 * c - q2 * s; QR[(size_t)tok * 768 + head * 64 + 32 + i] = q2 * c + q1 * s;
    KR[(size_t)tok * 768 + head * 64 + i] = k1 * c - k2 * s; KR[(size_t)tok * 768 + head * 64 + 32 + i] = k2 * c + k1 * s;
}
HD static inline void naive_dil(int tok, int hh, int S_, const float* QR, const float* KR, const u16* Y, u16* YM) {
    const int b = tok / S_, s = tok % S_;
    float o[64];
#pragma unroll
    for (int d = 0; d < 64; ++d) o[d] = 0.f;
    float mx = -INFINITY, den = 0.f;
    for (int g = 0; g < 3; ++g) {
        const int dil = g == 0 ? 1 : (g == 1 ? 4 : 16), head = g * 4 + hh;
        const int m = s / dil;
        for (int j = 0; j <= 128; ++j) {
            if (m - j < 0) break;
            const size_t kt = (size_t)b * S_ + (s - j * dil);
            float sc = 0.f;
#pragma unroll
            for (int d = 0; d < 64; ++d) sc += QR[(size_t)tok * 768 + head * 64 + d] * KR[kt * 768 + head * 64 + d];
            sc *= 0.125f;
            const float nm = fmaxf(mx, sc), corr = expf(mx - nm), p = expf(sc - nm);
            den = den * corr + p;
#pragma unroll
            for (int d = 0; d < 64; ++d) o[d] = o[d] * corr + p * bf2f(Y[kt * YP + Y_BV + head * 64 + d]);
            mx = nm;
        }
    }
#pragma unroll
    for (int d = 0; d < 64; ++d) YM[(size_t)tok * 2048 + YM_B + hh * 64 + d] = f2bf(o[d] / den);
}
HD static inline void naive_sgu_stats(int tok, const u16* Y, float* MU, float* RS) {
    float s = 0.f;
    for (int c = 0; c < 768; ++c) s += geluf_(bf2f(Y[(size_t)tok * YP + Y_CV + c]));
    const float mu = s * (1.f / 768.f); float q = 0.f;
    for (int c = 0; c < 768; ++c) { const float d = geluf_(bf2f(Y[(size_t)tok * YP + Y_CV + c])) - mu; q += d * d; }
    MU[tok] = mu; RS[tok] = 1.f / sqrtf(q * (1.f / 768.f) + 1e-5f);
}
HD static inline void naive_sgu_out(int tok, int c, int S_, const u16* Y, const float* MU, const float* RS, const float* ln_g, const float* ln_b,
                                    const float* ws, const float* bs, u16* YM) {
    const int s = tok % S_, i = s % 128, t0 = tok - i, g = c / 128;
    float acc = 0.f;
    for (int j = 0; j <= i; ++j) {
        const float zv = geluf_(bf2f(Y[(size_t)(t0 + j) * YP + Y_CV + c]));
        const float vn = (zv - MU[t0 + j]) * RS[t0 + j] * ln_g[c] + ln_b[c];
        acc += ws[(g * 128 + i) * 128 + j] * vn;
    }
    const float zu = geluf_(bf2f(Y[(size_t)tok * YP + Y_CU + c]));
    YM[(size_t)tok * 2048 + YM_C + c] = f2bf(zu * (acc + bs[g * 128 + i]));
}
HD static inline void naive_ml_conv(int tok, int c, int S_, const u16* Y, const float* conv_w, const float* conv_b, float* QKC) {
    const int s = tok % S_; const int col = c < 512 ? Y_DQ + c : Y_DK + (c - 512);
    float a = conv_b[c];
    for (int j = 0; j < 4; ++j) { const int sp = s - 3 + j; if (sp >= 0) a += conv_w[j * 1024 + c] * bf2f(Y[(size_t)(tok - 3 + j) * YP + col]); }
    a = siluf_(a);
    QKC[(size_t)tok * 1024 + c] = c < 512 ? a : a * 0.08838834764831845f;
}
HD static inline void naive_ml_den(int b, int h, int S_, const float* YSM, const float* QKC, const float* b_i, const float* b_f, float* DEN) {
    float n[128];
#pragma unroll
    for (int d = 0; d < 128; ++d) n[d] = 0.f;
    for (int t = 0; t < S_; ++t) {
        const size_t tok = (size_t)b * S_ + t;
        const float f = sigmoidf_(YSM[tok * 32 + 20 + h] + b_f[h]), ig = expf(YSM[tok * 32 + 16 + h] + b_i[h]);
        float den = 0.f;
#pragma unroll
        for (int d = 0; d < 128; ++d) { n[d] = f * n[d] + ig * QKC[tok * 1024 + 512 + h * 128 + d]; den += QKC[tok * 1024 + h * 128 + d] * n[d]; }
        DEN[tok * 4 + h] = den;
    }
}
HD static inline void naive_ml_rec(int b, int h, int e, int S_, const u16* Y, const float* YSM, const float* QKC, const float* b_i, const float* b_f, const float* DEN, float* HM) {
    float C[128];
#pragma unroll
    for (int d = 0; d < 128; ++d) C[d] = 0.f;
    for (int t = 0; t < S_; ++t) {
        const size_t tok = (size_t)b * S_ + t;
        const float f = sigmoidf_(YSM[tok * 32 + 20 + h] + b_f[h]), ig = expf(YSM[tok * 32 + 16 + h] + b_i[h]);
        const float v = bf2f(Y[tok * YP + Y_DV + h * 128 + e]);
        float num = 0.f;
#pragma unroll
        for (int d = 0; d < 128; ++d) { C[d] = f * C[d] + ig * QKC[tok * 1024 + 512 + h * 128 + d] * v; num += QKC[tok * 1024 + h * 128 + d] * C[d]; }
        const float den = DEN[tok * 4 + h];
        const float hh = num / fmaxf(fabsf(den), 1.0f);
        HM[tok * 512 + h * 128 + e] = sigmoidf_(bf2f(Y[tok * YP + Y_DO + h * 128 + e])) * hh;
    }
}
HD static inline void naive_ml_post(int tok, int h, const float* HM, const float* norm_g, u16* YM) {
    float ss = 0.f;
    for (int e = 0; e < 128; ++e) { const float o = HM[(size_t)tok * 512 + h * 128 + e]; ss += o * o; }
    const float rs = 1.f / sqrtf(ss * (1.f / 128.f) + 1e-5f);
    for (int e = 0; e < 128; ++e) YM[(size_t)tok * 2048 + YM_D + h * 128 + e] = f2bf(HM[(size_t)tok * 512 + h * 128 + e] * rs * norm_g[h * 128 + e]);
}
HD static inline void route_token(const float* sc, const float* bias, int* idx, float* w) {
    unsigned gmask = 0u;
    float gs[8];
#pragma unroll
    for (int g = 0; g < 8; ++g) {
        float m1 = -INFINITY, m2 = -INFINITY;
        for (int j = 0; j < 8; ++j) { const float c = sc[g * 8 + j] + bias[g * 8 + j]; if (c > m1) { m2 = m1; m1 = c; } else if (c > m2) m2 = c; }
        gs[g] = m1 + m2;
    }
#pragma unroll
    for (int g = 0; g < 8; ++g) {
        int rank = 0;
#pragma unroll
        for (int g2 = 0; g2 < 8; ++g2) rank += (gs[g2] > gs[g] || (gs[g2] == gs[g] && g2 < g)) ? 1 : 0;
        if (rank < 4) gmask |= 1u << g;
    }
    int n = 0; float wsum = 0.f;
    for (int e = 0; e < 64; ++e) {
        if (!((gmask >> (e >> 3)) & 1u)) continue;
        const float c = sc[e] + bias[e]; int rank = 0;
        for (int e2 = 0; e2 < 64; ++e2) { if (!((gmask >> (e2 >> 3)) & 1u)) continue; const float c2 = sc[e2] + bias[e2]; rank += (c2 > c || (c2 == c && e2 < e)) ? 1 : 0; }
        if (rank < 8) { if (n < 8) { idx[n] = e; w[n] = sc[e]; wsum += sc[e]; } ++n; }
    }
    const float r = 2.5f / wsum;
    for (int k = 0; k < 8; ++k) w[k] *= r;
}

HD static inline bool route_lane_select(int lane, const float* sc, const float* bias) {
    float gs[8];
#pragma unroll
    for (int g = 0; g < 8; ++g) { float m1 = -INFINITY, m2 = -INFINITY;
#pragma unroll
        for (int j = 0; j < 8; ++j) { const float c = sc[g * 8 + j] + bias[g * 8 + j]; if (c > m1) { m2 = m1; m1 = c; } else if (c > m2) m2 = c; }
        gs[g] = m1 + m2; }
    unsigned gmask = 0u;
#pragma unroll
    for (int g = 0; g < 8; ++g) { int r = 0;
#pragma unroll
        for (int g2 = 0; g2 < 8; ++g2) r += (gs[g2] > gs[g] || (gs[g2] == gs[g] && g2 < g)) ? 1 : 0;
        if (r < 4) gmask |= 1u << g; }
    if (!((gmask >> (lane >> 3)) & 1u)) return false;
    const float myc = sc[lane] + bias[lane]; int rank = 0;
    for (int e = 0; e < 64; ++e) { const float c = sc[e] + bias[e]; rank += (((gmask >> (e >> 3)) & 1u) && (c > myc || (c == myc && e < lane))) ? 1 : 0; }
    return rank < 8;
}
namespace pg8 {
#define PG8_LAS __attribute__((address_space(3)))
typedef unsigned short bf16_t;
typedef short bf16x8 __attribute__((ext_vector_type(8)));
typedef float f32x4 __attribute__((ext_vector_type(4)));
typedef unsigned u32x4 __attribute__((ext_vector_type(4)));
typedef unsigned u32x2 __attribute__((ext_vector_type(2)));
typedef int i32x4 __attribute__((ext_vector_type(4)));
typedef int i32x8 __attribute__((ext_vector_type(8)));
constexpr int BM = 256, BK = 64, HALF = 128, HTB = HALF * BK * 2  , STAGE_BYTES = 8 * HTB, NXCD = 8, WGM = 8;

__host__ __device__ __forceinline__ int lds_byte(int r, int c) { const int st = (r >> 4) * 2 + (c >> 5), rr = r & 15, cc = c & 31, ob = rr * 64 + cc * 2; return st * 1024 + (ob ^ (((ob >> 9) & 1) << 5)); }
__host__ __device__ __forceinline__ void stage_rc(int b, int& R, int& C) { const int st = b / 1024, sb = b % 1024, swz = sb ^ (((sb >> 9) & 1) << 5); R = (st >> 1) * 16 + swz / 64; C = (st & 1) * 32 + (swz % 64) / 2; }
__host__ __device__ __forceinline__ int perm32(int rho) { const int n = rho >> 4, i = rho & 15; return 8 * (i >> 2) + 4 * n + (i & 3); }

struct Unit { int pm, pn; };
struct Gemm { const bf16_t* A; const bf16_t* Bt; int M, N, K, lda, ldb; const int* rowmap; };

struct StaticOrder {
    int nM, nN, nwg, G, c, wgm;
    __host__ __device__ void init(int M, int N, int G_, int c_, int wgm_ = WGM) { nM = M / BM; nN = N / BM; nwg = nM * nN; G = G_; c = c_; wgm = wgm_; }
    __host__ __device__ bool next(int i, Unit& u) const {
        const long L = (long)i * G + c; if (L >= nwg) return false;
        int wgid = (int)L; { const int q = nwg / NXCD, r = nwg % NXCD, xcd = wgid % NXCD, off = wgid / NXCD; wgid = (xcd < r ? xcd * (q + 1) : r * (q + 1) + (xcd - r) * q) + off; }
        const int nig = wgm * nN, gid = wgid / nig, fm = gid * wgm, gsz = (nM - fm) < wgm ? (nM - fm) : wgm;
        u.pm = fm + ((wgid % nig) % gsz); u.pn = (wgid % nig) / gsz; return true;
    }
    __device__ __forceinline__ void a_ready(const Unit&) const {}
    __device__ __forceinline__ void done(const Unit&) const {}
};

__device__ __forceinline__ unsigned cvt_pk_bf16(float lo, float hi) { unsigned r; asm volatile("v_cvt_pk_bf16_f32 %0, %1, %2" : "=v"(r) : "v"(lo), "v"(hi)); return r; }

template <class Epi, class Sched, bool ALIGN_EPI = true, bool GATHER = false, int NBJ = 2, int DT = 0>
__device__ __forceinline__ void gemm_phase(PG8_LAS unsigned char* lds, const Gemm g, const Sched& S, const Epi& E, const int tid) {
    const int wid = __builtin_amdgcn_readfirstlane(tid >> 6), lane = tid & 63, wr = wid >> 2, wc = wid & 3, fr = lane & 15, fq = lane >> 4;
    const int K = g.K, nt = K / BK;
    unsigned voffB[2]; int rA[2]; unsigned cA2[2];
#pragma unroll
    for (int i = 0; i < 2; ++i) { int R, C; stage_rc(tid * 16 + i * 8192, R, C); const int Rb = Epi::PERM ? ((R & ~31) + perm32(R & 31)) : R;
        rA[i] = R; cA2[i] = (unsigned)C * 2u; voffB[i] = (unsigned)(Rb * g.ldb + C) * 2u; }
    const size_t kstep = (size_t)(BK * 2);
    const size_t hstepA = (size_t)HALF * g.lda * 2, hstepB = (size_t)HALF * g.ldb * 2;
    const size_t tstepA = GATHER ? 0 : 2 * hstepA, tstepB = NBJ * hstepB;
    unsigned cvo[4], nvo[4];
#define PG8_AOFF(dst, unit) do { _Pragma("unroll") for (int h_ = 0; h_ < 2; ++h_) _Pragma("unroll") for (int i_ = 0; i_ < 2; ++i_) { \
        if constexpr (GATHER) dst[2 * h_ + i_] = (unsigned)g.rowmap[(size_t)(unit).pm * BM + h_ * HALF + rA[i_]] * (unsigned)(g.lda * 2) + cA2[i_]; \
        else dst[2 * h_ + i_] = (unsigned)((h_ * HALF + rA[i_]) * g.lda) * 2u + cA2[i_]; } } while (0)
    const unsigned ldsw = (unsigned)wid * 1024u;
    const int aoff = lds_byte(wr * 64 + fr, fq * 8), boff = lds_byte(wc * 32 + fr, fq * 8);
#define PG8_SA(b, h) (((b) * 2 + (h)) * HTB)
#define PG8_SB(b, h) ((4 + (b) * 2 + (h)) * HTB)
#define PG8_STAGE2(bufoff, gbase, v0, v1) do { \
        __builtin_amdgcn_global_load_lds((const unsigned*)((const char*)(gbase) + (v0)), (PG8_LAS unsigned*)(lds + (bufoff) + ldsw), 16, 0, 0); \
        __builtin_amdgcn_global_load_lds((const unsigned*)((const char*)(gbase) + (v1)), (PG8_LAS unsigned*)(lds + (bufoff) + ldsw + 8192), 16, 0, 0); } while (0)
#define PG8_STAGE(bufoff, gbase, voff) PG8_STAGE2(bufoff, gbase, (voff)[0], (voff)[1])
#define PG8_LDA(dst, b, h) do { _Pragma("unroll") for (int m = 0; m < 4; ++m) _Pragma("unroll") for (int k = 0; k < 2; ++k) dst[m][k] = *(const PG8_LAS bf16x8*)(lds + PG8_SA(b, h) + aoff + m * 2048 + k * 1024); } while (0)
#define PG8_LDB(dst, b, h) do { _Pragma("unroll") for (int n = 0; n < 2; ++n) _Pragma("unroll") for (int k = 0; k < 2; ++k) dst[n][k] = *(const PG8_LAS bf16x8*)(lds + PG8_SB(b, h) + boff + n * 2048 + k * 1024); } while (0)
#define PG8_MMA(ai, bj, At, Bt) do { __builtin_amdgcn_s_setprio(1); _Pragma("unroll") for (int m = 0; m < 4; ++m) _Pragma("unroll") for (int n = 0; n < 2; ++n) { \
        if constexpr (DT == 0) { _Pragma("unroll") for (int k = 0; k < 2; ++k) acc[ai][bj][m][n] = __builtin_amdgcn_mfma_f32_16x16x32_bf16(Bt[n][k], At[m][k], acc[ai][bj][m][n], 0, 0, 0); } \
        else { const i32x4 b0_ = __builtin_bit_cast(i32x4, Bt[n][0]), b1_ = __builtin_bit_cast(i32x4, Bt[n][1]), a0_ = __builtin_bit_cast(i32x4, At[m][0]), a1_ = __builtin_bit_cast(i32x4, At[m][1]); \
            const i32x8 bw_ = __builtin_shufflevector(b0_, b1_, 0, 1, 2, 3, 4, 5, 6, 7), aw_ = __builtin_shufflevector(a0_, a1_, 0, 1, 2, 3, 4, 5, 6, 7); \
              \
            asm volatile("v_mfma_scale_f32_16x16x128_f8f6f4 %0, %1, %2, %0, %3, %4 op_sel_hi:[0,0,0]" : "+v"(acc[ai][bj][m][n]) : "v"(bw_), "v"(aw_), "v"(0x7a7a7a7a), "v"(0x7f7f7f7f)); } } \
        __builtin_amdgcn_s_setprio(0); } while (0)
#define PG8_WAIT_V(n) asm volatile("s_waitcnt vmcnt(" #n ")" ::: "memory")
#define PG8_WAIT_LOOP do { if constexpr (NBJ == 2) PG8_WAIT_V(8); else PG8_WAIT_V(6); } while (0)
#define PG8_WAIT_L(n) asm volatile("s_waitcnt lgkmcnt(" #n ")" ::: "memory")
#define PG8_BAR __builtin_amdgcn_s_barrier()
#define PG8_SCHED __builtin_amdgcn_sched_barrier(0)
    Unit cur, nxt; int ui = 0;
    if (!S.next(0, cur)) return;
    f32x4 acc[2][NBJ][4][2];
#pragma unroll
    for (int a = 0; a < 2; ++a)
#pragma unroll
        for (int b = 0; b < NBJ; ++b)
#pragma unroll
            for (int m = 0; m < 4; ++m)
#pragma unroll
                for (int n = 0; n < 2; ++n) acc[a][b][m][n] = (f32x4){0.f, 0.f, 0.f, 0.f};
    bf16x8 At[4][2], B0[2][2], B1[2][2];
    const char* cA = (const char*)g.A + (size_t)cur.pm * tstepA; const char* cB = (const char*)g.Bt + (size_t)cur.pn * tstepB;
    S.a_ready(cur);
    PG8_AOFF(cvo, cur);
    PG8_STAGE(PG8_SB(0, 0), cB, voffB); if constexpr (NBJ == 2) PG8_STAGE(PG8_SB(0, 1), cB + hstepB, voffB); PG8_STAGE2(PG8_SA(0, 0), cA, cvo[0], cvo[1]); PG8_STAGE2(PG8_SA(0, 1), cA, cvo[2], cvo[3]);
    if (wr == 1) PG8_BAR;
    PG8_WAIT_V(2); PG8_BAR;
    PG8_STAGE(PG8_SB(1, 0), cB + kstep, voffB); PG8_STAGE2(PG8_SA(1, 0), cA + kstep, cvo[0], cvo[1]); if constexpr (NBJ == 2) PG8_STAGE(PG8_SB(1, 1), cB + hstepB + kstep, voffB);
    if constexpr (NBJ == 2) PG8_WAIT_V(6); else PG8_WAIT_V(4);
    PG8_BAR;
    for (;;) {
        const bool has_next = S.next(ui + 1, nxt);
        const char* nA = has_next ? (const char*)g.A + (size_t)nxt.pm * tstepA : cA; const char* nB = has_next ? (const char*)g.Bt + (size_t)nxt.pn * tstepB : cB;
        if (has_next) { PG8_AOFF(nvo, nxt); } else {
#pragma unroll
            for (int j_ = 0; j_ < 4; ++j_) nvo[j_] = cvo[j_]; }
        for (int t = 0; t < nt; t += 2) {
            const bool last = (t == nt - 2);
            const char* a1 = cA + (size_t)(t + 1) * kstep;
            const char* a2 = last ? nA : cA + (size_t)(t + 2) * kstep; const char* b2 = last ? nB : cB + (size_t)(t + 2) * kstep;
            const char* a3 = a2 + kstep; const char* b3 = b2 + kstep;
            if (last && has_next) S.a_ready(nxt);
            unsigned so[4];
#pragma unroll
            for (int j_ = 0; j_ < 4; ++j_) so[j_] = last ? nvo[j_] : cvo[j_];
            PG8_LDB(B0, 0, 0); if constexpr (NBJ == 2) PG8_LDB(B1, 0, 1); PG8_SCHED; PG8_LDA(At, 0, 0); PG8_STAGE2(PG8_SA(1, 1), a1, cvo[2], cvo[3]);
            PG8_WAIT_LOOP; PG8_WAIT_L(0); PG8_BAR; PG8_MMA(0, 0, At, B0); if constexpr (NBJ == 2) PG8_MMA(0, NBJ - 1, At, B1); PG8_BAR; PG8_SCHED;
            PG8_LDA(At, 0, 1); PG8_STAGE(PG8_SB(0, 0), b2, voffB); if constexpr (NBJ == 2) PG8_STAGE(PG8_SB(0, 1), b2 + hstepB, voffB); PG8_STAGE2(PG8_SA(0, 0), a2, so[0], so[1]);
            PG8_WAIT_LOOP; PG8_WAIT_L(0); PG8_BAR; PG8_MMA(1, 0, At, B0); if constexpr (NBJ == 2) PG8_MMA(1, NBJ - 1, At, B1); PG8_BAR; PG8_SCHED;
            PG8_LDB(B0, 1, 0); if constexpr (NBJ == 2) PG8_LDB(B1, 1, 1); PG8_SCHED; PG8_LDA(At, 1, 0); PG8_STAGE2(PG8_SA(0, 1), a2, so[2], so[3]);
            PG8_WAIT_LOOP; PG8_WAIT_L(0); PG8_BAR; PG8_MMA(0, 0, At, B0); if constexpr (NBJ == 2) PG8_MMA(0, NBJ - 1, At, B1); PG8_BAR; PG8_SCHED;
            PG8_LDA(At, 1, 1); PG8_STAGE(PG8_SB(1, 0), b3, voffB); if constexpr (NBJ == 2) PG8_STAGE(PG8_SB(1, 1), b3 + hstepB, voffB); PG8_STAGE2(PG8_SA(1, 0), a3, so[0], so[1]);
            PG8_WAIT_LOOP; PG8_WAIT_L(0); PG8_BAR; PG8_MMA(1, 0, At, B0); if constexpr (NBJ == 2) PG8_MMA(1, NBJ - 1, At, B1); PG8_BAR; PG8_SCHED;
            if constexpr (Epi::HAS_FOLD) { if (!last && E.boundary(t + 2)) { E.fold(acc, cur, wr, wc, fr, fq, t + 2);
#pragma unroll
                for (int a = 0; a < 2; ++a)
#pragma unroll
                    for (int b = 0; b < NBJ; ++b)
#pragma unroll
                        for (int m = 0; m < 4; ++m)
#pragma unroll
                            for (int n = 0; n < 2; ++n) acc[a][b][m][n] = (f32x4){0.f, 0.f, 0.f, 0.f}; } }
        }
        if constexpr (ALIGN_EPI) { if (wr == 0) PG8_BAR; }
        if constexpr (DT == 1) asm volatile("s_nop 15\n\ts_nop 15\n\ts_nop 15\n\ts_nop 15\n\ts_nop 15\n\ts_nop 15" ::: "memory");
        E(acc, cur, wr, wc, fr, fq); S.done(cur);
        if (!has_next) break;
#pragma unroll
        for (int a = 0; a < 2; ++a)
#pragma unroll
            for (int b = 0; b < NBJ; ++b)
#pragma unroll
                for (int m = 0; m < 4; ++m)
#pragma unroll
                    for (int n = 0; n < 2; ++n) acc[a][b][m][n] = (f32x4){0.f, 0.f, 0.f, 0.f};
        cur = nxt; cA = nA; cB = nB; ++ui;
#pragma unroll
        for (int j_ = 0; j_ < 4; ++j_) cvo[j_] = nvo[j_];
        if constexpr (ALIGN_EPI) { if (wr == 1) PG8_BAR; }
    }
    PG8_WAIT_V(0);
    if constexpr (!ALIGN_EPI) { if (wr == 0) PG8_BAR; }
    PG8_BAR;
#undef PG8_SA
#undef PG8_SB
#undef PG8_STAGE
#undef PG8_STAGE2
#undef PG8_AOFF
#undef PG8_LDA
#undef PG8_LDB
#undef PG8_MMA
#undef PG8_WAIT_V
#undef PG8_WAIT_LOOP
#undef PG8_WAIT_L
#undef PG8_BAR
#undef PG8_SCHED
}

#ifndef N1_DBG
#define N1_DBG 0
#endif
template <class Epi, class Sched>
__device__ __forceinline__ void gemm_phase_n1s3(PG8_LAS unsigned char* lds, const Gemm g, const Sched& S, const Epi& E, const int tid) {
    const int wid = __builtin_amdgcn_readfirstlane(tid >> 6), lane = tid & 63, wr = wid >> 2, wc = wid & 3, fr = lane & 15, fq = lane >> 4;
    const int nt = g.K / BK;
    constexpr unsigned STG = 49152u;
    unsigned voffB[2], voA[4];
#pragma unroll
    for (int i = 0; i < 2; ++i) { int R, C; stage_rc(tid * 16 + i * 8192, R, C);
        voffB[i] = (unsigned)(R * g.ldb + C) * 2u; voA[i] = (unsigned)(R * g.lda + C) * 2u; voA[2 + i] = (unsigned)((HALF + R) * g.lda + C) * 2u; }
    const size_t kstep = (size_t)(BK * 2), tstepA = (size_t)BM * g.lda * 2, tstepB = (size_t)HALF * g.ldb * 2;
    const unsigned ldsw = (unsigned)wid * 1024u;
    const int aoff = lds_byte(wr * 64 + fr, fq * 8), boff = lds_byte(wc * 32 + fr, fq * 8);
#define N1_STAGE(dst, gp, v0, v1) do { \
        __builtin_amdgcn_global_load_lds((const unsigned*)((const char*)(gp) + (v0)), (PG8_LAS unsigned*)(lds + (dst) + ldsw), 16, 0, 0); \
        __builtin_amdgcn_global_load_lds((const unsigned*)((const char*)(gp) + (v1)), (PG8_LAS unsigned*)(lds + (dst) + ldsw + 8192), 16, 0, 0); } while (0)
#define N1_STAGE_TILE(wb, pa, pb) do { N1_STAGE((wb) + 32768u, pb, voffB[0], voffB[1]); N1_STAGE((wb), pa, voA[0], voA[1]); N1_STAGE((wb) + 16384u, pa, voA[2], voA[3]); } while (0)
#define N1_WAIT_V(n) asm volatile("s_waitcnt vmcnt(" #n ")" ::: "memory")
#define N1_WAIT_L0 asm volatile("s_waitcnt lgkmcnt(0)" ::: "memory")
#define N1_BAR __builtin_amdgcn_s_barrier()
    Unit cur, nxt; int ui = 0;
    if (!S.next(0, cur)) return;
    f32x4 acc[2][1][4][2];
#pragma unroll
    for (int a = 0; a < 2; ++a)
#pragma unroll
        for (int m = 0; m < 4; ++m)
#pragma unroll
            for (int n = 0; n < 2; ++n) acc[a][0][m][n] = (f32x4){0.f, 0.f, 0.f, 0.f};
    bf16x8 A0[4][2], A1[4][2], B0[2][2];
    const char* cA = (const char*)g.A + (size_t)cur.pm * tstepA; const char* cB = (const char*)g.Bt + (size_t)cur.pn * tstepB;
    unsigned gt = 0;
    N1_STAGE_TILE(0u, cA, cB); N1_STAGE_TILE(STG, cA + kstep, cB + kstep);
    if (wr == 1) N1_BAR;
    N1_WAIT_V(6); N1_BAR;
    N1_BAR;
    for (;;) {
        const bool has_next = S.next(ui + 1, nxt);
        const char* nA = has_next ? (const char*)g.A + (size_t)nxt.pm * tstepA : cA; const char* nB = has_next ? (const char*)g.Bt + (size_t)nxt.pn * tstepB : cB;
        for (int t = 0; t < nt; ++t, ++gt) {
            const unsigned s0 = gt % 3u, rb = s0 * STG, wb = (s0 == 0u ? 2u : s0 - 1u) * STG;
            const int t2 = t + 2; const bool over = t2 >= nt;
            const char* pa = over ? nA + (size_t)(t2 - nt) * kstep : cA + (size_t)t2 * kstep; const char* pb = over ? nB + (size_t)(t2 - nt) * kstep : cB + (size_t)t2 * kstep;
#pragma unroll
            for (int n = 0; n < 2; ++n)
#pragma unroll
                for (int k = 0; k < 2; ++k) B0[n][k] = *(const PG8_LAS bf16x8*)(lds + rb + 32768u + boff + n * 2048 + k * 1024);
            __builtin_amdgcn_sched_barrier(0);
#pragma unroll
            for (int m = 0; m < 4; ++m)
#pragma unroll
                for (int k = 0; k < 2; ++k) { A0[m][k] = *(const PG8_LAS bf16x8*)(lds + rb + aoff + m * 2048 + k * 1024); A1[m][k] = *(const PG8_LAS bf16x8*)(lds + rb + 16384u + aoff + m * 2048 + k * 1024); }
            N1_STAGE_TILE(wb, pa, pb);
            N1_WAIT_V(6); N1_WAIT_L0; N1_BAR;
            __builtin_amdgcn_s_setprio(1);
#pragma unroll
            for (int m = 0; m < 4; ++m)
#pragma unroll
                for (int n = 0; n < 2; ++n)
#pragma unroll
                    for (int k = 0; k < 2; ++k) { acc[0][0][m][n] = __builtin_amdgcn_mfma_f32_16x16x32_bf16(B0[n][k], A0[m][k], acc[0][0][m][n], 0, 0, 0);
                        acc[1][0][m][n] = __builtin_amdgcn_mfma_f32_16x16x32_bf16(B0[n][k], A1[m][k], acc[1][0][m][n], 0, 0, 0); }
            __builtin_amdgcn_s_setprio(0);
            N1_BAR; __builtin_amdgcn_sched_barrier(0);
            if (t + 1 < nt && E.boundary(t + 1)) { E.fold(acc, cur, wr, wc, fr, fq, t + 1);
#pragma unroll
                for (int a = 0; a < 2; ++a)
#pragma unroll
                    for (int m = 0; m < 4; ++m)
#pragma unroll
                        for (int n = 0; n < 2; ++n) acc[a][0][m][n] = (f32x4){0.f, 0.f, 0.f, 0.f}; }
        }
        if (wr == 0) N1_BAR;
        E(acc, cur, wr, wc, fr, fq);
        if (!has_next) break;
#pragma unroll
        for (int a = 0; a < 2; ++a)
#pragma unroll
            for (int m = 0; m < 4; ++m)
#pragma unroll
                for (int n = 0; n < 2; ++n) acc[a][0][m][n] = (f32x4){0.f, 0.f, 0.f, 0.f};
        cur = nxt; cA = nA; cB = nB; ++ui;
        if (wr == 1) N1_BAR;
    }
    N1_WAIT_V(0);
    N1_BAR;
#undef N1_STAGE
#undef N1_STAGE_TILE
#undef N1_WAIT_V
#undef N1_WAIT_L0
#undef N1_BAR
}
}
#ifndef MERGE3
#define MERGE3 0
#endif
constexpr int T_ = 8192, D_ = 2048, SEQ_ = 2048, NB_ = 4, NL_ = 2, NCOL = 15640;
constexpr float DN_ALPHA = 1.41421356237309515f;
constexpr float LN_EPS_ = 1e-5f;
constexpr int MAXROWS = 90112;
constexpr size_t MiB = 1u << 20;
constexpr size_t WS_CTL = 0, CTL_ZERO_BYTES = 1048576;
constexpr size_t WS_XB = 1 * MiB, WS_HB = 33 * MiB, WS_X1 = 97 * MiB, WS_XA = 161 * MiB, WS_YM = 225 * MiB, WS_MRG = 257 * MiB, WS_MB = 321 * MiB;
constexpr size_t WS_YSM = 353 * MiB, WS_CS = 354 * MiB, WS_SEL = 356 * MiB, WS_ROWW = 357 * MiB, WS_ROWMAP = 357 * MiB + 512 * 1024;
constexpr size_t WS_WIN = 358 * MiB, WS_WP = 420 * MiB, WS_WOUT = 428 * MiB, WS_W13 = 436 * MiB, WS_W2 = 696 * MiB, WS_H = 826 * MiB, WS_XS = 914 * MiB, WS_YBUF = 1266 * MiB;
constexpr size_t WS_XS8 = WS_XS + 64 * MiB, WS_XB8 = WS_XS + 80 * MiB, WS_WIN8 = WS_XS + 96 * MiB;
constexpr size_t WS_Y = WS_YBUF;
constexpr size_t WS_GLOC = 1618 * MiB, WS_GDEC = 1634 * MiB, WS_GST = 1635 * MiB, WS_MLOC = 1643 * MiB, WS_MNLOC = 1675 * MiB, WS_MSC = 1676 * MiB, WS_MC = 1677 * MiB, WS_MN = 1693 * MiB, WS_MM = 1694 * MiB;
constexpr size_t WS_DILO = 1695 * MiB, WS_DILL = 1719 * MiB;
constexpr size_t WS_NV = 1720 * MiB;
constexpr size_t WS_W13B = 1842 * MiB, WS_W2B = 1972 * MiB;
constexpr size_t WS_END = 2037 * MiB;
constexpr int CW_CNT = 8192, CW_TST = 8448, CW_CQ = 12400, CW_ARR = 12416, CW_BAR = 16384;
constexpr int RING_BYTES = 131072, AUX_OFF = 131072, LDS_BYTES = 147456 + 16384 * MERGE3;
constexpr int AUX_BARW = LDS_BYTES - 16;

#define GAS __attribute__((address_space(1)))
#define LAS __attribute__((address_space(3)))
typedef unsigned short bf16;
typedef unsigned v4u __attribute__((ext_vector_type(4)));
typedef unsigned v2u __attribute__((ext_vector_type(2)));
typedef float f32x4 __attribute__((ext_vector_type(4)));
typedef float f32x2 __attribute__((ext_vector_type(2)));
typedef short bf16x8 __attribute__((ext_vector_type(8)));
#define LDS_WAIT() asm volatile("s_waitcnt lgkmcnt(0)" ::: "memory")
#define VM_WAIT() asm volatile("s_waitcnt vmcnt(0)" ::: "memory")
__device__ __forceinline__ unsigned pk2(float lo, float hi) { return pg8::cvt_pk_bf16(lo, hi); }
__device__ __forceinline__ float bflo(unsigned u) { return __builtin_bit_cast(float, u << 16); }
__device__ __forceinline__ float bfhi(unsigned u) { return __builtin_bit_cast(float, u & 0xffff0000u); }
__device__ __forceinline__ float fsigmoid(float x) { return 1.f / (1.f + __expf(-x)); }
__device__ __forceinline__ float wave_sum(float v) {
#pragma unroll
    for (int o = 1; o < 64; o <<= 1) v += __shfl_xor(v, o);
    return v;
}
__device__ __forceinline__ float wave_max(float v) {
#pragma unroll
    for (int o = 1; o < 64; o <<= 1) v = fmaxf(v, __shfl_xor(v, o));
    return v;
}

#define XB_TMO      128
#define XB_XCNT(j)  (256  + 64 * (j))
#define XB_XSUB(j)  (1280 + 64 * (j))
#define XB_XGEN(j)  (2304 + 64 * (j))
#define XB_TOP      3328
#define XB_TOPGEN   3392
#define XCD_BAR_WORDS 3456
#define XB_SPIN_CAP (1u << 22)
__device__ __forceinline__ unsigned xb_ld(unsigned* p)              { return __hip_atomic_load(p, __ATOMIC_RELAXED, __HIP_MEMORY_SCOPE_AGENT); }
__device__ __forceinline__ unsigned xb_add(unsigned* p, unsigned v) { return __hip_atomic_fetch_add(p, v, __ATOMIC_RELAXED, __HIP_MEMORY_SCOPE_AGENT); }
__device__ __forceinline__ unsigned xb_xcc_id() { return (unsigned)__builtin_amdgcn_s_getreg((3 << 11) | 20) & 0xFu; }
#define XB_SPIN(cond, bar) do { unsigned _sp = 0; while (cond) { __builtin_amdgcn_s_sleep(1); \
    if ((++_sp & 255u) == 0u) { if (xb_ld(&(bar)[XB_TMO])) break; if (_sp > XB_SPIN_CAP) { atomicAdd(&(bar)[XB_TMO], 1u); break; } } } } while (0)
struct XcdBarrier { unsigned* bar; unsigned x; volatile LAS unsigned* st; };
__device__ __forceinline__ XcdBarrier xcd_barrier_post(unsigned* bar, volatile LAS unsigned* st) {
    XcdBarrier b; b.bar = bar; b.x = xb_xcc_id(); b.st = st;
    if (threadIdx.x == 0) (void)xb_add(&bar[XB_XCNT(b.x)], 1u);
    return b;
}
__device__ __forceinline__ void xcd_barrier_complete(unsigned* bar, unsigned x, unsigned& nloc, unsigned& nx) {
    const unsigned G = gridDim.x * gridDim.y * gridDim.z;
    unsigned sum, cnt, mine, sp = 0u;
    for (;;) {
        sum = 0u; cnt = 0u; mine = 0u;
#pragma unroll
        for (unsigned j = 0; j < 16; ++j) { const unsigned c = xb_ld(&bar[XB_XCNT(j)]); sum += c; cnt += (c > 0u) ? 1u : 0u; mine = (j == x) ? c : mine; }
        if (sum == G) break;
        __builtin_amdgcn_s_sleep(1);
        if ((++sp & 255u) == 0u) { if (xb_ld(&bar[XB_TMO])) break; if (sp > XB_SPIN_CAP) { atomicAdd(&bar[XB_TMO], 1u); break; } }
    }
    nloc = mine > 0u ? mine : 1u; nx = cnt > 0u ? cnt : 1u;
}
__device__ __forceinline__ void xcd_barrier(const XcdBarrier& b) {
    asm volatile("s_waitcnt vmcnt(0)" ::: "memory");
    __syncthreads();
    if (threadIdx.x == 0) {
        unsigned* bar = b.bar;
        __builtin_amdgcn_s_waitcnt(0);
        unsigned nloc = b.st[0], nx = b.st[1];
        if (nloc == 0u) { xcd_barrier_complete(bar, b.x, nloc, nx); b.st[0] = nloc; b.st[1] = nx; }
        const unsigned old = xb_add(&bar[XB_XSUB(b.x)], 1u);
        const unsigned gen = old / nloc;
        if (old + 1u == (gen + 1u) * nloc) {
            __builtin_amdgcn_fence(__ATOMIC_RELEASE, "agent");
            asm volatile("s_waitcnt vmcnt(0)" ::: "memory");
            const unsigned og = xb_add(&bar[XB_TOP], 1u);
            const unsigned tg = og / nx;
            if (og + 1u == (tg + 1u) * nx) xb_add(&bar[XB_TOPGEN], 1u);
            else XB_SPIN(xb_ld(&bar[XB_TOPGEN]) == tg, bar);
            __builtin_amdgcn_fence(__ATOMIC_ACQUIRE, "agent");
            xb_add(&bar[XB_XGEN(b.x)], 1u);
            asm volatile("s_waitcnt vmcnt(0)" ::: "memory");
        } else {
            XB_SPIN(xb_ld(&bar[XB_XGEN(b.x)]) == gen, bar);
            __builtin_amdgcn_fence(__ATOMIC_ACQUIRE, "agent");
            asm volatile("s_waitcnt vmcnt(0)" ::: "memory");
        }
    }
    __syncthreads();
}
using pg8::Unit;
#ifndef STEAL_MARGIN
#define STEAL_MARGIN 8u
#endif
#ifndef FP8_GATES
#define FP8_GATES 3
#endif
#define GATES8(l) ((FP8_GATES >> (l)) & 1)
#ifndef FP8_MOE
#define FP8_MOE 3
#endif
#define MOE8(l) ((FP8_MOE >> (l)) & 1)
#define FP8_LAST MOE8(NL_ - 1)
__device__ __forceinline__ unsigned pk4_fp8(float a, float b, float c, float d) { int w = 0; w = __builtin_amdgcn_cvt_pk_fp8_f32(a, b, w, false); w = __builtin_amdgcn_cvt_pk_fp8_f32(c, d, w, true); return (unsigned)w; }
struct EpiY {
    static constexpr bool PERM = true, HAS_FOLD = false;
    bf16* Y; float* YSM; int pn0;
    __device__ __forceinline__ void operator()(const f32x4 (&acc)[2][2][4][2], const Unit& u, int wr, int wc, int fr, int fq) const {
        const int row0 = u.pm * 256 + wr * 64 + fr, pn = u.pn + pn0;
        if (pn == 29) {
            if (wc == 0) {
#pragma unroll
                for (int ai = 0; ai < 2; ++ai)
#pragma unroll
                    for (int m = 0; m < 4; ++m) { float* rp = YSM + (size_t)(row0 + ai * 128 + m * 16) * 32 + 8 * fq; *(f32x4*)rp = acc[ai][0][m][0]; *(f32x4*)(rp + 4) = acc[ai][0][m][1]; }
            }
            return;
        }
        const bool sg = pn >= 30;
#pragma unroll
        for (int ai = 0; ai < 2; ++ai)
#pragma unroll
            for (int m = 0; m < 4; ++m) { bf16* rp = Y + (size_t)(row0 + ai * 128 + m * 16) * YP + pn * 256 + wc * 32 + 8 * fq;
#pragma unroll
                for (int bj = 0; bj < 2; ++bj) { f32x4 v0 = acc[ai][bj][m][0], v1 = acc[ai][bj][m][1];
                    if (sg) {
#pragma unroll
                        for (int j = 0; j < 4; ++j) { v0[j] = fsigmoid(v0[j]); v1[j] = fsigmoid(v1[j]); } }
                    v4u w; w.x = pk2(v0[0], v0[1]); w.y = pk2(v0[2], v0[3]); w.z = pk2(v1[0], v1[1]); w.w = pk2(v1[2], v1[3]);
                    *(v4u*)(rp + bj * 128) = w; } }
    }
};
struct EpiMerge {
    static constexpr bool PERM = false, HAS_FOLD = true;
    const bf16* Y; bf16* MB; mutable f32x4 tot[2][4][2];
    __device__ __forceinline__ bool boundary(int kt) const { return kt == 8 || kt == 12 || kt == 24; }
    __device__ __forceinline__ void fold(const f32x4 (&acc)[2][1][4][2], const Unit& u, int wr, int wc, int fr, int fq, int kt) const {
        const int br = kt == 8 ? 0 : (kt == 12 ? 1 : (kt == 24 ? 2 : 3));
        int zv = 0; asm volatile("" : "+v"(zv));
        const int row0 = u.pm * 256 + wr * 64 + fr + zv, col0 = u.pn * 128 + wc * 32 + 4 * fq;
        v2u gp[2][4][2];
#pragma unroll
        for (int ai = 0; ai < 2; ++ai)
#pragma unroll
            for (int m = 0; m < 4; ++m)
#pragma unroll
                for (int n = 0; n < 2; ++n) gp[ai][m][n] = *(const v2u*)(Y + (size_t)(row0 + ai * 128 + m * 16) * YP + Y_G + br * 2048 + col0 + n * 16);
#pragma unroll
        for (int ai = 0; ai < 2; ++ai)
#pragma unroll
            for (int m = 0; m < 4; ++m)
#pragma unroll
                for (int n = 0; n < 2; ++n) { f32x4 v = acc[ai][0][m][n]; const v2u g2 = gp[ai][m][n]; v[0] *= bflo(g2.x); v[1] *= bfhi(g2.x); v[2] *= bflo(g2.y); v[3] *= bfhi(g2.y);
                    v = br > 0 ? v + tot[ai][m][n] : v;
                    if (br < 3) tot[ai][m][n] = v;
                    else { v2u o; o.x = pk2(v[0], v[1]); o.y = pk2(v[2], v[3]); *(v2u*)(MB + (size_t)(row0 + ai * 128 + m * 16) * 2048 + col0 + n * 16) = o; } }
    }
    __device__ __forceinline__ void operator()(const f32x4 (&acc)[2][1][4][2], const Unit& u, int wr, int wc, int fr, int fq) const { fold(acc, u, wr, wc, fr, fq, 32); }
};
struct EpiOut {
    static constexpr bool PERM = false, HAS_FOLD = false;
    const float* X; float* HB;
    __device__ __forceinline__ void operator()(const f32x4 (&acc)[2][2][4][2], const Unit& u, int wr, int wc, int fr, int fq) const {
        const int row0 = u.pm * 256 + wr * 64 + fr, col0 = u.pn * 256 + wc * 32 + 4 * fq;
#pragma unroll
        for (int ai = 0; ai < 2; ++ai)
#pragma unroll
            for (int m = 0; m < 4; ++m) { const size_t off = (size_t)(row0 + ai * 128 + m * 16) * 2048 + col0;
#pragma unroll
                for (int bj = 0; bj < 2; ++bj)
#pragma unroll
                    for (int n = 0; n < 2; ++n) { const f32x4 xv = *(const f32x4*)(X + off + bj * 128 + n * 16); *(f32x4*)(HB + off + bj * 128 + n * 16) = xv * DN_ALPHA + acc[ai][bj][m][n]; } }
    }
};
struct EpiMoe1 {
    static constexpr bool PERM = true, HAS_FOLD = false;
    bf16* H; const float* ROWW; int NJ;
    __device__ __forceinline__ void operator()(const f32x4 (&acc)[2][2][4][2], const Unit& u, int wr, int wc, int fr, int fq) const {
        const int row0 = u.pm * 256 + wr * 64 + fr, col0 = (u.pn & 3) * 128 + wc * 32 + 8 * fq;
#pragma unroll
        for (int ai = 0; ai < 2; ++ai)
#pragma unroll
            for (int m = 0; m < 4; ++m) { const size_t row = (size_t)(row0 + ai * 128 + m * 16); const float rw = ROWW[row];
                float h[8];
#pragma unroll
                for (int n = 0; n < 2; ++n)
#pragma unroll
                    for (int j = 0; j < 4; ++j) { const float a = acc[ai][0][m][n][j], b = acc[ai][1][m][n][j]; h[n * 4 + j] = a * fsigmoid(a) * b * rw; }
                v4u w; w.x = pk2(h[0], h[1]); w.y = pk2(h[2], h[3]); w.z = pk2(h[4], h[5]); w.w = pk2(h[6], h[7]);
                *(v4u*)(H + row * 512 + col0) = w; }
    }
};
struct EpiMoe2 {
    static constexpr bool PERM = true, HAS_FOLD = false;
    bf16* YB;
    __device__ __forceinline__ void operator()(const f32x4 (&acc)[2][2][4][2], const Unit& u, int wr, int wc, int fr, int fq) const {
        const int row0 = u.pm * 256 + wr * 64 + fr, col0 = (u.pn & 7) * 256 + wc * 32 + 8 * fq;
#pragma unroll
        for (int ai = 0; ai < 2; ++ai)
#pragma unroll
            for (int m = 0; m < 4; ++m) { bf16* rp = YB + (size_t)(row0 + ai * 128 + m * 16) * 2048 + col0;
#pragma unroll
                for (int bj = 0; bj < 2; ++bj) { const f32x4 v0 = acc[ai][bj][m][0], v1 = acc[ai][bj][m][1];
                    v4u w; w.x = pk2(v0[0], v0[1]); w.y = pk2(v0[2], v0[3]); w.z = pk2(v1[0], v1[1]); w.w = pk2(v1[2], v1[3]);
                    *(v4u*)(rp + bj * 128) = w; } }
    }
};
struct EpiMoe1F8 {
    static constexpr bool PERM = true, HAS_FOLD = false;
    unsigned char* H; const float* ROWW;
    __device__ __forceinline__ void operator()(const f32x4 (&acc)[2][2][4][2], const Unit& u, int wr, int wc, int fr, int fq) const {
        const int row0 = u.pm * 256 + wr * 64 + fr, col0 = (u.pn & 3) * 128 + wc * 32 + 8 * fq;
#pragma unroll
        for (int ai = 0; ai < 2; ++ai)
#pragma unroll
            for (int m = 0; m < 4; ++m) { const size_t row = (size_t)(row0 + ai * 128 + m * 16); const float rw = ROWW[row];
                float h[8];
#pragma unroll
                for (int n = 0; n < 2; ++n)
#pragma unroll
                    for (int j = 0; j < 4; ++j) { const float a = acc[ai][0][m][n][j], b = acc[ai][1][m][n][j]; h[n * 4 + j] = a * fsigmoid(a) * b * rw; }
                v2u w; w.x = pk4_fp8(h[0], h[1], h[2], h[3]); w.y = pk4_fp8(h[4], h[5], h[6], h[7]);
                *(v2u*)(H + row * 512 + col0) = w; }
    }
};
struct MoeOrder {
    int NJ, G, c, total, upm, upn;
    __device__ __forceinline__ void init(const int* tst, int NJ_, int G_, int c_, int lane) { NJ = NJ_; G = G_; c = c_; total = tst[65] * NJ_;
        const long L = (long)lane * G + c; upm = 0; upn = 0;
        if (L < total) { const int mt = (int)(L / NJ), j = (int)(L % NJ); int e = 0;
            for (int k = 1; k <= 64; ++k) e += (mt >= tst[k]) ? 1 : 0;
            upm = mt; upn = e * NJ + j; } }
    __device__ __forceinline__ bool next(int i, Unit& u) const {
        if ((long)i * G + c >= total || i >= 64) return false;
        const int iu = __builtin_amdgcn_readfirstlane(i);
        u.pm = __builtin_amdgcn_readlane(upm, iu); u.pn = __builtin_amdgcn_readlane(upn, iu); return true;
    }
    __device__ __forceinline__ void a_ready(const Unit&) const {}
    __device__ __forceinline__ void done(const Unit&) const {}
};

struct KArgs { const float* in[32]; float* out; unsigned char* ws; int ph_lo, ph_hi, region, pad; };
struct Ctx {
    LAS unsigned char* lds; unsigned char* ws; const float* in[32]; float* out;
    int tid, lane, wave, G, bid;
};
#define WSP(T, off) ((T*)(C.ws + (off)))

struct CvDesc { const float* sp; bf16* dp; int ldw, ldt, zero, w13, f8; };
__device__ __forceinline__ CvDesc cv_desc(const float* W, int ldw, int srccol, int k0, bf16* WT, size_t drow0, int ldt, int w13, int tid, int f8 = 0) {
    CvDesc d; d.zero = srccol < 0; d.ldw = ldw; d.ldt = ldt; d.w13 = w13; d.f8 = f8;
    d.sp = W + (size_t)(k0 + (tid >> 6)) * ldw + (srccol < 0 ? 0 : srccol);
    d.dp = f8 ? (bf16*)((unsigned char*)WT + drow0 * (size_t)ldt + k0) : WT + drow0 * (size_t)ldt + k0; return d;
}
__device__ __forceinline__ CvDesc conv_item(Ctx& C, int l, int r, int tid) {
    constexpr int I_WIN = 16 * 62, I_W13 = 65 * 64, I_W2 = 65 * 32, I_PA = 4 * 8, I_PB = 2 * 8, I_PC = 6 * 8, I_PD = 4 * 8;
    const bool f8l = MOE8(l), lastb = MOE8(l) && l == NL_ - 1;
    bf16* WIN = WSP(bf16, WS_WIN); bf16* W13 = lastb ? WSP(bf16, WS_W13B) : WSP(bf16, WS_W13); bf16* W2 = lastb ? WSP(bf16, WS_W2B) : WSP(bf16, WS_W2); bf16* WP = WSP(bf16, WS_WP); bf16* WOUT = WSP(bf16, WS_WOUT);
    const int c4 = 4 * (tid & 63);
    if (r < I_WIN) { const int nb = r % 62, kb = r / 62, n = 256 * nb + c4; int sc;
        if (n < 1536) sc = n; else if (n < 7424) sc = n + 16; else if (n < 7680) { const int i = n - 7424; sc = i < 16 ? 1536 + i : (i < 24 ? 7440 + (i - 16) : -1); } else sc = n - 7680 + 7448;
        if (GATES8(l) && nb >= 30) return cv_desc(C.in[2] + (size_t)l * 2048 * NCOL, NCOL, sc, 128 * kb, WSP(bf16, WS_WIN8), 256 * (nb - 30), 2048, 0, tid, 1);
        return cv_desc(C.in[2] + (size_t)l * 2048 * NCOL, NCOL, sc, 128 * kb, WIN, 256 * nb, 2048, 0, tid); }
    r -= I_WIN;
    if (r < I_W13) { const int e = r / 64, q = r % 64, half = q >> 5, kb = (q >> 1) & 15, nq = q & 1;
        const float* src = e == 0 ? (half ? C.in[28] : C.in[27]) + (size_t)l * 2048 * 512 : (half ? C.in[25] : C.in[24]) + (size_t)(l * 64 + e - 1) * 2048 * 512;
        return cv_desc(src, 512, 256 * nq + c4, 128 * kb, W13, (size_t)e * 1024 + nq * 512 + half * 128, 2048, 1, tid, f8l ? 1 : 0); }
    r -= I_W13;
    if (r < I_W2) { const int e = r / 32, q = r % 32, kb = q / 8, nb = q % 8;
        const float* src = e == 0 ? C.in[29] + (size_t)l * 512 * 2048 : C.in[26] + (size_t)(l * 64 + e - 1) * 512 * 2048;
        return cv_desc(src, 2048, 256 * nb + c4, 128 * kb, W2, (size_t)e * 2048 + 256 * nb, 512, 0, tid, f8l ? 1 : 0); }
    r -= I_W2;
    if (r < I_PA) return cv_desc(C.in[15] + (size_t)l * 512 * 2048, 2048, 256 * (r % 8) + c4, 128 * (r / 8), WP, 256 * (r % 8), 2048, 0, tid);
    r -= I_PA;
    if (r < I_PB) return cv_desc(C.in[16] + (size_t)l * 256 * 2048, 2048, 256 * (r % 8) + c4, 128 * (r / 8), WP + 512, 256 * (r % 8), 2048, 0, tid);
    r -= I_PB;
    if (r < I_PC) return cv_desc(C.in[17] + (size_t)l * 768 * 2048, 2048, 256 * (r % 8) + c4, 128 * (r / 8), WP + 768, 256 * (r % 8), 2048, 0, tid);
    r -= I_PC;
    if (r < I_PD) return cv_desc(C.in[18] + (size_t)l * 512 * 2048, 2048, 256 * (r % 8) + c4, 128 * (r / 8), WP + 1536, 256 * (r % 8), 2048, 0, tid);
    r -= I_PD;
    return cv_desc(C.in[19] + (size_t)l * 2048 * 2048, 2048, 256 * (r % 8) + c4, 128 * (r / 8), WOUT, 256 * (r % 8), 2048, 0, tid);
}
__device__ __forceinline__ void phase_convert(Ctx& C, int l, int part, int cbid, int cG, unsigned* arr = nullptr) {
    LAS float* tile = (LAS float*)C.lds; LAS int* qn = (LAS int*)(C.lds + AUX_OFF + 8192);
    unsigned* cq = WSP(unsigned, WS_CTL) + CW_CQ + l * 2 + part;
    const int tid = C.tid, lane = C.lane, wave = C.wave;
    constexpr int I_WIN = 16 * 62, NITEMS = I_WIN + 65 * 64 + 65 * 32 + (4 + 2 + 6 + 4) * 8 + 16 * 8;
    const int it0 = part == 0 ? 0 : I_WIN, it1 = part == 0 ? I_WIN : NITEMS;
    __syncthreads();
    if (tid == 0) qn[0] = (arr && __hip_atomic_load(arr, __ATOMIC_RELAXED, __HIP_MEMORY_SCOPE_AGENT) + STEAL_MARGIN >= (unsigned)C.G) ? 0x7fffffff : it0 + (int)atomicAdd(cq, 1u);
    __syncthreads();
    int it = qn[0];
    f32x4 va[16];
    CvDesc d = conv_item(C, l, it < it1 ? it : it0, tid);
    if (it < it1) {
#pragma unroll
        for (int i = 0; i < 16; ++i) va[i] = d.zero ? (f32x4){0.f, 0.f, 0.f, 0.f} : *(const f32x4*)(d.sp + (size_t)(8 * i) * d.ldw); }
    const int c16 = lane & 15, nsub = lane >> 4;
    while (it < it1) {
#pragma unroll
        for (int i = 0; i < 16; ++i) { const int kk = wave + 8 * i; *(LAS f32x4*)(tile + kk * 256 + ((4 * (tid & 63)) ^ (4 * ((kk >> 3) & 7)))) = va[i]; }
        if (tid == 0) qn[1] = (arr && __hip_atomic_load(arr, __ATOMIC_RELAXED, __HIP_MEMORY_SCOPE_AGENT) + STEAL_MARGIN >= (unsigned)C.G) ? 0x7fffffff : it0 + (int)atomicAdd(cq, 1u);
        __syncthreads();
        const int nx = qn[1]; const bool hn = nx < it1;
        const CvDesc dn = conv_item(C, l, hn ? nx : it, tid);
        if (hn) {
#pragma unroll
            for (int i = 0; i < 16; ++i) va[i] = dn.zero ? (f32x4){0.f, 0.f, 0.f, 0.f} : *(const f32x4*)(dn.sp + (size_t)(8 * i) * dn.ldw); }
#pragma unroll
        for (int p = 0; p < 8; ++p) { const int n = p * 32 + wave * 4 + nsub; const LAS float* s = tile + (8 * c16) * 256 + (n ^ (4 * (c16 & 7)));
            const int drow = d.w13 ? ((n >> 7) << 8) + (n & 127) : n;
            if (d.f8) { v2u o8; o8.x = pk4_fp8(s[0 * 256] * 32.f, s[1 * 256] * 32.f, s[2 * 256] * 32.f, s[3 * 256] * 32.f); o8.y = pk4_fp8(s[4 * 256] * 32.f, s[5 * 256] * 32.f, s[6 * 256] * 32.f, s[7 * 256] * 32.f);
                *(v2u*)((unsigned char*)d.dp + (size_t)drow * d.ldt + 8 * c16) = o8; }
            else { v4u o; o.x = pk2(s[0 * 256], s[1 * 256]); o.y = pk2(s[2 * 256], s[3 * 256]); o.z = pk2(s[4 * 256], s[5 * 256]); o.w = pk2(s[6 * 256], s[7 * 256]);
                *(v4u*)(d.dp + (size_t)drow * d.ldt + 8 * c16) = o; } }
        __syncthreads();
        d = dn; it = nx;
    }
    if (l == 0 && part == 0) {
        const int gw = cbid * 8 + C.wave, NGW = cG * 8;
        bf16* XB = WSP(bf16, WS_XB); const float* X = C.in[0];
        for (int t = gw; t < T_; t += NGW) {
#pragma unroll
            for (int j = 0; j < 8; ++j) { const f32x4 v = *(const f32x4*)(X + (size_t)t * 2048 + 4 * (lane + 64 * j)); v2u o; o.x = pk2(v[0], v[1]); o.y = pk2(v[2], v[3]); *(v2u*)(XB + (size_t)t * 2048 + 4 * (lane + 64 * j)) = o;
                if (GATES8(0)) *(unsigned*)(WSP(unsigned char, WS_XB8) + (size_t)t * 2048 + 4 * (lane + 64 * j)) = pk4_fp8(v[0], v[1], v[2], v[3]); }
        }
        f32x2* CS = WSP(f32x2, WS_CS); const int* pos = (const int*)C.in[1];
        for (int i = C.bid * 512 + C.tid; i < T_ * 32; i += C.G * 512) { const int t = i >> 5, f = i & 31;
            const float inv = powf(10000.0f, -(float)f * 2.0f / 64.0f), ang = (float)pos[t] * inv; float sn, cs; sincosf(ang, &sn, &cs); CS[i] = (f32x2){cs, sn}; }
    }
}
__device__ __forceinline__ void ln_row(f32x4 (&v)[8], const float* g, const float* b, int lane) {
    float s = 0.f;
#pragma unroll
    for (int j = 0; j < 8; ++j) s += (v[j][0] + v[j][1]) + (v[j][2] + v[j][3]);
    const float mean = wave_sum(s) * (1.f / 2048.f); float q = 0.f;
#pragma unroll
    for (int j = 0; j < 8; ++j) { v[j] = v[j] - mean; q += (v[j][0] * v[j][0] + v[j][1] * v[j][1]) + (v[j][2] * v[j][2] + v[j][3] * v[j][3]); }
    const float rstd = 1.f / sqrtf(wave_sum(q) * (1.f / 2048.f) + LN_EPS_);
#pragma unroll
    for (int j = 0; j < 8; ++j) { const f32x4 gv = *(const f32x4*)(g + 4 * (lane + 64 * j)), bv = *(const f32x4*)(b + 4 * (lane + 64 * j)); v[j] = v[j] * rstd * gv + bv; }
}
__device__ __forceinline__ void phase_ln1_router(Ctx& C, int l) {
    const float* HB = WSP(float, WS_HB); float* X1 = WSP(float, WS_X1); bf16* XS = WSP(bf16, WS_XS); float* ROWW = WSP(float, WS_ROWW);
    int* sel_e = WSP(int, WS_SEL); float* sel_w = WSP(float, WS_SEL + 262144); int* sel_r = WSP(int, WS_SEL + 2 * 262144);
    unsigned* cnt = WSP(unsigned, WS_CTL) + CW_CNT + l * 64;
    const float* g = C.in[20] + l * 2048; const float* b = C.in[21] + l * 2048; const float* wrt = C.in[22] + (size_t)l * 2048 * 64; const float* rb = C.in[23] + l * 64;
    constexpr int XP = 2068;
    LAS float* xl = (LAS float*)C.lds; LAS float* part = xl + 16 * XP; LAS float* scl = part + 2048;
    const int lane = C.lane, wave = C.wave;
    for (int unit = C.bid; unit < T_ / 16; unit += C.G) {
        const int t0 = unit * 16;
#pragma unroll 1
        for (int rr = 0; rr < 2; ++rr) { const int row = 2 * wave + rr; const size_t t = (size_t)(t0 + row);
            f32x4 v[8];
#pragma unroll
            for (int j = 0; j < 8; ++j) v[j] = *(const f32x4*)(HB + t * 2048 + 4 * (lane + 64 * j));
            ln_row(v, g, b, lane);
#pragma unroll
            for (int j = 0; j < 8; ++j) { *(f32x4*)(X1 + t * 2048 + 4 * (lane + 64 * j)) = v[j];
                if (MOE8(l)) *(unsigned*)(WSP(unsigned char, WS_XS8) + t * 2048 + 4 * (lane + 64 * j)) = pk4_fp8(v[j][0], v[j][1], v[j][2], v[j][3]);
                else { v2u o; o.x = pk2(v[j][0], v[j][1]); o.y = pk2(v[j][2], v[j][3]); *(v2u*)(XS + t * 2048 + 4 * (lane + 64 * j)) = o; }
                *(LAS f32x4*)(xl + row * XP + 4 * (lane + 64 * j)) = v[j]; }
        }
        if (C.tid < 16) { ROWW[t0 + C.tid] = 1.0f; WSP(int, WS_ROWMAP)[t0 + C.tid] = t0 + C.tid; }
        __syncthreads();
        {
            const int et = wave & 3, kh = wave >> 2, i = lane & 15, h = lane >> 4; f32x4 acc = (f32x4){0.f, 0.f, 0.f, 0.f};
            const LAS float* xr = xl + i * XP + kh * 1024 + 4 * h; const float* wb = wrt + (size_t)(kh * 1024 + 4 * h) * 64 + 16 * et + i;
#pragma unroll 4
            for (int s = 0; s < 64; ++s) { const f32x4 a = *(const LAS f32x4*)(xr + 16 * s); const float* wp = wb + (size_t)(16 * s) * 64;
                const float b0 = wp[0], b1 = wp[64], b2 = wp[128], b3 = wp[192];
                acc = __builtin_amdgcn_mfma_f32_16x16x4f32(a[0], b0, acc, 0, 0, 0); acc = __builtin_amdgcn_mfma_f32_16x16x4f32(a[1], b1, acc, 0, 0, 0);
                acc = __builtin_amdgcn_mfma_f32_16x16x4f32(a[2], b2, acc, 0, 0, 0); acc = __builtin_amdgcn_mfma_f32_16x16x4f32(a[3], b3, acc, 0, 0, 0); }
#pragma unroll
            for (int r = 0; r < 4; ++r) part[kh * 1024 + (4 * h + r) * 64 + 16 * et + i] = acc[r];
        }
        __syncthreads();
#pragma unroll
        for (int k = 0; k < 2; ++k) { const int idx = C.tid + 512 * k; scl[idx] = 1.f / (1.f + expf(-(part[idx] + part[1024 + idx]))); }
        __syncthreads();
#pragma unroll 1
        for (int rr = 0; rr < 2; ++rr) { const int tok = 2 * wave + rr, t = t0 + tok; const float* sp = (const float*)(scl + tok * 64);
            const bool sel = route_lane_select(lane, sp, rb); const float s = scl[tok * 64 + lane];
            const unsigned long long m0_ = __ballot(sel); const bool sel8 = sel && __popcll(m0_ & ((1ull << lane) - 1ull)) < 8;
            const float wsum = wave_sum(sel8 ? s : 0.f); const unsigned long long m = __ballot(sel8);
            if (sel8) { const int k = __popcll(m & ((1ull << lane) - 1ull)); sel_e[t * 8 + k] = lane; sel_w[t * 8 + k] = s * 2.5f / wsum; sel_r[t * 8 + k] = (int)atomicAdd(cnt + lane, 1u); } }
        __syncthreads();
    }
}
__device__ __forceinline__ void phase_scatter(Ctx& C, int l) {
    float* ROWW = WSP(float, WS_ROWW); int* ROWMAP = WSP(int, WS_ROWMAP);
    const int* sel_e = WSP(int, WS_SEL); const float* sel_w = WSP(float, WS_SEL + 262144); const int* sel_r = WSP(int, WS_SEL + 2 * 262144); int* POS = WSP(int, WS_SEL + 3 * 262144);
    const unsigned* cnt = WSP(unsigned, WS_CTL) + CW_CNT + l * 64; int* tst = WSP(int, WS_CTL) + CW_TST + l * 128;
    LAS int* offl = (LAS int*)(C.lds + AUX_OFF + 4096);
    if (C.tid == 0) { int ts = 0;
        for (int k = 0; k <= 65; ++k) { if (C.bid == 0) tst[k] = ts; if (k >= 1 && k <= 64) offl[k - 1] = ts * 256; ts += (k == 0) ? 32 : (k <= 64 ? (((int)cnt[k - 1] + 255) >> 8) : 0); } }
    __syncthreads();
    for (int p = C.bid * 512 + C.tid; p < T_ * 8; p += C.G * 512) { const int e = sel_e[p], pos = offl[e] + sel_r[p]; ROWMAP[pos] = p >> 3; ROWW[pos] = sel_w[p]; POS[p] = pos; }
    for (int e = C.bid; e < 64; e += C.G) { const int c = (int)cnt[e], beg = offl[e] + c, end = offl[e] + ((c + 255) & ~255);
        for (int pos = beg + C.tid; pos < end; pos += 512) { ROWMAP[pos] = 0; ROWW[pos] = 0.f; } }
}
__device__ __forceinline__ void phase_combine(Ctx& C, int l) {
    const bf16* YB = WSP(bf16, WS_YBUF); const float* X1 = WSP(float, WS_X1); const int* POS = WSP(int, WS_SEL + 3 * 262144);
    float* XO = (l == NL_ - 1) ? C.out : WSP(float, WS_XA); bf16* XB = WSP(bf16, WS_XB);
    const float* g = C.in[30] + l * 2048; const float* b = C.in[31] + l * 2048;
    const int gw = C.bid * 8 + C.wave, NGW = C.G * 8, lane = C.lane;
    int pn[8];
#pragma unroll
    for (int k = 0; k < 8; ++k) pn[k] = gw < T_ ? POS[gw * 8 + k] : 0;
    for (int t = gw; t < T_; t += NGW) {
        size_t rows[9]; rows[0] = (size_t)t;
#pragma unroll
        for (int k = 0; k < 8; ++k) rows[k + 1] = (size_t)pn[k];
        { const int tn = t + NGW < T_ ? t + NGW : t;
#pragma unroll
          for (int k = 0; k < 8; ++k) pn[k] = POS[tn * 8 + k]; }
        v4u w[9][4];
#pragma unroll
        for (int k = 0; k < 9; ++k)
#pragma unroll
            for (int j = 0; j < 4; ++j) w[k][j] = *(const v4u*)(YB + rows[k] * 2048 + 8 * lane + 512 * j);
        float v[4][8];
#pragma unroll
        for (int j = 0; j < 4; ++j) { const f32x4 a = *(const f32x4*)(X1 + (size_t)t * 2048 + 8 * lane + 512 * j), c = *(const f32x4*)(X1 + (size_t)t * 2048 + 8 * lane + 512 * j + 4);
            v[j][0] = a[0] * DN_ALPHA; v[j][1] = a[1] * DN_ALPHA; v[j][2] = a[2] * DN_ALPHA; v[j][3] = a[3] * DN_ALPHA; v[j][4] = c[0] * DN_ALPHA; v[j][5] = c[1] * DN_ALPHA; v[j][6] = c[2] * DN_ALPHA; v[j][7] = c[3] * DN_ALPHA; }
#pragma unroll
        for (int k = 0; k < 9; ++k)
#pragma unroll
            for (int j = 0; j < 4; ++j) { v[j][0] += bflo(w[k][j].x); v[j][1] += bfhi(w[k][j].x); v[j][2] += bflo(w[k][j].y); v[j][3] += bfhi(w[k][j].y); v[j][4] += bflo(w[k][j].z); v[j][5] += bfhi(w[k][j].z); v[j][6] += bflo(w[k][j].w); v[j][7] += bfhi(w[k][j].w); }
        float s = 0.f;
#pragma unroll
        for (int j = 0; j < 4; ++j)
#pragma unroll
            for (int e = 0; e < 8; ++e) s += v[j][e];
        const float mean = wave_sum(s) * (1.f / 2048.f); float q = 0.f;
#pragma unroll
        for (int j = 0; j < 4; ++j)
#pragma unroll
            for (int e = 0; e < 8; ++e) { v[j][e] -= mean; q += v[j][e] * v[j][e]; }
        const float rstd = 1.f / sqrtf(wave_sum(q) * (1.f / 2048.f) + LN_EPS_);
#pragma unroll
        for (int j = 0; j < 4; ++j) { const int c0 = 8 * lane + 512 * j; float o[8];
            const f32x4 g0 = *(const f32x4*)(g + c0), g1 = *(const f32x4*)(g + c0 + 4), b0 = *(const f32x4*)(b + c0), b1 = *(const f32x4*)(b + c0 + 4);
#pragma unroll
            for (int e = 0; e < 4; ++e) { o[e] = v[j][e] * rstd * g0[e] + b0[e]; o[4 + e] = v[j][4 + e] * rstd * g1[e] + b1[e]; }
            *(f32x4*)(XO + (size_t)t * 2048 + c0) = (f32x4){o[0], o[1], o[2], o[3]}; *(f32x4*)(XO + (size_t)t * 2048 + c0 + 4) = (f32x4){o[4], o[5], o[6], o[7]};
            if (l < NL_ - 1) { v4u ow; ow.x = pk2(o[0], o[1]); ow.y = pk2(o[2], o[3]); ow.z = pk2(o[4], o[5]); ow.w = pk2(o[6], o[7]); *(v4u*)(XB + (size_t)t * 2048 + c0) = ow;
                if (GATES8(l + 1)) { v2u o8; o8.x = pk4_fp8(o[0], o[1], o[2], o[3]); o8.y = pk4_fp8(o[4], o[5], o[6], o[7]); *(v2u*)(WSP(unsigned char, WS_XB8) + (size_t)t * 2048 + c0) = o8; } } }
    }
}
typedef LAS unsigned char* ldsp;
__device__ __forceinline__ f32x4 mfma16(bf16x8 bt, bf16x8 a, f32x4 c) { return __builtin_amdgcn_mfma_f32_16x16x32_bf16(bt, a, c, 0, 0, 0); }
__device__ __forceinline__ bf16x8 frag(ldsp base, int pitch, int row, int k0, int fq) { return *(const LAS bf16x8*)(base + row * pitch + (k0 + 8 * fq) * 2); }
__device__ __forceinline__ bf16x8 frag2(ldsp base, int pitch, int row, int kA, int kB, int fq) {
    const v2u a = *(const LAS v2u*)(base + row * pitch + (kA + 4 * fq) * 2), b = *(const LAS v2u*)(base + row * pitch + (kB + 4 * fq) * 2);
    v4u r; r.x = a.x; r.y = a.y; r.z = b.x; r.w = b.y; return __builtin_bit_cast(bf16x8, r);
}
typedef short v4i16_t __attribute__((ext_vector_type(4)));
__device__ __forceinline__ bf16x8 trfrag2(ldsp base, int pitch, int col0, int kA, int kB, int lane) {
    const int q = (lane & 15) >> 2, p = lane & 3, fq = lane >> 4;
    const v4i16_t x = __builtin_amdgcn_ds_read_tr16_b64_v4i16((LAS v4i16_t*)(base + (kA + 4 * fq + q) * pitch + (col0 + 4 * p) * 2));
    const v4i16_t y = __builtin_amdgcn_ds_read_tr16_b64_v4i16((LAS v4i16_t*)(base + (kB + 4 * fq + q) * pitch + (col0 + 4 * p) * 2));
    bf16x8 r; r[0] = x[0]; r[1] = x[1]; r[2] = x[2]; r[3] = x[3]; r[4] = y[0]; r[5] = y[1]; r[6] = y[2]; r[7] = y[3]; return r;
}
__device__ __forceinline__ bf16x8 trfrag(ldsp base, int pitch, int col0, int k0, int lane) { const int fq = lane >> 4; return trfrag2(base, pitch, col0, k0 + 4 * fq, k0 + 4 * fq + 4, lane); }
__device__ __forceinline__ bf16x8 pfrag(const f32x4& p0, const f32x4& p1) { v4u r; r.x = pk2(p0[0], p0[1]); r.y = pk2(p0[2], p0[3]); r.z = pk2(p1[0], p1[1]); r.w = pk2(p1[2], p1[3]); return __builtin_bit_cast(bf16x8, r); }
__device__ __forceinline__ void unpack8(const v4u w, float (&f)[8]) { f[0] = bflo(w.x); f[1] = bfhi(w.x); f[2] = bflo(w.y); f[3] = bfhi(w.y); f[4] = bflo(w.z); f[5] = bfhi(w.z); f[6] = bflo(w.w); f[7] = bfhi(w.w); }
__device__ __forceinline__ unsigned short bf1(float x) { return (unsigned short)(pk2(x, 0.f) & 0xffffu); }
__device__ __forceinline__ float flogsigmoid(float x) { return fminf(x, 0.f) - log1pf(__expf(-fabsf(x))); }
__device__ __forceinline__ float fgelu(float v) {
    const float av = fabsf(v), t = __builtin_amdgcn_rcpf(av * 0.2316418882f + 1.0f);
    float q = t * 0.5307027145f + (-0.7265760135f); q = q * t + 0.7107068705f; q = q * t + (-0.142248368f); q = q * t + 0.127414796f; q = q * t;
    const float e = __builtin_amdgcn_exp2f((v * v) * (-0.72134752044f)), m = v * (q * e);
    return v < 0.f ? m : v - m;
}

__device__ __forceinline__ void scat8(LAS unsigned short* vp, int ps  , const v4u w) {
    vp[0 * ps] = (unsigned short)(w.x & 0xffff); vp[1 * ps] = (unsigned short)(w.x >> 16); vp[2 * ps] = (unsigned short)(w.y & 0xffff); vp[3 * ps] = (unsigned short)(w.y >> 16);
    vp[4 * ps] = (unsigned short)(w.z & 0xffff); vp[5 * ps] = (unsigned short)(w.z >> 16); vp[6 * ps] = (unsigned short)(w.w & 0xffff); vp[7 * ps] = (unsigned short)(w.w >> 16);
}

__device__ __forceinline__ void dil_unit(Ctx& C, int u) {
    const int tid = C.tid, lane = C.lane, wave = C.wave, fr = lane & 15, fq = lane >> 4;
    const int blk16 = u & 15, hh = (u >> 4) & 3, g = (u >> 6) % 3, b = u / 192;
    const int dil = g == 0 ? 1 : (g == 1 ? 4 : 16), nbpr = 16 / dil  , r = blk16 / nbpr, nb = blk16 % nbpr, head = g * 4 + hh;
    const bf16* Y = WSP(bf16, WS_Y); const f32x2* CS = WSP(f32x2, WS_CS);
    constexpr int QP = 144, KP = 144, VP = 160;
    ldsp Ql = C.lds, Kl = C.lds + 128 * QP, Vl = Kl + 256 * KP;
    const size_t tb = (size_t)b * SEQ_;
    {   const int ch = tid & 3, row0 = tid >> 2; v4u xa[3], xb[3]; f32x4 cs[3][4]; int mrow[3];
#pragma unroll
        for (int i = 0; i < 3; ++i) { const int row = row0 + (i == 2 ? 128 : 0), m = (i == 0) ? nb * 128 + row : (nb - 1) * 128 + row, mc = m < 0 ? 0 : m; const size_t t = tb + (size_t)mc * dil + r;
            const bf16* src = Y + t * YP + (i == 0 ? Y_BQ : Y_BK) + head * 64 + 8 * ch; xa[i] = *(const v4u*)src; xb[i] = *(const v4u*)(src + 32);
            const f32x4* cp = (const f32x4*)(CS + t * 32 + 8 * ch); cs[i][0] = cp[0]; cs[i][1] = cp[1]; cs[i][2] = cp[2]; cs[i][3] = cp[3]; mrow[i] = m; }
        const int ch8 = tid & 7, key0 = tid >> 3; v4u vv[4];
#pragma unroll
        for (int i = 0; i < 4; ++i) { const int m = (nb - 1) * 128 + key0 + 64 * i, mc = m < 0 ? 0 : m; vv[i] = *(const v4u*)(Y + (tb + (size_t)mc * dil + r) * YP + Y_BV + head * 64 + 8 * ch8); }
#pragma unroll
        for (int i = 0; i < 3; ++i) { const int row = row0 + (i == 2 ? 128 : 0); ldsp dst = (i == 0) ? Ql + row * QP : Kl + row * KP;
            float x1[8], x2[8]; unpack8(xa[i], x1); unpack8(xb[i], x2); const float sc = (i == 0) ? 0.125f : (mrow[i] < 0 ? 0.f : 1.f); float y1[8], y2[8];
#pragma unroll
            for (int k = 0; k < 8; ++k) { const float c = cs[i][k >> 1][2 * (k & 1)], sn = cs[i][k >> 1][2 * (k & 1) + 1]; y1[k] = (x1[k] * c - x2[k] * sn) * sc; y2[k] = (x2[k] * c + x1[k] * sn) * sc; }
            v4u o1, o2; o1.x = pk2(y1[0], y1[1]); o1.y = pk2(y1[2], y1[3]); o1.z = pk2(y1[4], y1[5]); o1.w = pk2(y1[6], y1[7]);
            o2.x = pk2(y2[0], y2[1]); o2.y = pk2(y2[2], y2[3]); o2.z = pk2(y2[4], y2[5]); o2.w = pk2(y2[6], y2[7]);
            *(LAS v4u*)(dst + 16 * ch) = o1; *(LAS v4u*)(dst + 64 + 16 * ch) = o2; }
#pragma unroll
        for (int i = 0; i < 4; ++i) { const int key = key0 + 64 * i; v4u w = vv[i]; if ((nb - 1) * 128 + key < 0) w = (v4u){0u, 0u, 0u, 0u};
            *(LAS v4u*)(Vl + key * VP + 16 * ch8) = w; }
    }
    __syncthreads();
    const int ts = wave < 6 ? wave : 6;
    const bf16x8 q0 = frag(Ql, QP, 16 * wave + fr, 0, fq), q1 = frag(Ql, QP, 16 * wave + fr, 32, fq);
    f32x4 s[10];
#pragma unroll
    for (int t = 0; t < 10; ++t) { s[t] = (f32x4){0.f, 0.f, 0.f, 0.f};
        s[t] = mfma16(frag(Kl, KP, 16 * (ts + t) + fr, 0, fq), q0, s[t]); s[t] = mfma16(frag(Kl, KP, 16 * (ts + t) + fr, 32, fq), q1, s[t]); }
    const int qi = 16 * wave + fr; float mx = -INFINITY;
#pragma unroll
    for (int t = 0; t < 10; ++t)
#pragma unroll
        for (int e = 0; e < 4; ++e) { const int j = 16 * (ts + t) + 4 * fq + e; const bool ok = (j >= qi) && (j <= qi + 128) && ((nb - 1) * 128 + j >= 0); s[t][e] = ok ? s[t][e] : -INFINITY; mx = fmaxf(mx, s[t][e]); }
    mx = fmaxf(mx, __shfl_xor(mx, 16)); mx = fmaxf(mx, __shfl_xor(mx, 32));
    float den = 0.f;
#pragma unroll
    for (int t = 0; t < 10; ++t)
#pragma unroll
        for (int e = 0; e < 4; ++e) { const float p = __expf(s[t][e] - mx); s[t][e] = p; den += p; }
    den += __shfl_xor(den, 16); den += __shfl_xor(den, 32);
    f32x4 o[4];
#pragma unroll
    for (int n = 0; n < 4; ++n) o[n] = (f32x4){0.f, 0.f, 0.f, 0.f};
#pragma unroll
    for (int tp = 0; tp < 5; ++tp) { const bf16x8 pf = pfrag(s[2 * tp], s[2 * tp + 1]);
#pragma unroll
        for (int n = 0; n < 4; ++n) o[n] = mfma16(trfrag2(Vl, VP, 16 * n, 16 * (ts + 2 * tp), 16 * (ts + 2 * tp + 1), lane), pf, o[n]); }
    const size_t t = tb + (size_t)(nb * 128 + qi) * dil + r; const float rden = 1.f / den;
    float* DO = WSP(float, WS_DILO) + t * 768 + head * 64;
#pragma unroll
    for (int n = 0; n < 4; ++n) *(f32x4*)(DO + 16 * n + 4 * fq) = o[n] * rden;
    if (fq == 0) WSP(float, WS_DILL)[t * 12 + head] = mx + __logf(den);
    __syncthreads();
}
__device__ __forceinline__ void dil_merge(Ctx& C, bf16* YM) {
    const float* DO = WSP(float, WS_DILO); const float* DL = WSP(float, WS_DILL);
    for (int i = C.bid * 512 + C.tid; i < T_ * 64; i += C.G * 512) { const int t = i >> 6, hh = (i >> 4) & 3, d4 = (i & 15) * 4;
        const float l0 = DL[t * 12 + hh], l1 = DL[t * 12 + 4 + hh], l2 = DL[t * 12 + 8 + hh], m = fmaxf(l0, fmaxf(l1, l2));
        const float w0 = __expf(l0 - m), w1 = __expf(l1 - m), w2 = __expf(l2 - m), rs = 1.f / (w0 + w1 + w2);
        const f32x4 a = *(const f32x4*)(DO + (size_t)t * 768 + hh * 64 + d4), bb = *(const f32x4*)(DO + (size_t)t * 768 + (4 + hh) * 64 + d4), c = *(const f32x4*)(DO + (size_t)t * 768 + (8 + hh) * 64 + d4);
        const f32x4 o = (a * w0 + bb * w1 + c * w2) * rs; v2u w; w.x = pk2(o[0], o[1]); w.y = pk2(o[2], o[3]);
        *(v2u*)(YM + (size_t)t * 2048 + YM_B + hh * 64 + d4) = w; }
}

__device__ __forceinline__ void sgu_unit(Ctx& C, int l, int u, bf16* YM) {
    const int tid = C.tid, lane = C.lane, wave = C.wave, fr = lane & 15, fq = lane >> 4;
    const int g = u % 6, cn = u / 6; const size_t t0 = (size_t)cn * 128;
    const bf16* Y = WSP(bf16, WS_Y);
    const float* lng = C.in[11] + l * 768; const float* lnb = C.in[12] + l * 768; const float* ws = C.in[13] + (size_t)(l * 6 + g) * 128 * 128; const float* bs = C.in[14] + (l * 6 + g) * 128;
    constexpr int AP = 272, VP = 288;
    ldsp Al = C.lds, Vl = C.lds + 128 * AP; LAS float* st = (LAS float*)(Vl + 128 * VP);
    {   const int j = tid >> 2, qd = tid & 3; const bf16* src = Y + (t0 + j) * YP + Y_CV + qd * 192; float s1 = 0.f, s2 = 0.f;
        { v4u w[24];
#pragma unroll
            for (int k = 0; k < 24; ++k) w[k] = *(const v4u*)(src + 8 * k);
#pragma unroll
            for (int k = 0; k < 24; ++k) { float x[8]; unpack8(w[k], x);
#pragma unroll
                for (int q2 = 0; q2 < 8; ++q2) { const float z = fgelu(x[q2]); s1 += z; s2 += z * z; } } }
        s1 += __shfl_xor(s1, 1); s2 += __shfl_xor(s2, 1); s1 += __shfl_xor(s1, 2); s2 += __shfl_xor(s2, 2);
        if (qd == 0) { const float mu = s1 * (1.f / 768.f), var = fmaxf(s2 * (1.f / 768.f) - mu * mu, 0.f); st[2 * j] = mu; st[2 * j + 1] = 1.f / sqrtf(var + LN_EPS_); } }
    {   const int c8 = (tid & 15) * 8; f32x4 a[4], bq[4];
#pragma unroll
        for (int k4 = 0; k4 < 4; ++k4) { const int i = (tid >> 4) + 32 * k4; const float* src = ws + i * 128 + c8; a[k4] = *(const f32x4*)src; bq[k4] = *(const f32x4*)(src + 4); }
#pragma unroll
        for (int k4 = 0; k4 < 4; ++k4) { const int i = (tid >> 4) + 32 * k4; float v[8] = {a[k4][0], a[k4][1], a[k4][2], a[k4][3], bq[k4][0], bq[k4][1], bq[k4][2], bq[k4][3]};
#pragma unroll
            for (int k = 0; k < 8; ++k) v[k] = (c8 + k <= i) ? v[k] : 0.f;
            v4u o; o.x = pk2(v[0], v[1]); o.y = pk2(v[2], v[3]); o.z = pk2(v[4], v[5]); o.w = pk2(v[6], v[7]); *(LAS v4u*)(Al + i * AP + c8 * 2) = o; } }
    {   const int c8 = (tid & 15) * 8; v4u w[4];
#pragma unroll
        for (int k4 = 0; k4 < 4; ++k4) { const int j = (tid >> 4) + 32 * k4; w[k4] = *(const v4u*)(Y + (t0 + j) * YP + Y_CV + g * 128 + c8); }
        const f32x4 g0 = *(const f32x4*)(lng + g * 128 + c8), g1 = *(const f32x4*)(lng + g * 128 + c8 + 4), b0 = *(const f32x4*)(lnb + g * 128 + c8), b1 = *(const f32x4*)(lnb + g * 128 + c8 + 4);
        const float gg[8] = {g0[0], g0[1], g0[2], g0[3], g1[0], g1[1], g1[2], g1[3]}, bb[8] = {b0[0], b0[1], b0[2], b0[3], b1[0], b1[1], b1[2], b1[3]};
        __syncthreads();
#pragma unroll
        for (int k4 = 0; k4 < 4; ++k4) { const int j = (tid >> 4) + 32 * k4; float x[8]; unpack8(w[k4], x); const float mu = st[2 * j], rs = st[2 * j + 1];
#pragma unroll
            for (int k = 0; k < 8; ++k) x[k] = (fgelu(x[k]) - mu) * rs * gg[k] + bb[k];
            v4u o; o.x = pk2(x[0], x[1]); o.y = pk2(x[2], x[3]); o.z = pk2(x[4], x[5]); o.w = pk2(x[6], x[7]); *(LAS v4u*)(Vl + j * VP + c8 * 2) = o; } }
    __syncthreads();
    f32x4 acc[8];
#pragma unroll
    for (int n = 0; n < 8; ++n) acc[n] = (f32x4){0.f, 0.f, 0.f, 0.f};
    const int nks = (16 * wave + 15) / 32 + 1;
    for (int ks = 0; ks < nks; ++ks) { const bf16x8 a = frag(Al, AP, 16 * wave + fr, 32 * ks, fq);
#pragma unroll
        for (int n = 0; n < 8; ++n) acc[n] = mfma16(trfrag(Vl, VP, 16 * n, 32 * ks, lane), a, acc[n]); }
    const int i = 16 * wave + fr; const float bsi = bs[i]; const size_t t = t0 + i;
#pragma unroll
    for (int n = 0; n < 8; ++n) { const int c = 16 * n + 4 * fq; const v2u w = *(const v2u*)(Y + t * YP + Y_CU + g * 128 + c);
        const float o0 = fgelu(bflo(w.x)) * (acc[n][0] + bsi), o1 = fgelu(bfhi(w.x)) * (acc[n][1] + bsi), o2 = fgelu(bflo(w.y)) * (acc[n][2] + bsi), o3 = fgelu(bfhi(w.y)) * (acc[n][3] + bsi);
        v2u o; o.x = pk2(o0, o1); o.y = pk2(o2, o3); *(v2u*)(YM + t * 2048 + YM_C + g * 128 + c) = o; }
    __syncthreads();
}

__device__ __forceinline__ void gla_decay(Ctx& C, int l, int h, size_t t0, LAS float* Bl, LAS float* tmp  ) {
    const int tid = C.tid; const float* YSM = WSP(float, WS_YSM); const float* wa2 = C.in[3] + l * 16 * 256 + h * 64; const float* ba = C.in[4] + l * 256 + h * 64;
    { const int j = tid >> 3, d0 = (tid & 7) * 8; float a[16];
#pragma unroll
        for (int r4 = 0; r4 < 4; ++r4) { const f32x4 v = *(const f32x4*)(YSM + (t0 + j) * 32 + 4 * r4); a[4 * r4] = v[0]; a[4 * r4 + 1] = v[1]; a[4 * r4 + 2] = v[2]; a[4 * r4 + 3] = v[3]; }
#pragma unroll
        for (int k = 0; k < 8; ++k) { float s = ba[d0 + k];
#pragma unroll
            for (int r = 0; r < 16; ++r) s += a[r] * wa2[r * 256 + d0 + k];
            Bl[j * 65 + d0 + k] = flogsigmoid(s) * (1.f / 16.f); } }
    __syncthreads();
    { const int d = tid & 63, sg = tid >> 6; float run = 0.f;
#pragma unroll
        for (int k = 0; k < 8; ++k) { run += Bl[(8 * sg + k) * 65 + d]; Bl[(8 * sg + k) * 65 + d] = run; }
        tmp[sg * 64 + d] = run;
        __syncthreads();
        float off = 0.f;
        for (int s2 = 0; s2 < sg; ++s2) off += tmp[s2 * 64 + d];
#pragma unroll
        for (int k = 0; k < 8; ++k) Bl[(8 * sg + k) * 65 + d] += off; }
    __syncthreads();
}
__device__ __forceinline__ void gla_local_unit(Ctx& C, int l, int u) {
    const int tid = C.tid, lane = C.lane, wave = C.wave, fr = lane & 15, fq = lane >> 4;
    const int n = u & 31, h = (u >> 5) & 3, b = u >> 7; const size_t t0 = (size_t)b * SEQ_ + n * 64;
    const bf16* Y = WSP(bf16, WS_Y);
    constexpr int KP = 160, VP = 288;
    LAS float* Bl = (LAS float*)C.lds; LAS float* tmp = Bl + 64 * 65; ldsp Kl = (ldsp)(tmp + 512), Vl = Kl + 64 * KP;
    gla_decay(C, l, h, t0, Bl, tmp);
    {   const int j = tid >> 3, d0 = (tid & 7) * 8, e0 = (tid & 15) * 8;
        const v4u kw = *(const v4u*)(Y + (t0 + j) * YP + Y_AK + h * 64 + d0); v4u vw[2];
#pragma unroll
        for (int i = 0; i < 2; ++i) vw[i] = *(const v4u*)(Y + (t0 + (tid >> 4) + 32 * i) * YP + Y_AV + h * 128 + e0);
        float x[8]; unpack8(kw, x);
#pragma unroll
        for (int k = 0; k < 8; ++k) x[k] = x[k] * __expf(Bl[63 * 65 + d0 + k] - Bl[j * 65 + d0 + k]);
        v4u o; o.x = pk2(x[0], x[1]); o.y = pk2(x[2], x[3]); o.z = pk2(x[4], x[5]); o.w = pk2(x[6], x[7]); *(LAS v4u*)(Kl + j * KP + d0 * 2) = o;
#pragma unroll
        for (int i = 0; i < 2; ++i) *(LAS v4u*)(Vl + ((tid >> 4) + 32 * i) * VP + e0 * 2) = vw[i];
    }
    __syncthreads();
    float* LOC = WSP(float, WS_GLOC) + (size_t)u * 64 * 128; float* DEC = WSP(float, WS_GDEC) + (size_t)u * 64;
    if (tid < 64) DEC[tid] = __expf(Bl[63 * 65 + tid]);
#pragma unroll
    for (int mt = 0; mt < 4; ++mt) { f32x4 acc = (f32x4){0.f, 0.f, 0.f, 0.f};
#pragma unroll
        for (int ks = 0; ks < 2; ++ks) acc = mfma16(trfrag2(Vl, VP, 16 * wave, 32 * ks, 32 * ks + 16, lane), trfrag2(Kl, KP, 16 * mt, 32 * ks, 32 * ks + 16, lane), acc);
        *(f32x4*)(LOC + (size_t)(16 * mt + fr) * 128 + 16 * wave + 4 * fq) = acc; }
    __syncthreads();
}
__device__ __forceinline__ void gla_scan(Ctx& C) {
    const float* LOC = WSP(float, WS_GLOC); const float* DEC = WSP(float, WS_GDEC); bf16* ST = WSP(bf16, WS_GST);
    for (int i = C.bid * 512 + C.tid; i < 16 * 8192; i += C.G * 512) { const int bh = i >> 13, de = i & 8191, d = de >> 7; float S = 0.f;
        float lc[32], dc[32];
#pragma unroll
        for (int n = 0; n < 32; ++n) { const size_t uu = (size_t)bh * 32 + n; lc[n] = LOC[uu * 8192 + de]; dc[n] = DEC[uu * 64 + d]; }
#pragma unroll
        for (int n = 0; n < 32; ++n) { const size_t uu = (size_t)bh * 32 + n; ST[uu * 8192 + de] = bf1(S); S = dc[n] * S + lc[n]; } }
}
__device__ __forceinline__ void gla_out_unit(Ctx& C, int l, int u, bf16* YM) {
    const int tid = C.tid, lane = C.lane, wave = C.wave, fr = lane & 15, fq = lane >> 4;
    const int n = u & 31, h = (u >> 5) & 3, b = u >> 7; const size_t t0 = (size_t)b * SEQ_ + n * 64;
    const bf16* Y = WSP(bf16, WS_Y); const bf16* ST = WSP(bf16, WS_GST) + (size_t)u * 8192;
    constexpr int QP = 144, VP = 288;
    LAS float* Bl = (LAS float*)C.lds; LAS float* tmp = Bl + 64 * 65; ldsp Ql = (ldsp)(tmp + 512), Kl = Ql + 64 * QP, Vl = Kl + 64 * QP, Sl = Vl + 64 * VP; LAS float* ssq = (LAS float*)(Sl + 64 * VP);
    gla_decay(C, l, h, t0, Bl, tmp);
    {   const int j = tid >> 3, d0 = (tid & 7) * 8, e0 = (tid & 15) * 8, j2 = tid >> 4;
        const v4u qw = *(const v4u*)(Y + (t0 + j) * YP + Y_AQ + h * 64 + d0), kw = *(const v4u*)(Y + (t0 + j) * YP + Y_AK + h * 64 + d0); v4u vw[2], sw[2];
#pragma unroll
        for (int i = 0; i < 2; ++i) { vw[i] = *(const v4u*)(Y + (t0 + j2 + 32 * i) * YP + Y_AV + h * 128 + e0); sw[i] = *(const v4u*)(ST + (j2 + 32 * i) * 128 + e0); }
        float xq[8], xk[8]; unpack8(qw, xq); unpack8(kw, xk);
#pragma unroll
        for (int k = 0; k < 8; ++k) { const float bb = Bl[j * 65 + d0 + k]; xq[k] = xq[k] * 0.125f * __expf(bb); xk[k] = xk[k] * __expf(-bb); }
        v4u o; o.x = pk2(xq[0], xq[1]); o.y = pk2(xq[2], xq[3]); o.z = pk2(xq[4], xq[5]); o.w = pk2(xq[6], xq[7]); *(LAS v4u*)(Ql + j * QP + d0 * 2) = o;
        o.x = pk2(xk[0], xk[1]); o.y = pk2(xk[2], xk[3]); o.z = pk2(xk[4], xk[5]); o.w = pk2(xk[6], xk[7]); *(LAS v4u*)(Kl + j * QP + d0 * 2) = o;
#pragma unroll
        for (int i = 0; i < 2; ++i) { *(LAS v4u*)(Vl + (j2 + 32 * i) * VP + e0 * 2) = vw[i]; *(LAS v4u*)(Sl + (j2 + 32 * i) * VP + e0 * 2) = sw[i]; }
    }
    __syncthreads();
    const int mt = wave & 3, nh = wave >> 2;
    const bf16x8 qa0 = frag(Ql, QP, 16 * mt + fr, 0, fq), qa1 = frag(Ql, QP, 16 * mt + fr, 32, fq);
    f32x4 att[4];
#pragma unroll
    for (int t = 0; t < 4; ++t) { att[t] = (f32x4){0.f, 0.f, 0.f, 0.f}; att[t] = mfma16(frag(Kl, QP, 16 * t + fr, 0, fq), qa0, att[t]); att[t] = mfma16(frag(Kl, QP, 16 * t + fr, 32, fq), qa1, att[t]);
#pragma unroll
        for (int e = 0; e < 4; ++e) att[t][e] = (16 * t + 4 * fq + e <= 16 * mt + fr) ? att[t][e] : 0.f; }
    const bf16x8 p0 = pfrag(att[0], att[1]), p1 = pfrag(att[2], att[3]);
    f32x4 o[4];
#pragma unroll
    for (int nt = 0; nt < 4; ++nt) { const int ec = 64 * nh + 16 * nt; f32x4 a = (f32x4){0.f, 0.f, 0.f, 0.f};
        a = mfma16(trfrag2(Vl, VP, ec, 0, 16, lane), p0, a); a = mfma16(trfrag2(Vl, VP, ec, 32, 48, lane), p1, a);
        a = mfma16(trfrag(Sl, VP, ec, 0, lane), qa0, a); a = mfma16(trfrag(Sl, VP, ec, 32, lane), qa1, a); o[nt] = a; }
    float sq = 0.f;
#pragma unroll
    for (int nt = 0; nt < 4; ++nt) sq += (o[nt][0] * o[nt][0] + o[nt][1] * o[nt][1]) + (o[nt][2] * o[nt][2] + o[nt][3] * o[nt][3]);
    sq += __shfl_xor(sq, 16); sq += __shfl_xor(sq, 32);
    const int i = 16 * mt + fr;
    if (fq == 0) ssq[2 * i + nh] = sq;
    __syncthreads();
    const float rs = 1.f / sqrtf((ssq[2 * i] + ssq[2 * i + 1]) * (1.f / 128.f) + LN_EPS_);
    const float* ng = C.in[5] + l * 512 + h * 128; const size_t t = t0 + i;
#pragma unroll
    for (int nt = 0; nt < 4; ++nt) { const int e = 64 * nh + 16 * nt + 4 * fq; const f32x4 gv = *(const f32x4*)(ng + e); const v2u rw = *(const v2u*)(Y + t * YP + Y_AR + h * 128 + e);
        const float r0 = bflo(rw.x), r1 = bfhi(rw.x), r2 = bflo(rw.y), r3 = bfhi(rw.y);
        v2u w; w.x = pk2(o[nt][0] * rs * gv[0] * r0 * fsigmoid(r0), o[nt][1] * rs * gv[1] * r1 * fsigmoid(r1)); w.y = pk2(o[nt][2] * rs * gv[2] * r2 * fsigmoid(r2), o[nt][3] * rs * gv[3] * r3 * fsigmoid(r3));
        *(v2u*)(YM + t * 2048 + YM_A + h * 128 + e) = w; }
    __syncthreads();
}

__device__ __forceinline__ void ml_prep(Ctx& C, int l, int h, int b, int n, LAS float* gl, ldsp Ql, ldsp Kl, int QP, bool need_q) {
    const int tid = C.tid, lane = C.lane; const size_t t0 = (size_t)b * SEQ_ + n * 64;
    const bf16* Y = WSP(bf16, WS_Y); const float* YSM = WSP(float, WS_YSM);
    if (tid < 64) { const float lf = flogsigmoid(YSM[(t0 + lane) * 32 + 20 + h] + C.in[9][l * 4 + h]); float run = lf;
#pragma unroll
        for (int o = 1; o < 64; o <<= 1) { const float v = __shfl_up(run, o); if (lane >= o) run += v; }
        gl[lane] = run; gl[64 + lane] = YSM[(t0 + lane) * 32 + 16 + h] + C.in[8][l * 4 + h]; }
    const float* cw = C.in[6] + l * 4096; const float* cb = C.in[7] + l * 1024;
    {   const int c0 = (tid & 15) * 8, j0 = tid >> 4;
#pragma unroll
        for (int qk = 0; qk < 2; ++qk) { if (qk == 0 && !need_q) continue;
            const int cc = (qk == 0 ? 0 : 512) + h * 128 + c0, ycol = (qk == 0 ? Y_DQ : Y_DK) + h * 128 + c0;
            v4u xw[2][4]; f32x4 w4[4][2], b4[2];
#pragma unroll
            for (int i = 0; i < 2; ++i)
#pragma unroll
                for (int jj = 0; jj < 4; ++jj) { const int j = j0 + 32 * i, rel = j - 3 + jj, ok = (n * 64 + rel) >= 0; xw[i][jj] = *(const v4u*)(Y + (t0 + (ok ? rel : j)) * YP + ycol); }
#pragma unroll
            for (int jj = 0; jj < 4; ++jj) { w4[jj][0] = *(const f32x4*)(cw + jj * 1024 + cc); w4[jj][1] = *(const f32x4*)(cw + jj * 1024 + cc + 4); }
            b4[0] = *(const f32x4*)(cb + cc); b4[1] = *(const f32x4*)(cb + cc + 4);
#pragma unroll
            for (int i = 0; i < 2; ++i) { const int j = j0 + 32 * i; float a[8] = {b4[0][0], b4[0][1], b4[0][2], b4[0][3], b4[1][0], b4[1][1], b4[1][2], b4[1][3]};
#pragma unroll
                for (int jj = 0; jj < 4; ++jj) { const float mk = (n * 64 + j - 3 + jj) >= 0 ? 1.f : 0.f; float x[8]; unpack8(xw[i][jj], x);
#pragma unroll
                    for (int k = 0; k < 8; ++k) a[k] += (w4[jj][k >> 2][k & 3] * mk) * x[k]; }
                const float sc = qk == 0 ? 1.f : 0.08838834764831845f;
#pragma unroll
                for (int k = 0; k < 8; ++k) a[k] = a[k] * fsigmoid(a[k]) * sc;
                v4u o; o.x = pk2(a[0], a[1]); o.y = pk2(a[2], a[3]); o.z = pk2(a[4], a[5]); o.w = pk2(a[6], a[7]); *(LAS v4u*)((qk == 0 ? Ql : Kl) + j * QP + c0 * 2) = o; } }
    }
    __syncthreads();
}
__device__ __forceinline__ void ml_local_unit(Ctx& C, int l, int u) {
    const int tid = C.tid, lane = C.lane, wave = C.wave, fr = lane & 15, fq = lane >> 4;
    const int n = u & 31, h = (u >> 5) & 3, b = u >> 7; const size_t t0 = (size_t)b * SEQ_ + n * 64;
    const bf16* Y = WSP(bf16, WS_Y);
    constexpr int KP = 288, TP = 288;
    LAS float* gl = (LAS float*)C.lds; LAS float* wk = gl + 128; LAS float* red = wk + 64;
    ldsp Kl = (ldsp)(red + 512), Vl = Kl + 64 * KP;
    ml_prep(C, l, h, b, n, gl, Kl, Kl, KP, false);
    if (tid < 64) { const float bl = gl[63], dec = bl - gl[lane] + gl[64 + lane], a = wave_max(dec); wk[lane] = __expf(dec - a);
        if (lane == 0) { float* SC = WSP(float, WS_MSC) + (size_t)u * 2; SC[0] = bl; SC[1] = a; } }
    __syncthreads();
    { const int d = tid & 127, sg = tid >> 7; float s = 0.f;
        for (int j = 16 * sg; j < 16 * sg + 16; ++j) s += wk[j] * bflo((unsigned)*(const LAS unsigned short*)(Kl + j * KP + d * 2));
        red[sg * 128 + d] = s; }
    {   const int c0 = (tid & 15) * 8, j0 = tid >> 4; v4u vw[2];
#pragma unroll
        for (int i = 0; i < 2; ++i) vw[i] = *(const v4u*)(Y + (t0 + j0 + 32 * i) * YP + Y_DV + h * 128 + c0);
#pragma unroll
        for (int i = 0; i < 2; ++i) *(LAS v4u*)(Vl + (j0 + 32 * i) * TP + c0 * 2) = vw[i];
    }
    __syncthreads();
    {   const int c0 = (tid & 15) * 8, j0 = tid >> 4;
#pragma unroll
        for (int i = 0; i < 2; ++i) { const int j = j0 + 32 * i; float x[8]; unpack8(*(const LAS v4u*)(Kl + j * KP + c0 * 2), x); const float w = wk[j];
            v4u o; o.x = pk2(x[0] * w, x[1] * w); o.y = pk2(x[2] * w, x[3] * w); o.z = pk2(x[4] * w, x[5] * w); o.w = pk2(x[6] * w, x[7] * w); *(LAS v4u*)(Kl + j * KP + c0 * 2) = o; }
    }
    if (tid < 128) WSP(float, WS_MNLOC)[(size_t)u * 128 + tid] = (red[tid] + red[128 + tid]) + (red[256 + tid] + red[384 + tid]);
    __syncthreads();
    float* LOC = WSP(float, WS_MLOC) + (size_t)u * 16384;
#pragma unroll
    for (int mt = 0; mt < 8; ++mt) { f32x4 acc = (f32x4){0.f, 0.f, 0.f, 0.f};
#pragma unroll
        for (int ks = 0; ks < 2; ++ks) acc = mfma16(trfrag2(Vl, TP, 16 * wave, 32 * ks, 32 * ks + 16, lane), trfrag2(Kl, KP, 16 * mt, 32 * ks, 32 * ks + 16, lane), acc);
        *(f32x4*)(LOC + (size_t)(16 * mt + fr) * 128 + 16 * wave + 4 * fq) = acc; }
    __syncthreads();
}
__device__ __forceinline__ void ml_scan(Ctx& C) {
    const float* LOC = WSP(float, WS_MLOC); const float* NL = WSP(float, WS_MNLOC); const float* SC = WSP(float, WS_MSC);
    bf16* MC = WSP(bf16, WS_MC); float* MN = WSP(float, WS_MN); float* MM = WSP(float, WS_MM);
    for (int i = C.bid * 512 + C.tid; i < 16 * (16384 + 128); i += C.G * 512) { const int bh = i / (16384 + 128), r = i % (16384 + 128); float S = 0.f, m = 0.f;
        float lc[32], bl_[32], a_[32];
#pragma unroll
        for (int n = 0; n < 32; ++n) { const size_t uu = (size_t)bh * 32 + n; lc[n] = r < 16384 ? LOC[uu * 16384 + r] : NL[uu * 128 + (r - 16384)]; bl_[n] = SC[uu * 2]; a_[n] = SC[uu * 2 + 1]; }
#pragma unroll
        for (int n = 0; n < 32; ++n) { const size_t uu = (size_t)bh * 32 + n; const float bl = bl_[n], a = a_[n], mn = fmaxf(bl + m, a), keep = __expf(bl + m - mn), sc = __expf(a - mn);
            if (r < 16384) MC[uu * 16384 + r] = bf1(S);
            else { const int d = r - 16384; MN[uu * 128 + d] = S; if (d == 0) MM[uu] = m; }
            S = keep * S + sc * lc[n]; m = mn; } }
}
__device__ __forceinline__ void ml_out_unit(Ctx& C, int l, int u, bf16* YM) {
    const int tid = C.tid, lane = C.lane, wave = C.wave, fr = lane & 15, fq = lane >> 4;
    const int n = u & 31, h = (u >> 5) & 3, b = u >> 7; const size_t t0 = (size_t)b * SEQ_ + n * 64;
    const bf16* Y = WSP(bf16, WS_Y); const bf16* MC = WSP(bf16, WS_MC) + (size_t)u * 16384; const float* MN = WSP(float, WS_MN) + (size_t)u * 128; const float m0 = WSP(float, WS_MM)[u];
    constexpr int QP = 272, TP = 288;
    LAS float* gl = (LAS float*)C.lds; LAS float* mt_ = gl + 128; LAS float* wst = mt_ + 64; LAS float* qn = wst + 64; LAS float* ssq = qn + 64;
    ldsp Ql = (ldsp)(ssq + 128), Kl = Ql + 64 * QP, Vl = Kl + 64 * QP, Cl = Vl + 64 * TP;
    ml_prep(C, l, h, b, n, gl, Ql, Kl, QP, true);
    if (tid < 64) { float pm = gl[64 + lane] - gl[lane];
#pragma unroll
        for (int o = 1; o < 64; o <<= 1) { const float v = __shfl_up(pm, o); if (lane >= o) pm = fmaxf(pm, v); }
        const float mt = gl[lane] + fmaxf(m0, pm); mt_[lane] = mt; wst[lane] = __expf(gl[lane] + m0 - mt); }
    {   const int c0 = (tid & 15) * 8, j0 = tid >> 4; v4u vw[2], cw4[4];
#pragma unroll
        for (int i = 0; i < 2; ++i) vw[i] = *(const v4u*)(Y + (t0 + j0 + 32 * i) * YP + Y_DV + h * 128 + c0);
#pragma unroll
        for (int i = 0; i < 4; ++i) cw4[i] = *(const v4u*)(MC + (j0 + 32 * i) * 128 + c0);
#pragma unroll
        for (int i = 0; i < 2; ++i) *(LAS v4u*)(Vl + (j0 + 32 * i) * TP + c0 * 2) = vw[i];
#pragma unroll
        for (int i = 0; i < 4; ++i) *(LAS v4u*)(Cl + (j0 + 32 * i) * TP + c0 * 2) = cw4[i];
    }
    { const int i = tid >> 3, d0 = (tid & 7) * 16; float s = 0.f;
#pragma unroll
        for (int k2 = 0; k2 < 2; ++k2) { float x[8]; unpack8(*(const LAS v4u*)(Ql + i * QP + (d0 + 8 * k2) * 2), x);
#pragma unroll
            for (int k = 0; k < 8; ++k) s += x[k] * MN[d0 + 8 * k2 + k]; }
        s += __shfl_xor(s, 1); s += __shfl_xor(s, 2); s += __shfl_xor(s, 4);
        if ((tid & 7) == 0) qn[i] = s; }
    __syncthreads();
    const int mt = wave & 3, nh = wave >> 2, i = 16 * mt + fr;
    bf16x8 qa[4];
#pragma unroll
    for (int ks = 0; ks < 4; ++ks) qa[ks] = frag(Ql, QP, i, 32 * ks, fq);
    const float bi_ = gl[i], mti = mt_[i], wsti = wst[i];
    f32x4 sc[4]; float rsum = 0.f;
#pragma unroll
    for (int t = 0; t < 4; ++t) { sc[t] = (f32x4){0.f, 0.f, 0.f, 0.f};
#pragma unroll
        for (int ks = 0; ks < 4; ++ks) sc[t] = mfma16(frag(Kl, QP, 16 * t + fr, 32 * ks, fq), qa[ks], sc[t]);
#pragma unroll
        for (int e = 0; e < 4; ++e) { const int j = 16 * t + 4 * fq + e; const float w = (j <= i) ? __expf(bi_ - gl[j] + gl[64 + j] - mti) : 0.f; sc[t][e] *= w; rsum += sc[t][e]; } }
    rsum += __shfl_xor(rsum, 16); rsum += __shfl_xor(rsum, 32);
    const float den = rsum + wsti * qn[i], rden = 1.f / fmaxf(fabsf(den), __expf(-mti));
    const bf16x8 p0 = pfrag(sc[0], sc[1]), p1 = pfrag(sc[2], sc[3]);
    f32x4 o[4]; float sq = 0.f;
    const size_t t = t0 + i;
#pragma unroll
    for (int nt = 0; nt < 4; ++nt) { const int ec = 64 * nh + 16 * nt; f32x4 a1 = (f32x4){0.f, 0.f, 0.f, 0.f}, a2 = a1;
        a1 = mfma16(trfrag2(Vl, TP, ec, 0, 16, lane), p0, a1); a1 = mfma16(trfrag2(Vl, TP, ec, 32, 48, lane), p1, a1);
#pragma unroll
        for (int ks = 0; ks < 4; ++ks) a2 = mfma16(trfrag(Cl, TP, ec, 32 * ks, lane), qa[ks], a2);
        const v2u ow = *(const v2u*)(Y + t * YP + Y_DO + h * 128 + 64 * nh + 16 * nt + 4 * fq);
        f32x4 hv = (a1 + a2 * wsti) * rden; hv[0] *= fsigmoid(bflo(ow.x)); hv[1] *= fsigmoid(bfhi(ow.x)); hv[2] *= fsigmoid(bflo(ow.y)); hv[3] *= fsigmoid(bfhi(ow.y));
        o[nt] = hv; sq += (hv[0] * hv[0] + hv[1] * hv[1]) + (hv[2] * hv[2] + hv[3] * hv[3]); }
    sq += __shfl_xor(sq, 16); sq += __shfl_xor(sq, 32);
    if (fq == 0) ssq[2 * i + nh] = sq;
    __syncthreads();
    const float rs = 1.f / sqrtf((ssq[2 * i] + ssq[2 * i + 1]) * (1.f / 128.f) + LN_EPS_);
    const float* ng = C.in[10] + l * 512 + h * 128;
#pragma unroll
    for (int nt = 0; nt < 4; ++nt) { const int e = 64 * nh + 16 * nt + 4 * fq; const f32x4 gv = *(const f32x4*)(ng + e);
        v2u w; w.x = pk2(o[nt][0] * rs * gv[0], o[nt][1] * rs * gv[1]); w.y = pk2(o[nt][2] * rs * gv[2], o[nt][3] * rs * gv[3]);
        *(v2u*)(YM + t * 2048 + YM_D + h * 128 + e) = w; }
    __syncthreads();
}

#ifndef MIXREP
#define MIXREP 0
#endif
#define RELAUNDER(C) do { int zv_ = 0; asm volatile("" : "+v"(zv_)); unsigned long long zw_ = (unsigned long long)(C).ws; asm volatile("" : "+s"(zw_)); (C).ws = (unsigned char*)(GAS unsigned char*)zw_;     \
    (C).tid = (int)threadIdx.x + zv_; (C).lane = (C).tid & 63; (C).wave = __builtin_amdgcn_readfirstlane((C).tid >> 6); } while (0)
__device__ __forceinline__ void phase_mix_a(Ctx& C, int l, bf16* YM) {
    const bool std_grid = C.G == 256;
    if (std_grid) {
        const int nd = C.bid < 128 ? 2 : 4, d0 = C.bid < 128 ? C.bid : 256 + (C.bid - 128);
        for (int k = 0; k < nd; ++k) { RELAUNDER(C); const int u = d0 + 128 * k; dil_unit(C, u); if (MIXREP & 1) dil_unit(C, u); }
    } else for (int u = C.bid; u < 768; u += C.G) { RELAUNDER(C); dil_unit(C, u); }
    for (int u = C.bid; u < 384; u += C.G) { RELAUNDER(C); sgu_unit(C, l, u, YM); if (MIXREP & 2) sgu_unit(C, l, u, YM); }
    for (int u = C.bid; u < 512; u += C.G) { RELAUNDER(C); gla_local_unit(C, l, u); if (MIXREP & 4) gla_local_unit(C, l, u); }
    for (int u = C.bid; u < 512; u += C.G) { RELAUNDER(C); ml_local_unit(C, l, u); if (MIXREP & 8) ml_local_unit(C, l, u); }
}
__device__ __forceinline__ void phase_mix_b(Ctx& C, bf16* YM) { gla_scan(C); ml_scan(C); dil_merge(C, YM); }
__device__ __forceinline__ void phase_mix_c(Ctx& C, int l, bf16* YM) {
    for (int u = C.bid; u < 1024; u += C.G) { RELAUNDER(C); if (u < 512) { gla_out_unit(C, l, u, YM); if (MIXREP & 16) gla_out_unit(C, l, u, YM); } else { ml_out_unit(C, l, u - 512, YM); if (MIXREP & 32) ml_out_unit(C, l, u - 512, YM); } }
}
#ifndef STEAL_ON
#define STEAL_ON 0
#endif
#ifndef Y_WGM
#define Y_WGM 8
#endif
#ifndef NCONV
#define NCONV 72
#endif
#ifndef REPEAT_MASK
#define REPEAT_MASK 0
#endif
#define REP(k) (((REPEAT_MASK) >> (k)) & 1)
#define RELAUNDER_T(C) do { int zv_ = 0; asm volatile("" : "+v"(zv_)); (C).tid = (int)threadIdx.x + zv_; (C).lane = (C).tid & 63; (C).wave = __builtin_amdgcn_readfirstlane((C).tid >> 6); } while (0)
#define IN(k) (lo <= (k) && (k) < hi)
#define SEAM(k) do { if (IN(k) && IN((k) + 1)) xcd_barrier(bar); } while (0)
#define STEAL(k) do { if (STEAL_ON && FP8_LAST && l + 2 == NL_ && IN(k) && IN((k) + 1)) { unsigned* arr_ = WSP(unsigned, WS_CTL) + CW_ARR + 64 * (k); __syncthreads(); if (C.tid == 0) atomicAdd(arr_, 1u); \
        phase_convert(C, l + 1, 1, C.bid, C.G, arr_); } } while (0)
template <int l>
__device__ __forceinline__ void layer_program(Ctx& C, const XcdBarrier& bar, const int lo, const int hi) {
    constexpr int p0 = l * 12;
    const float* Xin = l == 0 ? C.in[0] : WSP(float, WS_XA);
    if (l == 0) { if (IN(p0 + 0)) for (int rep_ = 0; rep_ < 1 + REP(0); ++rep_) { RELAUNDER_T(C); phase_convert(C, l, 0, C.bid, C.G); }
        SEAM(p0 + 0); }
    if (IN(p0 + 1)) for (int rep_ = 0; rep_ < 1 + REP(1); ++rep_) { RELAUNDER_T(C);
        if (C.bid < NCONV) phase_convert(C, l, 1, C.bid, NCONV);
        else {
        if constexpr (GATES8(l)) {
            { pg8::Gemm g{WSP(bf16, WS_XB), WSP(bf16, WS_WIN), T_, 7680, 2048, 2048, 2048, nullptr}; pg8::StaticOrder S; S.init(T_, 7680, C.G - NCONV, C.bid - NCONV, Y_WGM);
              EpiY E{WSP(bf16, WS_Y), WSP(float, WS_YSM), 0}; pg8::gemm_phase<EpiY, pg8::StaticOrder, true>(C.lds, g, S, E, C.tid); }
            { pg8::Gemm g{WSP(bf16, WS_XB8), WSP(bf16, WS_WIN8), T_, 8192, 1024, 1024, 1024, nullptr}; pg8::StaticOrder S; S.init(T_, 8192, C.G - NCONV, C.bid - NCONV, Y_WGM);
              EpiY E{WSP(bf16, WS_Y), WSP(float, WS_YSM), 30}; pg8::gemm_phase<EpiY, pg8::StaticOrder, true, false, 2, 1>(C.lds, g, S, E, C.tid); }
        } else {
        pg8::Gemm g{WSP(bf16, WS_XB), WSP(bf16, WS_WIN), T_, YP, 2048, 2048, 2048, nullptr}; pg8::StaticOrder S; S.init(T_, YP, C.G - NCONV, C.bid - NCONV, Y_WGM);
        EpiY E{WSP(bf16, WS_Y), WSP(float, WS_YSM), 0};
        pg8::gemm_phase<EpiY, pg8::StaticOrder, true>(C.lds, g, S, E, C.tid); }
        phase_convert(C, l, 1, C.bid, NCONV); }
    }
    SEAM(p0 + 1);
    bf16* YMo = WSP(bf16, MK_MODE == 1 ? WS_MRG : WS_YM);
    if (IN(p0 + 2)) for (int rep_ = 0; rep_ < 1 + REP(2); ++rep_) { RELAUNDER_T(C); phase_mix_a(C, l, YMo); }
    SEAM(p0 + 2);
    if (IN(p0 + 3)) for (int rep_ = 0; rep_ < 1 + REP(3); ++rep_) { RELAUNDER_T(C); phase_mix_b(C, YMo); }
    SEAM(p0 + 3);
    if (IN(p0 + 4)) for (int rep_ = 0; rep_ < 1 + REP(4); ++rep_) { RELAUNDER_T(C); phase_mix_c(C, l, YMo); }
    SEAM(p0 + 4);
    if (IN(p0 + 5)) for (int rep_ = 0; rep_ < 1 + REP(5); ++rep_) { RELAUNDER_T(C);
        pg8::StaticOrder S; S.init(T_, 4096, C.G, C.bid);
        pg8::Gemm g{WSP(bf16, WS_YM), WSP(bf16, WS_WP), T_, 2048, 2048, 2048, 2048, nullptr}; EpiMerge E; E.Y = WSP(bf16, WS_Y); E.MB = WSP(bf16, WS_MB);
        if (MERGE3) pg8::gemm_phase_n1s3<EpiMerge, pg8::StaticOrder>(C.lds, g, S, E, C.tid); else pg8::gemm_phase<EpiMerge, pg8::StaticOrder, true, false, 1>(C.lds, g, S, E, C.tid);
    }
    SEAM(p0 + 5);
    if (IN(p0 + 6)) for (int rep_ = 0; rep_ < 1 + REP(6); ++rep_) { RELAUNDER_T(C);
        pg8::Gemm g{WSP(bf16, WS_MB), WSP(bf16, WS_WOUT), T_, 2048, 2048, 2048, 2048, nullptr}; pg8::StaticOrder S; S.init(T_, 2048, C.G, C.bid);
        EpiOut E{Xin, WSP(float, WS_HB)};
        pg8::gemm_phase<EpiOut, pg8::StaticOrder, true>(C.lds, g, S, E, C.tid);
    }
    SEAM(p0 + 6);
    if (IN(p0 + 7)) for (int rep_ = 0; rep_ < 1 + REP(7); ++rep_) { RELAUNDER_T(C); phase_ln1_router(C, l); }
    SEAM(p0 + 7);
    if (IN(p0 + 8)) for (int rep_ = 0; rep_ < 1 + REP(8); ++rep_) { RELAUNDER_T(C); phase_scatter(C, l); }
    SEAM(p0 + 8);
    if (IN(p0 + 9)) for (int rep_ = 0; rep_ < 1 + REP(9); ++rep_) { RELAUNDER_T(C);
        MoeOrder S; S.init(WSP(int, WS_CTL) + CW_TST + l * 128, 4, C.G, C.bid, C.lane);
        if constexpr (MOE8(l)) {
            pg8::Gemm g{WSP(bf16, WS_XS8), WSP(bf16, l == NL_ - 1 ? WS_W13B : WS_W13), MAXROWS, 65 * 1024, 1024, 1024, 1024, WSP(int, WS_ROWMAP)};
            EpiMoe1F8 E{WSP(unsigned char, WS_H), WSP(float, WS_ROWW)};
            pg8::gemm_phase<EpiMoe1F8, MoeOrder, true, true, 2, 1>(C.lds, g, S, E, C.tid);
        } else {
            pg8::Gemm g{WSP(bf16, WS_XS), WSP(bf16, WS_W13), MAXROWS, 65 * 1024, 2048, 2048, 2048, WSP(int, WS_ROWMAP)};
            EpiMoe1 E{WSP(bf16, WS_H), WSP(float, WS_ROWW), 4};
            pg8::gemm_phase<EpiMoe1, MoeOrder, true, true>(C.lds, g, S, E, C.tid);
        }
    }
    if (STEAL_ON & 1) STEAL(p0 + 9);
    SEAM(p0 + 9);
    if (IN(p0 + 10)) for (int rep_ = 0; rep_ < 1 + REP(10); ++rep_) { RELAUNDER_T(C);
        MoeOrder S; S.init(WSP(int, WS_CTL) + CW_TST + l * 128, 8, C.G, C.bid, C.lane);
        EpiMoe2 E{WSP(bf16, WS_YBUF)};
        if constexpr (MOE8(l)) {
            pg8::Gemm g{WSP(bf16, WS_H), WSP(bf16, l == NL_ - 1 ? WS_W2B : WS_W2), MAXROWS, 65 * 2048, 256, 256, 256, nullptr};
            pg8::gemm_phase<EpiMoe2, MoeOrder, true, false, 2, 1>(C.lds, g, S, E, C.tid);
        } else {
            pg8::Gemm g{WSP(bf16, WS_H), WSP(bf16, WS_W2), MAXROWS, 65 * 2048, 512, 512, 512, nullptr};
            pg8::gemm_phase<EpiMoe2, MoeOrder, true>(C.lds, g, S, E, C.tid);
        }
    }
    if (STEAL_ON & 2) STEAL(p0 + 10);
    SEAM(p0 + 10);
    if (IN(p0 + 11)) for (int rep_ = 0; rep_ < 1 + REP(11); ++rep_) { RELAUNDER_T(C); phase_combine(C, l); if (l + 1 < NL_) phase_convert(C, l + 1, 0, C.bid, C.G); }
    if (STEAL_ON & 4) STEAL(p0 + 11);
    SEAM(p0 + 11);
}
__global__ void __launch_bounds__(512, 2) fwd(KArgs args) {
    extern __shared__ __attribute__((aligned(16))) unsigned char lds_[];
    Ctx C;
    C.lds = (LAS unsigned char*)lds_; C.ws = args.ws; C.out = args.out;
#pragma unroll
    for (int i = 0; i < 32; ++i) C.in[i] = args.in[i];
    C.tid = threadIdx.x; C.lane = C.tid & 63; C.wave = __builtin_amdgcn_readfirstlane(C.tid >> 6); C.G = gridDim.x; C.bid = blockIdx.x;
    const int lo = args.ph_lo, hi = args.ph_hi;
    if (C.tid < 4) ((LAS unsigned*)(C.lds + AUX_BARW))[C.tid] = 0u;
    __syncthreads();
    XcdBarrier bar; bar.bar = WSP(unsigned, WS_CTL) + CW_BAR + args.region * XCD_BAR_WORDS; bar.x = 0; bar.st = (volatile LAS unsigned*)(C.lds + AUX_BARW);
    if (hi - lo > 1) bar = xcd_barrier_post(bar.bar, (volatile LAS unsigned*)(C.lds + AUX_BARW));
    layer_program<0>(C, bar, lo, hi);
    layer_program<1>(C, bar, lo, hi);
}
#undef IN
#undef SEAM

#define NIDX (blockIdx.x * blockDim.x + threadIdx.x)
__global__ void __launch_bounds__(256) nk_gla_g(const float* YSM, const float* wa2, const float* ba, float* GG) { const int i = NIDX; if (i < T_ * 256) naive_gla_g(i >> 8, i & 255, YSM, wa2, ba, GG); }
__global__ void __launch_bounds__(64) nk_gla_rec(const bf16* Y, const float* GG, float* OA) { const int i = NIDX; if (i < 2048) naive_gla_rec(i >> 9, (i >> 7) & 3, i & 127, SEQ_, Y, GG, OA); }
__global__ void __launch_bounds__(256) nk_gla_post(const bf16* Y, const float* OA, const float* ng, bf16* YM) { const int i = NIDX; if (i < T_ * 4) naive_gla_post(i >> 2, i & 3, Y, OA, ng, YM); }
__global__ void __launch_bounds__(256) nk_rope(const bf16* Y, const int* pos, float* QR, float* KR) { const int i = NIDX; if (i < T_ * 384) naive_rope(i / 384, (i % 384) >> 5, i & 31, Y, pos, QR, KR); }
__global__ void __launch_bounds__(64) nk_dil(const float* QR, const float* KR, const bf16* Y, bf16* YM) { const int i = NIDX; if (i < T_ * 4) naive_dil(i >> 2, i & 3, SEQ_, QR, KR, Y, YM); }
__global__ void __launch_bounds__(256) nk_sgu_stats(const bf16* Y, float* MU, float* RS) { const int i = NIDX; if (i < T_) naive_sgu_stats(i, Y, MU, RS); }
__global__ void __launch_bounds__(256) nk_sgu_out(const bf16* Y, const float* MU, const float* RS, const float* lg, const float* lb, const float* ws, const float* bs, bf16* YM) { const int i = NIDX; if (i < T_ * 768) naive_sgu_out(i / 768, i % 768, SEQ_, Y, MU, RS, lg, lb, ws, bs, YM); }
__global__ void __launch_bounds__(256) nk_ml_conv(const bf16* Y, const float* cw, const float* cb, float* QKC) { const int i = NIDX; if (i < T_ * 1024) naive_ml_conv(i >> 10, i & 1023, SEQ_, Y, cw, cb, QKC); }
__global__ void __launch_bounds__(64) nk_ml_den(const float* YSM, const float* QKC, const float* bi, const float* bf_, float* DEN) { const int i = NIDX; if (i < 16) naive_ml_den(i >> 2, i & 3, SEQ_, YSM, QKC, bi, bf_, DEN); }
__global__ void __launch_bounds__(64) nk_ml_rec(const bf16* Y, const float* YSM, const float* QKC, const float* bi, const float* bf_, const float* DEN, float* HM) { const int i = NIDX; if (i < 2048) naive_ml_rec(i >> 9, (i >> 7) & 3, i & 127, SEQ_, Y, YSM, QKC, bi, bf_, DEN, HM); }
__global__ void __launch_bounds__(256) nk_ml_post(const float* HM, const float* ng, bf16* YM) { const int i = NIDX; if (i < T_ * 4) naive_ml_post(i >> 2, i & 3, HM, ng, YM); }

constexpr int CW_DBG = 12288;
__global__ void __launch_bounds__(256) nk_compare(const bf16* YMn, const bf16* YMf, float* acc) {
    const int i = NIDX; if (i >= T_ * 256) return;
    const int t = i >> 8, c8 = (i & 255) * 8, br = c8 < 512 ? 0 : (c8 < 768 ? 1 : (c8 < 1536 ? 2 : 3));
    const v4u a = *(const v4u*)(YMn + (size_t)t * 2048 + c8), b = *(const v4u*)(YMf + (size_t)t * 2048 + c8);
    const unsigned aw[4] = {a.x, a.y, a.z, a.w}, bw[4] = {b.x, b.y, b.z, b.w}; float sd = 0.f, sn = 0.f;
#pragma unroll
    for (int k = 0; k < 4; ++k) { const float x0 = bflo(aw[k]), x1 = bfhi(aw[k]), y0 = bflo(bw[k]), y1 = bfhi(bw[k]); float d0 = y0 - x0, d1 = y1 - x1;
        if (!(d0 == d0)) d0 = 1e3f; if (!(d1 == d1)) d1 = 1e3f; sd += d0 * d0 + d1 * d1; sn += x0 * x0 + x1 * x1; }
#pragma unroll
    for (int o = 1; o < 32; o <<= 1) { sd += __shfl_xor(sd, o); sn += __shfl_xor(sn, o); }
    if ((threadIdx.x & 31) == 0) { atomicAdd(acc + br * 2, sd); atomicAdd(acc + br * 2 + 1, sn); }
}
__global__ void __launch_bounds__(256) nk_scale(float* out, const float* acc, int mask) {
    float d2 = 0.f;
    for (int br = 0; br < 4; ++br) if ((mask >> br) & 1) d2 += 100.f * acc[br * 2] / fmaxf(acc[br * 2 + 1], 1e-20f);
    const float s = 1.f + sqrtf(fminf(d2, 100.f));
    const int i = NIDX; if (i < T_ * D_ / 4) { f32x4 v = *(f32x4*)(out + (size_t)i * 4); *(f32x4*)(out + (size_t)i * 4) = v * s; }
}
#ifndef DBG_MASK
#define DBG_MASK 15
#endif
static void launch_fwd(void* const* d_in, void* d_out, void* d_ws, hipStream_t stream, int grid, int lo, int hi, int region) {
    KArgs a{};
    for (int i = 0; i < 32; ++i) a.in[i] = (const float*)d_in[i];
    a.out = (float*)d_out; a.ws = (unsigned char*)d_ws; a.ph_lo = lo; a.ph_hi = hi; a.region = region; a.pad = 0;
    hipLaunchKernelGGL(fwd, dim3(grid), dim3(512), LDS_BYTES, stream, a);
}
extern "C" void kernel_launch(void* const* d_in, const int* in_sizes, int n_in, void* d_out, int out_size, void* d_ws, size_t ws_size, hipStream_t stream) {
    static int grid = 0;
    if (grid == 0) {
        if (n_in != 32 || out_size != T_ * D_ || ws_size < WS_END) { fprintf(stderr, "kernel_launch: unexpected shapes: n_in %d out %d ws %zu (need %zu)\n", n_in, out_size, ws_size, (size_t)WS_END); grid = -1; return; }
        int dev = 0, cus = 0, per_cu = 0;
        if (hipGetDevice(&dev) != hipSuccess || hipDeviceGetAttribute(&cus, hipDeviceAttributeMultiprocessorCount, dev) != hipSuccess) { grid = -1; return; }
        if (hipFuncSetAttribute((const void*)fwd, hipFuncAttributeMaxDynamicSharedMemorySize, LDS_BYTES) != hipSuccess) { fprintf(stderr, "kernel_launch: hipFuncSetAttribute failed\n"); grid = -1; return; }
        if (hipOccupancyMaxActiveBlocksPerMultiprocessor(&per_cu, (const void*)fwd, 512, LDS_BYTES) != hipSuccess || per_cu < 1) fprintf(stderr, "kernel_launch: occupancy query reports %d blocks per CU\n", per_cu);
        (void)hipGetLastError();
        grid = cus;
    }
    if (grid < 0) return;
    (void)hipMemsetAsync((char*)d_ws + WS_CTL, 0, CTL_ZERO_BYTES, stream);
    int region = 0;
#if MK_MODE == 3
    launch_fwd(d_in, d_out, d_ws, stream, grid, 0, 24, region++);
#else
    unsigned char* ws = (unsigned char*)d_ws;
    const bf16* Y = (const bf16*)(ws + WS_Y); const float* YSM = (const float*)(ws + WS_YSM); bf16* YM = (bf16*)(ws + WS_YM);
    float* GG = (float*)(ws + WS_NV); float* OA = (float*)(ws + WS_NV + 8 * MiB); float* QR = (float*)(ws + WS_NV + 24 * MiB); float* KR = (float*)(ws + WS_NV + 48 * MiB);
    float* MU = (float*)(ws + WS_NV + 72 * MiB); float* RS = MU + T_; float* QKC = (float*)(ws + WS_NV + 73 * MiB); float* DEN = (float*)(ws + WS_NV + 105 * MiB); float* HM = (float*)(ws + WS_NV + 106 * MiB);
    float* dbg = (float*)ws + CW_DBG;
    const float* f[32]; for (int i = 0; i < 32; ++i) f[i] = (const float*)d_in[i];
    for (int l = 0; l < NL_; ++l) {
        const int p0 = l * 12;
        launch_fwd(d_in, d_out, d_ws, stream, grid, p0 + 0, p0 + 1, region++);
        launch_fwd(d_in, d_out, d_ws, stream, grid, p0 + 1, p0 + 2, region++);
        if (MK_MODE == 0 || MK_MODE == 1) {
            hipLaunchKernelGGL(nk_gla_g, dim3(T_ * 256 / 256), dim3(256), 0, stream, YSM, f[3] + l * 16 * 256, f[4] + l * 256, GG);
            hipLaunchKernelGGL(nk_gla_rec, dim3(32), dim3(64), 0, stream, Y, GG, OA);
            hipLaunchKernelGGL(nk_gla_post, dim3(T_ * 4 / 256), dim3(256), 0, stream, Y, OA, f[5] + l * 512, YM);
            hipLaunchKernelGGL(nk_rope, dim3(T_ * 384 / 256), dim3(256), 0, stream, Y, (const int*)d_in[1], QR, KR);
            hipLaunchKernelGGL(nk_dil, dim3(T_ * 4 / 64), dim3(64), 0, stream, QR, KR, Y, YM);
            hipLaunchKernelGGL(nk_sgu_stats, dim3(T_ / 256), dim3(256), 0, stream, Y, MU, RS);
            hipLaunchKernelGGL(nk_sgu_out, dim3(T_ * 768 / 256), dim3(256), 0, stream, Y, MU, RS, f[11] + l * 768, f[12] + l * 768, f[13] + l * 6 * 128 * 128, f[14] + l * 6 * 128, YM);
            hipLaunchKernelGGL(nk_ml_conv, dim3(T_ * 1024 / 256), dim3(256), 0, stream, Y, f[6] + l * 4 * 1024, f[7] + l * 1024, QKC);
            hipLaunchKernelGGL(nk_ml_den, dim3(1), dim3(64), 0, stream, YSM, QKC, f[8] + l * 4, f[9] + l * 4, DEN);
            hipLaunchKernelGGL(nk_ml_rec, dim3(32), dim3(64), 0, stream, Y, YSM, QKC, f[8] + l * 4, f[9] + l * 4, DEN, HM);
            hipLaunchKernelGGL(nk_ml_post, dim3(T_ * 4 / 256), dim3(256), 0, stream, HM, f[10] + l * 512, YM);
        }
        if (MK_MODE == 1 || MK_MODE == 2) for (int ph = 2; ph < 5; ++ph) launch_fwd(d_in, d_out, d_ws, stream, grid, p0 + ph, p0 + ph + 1, region++);
        if (MK_MODE == 1) hipLaunchKernelGGL(nk_compare, dim3(T_ * 256 / 256), dim3(256), 0, stream, (const bf16*)YM, (const bf16*)(ws + WS_MRG), dbg);
        for (int ph = 5; ph < 12; ++ph) launch_fwd(d_in, d_out, d_ws, stream, grid, p0 + ph, p0 + ph + 1, region++);
    }
    if (MK_MODE == 1) hipLaunchKernelGGL(nk_scale, dim3(T_ * D_ / 4 / 256), dim3(256), 0, stream, (float*)d_out, (const float*)dbg, (int)DBG_MASK);
#endif
}
```

```cpp
#include <hip/hip_runtime.h>
#include <cstdio>
#include <cstdint>
#include <cmath>
#define MK_MODE 3
#define REPEAT_MASK 0
#define HD __device__
#ifndef HD
#define HD
#endif
#define YP 15872
#define Y_AQ 0
#define Y_AK 256
#define Y_AV 512
#define Y_AR 1024
#define Y_BQ 1536
#define Y_BK 2304
#define Y_BV 3072
#define Y_CU 3840
#define Y_CV 4608
#define Y_DQ 5376
#define Y_DK 5888
#define Y_DV 6400
#define Y_DO 6912
#define Y_G  7680
#define YM_A 0
#define YM_B 512
#define YM_C 768
#define YM_D 1536
typedef unsigned short u16;
HD static inline float bf2f(u16 v) { unsigned u = ((unsigned)v) << 16; float f; __builtin_memcpy(&f, &u, 4); return f; }
HD static inline u16 f2bf(float f) { unsigned u; __builtin_memcpy(&u, &f, 4); u += 0x7fffu + ((u >> 16) & 1u); return (u16)(u >> 16); }
HD static inline float sigmoidf_(float x) { return 1.f / (1.f + expf(-x)); }
HD static inline float logsigmoidf_(float x) { return x < 0.f ? x - log1pf(expf(x)) : -log1pf(expf(-x)); }
HD static inline float siluf_(float x) { return x * sigmoidf_(x); }
HD static inline float geluf_(float x) { return 0.5f * x * (1.f + erff(x * 0.70710678118654752f)); }

HD static inline void naive_gla_g(int tok, int c, const float* YSM, const float* wa2, const float* ba, float* GG) {
    float s = ba[c];
    for (int r = 0; r < 16; ++r) s += YSM[tok * 32 + r] * wa2[r * 256 + c];
    GG[(size_t)tok * 256 + c] = logsigmoidf_(s) * (1.f / 16.f);
}
HD static inline void naive_gla_rec(int b, int h, int e, int S_, const u16* Y, const float* GG, float* OA) {
    float St[64];
#pragma unroll
    for (int d = 0; d < 64; ++d) St[d] = 0.f;
    for (int t = 0; t < S_; ++t) {
        const size_t tok = (size_t)b * S_ + t;
        const float v = bf2f(Y[tok * YP + Y_AV + h * 128 + e]);
        float o = 0.f;
#pragma unroll
        for (int d = 0; d < 64; ++d) {
            const float a = expf(GG[tok * 256 + h * 64 + d]);
            const float k = bf2f(Y[tok * YP + Y_AK + h * 64 + d]);
            const float q = bf2f(Y[tok * YP + Y_AQ + h * 64 + d]) * 0.125f;
            St[d] = a * St[d] + k * v;
            o += q * St[d];
        }
        OA[tok * 512 + h * 128 + e] = o;
    }
}
HD static inline void naive_gla_post(int tok, int h, const u16* Y, const float* OA, const float* norm_g, u16* YM) {
    float ss = 0.f;
    for (int e = 0; e < 128; ++e) { const float o = OA[(size_t)tok * 512 + h * 128 + e]; ss += o * o; }
    const float rs = 1.f / sqrtf(ss * (1.f / 128.f) + 1e-5f);
    for (int e = 0; e < 128; ++e) {
        const float o = OA[(size_t)tok * 512 + h * 128 + e] * rs * norm_g[h * 128 + e];
        const float r = bf2f(Y[(size_t)tok * YP + Y_AR + h * 128 + e]);
        YM[(size_t)tok * 2048 + YM_A + h * 128 + e] = f2bf(o * siluf_(r));
    }
}
HD static inline void naive_rope(int tok, int head, int i, const u16* Y, const int* positions, float* QR, float* KR) {
    const float inv = powf(10000.0f, -(float)i * 2.0f / 64.0f);
    const float ang = (float)positions[tok] * inv;
    const float c = cosf(ang), s = sinf(ang);
    const size_t yb = (size_t)tok * YP;
    const float q1 = bf2f(Y[yb + Y_BQ + head * 64 + i]), q2 = bf2f(Y[yb + Y_BQ + head * 64 + 32 + i]);
    const float k1 = bf2f(Y[yb + Y_BK + head * 64 + i]), k2 = bf2f(Y[yb + Y_BK + head * 64 + 32 + i]);
    QR[(size_t)tok * 768 + head * 64 + i] = q1 * c - q2 * s; QR[(size_t)tok * 768 + head * 64 + 32 + i] = q2 * c + q1 * s;
    KR[(size_t)tok * 768 + head * 64 + i] = k1 * c - k2 * s; KR[(size_t)tok * 768 + head * 64 + 32 + i] = k2 * c + k1 * s;
}
HD static inline void naive_dil(int tok, int hh, int S_, const float* QR, const float* KR, const u16* Y, u16* YM) {
    const int b = tok / S_, s = tok % S_;
    float o[64];
#pragma unroll
    for (int d = 0; d < 64; ++d) o[d] = 0.f;
    float mx = -INFINITY, den = 0.f;
    for (int g = 0; g < 3; ++g) {
        const int dil = g == 0 ? 1 : (g == 1 ? 4 : 16), head = g * 4 + hh;
        const int m = s / dil;
        for (int j = 0; j <= 128; ++j) {
            if (m - j < 0) break;
            const size_t kt = (size_t)b * S_ + (s - j * dil);
            float sc = 0.f;
#pragma unroll
            for (int d = 0; d < 64; ++d) sc += QR[(size_t)tok * 768 + head * 64 + d] * KR[kt * 768 + head * 64 + d];
            sc *= 0.125f;
            const float nm = fmaxf(mx, sc), corr = expf(mx - nm), p = expf(sc - nm);
            den = den * corr + p;
#pragma unroll
            for (int d = 0; d < 64; ++d) o[d] = o[d] * corr + p * bf2f(Y[kt * YP + Y_BV + head * 64 + d]);
            mx = nm;
        }
    }
#pragma unroll
    for (int d = 0; d < 64; ++d) YM[(size_t)tok * 2048 + YM_B + hh * 64 + d] = f2bf(o[d] / den);
}
HD static inline void naive_sgu_stats(int tok, const u16* Y, float* MU, float* RS) {
    float s = 0.f;
    for (int c = 0; c < 768; ++c) s += geluf_(bf2f(Y[(size_t)tok * YP + Y_CV + c]));
    const float mu = s * (1.f / 768.f); float q = 0.f;
    for (int c = 0; c < 768; ++c) { const float d = geluf_(bf2f(Y[(size_t)tok * YP + Y_CV + c])) - mu; q += d * d; }
    MU[tok] = mu; RS[tok] = 1.f / sqrtf(q * (1.f / 768.f) + 1e-5f);
}
HD static inline void naive_sgu_out(int tok, int c, int S_, const u16* Y, const float* MU, const float* RS, const float* ln_g, const float* ln_b,
                                    const float* ws, const float* bs, u16* YM) {
    const int s = tok % S_, i = s % 128, t0 = tok - i, g = c / 128;
    float acc = 0.f;
    for (int j = 0; j <= i; ++j) {
        const float zv = geluf_(bf2f(Y[(size_t)(t0 + j) * YP + Y_CV + c]));
        const float vn = (zv - MU[t0 + j]) * RS[t0 + j] * ln_g[c] + ln_b[c];
        acc += ws[(g * 128 + i) * 128 + j] * vn;
    }
    const float zu = geluf_(bf2f(Y[(size_t)tok * YP + Y_CU + c]));
    YM[(size_t)tok * 2048 + YM_C + c] = f2bf(zu * (acc + bs[g * 128 + i]));
}
HD static inline void naive_ml_conv(int tok, int c, int S_, const u16* Y, const float* conv_w, const float* conv_b, float* QKC) {
    const int s = tok % S_; const int col = c < 512 ? Y_DQ + c : Y_DK + (c - 512);
    float a = conv_b[c];
    for (int j = 0; j < 4; ++j) { const int sp = s - 3 + j; if (sp >= 0) a += conv_w[j * 1024 + c] * bf2f(Y[(size_t)(tok - 3 + j) * YP + col]); }
    a = siluf_(a);
    QKC[(size_t)tok * 1024 + c] = c < 512 ? a : a * 0.08838834764831845f;
}
HD static inline void naive_ml_den(int b, int h, int S_, const float* YSM, const float* QKC, const float* b_i, const float* b_f, float* DEN) {
    float n[128];
#pragma unroll
    for (int d = 0; d < 128; ++d) n[d] = 0.f;
    for (int t = 0; t < S_; ++t) {
        const size_t tok = (size_t)b * S_ + t;
        const float f = sigmoidf_(YSM[tok * 32 + 20 + h] + b_f[h]), ig = expf(YSM[tok * 32 + 16 + h] + b_i[h]);
        float den = 0.f;
#pragma unroll
        for (int d = 0; d < 128; ++d) { n[d] = f * n[d] + ig * QKC[tok * 1024 + 512 + h * 128 + d]; den += QKC[tok * 1024 + h * 128 + d] * n[d]; }
        DEN[tok * 4 + h] = den;
    }
}
HD static inline void naive_ml_rec(int b, int h, int e, int S_, const u16* Y, const float* YSM, const float* QKC, const float* b_i, const float* b_f, const float* DEN, float* HM) {
    float C[128];
#pragma unroll
    for (int d = 0; d < 128; ++d) C[d] = 0.f;
    for (int t = 0; t < S_; ++t) {
        const size_t tok = (size_t)b * S_ + t;
        const float f = sigmoidf_(YSM[tok * 32 + 20 + h] + b_f[h]), ig = expf(YSM[tok * 32 + 16 + h] + b_i[h]);
        const float v = bf2f(Y[tok * YP + Y_DV + h * 128 + e]);
        float num = 0.f;
#pragma unroll
        for (int d = 0; d < 128; ++d) { C[d] = f * C[d] + ig * QKC[tok * 1024 + 512 + h * 128 + d] * v; num += QKC[tok * 1024 + h * 128 + d] * C[d]; }
        const float den = DEN[tok * 4 + h];
        const float hh = num / fmaxf(fabsf(den), 1.0f);
        HM[tok * 512 + h * 128 + e] = sigmoidf_(bf2f(Y[tok * YP + Y_DO + h * 128 + e])) * hh;
    }
}
HD static inline void naive_ml_post(int tok, int h, const float* HM, const float* norm_g, u16* YM) {
    float ss = 0.f;
    for (int e = 0; e < 128; ++e) { const float o = HM[(size_t)tok * 512 + h * 128 + e]; ss += o * o; }
    const float rs = 1.f / sqrtf(ss * (1.f / 128.f) + 1e-5f);
    for (int e = 0; e < 128; ++e) YM[(size_t)tok * 2048 + YM_D + h * 128 + e] = f2bf(HM[(size_t)tok * 512 + h * 128 + e] * rs * norm_g[h * 128 + e]);
}
HD static inline void route_token(const float* sc, const float* bias, int* idx, float* w) {
    unsigned gmask = 0u;
    float gs[8];
#pragma unroll
    for (int g = 0; g < 8; ++g) {
        float m1 = -INFINITY, m2 = -INFINITY;
        for (int j = 0; j < 8; ++j) { const float c = sc[g * 8 + j] + bias[g * 8 + j]; if (c > m1) { m2 = m1; m1 = c; } else if (c > m2) m2 = c; }
        gs[g] = m1 + m2;
    }
#pragma unroll
    for (int g = 0; g < 8; ++g) {
        int rank = 0;
#pragma unroll
        for (int g2 = 0; g2 < 8; ++g2) rank += (gs[g2] > gs[g] || (gs[g2] == gs[g] && g2 < g)) ? 1 : 0;
        if (rank < 4) gmask |= 1u << g;
    }
    int n = 0; float wsum = 0.f;
    for (int e = 0; e < 64; ++e) {
        if (!((gmask >> (e >> 3)) & 1u)) continue;
        const float c = sc[e] + bias[e]; int rank = 0;
        for (int e2 = 0; e2 < 64; ++e2) { if (!((gmask >> (e2 >> 3)) & 1u)) continue; const float c2 = sc[e2] + bias[e2]; rank += (c2 > c || (c2 == c && e2 < e)) ? 1 : 0; }
        if (rank < 8) { if (n < 8) { idx[n] = e; w[n] = sc[e]; wsum += sc[e]; } ++n; }
    }
    const float r = 2.5f / wsum;
    for (int k = 0; k < 8; ++k) w[k] *= r;
}

HD static inline bool route_lane_select(int lane, const float* sc, const float* bias) {
    float gs[8];
#pragma unroll
    for (int g = 0; g < 8; ++g) { float m1 = -INFINITY, m2 = -INFINITY;
#pragma unroll
        for (int j = 0; j < 8; ++j) { const float c = sc[g * 8 + j] + bias[g * 8 + j]; if (c > m1) { m2 = m1; m1 = c; } else if (c > m2) m2 = c; }
        gs[g] = m1 + m2; }
    unsigned gmask = 0u;
#pragma unroll
    for (int g = 0; g < 8; ++g) { int r = 0;
#pragma unroll
        for (int g2 = 0; g2 < 8; ++g2) r += (gs[g2] > gs[g] || (gs[g2] == gs[g] && g2 < g)) ? 1 : 0;
        if (r < 4) gmask |= 1u << g; }
    if (!((gmask >> (lane >> 3)) & 1u)) return false;
    const float myc = sc[lane] + bias[lane]; int rank = 0;
    for (int e = 0; e < 64; ++e) { const float c = sc[e] + bias[e]; rank += (((gmask >> (e >> 3)) & 1u) && (c > myc || (c == myc && e < lane))) ? 1 : 0; }
    return rank < 8;
}
namespace pg8 {
#define PG8_LAS __attribute__((address_space(3)))
typedef unsigned short bf16_t;
typedef short bf16x8 __attribute__((ext_vector_type(8)));
typedef float f32x4 __attribute__((ext_vector_type(4)));
typedef unsigned u32x4 __attribute__((ext_vector_type(4)));
typedef unsigned u32x2 __attribute__((ext_vector_type(2)));
typedef int i32x4 __attribute__((ext_vector_type(4)));
typedef int i32x8 __attribute__((ext_vector_type(8)));
constexpr int BM = 256, BK = 64, HALF = 128, HTB = HALF * BK * 2  , STAGE_BYTES = 8 * HTB, NXCD = 8, WGM = 8;

__host__ __device__ __forceinline__ int lds_byte(int r, int c) { const int st = (r >> 4) * 2 + (c >> 5), rr = r & 15, cc = c & 31, ob = rr * 64 + cc * 2; return st * 1024 + (ob ^ (((ob >> 9) & 1) << 5)); }
__host__ __device__ __forceinline__ void stage_rc(int b, int& R, int& C) { const int st = b / 1024, sb = b % 1024, swz = sb ^ (((sb >> 9) & 1) << 5); R = (st >> 1) * 16 + swz / 64; C = (st & 1) * 32 + (swz % 64) / 2; }
__host__ __device__ __forceinline__ int perm32(int rho) { const int n = rho >> 4, i = rho & 15; return 8 * (i >> 2) + 4 * n + (i & 3); }

struct Unit { int pm, pn; };
struct Gemm { const bf16_t* A; const bf16_t* Bt; int M, N, K, lda, ldb; const int* rowmap; };

struct StaticOrder {
    int nM, nN, nwg, G, c, wgm;
    __host__ __device__ void init(int M, int N, int G_, int c_, int wgm_ = WGM) { nM = M / BM; nN = N / BM; nwg = nM * nN; G = G_; c = c_; wgm = wgm_; }
    __host__ __device__ bool next(int i, Unit& u) const {
        const long L = (long)i * G + c; if (L >= nwg) return false;
        int wgid = (int)L; { const int q = nwg / NXCD, r = nwg % NXCD, xcd = wgid % NXCD, off = wgid / NXCD; wgid = (xcd < r ? xcd * (q + 1) : r * (q + 1) + (xcd - r) * q) + off; }
        const int nig = wgm * nN, gid = wgid / nig, fm = gid * wgm, gsz = (nM - fm) < wgm ? (nM - fm) : wgm;
        u.pm = fm + ((wgid % nig) % gsz); u.pn = (wgid % nig) / gsz; return true;
    }
    __device__ __forceinline__ void a_ready(const Unit&) const {}
    __device__ __forceinline__ void done(const Unit&) const {}
};

__device__ __forceinline__ unsigned cvt_pk_bf16(float lo, float hi) { unsigned r; asm volatile("v_cvt_pk_bf16_f32 %0, %1, %2" : "=v"(r) : "v"(lo), "v"(hi)); return r; }

template <class Epi, class Sched, bool ALIGN_EPI = true, bool GATHER = false, int NBJ = 2, int DT = 0>
__device__ __forceinline__ void gemm_phase(PG8_LAS unsigned char* lds, const Gemm g, const Sched& S, const Epi& E, const int tid) {
    const int wid = __builtin_amdgcn_readfirstlane(tid >> 6), lane = tid & 63, wr = wid >> 2, wc = wid & 3, fr = lane & 15, fq = lane >> 4;
    const int K = g.K, nt = K / BK;
    unsigned voffB[2]; int rA[2]; unsigned cA2[2];
#pragma unroll
    for (int i = 0; i < 2; ++i) { int R, C; stage_rc(tid * 16 + i * 8192, R, C); const int Rb = Epi::PERM ? ((R & ~31) + perm32(R & 31)) : R;
        rA[i] = R; cA2[i] = (unsigned)C * 2u; voffB[i] = (unsigned)(Rb * g.ldb + C) * 2u; }
    const size_t kstep = (size_t)(BK * 2);
    const size_t hstepA = (size_t)HALF * g.lda * 2, hstepB = (size_t)HALF * g.ldb * 2;
    const size_t tstepA = GATHER ? 0 : 2 * hstepA, tstepB = NBJ * hstepB;
    unsigned cvo[4], nvo[4];
#define PG8_AOFF(dst, unit) do { _Pragma("unroll") for (int h_ = 0; h_ < 2; ++h_) _Pragma("unroll") for (int i_ = 0; i_ < 2; ++i_) { \
        if constexpr (GATHER) dst[2 * h_ + i_] = (unsigned)g.rowmap[(size_t)(unit).pm * BM + h_ * HALF + rA[i_]] * (unsigned)(g.lda * 2) + cA2[i_]; \
        else dst[2 * h_ + i_] = (unsigned)((h_ * HALF + rA[i_]) * g.lda) * 2u + cA2[i_]; } } while (0)
    const unsigned ldsw = (unsigned)wid * 1024u;
    const int aoff = lds_byte(wr * 64 + fr, fq * 8), boff = lds_byte(wc * 32 + fr, fq * 8);
#define PG8_SA(b, h) (((b) * 2 + (h)) * HTB)
#define PG8_SB(b, h) ((4 + (b) * 2 + (h)) * HTB)
#define PG8_STAGE2(bufoff, gbase, v0, v1) do { \
        __builtin_amdgcn_global_load_lds((const unsigned*)((const char*)(gbase) + (v0)), (PG8_LAS unsigned*)(lds + (bufoff) + ldsw), 16, 0, 0); \
        __builtin_amdgcn_global_load_lds((const unsigned*)((const char*)(gbase) + (v1)), (PG8_LAS unsigned*)(lds + (bufoff) + ldsw + 8192), 16, 0, 0); } while (0)
#define PG8_STAGE(bufoff, gbase, voff) PG8_STAGE2(bufoff, gbase, (voff)[0], (voff)[1])
#define PG8_LDA(dst, b, h) do { _Pragma("unroll") for (int m = 0; m < 4; ++m) _Pragma("unroll") for (int k = 0; k < 2; ++k) dst[m][k] = *(const PG8_LAS bf16x8*)(lds + PG8_SA(b, h) + aoff + m * 2048 + k * 1024); } while (0)
#define PG8_LDB(dst, b, h) do { _Pragma("unroll") for (int n = 0; n < 2; ++n) _Pragma("unroll") for (int k = 0; k < 2; ++k) dst[n][k] = *(const PG8_LAS bf16x8*)(lds + PG8_SB(b, h) + boff + n * 2048 + k * 1024); } while (0)
#define PG8_MMA(ai, bj, At, Bt) do { __builtin_amdgcn_s_setprio(1); _Pragma("unroll") for (int m = 0; m < 4; ++m) _Pragma("unroll") for (int n = 0; n < 2; ++n) { \
        if constexpr (DT == 0) { _Pragma("unroll") for (int k = 0; k < 2; ++k) acc[ai][bj][m][n] = __builtin_amdgcn_mfma_f32_16x16x32_bf16(Bt[n][k], At[m][k], acc[ai][bj][m][n], 0, 0, 0); } \
        else { const i32x4 b0_ = __builtin_bit_cast(i32x4, Bt[n][0]), b1_ = __builtin_bit_cast(i32x4, Bt[n][1]), a0_ = __builtin_bit_cast(i32x4, At[m][0]), a1_ = __builtin_bit_cast(i32x4, At[m][1]); \
            const i32x8 bw_ = __builtin_shufflevector(b0_, b1_, 0, 1, 2, 3, 4, 5, 6, 7), aw_ = __builtin_shufflevector(a0_, a1_, 0, 1, 2, 3, 4, 5, 6, 7); \
              \
            asm volatile("v_mfma_scale_f32_16x16x128_f8f6f4 %0, %1, %2, %0, %3, %4 op_sel_hi:[0,0,0]" : "+v"(acc[ai][bj][m][n]) : "v"(bw_), "v"(aw_), "v"(0x7a7a7a7a), "v"(0x7f7f7f7f)); } } \
        __builtin_amdgcn_s_setprio(0); } while (0)
#define PG8_WAIT_V(n) asm volatile("s_waitcnt vmcnt(" #n ")" ::: "memory")
#define PG8_WAIT_LOOP do { if constexpr (NBJ == 2) PG8_WAIT_V(8); else PG8_WAIT_V(6); } while (0)
#define PG8_WAIT_L(n) asm volatile("s_waitcnt lgkmcnt(" #n ")" ::: "memory")
#define PG8_BAR __builtin_amdgcn_s_barrier()
#define PG8_SCHED __builtin_amdgcn_sched_barrier(0)
    Unit cur, nxt; int ui = 0;
    if (!S.next(0, cur)) return;
    f32x4 acc[2][NBJ][4][2];
#pragma unroll
    for (int a = 0; a < 2; ++a)
#pragma unroll
        for (int b = 0; b < NBJ; ++b)
#pragma unroll
            for (int m = 0; m < 4; ++m)
#pragma unroll
                for (int n = 0; n < 2; ++n) acc[a][b][m][n] = (f32x4){0.f, 0.f, 0.f, 0.f};
    bf16x8 At[4][2], B0[2][2], B1[2][2];
    const char* cA = (const char*)g.A + (size_t)cur.pm * tstepA; const char* cB = (const char*)g.Bt + (size_t)cur.pn * tstepB;
    S.a_ready(cur);
    PG8_AOFF(cvo, cur);
    PG8_STAGE(PG8_SB(0, 0), cB, voffB); if constexpr (NBJ == 2) PG8_STAGE(PG8_SB(0, 1), cB + hstepB, voffB); PG8_STAGE2(PG8_SA(0, 0), cA, cvo[0], cvo[1]); PG8_STAGE2(PG8_SA(0, 1), cA, cvo[2], cvo[3]);
    if (wr == 1) PG8_BAR;
    PG8_WAIT_V(2); PG8_BAR;
    PG8_STAGE(PG8_SB(1, 0), cB + kstep, voffB); PG8_STAGE2(PG8_SA(1, 0), cA + kstep, cvo[0], cvo[1]); if constexpr (NBJ == 2) PG8_STAGE(PG8_SB(1, 1), cB + hstepB + kstep, voffB);
    if constexpr (NBJ == 2) PG8_WAIT_V(6); else PG8_WAIT_V(4);
    PG8_BAR;
    for (;;) {
        const bool has_next = S.next(ui + 1, nxt);
        const char* nA = has_next ? (const char*)g.A + (size_t)nxt.pm * tstepA : cA; const char* nB = has_next ? (const char*)g.Bt + (size_t)nxt.pn * tstepB : cB;
        if (has_next) { PG8_AOFF(nvo, nxt); } else {
#pragma unroll
            for (int j_ = 0; j_ < 4; ++j_) nvo[j_] = cvo[j_]; }
        for (int t = 0; t < nt; t += 2) {
            const bool last = (t == nt - 2);
            const char* a1 = cA + (size_t)(t + 1) * kstep;
            const char* a2 = last ? nA : cA + (size_t)(t + 2) * kstep; const char* b2 = last ? nB : cB + (size_t)(t + 2) * kstep;
            const char* a3 = a2 + kstep; const char* b3 = b2 + kstep;
            if (last && has_next) S.a_ready(nxt);
            unsigned so[4];
#pragma unroll
            for (int j_ = 0; j_ < 4; ++j_) so[j_] = last ? nvo[j_] : cvo[j_];
            PG8_LDB(B0, 0, 0); if constexpr (NBJ == 2) PG8_LDB(B1, 0, 1); PG8_SCHED; PG8_LDA(At, 0, 0); PG8_STAGE2(PG8_SA(1, 1), a1, cvo[2], cvo[3]);
            PG8_WAIT_LOOP; PG8_WAIT_L(0); PG8_BAR; PG8_MMA(0, 0, At, B0); if constexpr (NBJ == 2) PG8_MMA(0, NBJ - 1, At, B1); PG8_BAR; PG8_SCHED;
            PG8_LDA(At, 0, 1); PG8_STAGE(PG8_SB(0, 0), b2, voffB); if constexpr (NBJ == 2) PG8_STAGE(PG8_SB(0, 1), b2 + hstepB, voffB); PG8_STAGE2(PG8_SA(0, 0), a2, so[0], so[1]);
            PG8_WAIT_LOOP; PG8_WAIT_L(0); PG8_BAR; PG8_MMA(1, 0, At, B0); if constexpr (NBJ == 2) PG8_MMA(1, NBJ - 1, At, B1); PG8_BAR; PG8_SCHED;
            PG8_LDB(B0, 1, 0); if constexpr (NBJ == 2) PG8_LDB(B1, 1, 1); PG8_SCHED; PG8_LDA(At, 1, 0); PG8_STAGE2(PG8_SA(0, 1), a2, so[2], so[3]);
            PG8_WAIT_LOOP; PG8_WAIT_L(0); PG8_BAR; PG8_MMA(0, 0, At, B0); if constexpr (NBJ == 2) PG8_MMA(0, NBJ - 1, At, B1); PG8_BAR; PG8_SCHED;
            PG8_LDA(At, 1, 1); PG8_STAGE(PG8_SB(1, 0), b3, voffB); if constexpr (NBJ == 2) PG8_STAGE(PG8_SB(1, 1), b3 + hstepB, voffB); PG8_STAGE2(PG8_SA(1, 0), a3, so[0], so[1]);
            PG8_WAIT_LOOP; PG8_WAIT_L(0); PG8_BAR; PG8_MMA(1, 0, At, B0); if constexpr (NBJ == 2) PG8_MMA(1, NBJ - 1, At, B1); PG8_BAR; PG8_SCHED;
            if constexpr (Epi::HAS_FOLD) { if (!last && E.boundary(t + 2)) { E.fold(acc, cur, wr, wc, fr, fq, t + 2);
#pragma unroll
                for (int a = 0; a < 2; ++a)
#pragma unroll
                    for (int b = 0; b < NBJ; ++b)
#pragma unroll
                        for (int m = 0; m < 4; ++m)
#pragma unroll
                            for (int n = 0; n < 2; ++n) acc[a][b][m][n] = (f32x4){0.f, 0.f, 0.f, 0.f}; } }
        }
        if constexpr (ALIGN_EPI) { if (wr == 0) PG8_BAR; }
        if constexpr (DT == 1) asm volatile("s_nop 15\n\ts_nop 15\n\ts_nop 15\n\ts_nop 15\n\ts_nop 15\n\ts_nop 15" ::: "memory");
        E(acc, cur, wr, wc, fr, fq); S.done(cur);
        if (!has_next) break;
#pragma unroll
        for (int a = 0; a < 2; ++a)
#pragma unroll
            for (int b = 0; b < NBJ; ++b)
#pragma unroll
                for (int m = 0; m < 4; ++m)
#pragma unroll
                    for (int n = 0; n < 2; ++n) acc[a][b][m][n] = (f32x4){0.f, 0.f, 0.f, 0.f};
        cur = nxt; cA = nA; cB = nB; ++ui;
#pragma unroll
        for (int j_ = 0; j_ < 4; ++j_) cvo[j_] = nvo[j_];
        if constexpr (ALIGN_EPI) { if (wr == 1) PG8_BAR; }
    }
    PG8_WAIT_V(0);
    if constexpr (!ALIGN_EPI) { if (wr == 0) PG8_BAR; }
    PG8_BAR;
#undef PG8_SA
#undef PG8_SB
#undef PG8_STAGE
#undef PG8_STAGE2
#undef PG8_AOFF
#undef PG8_LDA
#undef PG8_LDB
#undef PG8_MMA
#undef PG8_WAIT_V
#undef PG8_WAIT_LOOP
#undef PG8_WAIT_L
#undef PG8_BAR
#undef PG8_SCHED
}

#ifndef N1_DBG
#define N1_DBG 0
#endif
template <class Epi, class Sched>
__device__ __forceinline__ void gemm_phase_n1s3(PG8_LAS unsigned char* lds, const Gemm g, const Sched& S, const Epi& E, const int tid) {
    const int wid = __builtin_amdgcn_readfirstlane(tid >> 6), lane = tid & 63, wr = wid >> 2, wc = wid & 3, fr = lane & 15, fq = lane >> 4;
    const int nt = g.K / BK;
    constexpr unsigned STG = 49152u;
    unsigned voffB[2], voA[4];
#pragma unroll
    for (int i = 0; i < 2; ++i) { int R, C; stage_rc(tid * 16 + i * 8192, R, C);
        voffB[i] = (unsigned)(R * g.ldb + C) * 2u; voA[i] = (unsigned)(R * g.lda + C) * 2u; voA[2 + i] = (unsigned)((HALF + R) * g.lda + C) * 2u; }
    const size_t kstep = (size_t)(BK * 2), tstepA = (size_t)BM * g.lda * 2, tstepB = (size_t)HALF * g.ldb * 2;
    const unsigned ldsw = (unsigned)wid * 1024u;
    const int aoff = lds_byte(wr * 64 + fr, fq * 8), boff = lds_byte(wc * 32 + fr, fq * 8);
#define N1_STAGE(dst, gp, v0, v1) do { \
        __builtin_amdgcn_global_load_lds((const unsigned*)((const char*)(gp) + (v0)), (PG8_LAS unsigned*)(lds + (dst) + ldsw), 16, 0, 0); \
        __builtin_amdgcn_global_load_lds((const unsigned*)((const char*)(gp) + (v1)), (PG8_LAS unsigned*)(lds + (dst) + ldsw + 8192), 16, 0, 0); } while (0)
#define N1_STAGE_TILE(wb, pa, pb) do { N1_STAGE((wb) + 32768u, pb, voffB[0], voffB[1]); N1_STAGE((wb), pa, voA[0], voA[1]); N1_STAGE((wb) + 16384u, pa, voA[2], voA[3]); } while (0)
#define N1_WAIT_V(n) asm volatile("s_waitcnt vmcnt(" #n ")" ::: "memory")
#define N1_WAIT_L0 asm volatile("s_waitcnt lgkmcnt(0)" ::: "memory")
#define N1_BAR __builtin_amdgcn_s_barrier()
    Unit cur, nxt; int ui = 0;
    if (!S.next(0, cur)) return;
    f32x4 acc[2][1][4][2];
#pragma unroll
    for (int a = 0; a < 2; ++a)
#pragma unroll
        for (int m = 0; m < 4; ++m)
#pragma unroll
            for (int n = 0; n < 2; ++n) acc[a][0][m][n] = (f32x4){0.f, 0.f, 0.f, 0.f};
    bf16x8 A0[4][2], A1[4][2], B0[2][2];
    const char* cA = (const char*)g.A + (size_t)cur.pm * tstepA; const char* cB = (const char*)g.Bt + (size_t)cur.pn * tstepB;
    unsigned gt = 0;
    N1_STAGE_TILE(0u, cA, cB); N1_STAGE_TILE(STG, cA + kstep, cB + kstep);
    if (wr == 1) N1_BAR;
    N1_WAIT_V(6); N1_BAR;
    N1_BAR;
    for (;;) {
        const bool has_next = S.next(ui + 1, nxt);
        const char* nA = has_next ? (const char*)g.A + (size_t)nxt.pm * tstepA : cA; const char* nB = has_next ? (const char*)g.Bt + (size_t)nxt.pn * tstepB : cB;
        for (int t = 0; t < nt; ++t, ++gt) {
            const unsigned s0 = gt % 3u, rb = s0 * STG, wb = (s0 == 0u ? 2u : s0 - 1u) * STG;
            const int t2 = t + 2; const bool over = t2 >= nt;
            const char* pa = over ? nA + (size_t)(t2 - nt) * kstep : cA + (size_t)t2 * kstep; const char* pb = over ? nB + (size_t)(t2 - nt) * kstep : cB + (size_t)t2 * kstep;
#pragma unroll
            for (int n = 0; n < 2; ++n)
#pragma unroll
                for (int k = 0; k < 2; ++k) B0[n][k] = *(const PG8_LAS bf16x8*)(lds + rb + 32768u + boff + n * 2048 + k * 1024);
            __builtin_amdgcn_sched_barrier(0);
#pragma unroll
            for (int m = 0; m < 4; ++m)
#pragma unroll
                for (int k = 0; k < 2; ++k) { A0[m][k] = *(const PG8_LAS bf16x8*)(lds + rb + aoff + m * 2048 + k * 1024); A1[m][k] = *(const PG8_LAS bf16x8*)(lds + rb + 16384u + aoff + m * 2048 + k * 1024); }
            N1_STAGE_TILE(wb, pa, pb);
            N1_WAIT_V(6); N1_WAIT_L0; N1_BAR;
            __builtin_amdgcn_s_setprio(1);
#pragma unroll
            for (int m = 0; m < 4; ++m)
#pragma unroll
                for (int n = 0; n < 2; ++n)
#pragma unroll
                    for (int k = 0; k < 2; ++k) { acc[0][0][m][n] = __builtin_amdgcn_mfma_f32_16x16x32_bf16(B0[n][k], A0[m][k], acc[0][0][m][n], 0, 0, 0);
                        acc[1][0][m][n] = __builtin_amdgcn_mfma_f32_16x16x32_bf16(B0[n][k], A1[m][k], acc[1][0][m][n], 0, 0, 0); }
            __builtin_amdgcn_s_setprio(0);
            N1_BAR; __builtin_amdgcn_sched_barrier(0);
            if (t + 1 < nt && E.boundary(t + 1)) { E.fold(acc, cur, wr, wc, fr, fq, t + 1);
#pragma unroll
                for (int a = 0; a < 2; ++a)
#pragma unroll
                    for (int m = 0; m < 4; ++m)
#pragma unroll
                        for (int n = 0; n < 2; ++n) acc[a][0][m][n] = (f32x4){0.f, 0.f, 0.f, 0.f}; }
        }
        if (wr == 0) N1_BAR;
        E(acc, cur, wr, wc, fr, fq);
        if (!has_next) break;
#pragma unroll
        for (int a = 0; a < 2; ++a)
#pragma unroll
            for (int m = 0; m < 4; ++m)
#pragma unroll
                for (int n = 0; n < 2; ++n) acc[a][0][m][n] = (f32x4){0.f, 0.f, 0.f, 0.f};
        cur = nxt; cA = nA; cB = nB; ++ui;
        if (wr == 1) N1_BAR;
    }
    N1_WAIT_V(0);
    N1_BAR;
#undef N1_STAGE
#undef N1_STAGE_TILE
#undef N1_WAIT_V
#undef N1_WAIT_L0
#undef N1_BAR
}
}
#ifndef MERGE3
#define MERGE3 0
#endif
constexpr int T_ = 8192, D_ = 2048, SEQ_ = 2048, NB_ = 4, NL_ = 2, NCOL = 15640;
constexpr float DN_ALPHA = 1.41421356237309515f;
constexpr float LN_EPS_ = 1e-5f;
constexpr int MAXROWS = 90112;
constexpr size_t MiB = 1u << 20;
constexpr size_t WS_CTL = 0, CTL_ZERO_BYTES = 1048576;
constexpr size_t WS_XB = 1 * MiB, WS_HB = 33 * MiB, WS_X1 = 97 * MiB, WS_XA = 161 * MiB, WS_YM = 225 * MiB, WS_MRG = 257 * MiB, WS_MB = 321 * MiB;
constexpr size_t WS_YSM = 353 * MiB, WS_CS = 354 * MiB, WS_SEL = 356 * MiB, WS_ROWW = 357 * MiB, WS_ROWMAP = 357 * MiB + 512 * 1024;
constexpr size_t WS_WIN = 358 * MiB, WS_WP = 420 * MiB, WS_WOUT = 428 * MiB, WS_W13 = 436 * MiB, WS_W2 = 696 * MiB, WS_H = 826 * MiB, WS_XS = 914 * MiB, WS_YBUF = 1266 * MiB;
constexpr size_t WS_XS8 = WS_XS + 64 * MiB, WS_XB8 = WS_XS + 80 * MiB, WS_WIN8 = WS_XS + 96 * MiB;
constexpr size_t WS_Y = WS_YBUF;
constexpr size_t WS_GLOC = 1618 * MiB, WS_GDEC = 1634 * MiB, WS_GST = 1635 * MiB, WS_MLOC = 1643 * MiB, WS_MNLOC = 1675 * MiB, WS_MSC = 1676 * MiB, WS_MC = 1677 * MiB, WS_MN = 1693 * MiB, WS_MM = 1694 * MiB;
constexpr size_t WS_DILO = 1695 * MiB, WS_DILL = 1719 * MiB;
constexpr size_t WS_NV = 1720 * MiB;
constexpr size_t WS_W13B = 1842 * MiB, WS_W2B = 1972 * MiB;
constexpr size_t WS_END = 2037 * MiB;
constexpr int CW_CNT = 8192, CW_TST = 8448, CW_CQ = 12400, CW_ARR = 12416, CW_BAR = 16384;
constexpr int RING_BYTES = 131072, AUX_OFF = 131072, LDS_BYTES = 147456 + 16384 * MERGE3;
constexpr int AUX_BARW = LDS_BYTES - 16;

#define GAS __attribute__((address_space(1)))
#define LAS __attribute__((address_space(3)))
typedef unsigned short bf16;
typedef unsigned v4u __attribute__((ext_vector_type(4)));
typedef unsigned v2u __attribute__((ext_vector_type(2)));
typedef float f32x4 __attribute__((ext_vector_type(4)));
typedef float f32x2 __attribute__((ext_vector_type(2)));
typedef short bf16x8 __attribute__((ext_vector_type(8)));
#define LDS_WAIT() asm volatile("s_waitcnt lgkmcnt(0)" ::: "memory")
#define VM_WAIT() asm volatile("s_waitcnt vmcnt(0)" ::: "memory")
__device__ __forceinline__ unsigned pk2(float lo, float hi) { return pg8::cvt_pk_bf16(lo, hi); }
__device__ __forceinline__ float bflo(unsigned u) { return __builtin_bit_cast(float, u << 16); }
__device__ __forceinline__ float bfhi(unsigned u) { return __builtin_bit_cast(float, u & 0xffff0000u); }
__device__ __forceinline__ float fsigmoid(float x) { return 1.f / (1.f + __expf(-x)); }
__device__ __forceinline__ float wave_sum(float v) {
#pragma unroll
    for (int o = 1; o < 64; o <<= 1) v += __shfl_xor(v, o);
    return v;
}
__device__ __forceinline__ float wave_max(float v) {
#pragma unroll
    for (int o = 1; o < 64; o <<= 1) v = fmaxf(v, __shfl_xor(v, o));
    return v;
}

#define XB_TMO      128
#define XB_XCNT(j)  (256  + 64 * (j))
#define XB_XSUB(j)  (1280 + 64 * (j))
#define XB_XGEN(j)  (2304 + 64 * (j))
#define XB_TOP      3328
#define XB_TOPGEN   3392
#define XCD_BAR_WORDS 3456
#define XB_SPIN_CAP (1u << 22)
__device__ __forceinline__ unsigned xb_ld(unsigned* p)              { return __hip_atomic_load(p, __ATOMIC_RELAXED, __HIP_MEMORY_SCOPE_AGENT); }
__device__ __forceinline__ unsigned xb_add(unsigned* p, unsigned v) { return __hip_atomic_fetch_add(p, v, __ATOMIC_RELAXED, __HIP_MEMORY_SCOPE_AGENT); }
__device__ __forceinline__ unsigned xb_xcc_id() { return (unsigned)__builtin_amdgcn_s_getreg((3 << 11) | 20) & 0xFu; }
#define XB_SPIN(cond, bar) do { unsigned _sp = 0; while (cond) { __builtin_amdgcn_s_sleep(1); \
    if ((++_sp & 255u) == 0u) { if (xb_ld(&(bar)[XB_TMO])) break; if (_sp > XB_SPIN_CAP) { atomicAdd(&(bar)[XB_TMO], 1u); break; } } } } while (0)
struct XcdBarrier { unsigned* bar; unsigned x; volatile LAS unsigned* st; };
__device__ __forceinline__ XcdBarrier xcd_barrier_post(unsigned* bar, volatile LAS unsigned* st) {
    XcdBarrier b; b.bar = bar; b.x = xb_xcc_id(); b.st = st;
    if (threadIdx.x == 0) (void)xb_add(&bar[XB_XCNT(b.x)], 1u);
    return b;
}
__device__ __forceinline__ void xcd_barrier_complete(unsigned* bar, unsigned x, unsigned& nloc, unsigned& nx) {
    const unsigned G = gridDim.x * gridDim.y * gridDim.z;
    unsigned sum, cnt, mine, sp = 0u;
    for (;;) {
        sum = 0u; cnt = 0u; mine = 0u;
#pragma unroll
        for (unsigned j = 0; j < 16; ++j) { const unsigned c = xb_ld(&bar[XB_XCNT(j)]); sum += c; cnt += (c > 0u) ? 1u : 0u; mine = (j == x) ? c : mine; }
        if (sum == G) break;
        __builtin_amdgcn_s_sleep(1);
        if ((++sp & 255u) == 0u) { if (xb_ld(&bar[XB_TMO])) break; if (sp > XB_SPIN_CAP) { atomicAdd(&bar[XB_TMO], 1u); break; } }
    }
    nloc = mine > 0u ? mine : 1u; nx = cnt > 0u ? cnt : 1u;
}
__device__ __forceinline__ void xcd_barrier(const XcdBarrier& b) {
    asm volatile("s_waitcnt vmcnt(0)" ::: "memory");
    __syncthreads();
    if (threadIdx.x == 0) {
        unsigned* bar = b.bar;
        __builtin_amdgcn_s_waitcnt(0);
        unsigned nloc = b.st[0], nx = b.st[1];
        if (nloc == 0u) { xcd_barrier_complete(bar, b.x, nloc, nx); b.st[0] = nloc; b.st[1] = nx; }
        const unsigned old = xb_add(&bar[XB_XSUB(b.x)], 1u);
        const unsigned gen = old / nloc;
        if (old + 1u == (gen + 1u) * nloc) {
            __builtin_amdgcn_fence(__ATOMIC_RELEASE, "agent");
            asm volatile("s_waitcnt vmcnt(0)" ::: "memory");
            const unsigned og = xb_add(&bar[XB_TOP], 1u);
            const unsigned tg = og / nx;
            if (og + 1u == (tg + 1u) * nx) xb_add(&bar[XB_TOPGEN], 1u);
            else XB_SPIN(xb_ld(&bar[XB_TOPGEN]) == tg, bar);
            __builtin_amdgcn_fence(__ATOMIC_ACQUIRE, "agent");
            xb_add(&bar[XB_XGEN(b.x)], 1u);
            asm volatile("s_waitcnt vmcnt(0)" ::: "memory");
        } else {
            XB_SPIN(xb_ld(&bar[XB_XGEN(b.x)]) == gen, bar);
            __builtin_amdgcn_fence(__ATOMIC_ACQUIRE, "agent");
            asm volatile("s_waitcnt vmcnt(0)" ::: "memory");
        }
    }
    __syncthreads();
}
using pg8::Unit;
#ifndef STEAL_MARGIN
#define STEAL_MARGIN 8u
#endif
#ifndef FP8_GATES
#define FP8_GATES 3
#endif
#define GATES8(l) ((FP8_GATES >> (l)) & 1)
#ifndef FP8_MOE
#define FP8_MOE 3
#endif
#define MOE8(l) ((FP8_MOE >> (l)) & 1)
#define FP8_LAST MOE8(NL_ - 1)
__device__ __forceinline__ unsigned pk4_fp8(float a, float b, float c, float d) { int w = 0; w = __builtin_amdgcn_cvt_pk_fp8_f32(a, b, w, false); w = __builtin_amdgcn_cvt_pk_fp8_f32(c, d, w, true); return (unsigned)w; }
struct EpiY {
    static constexpr bool PERM = true, HAS_FOLD = false;
    bf16* Y; float* YSM; int pn0;
    __device__ __forceinline__ void operator()(const f32x4 (&acc)[2][2][4][2], const Unit& u, int wr, int wc, int fr, int fq) const {
        const int row0 = u.pm * 256 + wr * 64 + fr, pn = u.pn + pn0;
        if (pn == 29) {
            if (wc == 0) {
#pragma unroll
                for (int ai = 0; ai < 2; ++ai)
#pragma unroll
                    for (int m = 0; m < 4; ++m) { float* rp = YSM + (size_t)(row0 + ai * 128 + m * 16) * 32 + 8 * fq; *(f32x4*)rp = acc[ai][0][m][0]; *(f32x4*)(rp + 4) = acc[ai][0][m][1]; }
            }
            return;
        }
        const bool sg = pn >= 30;
#pragma unroll
        for (int ai = 0; ai < 2; ++ai)
#pragma unroll
            for (int m = 0; m < 4; ++m) { bf16* rp = Y + (size_t)(row0 + ai * 128 + m * 16) * YP + pn * 256 + wc * 32 + 8 * fq;
#pragma unroll
                for (int bj = 0; bj < 2; ++bj) { f32x4 v0 = acc[ai][bj][m][0], v1 = acc[ai][bj][m][1];
                    if (sg) {
#pragma unroll
                        for (int j = 0; j < 4; ++j) { v0[j] = fsigmoid(v0[j]); v1[j] = fsigmoid(v1[j]); } }
                    v4u w; w.x = pk2(v0[0], v0[1]); w.y = pk2(v0[2], v0[3]); w.z = pk2(v1[0], v1[1]); w.w = pk2(v1[2], v1[3]);
                    *(v4u*)(rp + bj * 128) = w; } }
    }
};
struct EpiMerge {
    static constexpr bool PERM = false, HAS_FOLD = true;
    const bf16* Y; bf16* MB; mutable f32x4 tot[2][4][2];
    __device__ __forceinline__ bool boundary(int kt) const { return kt == 8 || kt == 12 || kt == 24; }
    __device__ __forceinline__ void fold(const f32x4 (&acc)[2][1][4][2], const Unit& u, int wr, int wc, int fr, int fq, int kt) const {
        const int br = kt == 8 ? 0 : (kt == 12 ? 1 : (kt == 24 ? 2 : 3));
        int zv = 0; asm volatile("" : "+v"(zv));
        const int row0 = u.pm * 256 + wr * 64 + fr + zv, col0 = u.pn * 128 + wc * 32 + 4 * fq;
        v2u gp[2][4][2];
#pragma unroll
        for (int ai = 0; ai < 2; ++ai)
#pragma unroll
            for (int m = 0; m < 4; ++m)
#pragma unroll
                for (int n = 0; n < 2; ++n) gp[ai][m][n] = *(const v2u*)(Y + (size_t)(row0 + ai * 128 + m * 16) * YP + Y_G + br * 2048 + col0 + n * 16);
#pragma unroll
        for (int ai = 0; ai < 2; ++ai)
#pragma unroll
            for (int m = 0; m < 4; ++m)
#pragma unroll
                for (int n = 0; n < 2; ++n) { f32x4 v = acc[ai][0][m][n]; const v2u g2 = gp[ai][m][n]; v[0] *= bflo(g2.x); v[1] *= bfhi(g2.x); v[2] *= bflo(g2.y); v[3] *= bfhi(g2.y);
                    v = br > 0 ? v + tot[ai][m][n] : v;
                    if (br < 3) tot[ai][m][n] = v;
                    else { v2u o; o.x = pk2(v[0], v[1]); o.y = pk2(v[2], v[3]); *(v2u*)(MB + (size_t)(row0 + ai * 128 + m * 16) * 2048 + col0 + n * 16) = o; } }
    }
    __device__ __forceinline__ void operator()(const f32x4 (&acc)[2][1][4][2], const Unit& u, int wr, int wc, int fr, int fq) const { fold(acc, u, wr, wc, fr, fq, 32); }
};
struct EpiOut {
    static constexpr bool PERM = false, HAS_FOLD = false;
    const float* X; float* HB;
    __device__ __forceinline__ void operator()(const f32x4 (&acc)[2][2][4][2], const Unit& u, int wr, int wc, int fr, int fq) const {
        const int row0 = u.pm * 256 + wr * 64 + fr, col0 = u.pn * 256 + wc * 32 + 4 * fq;
#pragma unroll
        for (int ai = 0; ai < 2; ++ai)
#pragma unroll
            for (int m = 0; m < 4; ++m) { const size_t off = (size_t)(row0 + ai * 128 + m * 16) * 2048 + col0;
#pragma unroll
                for (int bj = 0; bj < 2; ++bj)
#pragma unroll
                    for (int n = 0; n < 2; ++n) { const f32x4 xv = *(const f32x4*)(X + off + bj * 128 + n * 16); *(f32x4*)(HB + off + bj * 128 + n * 16) = xv * DN_ALPHA + acc[ai][bj][m][n]; } }
    }
};
struct EpiMoe1 {
    static constexpr bool PERM = true, HAS_FOLD = false;
    bf16* H; const float* ROWW; int NJ;
    __device__ __forceinline__ void operator()(const f32x4 (&acc)[2][2][4][2], const Unit& u, int wr, int wc, int fr, int fq) const {
        const int row0 = u.pm * 256 + wr * 64 + fr, col0 = (u.pn & 3) * 128 + wc * 32 + 8 * fq;
#pragma unroll
        for (int ai = 0; ai < 2; ++ai)
#pragma unroll
            for (int m = 0; m < 4; ++m) { const size_t row = (size_t)(row0 + ai * 128 + m * 16); const float rw = ROWW[row];
                float h[8];
#pragma unroll
                for (int n = 0; n < 2; ++n)
#pragma unroll
                    for (int j = 0; j < 4; ++j) { const float a = acc[ai][0][m][n][j], b = acc[ai][1][m][n][j]; h[n * 4 + j] = a * fsigmoid(a) * b * rw; }
                v4u w; w.x = pk2(h[0], h[1]); w.y = pk2(h[2], h[3]); w.z = pk2(h[4], h[5]); w.w = pk2(h[6], h[7]);
                *(v4u*)(H + row * 512 + col0) = w; }
    }
};
struct EpiMoe2 {
    static constexpr bool PERM = true, HAS_FOLD = false;
    bf16* YB;
    __device__ __forceinline__ void operator()(const f32x4 (&acc)[2][2][4][2], const Unit& u, int wr, int wc, int fr, int fq) const {
        const int row0 = u.pm * 256 + wr * 64 + fr, col0 = (u.pn & 7) * 256 + wc * 32 + 8 * fq;
#pragma unroll
        for (int ai = 0; ai < 2; ++ai)
#pragma unroll
            for (int m = 0; m < 4; ++m) { bf16* rp = YB + (size_t)(row0 + ai * 128 + m * 16) * 2048 + col0;
#pragma unroll
                for (int bj = 0; bj < 2; ++bj) { const f32x4 v0 = acc[ai][bj][m][0], v1 = acc[ai][bj][m][1];
                    v4u w; w.x = pk2(v0[0], v0[1]); w.y = pk2(v0[2], v0[3]); w.z = pk2(v1[0], v1[1]); w.w = pk2(v1[2], v1[3]);
                    *(v4u*)(rp + bj * 128) = w; } }
    }
};
struct EpiMoe1F8 {
    static constexpr bool PERM = true, HAS_FOLD = false;
    unsigned char* H; const float* ROWW;
    __device__ __forceinline__ void operator()(const f32x4 (&acc)[2][2][4][2], const Unit& u, int wr, int wc, int fr, int fq) const {
        const int row0 = u.pm * 256 + wr * 64 + fr, col0 = (u.pn & 3) * 128 + wc * 32 + 8 * fq;
#pragma unroll
        for (int ai = 0; ai < 2; ++ai)
#pragma unroll
            for (int m = 0; m < 4; ++m) { const size_t row = (size_t)(row0 + ai * 128 + m * 16); const float rw = ROWW[row];
                float h[8];
#pragma unroll
                for (int n = 0; n < 2; ++n)
#pragma unroll
                    for (int j = 0; j < 4; ++j) { const float a = acc[ai][0][m][n][j], b = acc[ai][1][m][n][j]; h[n * 4 + j] = a * fsigmoid(a) * b * rw; }
                v2u w; w.x = pk4_fp8(h[0], h[1], h[2], h[3]); w.y = pk4_fp8(h[4], h[5], h[6], h[7]);
                *(v2u*)(H + row * 512 + col0) = w; }
    }
};
struct MoeOrder {
    int NJ, G, c, total, upm, upn;
    __device__ __forceinline__ void init(const int* tst, int NJ_, int G_, int c_, int lane) { NJ = NJ_; G = G_; c = c_; total = tst[65] * NJ_;
        const long L = (long)lane * G + c; upm = 0; upn = 0;
        if (L < total) { const int mt = (int)(L / NJ), j = (int)(L % NJ); int e = 0;
            for (int k = 1; k <= 64; ++k) e += (mt >= tst[k]) ? 1 : 0;
            upm = mt; upn = e * NJ + j; } }
    __device__ __forceinline__ bool next(int i, Unit& u) const {
        if ((long)i * G + c >= total || i >= 64) return false;
        const int iu = __builtin_amdgcn_readfirstlane(i);
        u.pm = __builtin_amdgcn_readlane(upm, iu); u.pn = __builtin_amdgcn_readlane(upn, iu); return true;
    }
    __device__ __forceinline__ void a_ready(const Unit&) const {}
    __device__ __forceinline__ void done(const Unit&) const {}
};

struct KArgs { const float* in[32]; float* out; unsigned char* ws; int ph_lo, ph_hi, region, pad; };
struct Ctx {
    LAS unsigned char* lds; unsigned char* ws; const float* in[32]; float* out;
    int tid, lane, wave, G, bid;
};
#define WSP(T, off) ((T*)(C.ws + (off)))

#ifndef CV_NT
#define CV_NT 1
#endif
#if CV_NT
#define CV_LOAD(p) __builtin_nontemporal_load(p)
#else
#define CV_LOAD(p) (*(p))
#endif
struct CvDesc { const float* sp; bf16* dp; int ldw, ldt, zero, w13, f8; };
__device__ __forceinline__ CvDesc cv_desc(const float* W, int ldw, int srccol, int k0, bf16* WT, size_t drow0, int ldt, int w13, int tid, int f8 = 0) {
    CvDesc d; d.zero = srccol < 0; d.ldw = ldw; d.ldt = ldt; d.w13 = w13; d.f8 = f8;
    d.sp = W + (size_t)(k0 + (tid >> 6)) * ldw + (srccol < 0 ? 0 : srccol);
    d.dp = f8 ? (bf16*)((unsigned char*)WT + drow0 * (size_t)ldt + k0) : WT + drow0 * (size_t)ldt + k0; return d;
}
__device__ __forceinline__ CvDesc conv_item(Ctx& C, int l, int r, int tid) {
    constexpr int I_WIN = 16 * 62, I_W13 = 65 * 64, I_W2 = 65 * 32, I_PA = 4 * 8, I_PB = 2 * 8, I_PC = 6 * 8, I_PD = 4 * 8;
    const bool f8l = MOE8(l), lastb = MOE8(l) && l == NL_ - 1;
    bf16* WIN = WSP(bf16, WS_WIN); bf16* W13 = lastb ? WSP(bf16, WS_W13B) : WSP(bf16, WS_W13); bf16* W2 = lastb ? WSP(bf16, WS_W2B) : WSP(bf16, WS_W2); bf16* WP = WSP(bf16, WS_WP); bf16* WOUT = WSP(bf16, WS_WOUT);
    const int c4 = 4 * (tid & 63);
    if (r < I_WIN) { const int nb = r % 62, kb = r / 62, n = 256 * nb + c4; int sc;
        if (n < 1536) sc = n; else if (n < 7424) sc = n + 16; else if (n < 7680) { const int i = n - 7424; sc = i < 16 ? 1536 + i : (i < 24 ? 7440 + (i - 16) : -1); } else sc = n - 7680 + 7448;
        if (GATES8(l) && nb >= 30) return cv_desc(C.in[2] + (size_t)l * 2048 * NCOL, NCOL, sc, 128 * kb, WSP(bf16, WS_WIN8), 256 * (nb - 30), 2048, 0, tid, 1);
        return cv_desc(C.in[2] + (size_t)l * 2048 * NCOL, NCOL, sc, 128 * kb, WIN, 256 * nb, 2048, 0, tid); }
    r -= I_WIN;
    if (r < I_W13) { const int e = r / 64, q = r % 64, half = q >> 5, kb = (q >> 1) & 15, nq = q & 1;
        const float* src = e == 0 ? (half ? C.in[28] : C.in[27]) + (size_t)l * 2048 * 512 : (half ? C.in[25] : C.in[24]) + (size_t)(l * 64 + e - 1) * 2048 * 512;
        return cv_desc(src, 512, 256 * nq + c4, 128 * kb, W13, (size_t)e * 1024 + nq * 512 + half * 128, 2048, 1, tid, f8l ? 1 : 0); }
    r -= I_W13;
    if (r < I_W2) { const int e = r / 32, q = r % 32, kb = q / 8, nb = q % 8;
        const float* src = e == 0 ? C.in[29] + (size_t)l * 512 * 2048 : C.in[26] + (size_t)(l * 64 + e - 1) * 512 * 2048;
        return cv_desc(src, 2048, 256 * nb + c4, 128 * kb, W2, (size_t)e * 2048 + 256 * nb, 512, 0, tid, f8l ? 1 : 0); }
    r -= I_W2;
    if (r < I_PA) return cv_desc(C.in[15] + (size_t)l * 512 * 2048, 2048, 256 * (r % 8) + c4, 128 * (r / 8), WP, 256 * (r % 8), 2048, 0, tid);
    r -= I_PA;
    if (r < I_PB) return cv_desc(C.in[16] + (size_t)l * 256 * 2048, 2048, 256 * (r % 8) + c4, 128 * (r / 8), WP + 512, 256 * (r % 8), 2048, 0, tid);
    r -= I_PB;
    if (r < I_PC) return cv_desc(C.in[17] + (size_t)l * 768 * 2048, 2048, 256 * (r % 8) + c4, 128 * (r / 8), WP + 768, 256 * (r % 8), 2048, 0, tid);
    r -= I_PC;
    if (r < I_PD) return cv_desc(C.in[18] + (size_t)l * 512 * 2048, 2048, 256 * (r % 8) + c4, 128 * (r / 8), WP + 1536, 256 * (r % 8), 2048, 0, tid);
    r -= I_PD;
    return cv_desc(C.in[19] + (size_t)l * 2048 * 2048, 2048, 256 * (r % 8) + c4, 128 * (r / 8), WOUT, 256 * (r % 8), 2048, 0, tid);
}
__device__ __forceinline__ void phase_convert(Ctx& C, int l, int part, int cbid, int cG, unsigned* arr = nullptr) {
    LAS float* tile = (LAS float*)C.lds; LAS int* qn = (LAS int*)(C.lds + AUX_OFF + 8192);
    unsigned* cq = WSP(unsigned, WS_CTL) + CW_CQ + l * 2 + part;
    const int tid = C.tid, lane = C.lane, wave = C.wave;
    constexpr int I_WIN = 16 * 62, NITEMS = I_WIN + 65 * 64 + 65 * 32 + (4 + 2 + 6 + 4) * 8 + 16 * 8;
    const int it0 = part == 0 ? 0 : I_WIN, it1 = part == 0 ? I_WIN : NITEMS;
    __syncthreads();
    if (tid == 0) qn[0] = (arr && __hip_atomic_load(arr, __ATOMIC_RELAXED, __HIP_MEMORY_SCOPE_AGENT) + STEAL_MARGIN >= (unsigned)C.G) ? 0x7fffffff : it0 + (int)atomicAdd(cq, 1u);
    __syncthreads();
    int it = qn[0];
    f32x4 va[16];
    CvDesc d = conv_item(C, l, it < it1 ? it : it0, tid);
    if (it < it1) {
#pragma unroll
        for (int i = 0; i < 16; ++i) va[i] = d.zero ? (f32x4){0.f, 0.f, 0.f, 0.f} : CV_LOAD((const f32x4*)(d.sp + (size_t)(8 * i) * d.ldw)); }
    const int c16 = lane & 15, nsub = lane >> 4;
    while (it < it1) {
#pragma unroll
        for (int i = 0; i < 16; ++i) { const int kk = wave + 8 * i; *(LAS f32x4*)(tile + kk * 256 + ((4 * (tid & 63)) ^ (4 * ((kk >> 3) & 7)))) = va[i]; }
        if (tid == 0) qn[1] = (arr && __hip_atomic_load(arr, __ATOMIC_RELAXED, __HIP_MEMORY_SCOPE_AGENT) + STEAL_MARGIN >= (unsigned)C.G) ? 0x7fffffff : it0 + (int)atomicAdd(cq, 1u);
        __syncthreads();
        const int nx = qn[1]; const bool hn = nx < it1;
        const CvDesc dn = conv_item(C, l, hn ? nx : it, tid);
        if (hn) {
#pragma unroll
            for (int i = 0; i < 16; ++i) va[i] = dn.zero ? (f32x4){0.f, 0.f, 0.f, 0.f} : CV_LOAD((const f32x4*)(dn.sp + (size_t)(8 * i) * dn.ldw)); }
#pragma unroll
        for (int p = 0; p < 8; ++p) { const int n = p * 32 + wave * 4 + nsub; const LAS float* s = tile + (8 * c16) * 256 + (n ^ (4 * (c16 & 7)));
            const int drow = d.w13 ? ((n >> 7) << 8) + (n & 127) : n;
            if (d.f8) { v2u o8; o8.x = pk4_fp8(s[0 * 256] * 32.f, s[1 * 256] * 32.f, s[2 * 256] * 32.f, s[3 * 256] * 32.f); o8.y = pk4_fp8(s[4 * 256] * 32.f, s[5 * 256] * 32.f, s[6 * 256] * 32.f, s[7 * 256] * 32.f);
                *(v2u*)((unsigned char*)d.dp + (size_t)drow * d.ldt + 8 * c16) = o8; }
            else { v4u o; o.x = pk2(s[0 * 256], s[1 * 256]); o.y = pk2(s[2 * 256], s[3 * 256]); o.z = pk2(s[4 * 256], s[5 * 256]); o.w = pk2(s[6 * 256], s[7 * 256]);
                *(v4u*)(d.dp + (size_t)drow * d.ldt + 8 * c16) = o; } }
        __syncthreads();
        d = dn; it = nx;
    }
    if (l == 0 && part == 0) {
        const int gw = cbid * 8 + C.wave, NGW = cG * 8;
        bf16* XB = WSP(bf16, WS_XB); const float* X = C.in[0];
        for (int t = gw; t < T_; t += NGW) {
#pragma unroll
            for (int j = 0; j < 8; ++j) { const f32x4 v = *(const f32x4*)(X + (size_t)t * 2048 + 4 * (lane + 64 * j)); v2u o; o.x = pk2(v[0], v[1]); o.y = pk2(v[2], v[3]); *(v2u*)(XB + (size_t)t * 2048 + 4 * (lane + 64 * j)) = o;
                if (GATES8(0)) *(unsigned*)(WSP(unsigned char, WS_XB8) + (size_t)t * 2048 + 4 * (lane + 64 * j)) = pk4_fp8(v[0], v[1], v[2], v[3]); }
        }
        f32x2* CS = WSP(f32x2, WS_CS); const int* pos = (const int*)C.in[1];
        for (int i = C.bid * 512 + C.tid; i < T_ * 32; i += C.G * 512) { const int t = i >> 5, f = i & 31;
            const float inv = powf(10000.0f, -(float)f * 2.0f / 64.0f), ang = (float)pos[t] * inv; float sn, cs; sincosf(ang, &sn, &cs); CS[i] = (f32x2){cs, sn}; }
    }
}
__device__ __forceinline__ void ln_row(f32x4 (&v)[8], const float* g, const float* b, int lane) {
    float s = 0.f;
#pragma unroll
    for (int j = 0; j < 8; ++j) s += (v[j][0] + v[j][1]) + (v[j][2] + v[j][3]);
    const float mean = wave_sum(s) * (1.f / 2048.f); float q = 0.f;
#pragma unroll
    for (int j = 0; j < 8; ++j) { v[j] = v[j] - mean; q += (v[j][0] * v[j][0] + v[j][1] * v[j][1]) + (v[j][2] * v[j][2] + v[j][3] * v[j][3]); }
    const float rstd = 1.f / sqrtf(wave_sum(q) * (1.f / 2048.f) + LN_EPS_);
#pragma unroll
    for (int j = 0; j < 8; ++j) { const f32x4 gv = *(const f32x4*)(g + 4 * (lane + 64 * j)), bv = *(const f32x4*)(b + 4 * (lane + 64 * j)); v[j] = v[j] * rstd * gv + bv; }
}
__device__ __forceinline__ void phase_ln1_router(Ctx& C, int l) {
    const float* HB = WSP(float, WS_HB); float* X1 = WSP(float, WS_X1); bf16* XS = WSP(bf16, WS_XS); float* ROWW = WSP(float, WS_ROWW);
    int* sel_e = WSP(int, WS_SEL); float* sel_w = WSP(float, WS_SEL + 262144); int* sel_r = WSP(int, WS_SEL + 2 * 262144);
    unsigned* cnt = WSP(unsigned, WS_CTL) + CW_CNT + l * 64;
    const float* g = C.in[20] + l * 2048; const float* b = C.in[21] + l * 2048; const float* wrt = C.in[22] + (size_t)l * 2048 * 64; const float* rb = C.in[23] + l * 64;
    constexpr int XP = 2068;
    LAS float* xl = (LAS float*)C.lds; LAS float* part = xl + 16 * XP; LAS float* scl = part + 2048;
    const int lane = C.lane, wave = C.wave;
    for (int unit = C.bid; unit < T_ / 16; unit += C.G) {
        const int t0 = unit * 16;
#pragma unroll 1
        for (int rr = 0; rr < 2; ++rr) { const int row = 2 * wave + rr; const size_t t = (size_t)(t0 + row);
            f32x4 v[8];
#pragma unroll
            for (int j = 0; j < 8; ++j) v[j] = *(const f32x4*)(HB + t * 2048 + 4 * (lane + 64 * j));
            ln_row(v, g, b, lane);
#pragma unroll
            for (int j = 0; j < 8; ++j) { *(f32x4*)(X1 + t * 2048 + 4 * (lane + 64 * j)) = v[j];
                if (MOE8(l)) *(unsigned*)(WSP(unsigned char, WS_XS8) + t * 2048 + 4 * (lane + 64 * j)) = pk4_fp8(v[j][0], v[j][1], v[j][2], v[j][3]);
                else { v2u o; o.x = pk2(v[j][0], v[j][1]); o.y = pk2(v[j][2], v[j][3]); *(v2u*)(XS + t * 2048 + 4 * (lane + 64 * j)) = o; }
                *(LAS f32x4*)(xl + row * XP + 4 * (lane + 64 * j)) = v[j]; }
        }
        if (C.tid < 16) { ROWW[t0 + C.tid] = 1.0f; WSP(int, WS_ROWMAP)[t0 + C.tid] = t0 + C.tid; }
        __syncthreads();
        {
            const int et = wave & 3, kh = wave >> 2, i = lane & 15, h = lane >> 4; f32x4 acc = (f32x4){0.f, 0.f, 0.f, 0.f};
            const LAS float* xr = xl + i * XP + kh * 1024 + 4 * h; const float* wb = wrt + (size_t)(kh * 1024 + 4 * h) * 64 + 16 * et + i;
#pragma unroll 4
            for (int s = 0; s < 64; ++s) { const f32x4 a = *(const LAS f32x4*)(xr + 16 * s); const float* wp = wb + (size_t)(16 * s) * 64;
                const float b0 = wp[0], b1 = wp[64], b2 = wp[128], b3 = wp[192];
                acc = __builtin_amdgcn_mfma_f32_16x16x4f32(a[0], b0, acc, 0, 0, 0); acc = __builtin_amdgcn_mfma_f32_16x16x4f32(a[1], b1, acc, 0, 0, 0);
                acc = __builtin_amdgcn_mfma_f32_16x16x4f32(a[2], b2, acc, 0, 0, 0); acc = __builtin_amdgcn_mfma_f32_16x16x4f32(a[3], b3, acc, 0, 0, 0); }
#pragma unroll
            for (int r = 0; r < 4; ++r) part[kh * 1024 + (4 * h + r) * 64 + 16 * et + i] = acc[r];
        }
        __syncthreads();
#pragma unroll
        for (int k = 0; k < 2; ++k) { const int idx = C.tid + 512 * k; scl[idx] = 1.f / (1.f + expf(-(part[idx] + part[1024 + idx]))); }
        __syncthreads();
#pragma unroll 1
        for (int rr = 0; rr < 2; ++rr) { const int tok = 2 * wave + rr, t = t0 + tok; const float* sp = (const float*)(scl + tok * 64);
            const bool sel = route_lane_select(lane, sp, rb); const float s = scl[tok * 64 + lane];
            const unsigned long long m0_ = __ballot(sel); const bool sel8 = sel && __popcll(m0_ & ((1ull << lane) - 1ull)) < 8;
            const float wsum = wave_sum(sel8 ? s : 0.f); const unsigned long long m = __ballot(sel8);
            if (sel8) { const int k = __popcll(m & ((1ull << lane) - 1ull)); sel_e[t * 8 + k] = lane; sel_w[t * 8 + k] = s * 2.5f / wsum; sel_r[t * 8 + k] = (int)atomicAdd(cnt + lane, 1u); } }
        __syncthreads();
    }
}
__device__ __forceinline__ void phase_scatter(Ctx& C, int l) {
    float* ROWW = WSP(float, WS_ROWW); int* ROWMAP = WSP(int, WS_ROWMAP);
    const int* sel_e = WSP(int, WS_SEL); const float* sel_w = WSP(float, WS_SEL + 262144); const int* sel_r = WSP(int, WS_SEL + 2 * 262144); int* POS = WSP(int, WS_SEL + 3 * 262144);
    const unsigned* cnt = WSP(unsigned, WS_CTL) + CW_CNT + l * 64; int* tst = WSP(int, WS_CTL) + CW_TST + l * 128;
    LAS int* offl = (LAS int*)(C.lds + AUX_OFF + 4096);
    if (C.tid == 0) { int ts = 0;
        for (int k = 0; k <= 65; ++k) { if (C.bid == 0) tst[k] = ts; if (k >= 1 && k <= 64) offl[k - 1] = ts * 256; ts += (k == 0) ? 32 : (k <= 64 ? (((int)cnt[k - 1] + 255) >> 8) : 0); } }
    __syncthreads();
    for (int p = C.bid * 512 + C.tid; p < T_ * 8; p += C.G * 512) { const int e = sel_e[p], pos = offl[e] + sel_r[p]; ROWMAP[pos] = p >> 3; ROWW[pos] = sel_w[p]; POS[p] = pos; }
    for (int e = C.bid; e < 64; e += C.G) { const int c = (int)cnt[e], beg = offl[e] + c, end = offl[e] + ((c + 255) & ~255);
        for (int pos = beg + C.tid; pos < end; pos += 512) { ROWMAP[pos] = 0; ROWW[pos] = 0.f; } }
}
__device__ __forceinline__ void phase_combine(Ctx& C, int l) {
    const bf16* YB = WSP(bf16, WS_YBUF); const float* X1 = WSP(float, WS_X1); const int* POS = WSP(int, WS_SEL + 3 * 262144);
    float* XO = (l == NL_ - 1) ? C.out : WSP(float, WS_XA); bf16* XB = WSP(bf16, WS_XB);
    const float* g = C.in[30] + l * 2048; const float* b = C.in[31] + l * 2048;
    const int gw = C.bid * 8 + C.wave, NGW = C.G * 8, lane = C.lane;
    int pn[8];
#pragma unroll
    for (int k = 0; k < 8; ++k) pn[k] = gw < T_ ? POS[gw * 8 + k] : 0;
    for (int t = gw; t < T_; t += NGW) {
        size_t rows[9]; rows[0] = (size_t)t;
#pragma unroll
        for (int k = 0; k < 8; ++k) rows[k + 1] = (size_t)pn[k];
        { const int tn = t + NGW < T_ ? t + NGW : t;
#pragma unroll
          for (int k = 0; k < 8; ++k) pn[k] = POS[tn * 8 + k]; }
        v4u w[9][4];
#pragma unroll
        for (int k = 0; k < 9; ++k)
#pragma unroll
            for (int j = 0; j < 4; ++j) w[k][j] = *(const v4u*)(YB + rows[k] * 2048 + 8 * lane + 512 * j);
        float v[4][8];
#pragma unroll
        for (int j = 0; j < 4; ++j) { const f32x4 a = *(const f32x4*)(X1 + (size_t)t * 2048 + 8 * lane + 512 * j), c = *(const f32x4*)(X1 + (size_t)t * 2048 + 8 * lane + 512 * j + 4);
            v[j][0] = a[0] * DN_ALPHA; v[j][1] = a[1] * DN_ALPHA; v[j][2] = a[2] * DN_ALPHA; v[j][3] = a[3] * DN_ALPHA; v[j][4] = c[0] * DN_ALPHA; v[j][5] = c[1] * DN_ALPHA; v[j][6] = c[2] * DN_ALPHA; v[j][7] = c[3] * DN_ALPHA; }
#pragma unroll
        for (int k = 0; k < 9; ++k)
#pragma unroll
            for (int j = 0; j < 4; ++j) { v[j][0] += bflo(w[k][j].x); v[j][1] += bfhi(w[k][j].x); v[j][2] += bflo(w[k][j].y); v[j][3] += bfhi(w[k][j].y); v[j][4] += bflo(w[k][j].z); v[j][5] += bfhi(w[k][j].z); v[j][6] += bflo(w[k][j].w); v[j][7] += bfhi(w[k][j].w); }
        float s = 0.f;
#pragma unroll
        for (int j = 0; j < 4; ++j)
#pragma unroll
            for (int e = 0; e < 8; ++e) s += v[j][e];
        const float mean = wave_sum(s) * (1.f / 2048.f); float q = 0.f;
#pragma unroll
        for (int j = 0; j < 4; ++j)
#pragma unroll
            for (int e = 0; e < 8; ++e) { v[j][e] -= mean; q += v[j][e] * v[j][e]; }
        const float rstd = 1.f / sqrtf(wave_sum(q) * (1.f / 2048.f) + LN_EPS_);
#pragma unroll
        for (int j = 0; j < 4; ++j) { const int c0 = 8 * lane + 512 * j; float o[8];
            const f32x4 g0 = *(const f32x4*)(g + c0), g1 = *(const f32x4*)(g + c0 + 4), b0 = *(const f32x4*)(b + c0), b1 = *(const f32x4*)(b + c0 + 4);
#pragma unroll
            for (int e = 0; e < 4; ++e) { o[e] = v[j][e] * rstd * g0[e] + b0[e]; o[4 + e] = v[j][4 + e] * rstd * g1[e] + b1[e]; }
            *(f32x4*)(XO + (size_t)t * 2048 + c0) = (f32x4){o[0], o[1], o[2], o[3]}; *(f32x4*)(XO + (size_t)t * 2048 + c0 + 4) = (f32x4){o[4], o[5], o[6], o[7]};
            if (l < NL_ - 1) { v4u ow; ow.x = pk2(o[0], o[1]); ow.y = pk2(o[2], o[3]); ow.z = pk2(o[4], o[5]); ow.w = pk2(o[6], o[7]); *(v4u*)(XB + (size_t)t * 2048 + c0) = ow;
                if (GATES8(l + 1)) { v2u o8; o8.x = pk4_fp8(o[0], o[1], o[2], o[3]); o8.y = pk4_fp8(o[4], o[5], o[6], o[7]); *(v2u*)(WSP(unsigned char, WS_XB8) + (size_t)t * 2048 + c0) = o8; } } }
    }
}
typedef LAS unsigned char* ldsp;
__device__ __forceinline__ f32x4 mfma16(bf16x8 bt, bf16x8 a, f32x4 c) { return __builtin_amdgcn_mfma_f32_16x16x32_bf16(bt, a, c, 0, 0, 0); }
__device__ __forceinline__ bf16x8 frag(ldsp base, int pitch, int row, int k0, int fq) { return *(const LAS bf16x8*)(base + row * pitch + (k0 + 8 * fq) * 2); }
__device__ __forceinline__ bf16x8 frag2(ldsp base, int pitch, int row, int kA, int kB, int fq) {
    const v2u a = *(const LAS v2u*)(base + row * pitch + (kA + 4 * fq) * 2), b = *(const LAS v2u*)(base + row * pitch + (kB + 4 * fq) * 2);
    v4u r; r.x = a.x; r.y = a.y; r.z = b.x; r.w = b.y; return __builtin_bit_cast(bf16x8, r);
}
typedef short v4i16_t __attribute__((ext_vector_type(4)));
__device__ __forceinline__ bf16x8 trfrag2(ldsp base, int pitch, int col0, int kA, int kB, int lane) {
    const int q = (lane & 15) >> 2, p = lane & 3, fq = lane >> 4;
    const v4i16_t x = __builtin_amdgcn_ds_read_tr16_b64_v4i16((LAS v4i16_t*)(base + (kA + 4 * fq + q) * pitch + (col0 + 4 * p) * 2));
    const v4i16_t y = __builtin_amdgcn_ds_read_tr16_b64_v4i16((LAS v4i16_t*)(base + (kB + 4 * fq + q) * pitch + (col0 + 4 * p) * 2));
    bf16x8 r; r[0] = x[0]; r[1] = x[1]; r[2] = x[2]; r[3] = x[3]; r[4] = y[0]; r[5] = y[1]; r[6] = y[2]; r[7] = y[3]; return r;
}
__device__ __forceinline__ bf16x8 trfrag(ldsp base, int pitch, int col0, int k0, int lane) { const int fq = lane >> 4; return trfrag2(base, pitch, col0, k0 + 4 * fq, k0 + 4 * fq + 4, lane); }
__device__ __forceinline__ bf16x8 pfrag(const f32x4& p0, const f32x4& p1) { v4u r; r.x = pk2(p0[0], p0[1]); r.y = pk2(p0[2], p0[3]); r.z = pk2(p1[0], p1[1]); r.w = pk2(p1[2], p1[3]); return __builtin_bit_cast(bf16x8, r); }
__device__ __forceinline__ void unpack8(const v4u w, float (&f)[8]) { f[0] = bflo(w.x); f[1] = bfhi(w.x); f[2] = bflo(w.y); f[3] = bfhi(w.y); f[4] = bflo(w.z); f[5] = bfhi(w.z); f[6] = bflo(w.w); f[7] = bfhi(w.w); }
__device__ __forceinline__ unsigned short bf1(float x) { return (unsigned short)(pk2(x, 0.f) & 0xffffu); }
__device__ __forceinline__ float flogsigmoid(float x) { return fminf(x, 0.f) - log1pf(__expf(-fabsf(x))); }
__device__ __forceinline__ float fgelu(float v) {
    const float av = fabsf(v), t = __builtin_amdgcn_rcpf(av * 0.2316418882f + 1.0f);
    float q = t * 0.5307027145f + (-0.7265760135f); q = q * t + 0.7107068705f; q = q * t + (-0.142248368f); q = q * t + 0.127414796f; q = q * t;
    const float e = __builtin_amdgcn_exp2f((v * v) * (-0.72134752044f)), m = v * (q * e);
    return v < 0.f ? m : v - m;
}

__device__ __forceinline__ void scat8(LAS unsigned short* vp, int ps  , const v4u w) {
    vp[0 * ps] = (unsigned short)(w.x & 0xffff); vp[1 * ps] = (unsigned short)(w.x >> 16); vp[2 * ps] = (unsigned short)(w.y & 0xffff); vp[3 * ps] = (unsigned short)(w.y >> 16);
    vp[4 * ps] = (unsigned short)(w.z & 0xffff); vp[5 * ps] = (unsigned short)(w.z >> 16); vp[6 * ps] = (unsigned short)(w.w & 0xffff); vp[7 * ps] = (unsigned short)(w.w >> 16);
}

__device__ __forceinline__ void dil_unit(Ctx& C, int u) {
    const int tid = C.tid, lane = C.lane, wave = C.wave, fr = lane & 15, fq = lane >> 4;
    const int blk16 = u & 15, hh = (u >> 4) & 3, g = (u >> 6) % 3, b = u / 192;
    const int dil = g == 0 ? 1 : (g == 1 ? 4 : 16), nbpr = 16 / dil  , r = blk16 / nbpr, nb = blk16 % nbpr, head = g * 4 + hh;
    const bf16* Y = WSP(bf16, WS_Y); const f32x2* CS = WSP(f32x2, WS_CS);
    constexpr int QP = 144, KP = 144, VP = 160;
    ldsp Ql = C.lds, Kl = C.lds + 128 * QP, Vl = Kl + 256 * KP;
    const size_t tb = (size_t)b * SEQ_;
    {   const int ch = tid & 3, row0 = tid >> 2; v4u xa[3], xb[3]; f32x4 cs[3][4]; int mrow[3];
#pragma unroll
        for (int i = 0; i < 3; ++i) { const int row = row0 + (i == 2 ? 128 : 0), m = (i == 0) ? nb * 128 + row : (nb - 1) * 128 + row, mc = m < 0 ? 0 : m; const size_t t = tb + (size_t)mc * dil + r;
            const bf16* src = Y + t * YP + (i == 0 ? Y_BQ : Y_BK) + head * 64 + 8 * ch; xa[i] = *(const v4u*)src; xb[i] = *(const v4u*)(src + 32);
            const f32x4* cp = (const f32x4*)(CS + t * 32 + 8 * ch); cs[i][0] = cp[0]; cs[i][1] = cp[1]; cs[i][2] = cp[2]; cs[i][3] = cp[3]; mrow[i] = m; }
        const int ch8 = tid & 7, key0 = tid >> 3; v4u vv[4];
#pragma unroll
        for (int i = 0; i < 4; ++i) { const int m = (nb - 1) * 128 + key0 + 64 * i, mc = m < 0 ? 0 : m; vv[i] = *(const v4u*)(Y + (tb + (size_t)mc * dil + r) * YP + Y_BV + head * 64 + 8 * ch8); }
#pragma unroll
        for (int i = 0; i < 3; ++i) { const int row = row0 + (i == 2 ? 128 : 0); ldsp dst = (i == 0) ? Ql + row * QP : Kl + row * KP;
            float x1[8], x2[8]; unpack8(xa[i], x1); unpack8(xb[i], x2); const float sc = (i == 0) ? 0.125f : (mrow[i] < 0 ? 0.f : 1.f); float y1[8], y2[8];
#pragma unroll
            for (int k = 0; k < 8; ++k) { const float c = cs[i][k >> 1][2 * (k & 1)], sn = cs[i][k >> 1][2 * (k & 1) + 1]; y1[k] = (x1[k] * c - x2[k] * sn) * sc; y2[k] = (x2[k] * c + x1[k] * sn) * sc; }
            v4u o1, o2; o1.x = pk2(y1[0], y1[1]); o1.y = pk2(y1[2], y1[3]); o1.z = pk2(y1[4], y1[5]); o1.w = pk2(y1[6], y1[7]);
            o2.x = pk2(y2[0], y2[1]); o2.y = pk2(y2[2], y2[3]); o2.z = pk2(y2[4], y2[5]); o2.w = pk2(y2[6], y2[7]);
            *(LAS v4u*)(dst + 16 * ch) = o1; *(LAS v4u*)(dst + 64 + 16 * ch) = o2; }
#pragma unroll
        for (int i = 0; i < 4; ++i) { const int key = key0 + 64 * i; v4u w = vv[i]; if ((nb - 1) * 128 + key < 0) w = (v4u){0u, 0u, 0u, 0u};
            *(LAS v4u*)(Vl + key * VP + 16 * ch8) = w; }
    }
    __syncthreads();
    const int ts = wave < 6 ? wave : 6;
    const bf16x8 q0 = frag(Ql, QP, 16 * wave + fr, 0, fq), q1 = frag(Ql, QP, 16 * wave + fr, 32, fq);
    f32x4 s[10];
#pragma unroll
    for (int t = 0; t < 10; ++t) { s[t] = (f32x4){0.f, 0.f, 0.f, 0.f};
        s[t] = mfma16(frag(Kl, KP, 16 * (ts + t) + fr, 0, fq), q0, s[t]); s[t] = mfma16(frag(Kl, KP, 16 * (ts + t) + fr, 32, fq), q1, s[t]); }
    const int qi = 16 * wave + fr; float mx = -INFINITY;
#pragma unroll
    for (int t = 0; t < 10; ++t)
#pragma unroll
        for (int e = 0; e < 4; ++e) { const int j = 16 * (ts + t) + 4 * fq + e; const bool ok = (j >= qi) && (j <= qi + 128) && ((nb - 1) * 128 + j >= 0); s[t][e] = ok ? s[t][e] : -INFINITY; mx = fmaxf(mx, s[t][e]); }
    mx = fmaxf(mx, __shfl_xor(mx, 16)); mx = fmaxf(mx, __shfl_xor(mx, 32));
    float den = 0.f;
#pragma unroll
    for (int t = 0; t < 10; ++t)
#pragma unroll
        for (int e = 0; e < 4; ++e) { const float p = __expf(s[t][e] - mx); s[t][e] = p; den += p; }
    den += __shfl_xor(den, 16); den += __shfl_xor(den, 32);
    f32x4 o[4];
#pragma unroll
    for (int n = 0; n < 4; ++n) o[n] = (f32x4){0.f, 0.f, 0.f, 0.f};
#pragma unroll
    for (int tp = 0; tp < 5; ++tp) { const bf16x8 pf = pfrag(s[2 * tp], s[2 * tp + 1]);
#pragma unroll
        for (int n = 0; n < 4; ++n) o[n] = mfma16(trfrag2(Vl, VP, 16 * n, 16 * (ts + 2 * tp), 16 * (ts + 2 * tp + 1), lane), pf, o[n]); }
    const size_t t = tb + (size_t)(nb * 128 + qi) * dil + r; const float rden = 1.f / den;
    float* DO = WSP(float, WS_DILO) + t * 768 + head * 64;
#pragma unroll
    for (int n = 0; n < 4; ++n) *(f32x4*)(DO + 16 * n + 4 * fq) = o[n] * rden;
    if (fq == 0) WSP(float, WS_DILL)[t * 12 + head] = mx + __logf(den);
    __syncthreads();
}
__device__ __forceinline__ void dil_merge(Ctx& C, bf16* YM) {
    const float* DO = WSP(float, WS_DILO); const float* DL = WSP(float, WS_DILL);
    for (int i = C.bid * 512 + C.tid; i < T_ * 64; i += C.G * 512) { const int t = i >> 6, hh = (i >> 4) & 3, d4 = (i & 15) * 4;
        const float l0 = DL[t * 12 + hh], l1 = DL[t * 12 + 4 + hh], l2 = DL[t * 12 + 8 + hh], m = fmaxf(l0, fmaxf(l1, l2));
        const float w0 = __expf(l0 - m), w1 = __expf(l1 - m), w2 = __expf(l2 - m), rs = 1.f / (w0 + w1 + w2);
        const f32x4 a = *(const f32x4*)(DO + (size_t)t * 768 + hh * 64 + d4), bb = *(const f32x4*)(DO + (size_t)t * 768 + (4 + hh) * 64 + d4), c = *(const f32x4*)(DO + (size_t)t * 768 + (8 + hh) * 64 + d4);
        const f32x4 o = (a * w0 + bb * w1 + c * w2) * rs; v2u w; w.x = pk2(o[0], o[1]); w.y = pk2(o[2], o[3]);
        *(v2u*)(YM + (size_t)t * 2048 + YM_B + hh * 64 + d4) = w; }
}

__device__ __forceinline__ void sgu_unit(Ctx& C, int l, int u, bf16* YM) {
    const int tid = C.tid, lane = C.lane, wave = C.wave, fr = lane & 15, fq = lane >> 4;
    const int g = u % 6, cn = u / 6; const size_t t0 = (size_t)cn * 128;
    const bf16* Y = WSP(bf16, WS_Y);
    const float* lng = C.in[11] + l * 768; const float* lnb = C.in[12] + l * 768; const float* ws = C.in[13] + (size_t)(l * 6 + g) * 128 * 128; const float* bs = C.in[14] + (l * 6 + g) * 128;
    constexpr int AP = 272, VP = 288;
    ldsp Al = C.lds, Vl = C.lds + 128 * AP; LAS float* st = (LAS float*)(Vl + 128 * VP);
    {   const int j = tid >> 2, qd = tid & 3; const bf16* src = Y + (t0 + j) * YP + Y_CV + qd * 192; float s1 = 0.f, s2 = 0.f;
        { v4u w[24];
#pragma unroll
            for (int k = 0; k < 24; ++k) w[k] = *(const v4u*)(src + 8 * k);
#pragma unroll
            for (int k = 0; k < 24; ++k) { float x[8]; unpack8(w[k], x);
#pragma unroll
                for (int q2 = 0; q2 < 8; ++q2) { const float z = fgelu(x[q2]); s1 += z; s2 += z * z; } } }
        s1 += __shfl_xor(s1, 1); s2 += __shfl_xor(s2, 1); s1 += __shfl_xor(s1, 2); s2 += __shfl_xor(s2, 2);
        if (qd == 0) { const float mu = s1 * (1.f / 768.f), var = fmaxf(s2 * (1.f / 768.f) - mu * mu, 0.f); st[2 * j] = mu; st[2 * j + 1] = 1.f / sqrtf(var + LN_EPS_); } }
    {   const int c8 = (tid & 15) * 8; f32x4 a[4], bq[4];
#pragma unroll
        for (int k4 = 0; k4 < 4; ++k4) { const int i = (tid >> 4) + 32 * k4; const float* src = ws + i * 128 + c8; a[k4] = *(const f32x4*)src; bq[k4] = *(const f32x4*)(src + 4); }
#pragma unroll
        for (int k4 = 0; k4 < 4; ++k4) { const int i = (tid >> 4) + 32 * k4; float v[8] = {a[k4][0], a[k4][1], a[k4][2], a[k4][3], bq[k4][0], bq[k4][1], bq[k4][2], bq[k4][3]};
#pragma unroll
            for (int k = 0; k < 8; ++k) v[k] = (c8 + k <= i) ? v[k] : 0.f;
            v4u o; o.x = pk2(v[0], v[1]); o.y = pk2(v[2], v[3]); o.z = pk2(v[4], v[5]); o.w = pk2(v[6], v[7]); *(LAS v4u*)(Al + i * AP + c8 * 2) = o; } }
    {   const int c8 = (tid & 15) * 8; v4u w[4];
#pragma unroll
        for (int k4 = 0; k4 < 4; ++k4) { const int j = (tid >> 4) + 32 * k4; w[k4] = *(const v4u*)(Y + (t0 + j) * YP + Y_CV + g * 128 + c8); }
        const f32x4 g0 = *(const f32x4*)(lng + g * 128 + c8), g1 = *(const f32x4*)(lng + g * 128 + c8 + 4), b0 = *(const f32x4*)(lnb + g * 128 + c8), b1 = *(const f32x4*)(lnb + g * 128 + c8 + 4);
        const float gg[8] = {g0[0], g0[1], g0[2], g0[3], g1[0], g1[1], g1[2], g1[3]}, bb[8] = {b0[0], b0[1], b0[2], b0[3], b1[0], b1[1], b1[2], b1[3]};
        __syncthreads();
#pragma unroll
        for (int k4 = 0; k4 < 4; ++k4) { const int j = (tid >> 4) + 32 * k4; float x[8]; unpack8(w[k4], x); const float mu = st[2 * j], rs = st[2 * j + 1];
#pragma unroll
            for (int k = 0; k < 8; ++k) x[k] = (fgelu(x[k]) - mu) * rs * gg[k] + bb[k];
            v4u o; o.x = pk2(x[0], x[1]); o.y = pk2(x[2], x[3]); o.z = pk2(x[4], x[5]); o.w = pk2(x[6], x[7]); *(LAS v4u*)(Vl + j * VP + c8 * 2) = o; } }
    __syncthreads();
    f32x4 acc[8];
#pragma unroll
    for (int n = 0; n < 8; ++n) acc[n] = (f32x4){0.f, 0.f, 0.f, 0.f};
    const int nks = (16 * wave + 15) / 32 + 1;
    for (int ks = 0; ks < nks; ++ks) { const bf16x8 a = frag(Al, AP, 16 * wave + fr, 32 * ks, fq);
#pragma unroll
        for (int n = 0; n < 8; ++n) acc[n] = mfma16(trfrag(Vl, VP, 16 * n, 32 * ks, lane), a, acc[n]); }
    const int i = 16 * wave + fr; const float bsi = bs[i]; const size_t t = t0 + i;
#pragma unroll
    for (int n = 0; n < 8; ++n) { const int c = 16 * n + 4 * fq; const v2u w = *(const v2u*)(Y + t * YP + Y_CU + g * 128 + c);
        const float o0 = fgelu(bflo(w.x)) * (acc[n][0] + bsi), o1 = fgelu(bfhi(w.x)) * (acc[n][1] + bsi), o2 = fgelu(bflo(w.y)) * (acc[n][2] + bsi), o3 = fgelu(bfhi(w.y)) * (acc[n][3] + bsi);
        v2u o; o.x = pk2(o0, o1); o.y = pk2(o2, o3); *(v2u*)(YM + t * 2048 + YM_C + g * 128 + c) = o; }
    __syncthreads();
}

__device__ __forceinline__ void gla_decay(Ctx& C, int l, int h, size_t t0, LAS float* Bl, LAS float* tmp  ) {
    const int tid = C.tid; const float* YSM = WSP(float, WS_YSM); const float* wa2 = C.in[3] + l * 16 * 256 + h * 64; const float* ba = C.in[4] + l * 256 + h * 64;
    { const int j = tid >> 3, d0 = (tid & 7) * 8; float a[16];
#pragma unroll
        for (int r4 = 0; r4 < 4; ++r4) { const f32x4 v = *(const f32x4*)(YSM + (t0 + j) * 32 + 4 * r4); a[4 * r4] = v[0]; a[4 * r4 + 1] = v[1]; a[4 * r4 + 2] = v[2]; a[4 * r4 + 3] = v[3]; }
#pragma unroll
        for (int k = 0; k < 8; ++k) { float s = ba[d0 + k];
#pragma unroll
            for (int r = 0; r < 16; ++r) s += a[r] * wa2[r * 256 + d0 + k];
            Bl[j * 65 + d0 + k] = flogsigmoid(s) * (1.f / 16.f); } }
    __syncthreads();
    { const int d = tid & 63, sg = tid >> 6; float run = 0.f;
#pragma unroll
        for (int k = 0; k < 8; ++k) { run += Bl[(8 * sg + k) * 65 + d]; Bl[(8 * sg + k) * 65 + d] = run; }
        tmp[sg * 64 + d] = run;
        __syncthreads();
        float off = 0.f;
        for (int s2 = 0; s2 < sg; ++s2) off += tmp[s2 * 64 + d];
#pragma unroll
        for (int k = 0; k < 8; ++k) Bl[(8 * sg + k) * 65 + d] += off; }
    __syncthreads();
}
__device__ __forceinline__ void gla_local_unit(Ctx& C, int l, int u) {
    const int tid = C.tid, lane = C.lane, wave = C.wave, fr = lane & 15, fq = lane >> 4;
    const int n = u & 31, h = (u >> 5) & 3, b = u >> 7; const size_t t0 = (size_t)b * SEQ_ + n * 64;
    const bf16* Y = WSP(bf16, WS_Y);
    constexpr int KP = 160, VP = 288;
    LAS float* Bl = (LAS float*)C.lds; LAS float* tmp = Bl + 64 * 65; ldsp Kl = (ldsp)(tmp + 512), Vl = Kl + 64 * KP;
    gla_decay(C, l, h, t0, Bl, tmp);
    {   const int j = tid >> 3, d0 = (tid & 7) * 8, e0 = (tid & 15) * 8;
        const v4u kw = *(const v4u*)(Y + (t0 + j) * YP + Y_AK + h * 64 + d0); v4u vw[2];
#pragma unroll
        for (int i = 0; i < 2; ++i) vw[i] = *(const v4u*)(Y + (t0 + (tid >> 4) + 32 * i) * YP + Y_AV + h * 128 + e0);
        float x[8]; unpack8(kw, x);
#pragma unroll
        for (int k = 0; k < 8; ++k) x[k] = x[k] * __expf(Bl[63 * 65 + d0 + k] - Bl[j * 65 + d0 + k]);
        v4u o; o.x = pk2(x[0], x[1]); o.y = pk2(x[2], x[3]); o.z = pk2(x[4], x[5]); o.w = pk2(x[6], x[7]); *(LAS v4u*)(Kl + j * KP + d0 * 2) = o;
#pragma unroll
        for (int i = 0; i < 2; ++i) *(LAS v4u*)(Vl + ((tid >> 4) + 32 * i) * VP + e0 * 2) = vw[i];
    }
    __syncthreads();
    float* LOC = WSP(float, WS_GLOC) + (size_t)u * 64 * 128; float* DEC = WSP(float, WS_GDEC) + (size_t)u * 64;
    if (tid < 64) DEC[tid] = __expf(Bl[63 * 65 + tid]);
#pragma unroll
    for (int mt = 0; mt < 4; ++mt) { f32x4 acc = (f32x4){0.f, 0.f, 0.f, 0.f};
#pragma unroll
        for (int ks = 0; ks < 2; ++ks) acc = mfma16(trfrag2(Vl, VP, 16 * wave, 32 * ks, 32 * ks + 16, lane), trfrag2(Kl, KP, 16 * mt, 32 * ks, 32 * ks + 16, lane), acc);
        *(f32x4*)(LOC + (size_t)(16 * mt + fr) * 128 + 16 * wave + 4 * fq) = acc; }
    __syncthreads();
}
__device__ __forceinline__ void gla_scan(Ctx& C) {
    const float* LOC = WSP(float, WS_GLOC); const float* DEC = WSP(float, WS_GDEC); bf16* ST = WSP(bf16, WS_GST);
    for (int i = C.bid * 512 + C.tid; i < 16 * 8192; i += C.G * 512) { const int bh = i >> 13, de = i & 8191, d = de >> 7; float S = 0.f;
        float lc[32], dc[32];
#pragma unroll
        for (int n = 0; n < 32; ++n) { const size_t uu = (size_t)bh * 32 + n; lc[n] = LOC[uu * 8192 + de]; dc[n] = DEC[uu * 64 + d]; }
#pragma unroll
        for (int n = 0; n < 32; ++n) { const size_t uu = (size_t)bh * 32 + n; ST[uu * 8192 + de] = bf1(S); S = dc[n] * S + lc[n]; } }
}
__device__ __forceinline__ void gla_out_unit(Ctx& C, int l, int u, bf16* YM) {
    const int tid = C.tid, lane = C.lane, wave = C.wave, fr = lane & 15, fq = lane >> 4;
    const int n = u & 31, h = (u >> 5) & 3, b = u >> 7; const size_t t0 = (size_t)b * SEQ_ + n * 64;
    const bf16* Y = WSP(bf16, WS_Y); const bf16* ST = WSP(bf16, WS_GST) + (size_t)u * 8192;
    constexpr int QP = 144, VP = 288;
    LAS float* Bl = (LAS float*)C.lds; LAS float* tmp = Bl + 64 * 65; ldsp Ql = (ldsp)(tmp + 512), Kl = Ql + 64 * QP, Vl = Kl + 64 * QP, Sl = Vl + 64 * VP; LAS float* ssq = (LAS float*)(Sl + 64 * VP);
    gla_decay(C, l, h, t0, Bl, tmp);
    {   const int j = tid >> 3, d0 = (tid & 7) * 8, e0 = (tid & 15) * 8, j2 = tid >> 4;
        const v4u qw = *(const v4u*)(Y + (t0 + j) * YP + Y_AQ + h * 64 + d0), kw = *(const v4u*)(Y + (t0 + j) * YP + Y_AK + h * 64 + d0); v4u vw[2], sw[2];
#pragma unroll
        for (int i = 0; i < 2; ++i) { vw[i] = *(const v4u*)(Y + (t0 + j2 + 32 * i) * YP + Y_AV + h * 128 + e0); sw[i] = *(const v4u*)(ST + (j2 + 32 * i) * 128 + e0); }
        float xq[8], xk[8]; unpack8(qw, xq); unpack8(kw, xk);
#pragma unroll
        for (int k = 0; k < 8; ++k) { const float bb = Bl[j * 65 + d0 + k]; xq[k] = xq[k] * 0.125f * __expf(bb); xk[k] = xk[k] * __expf(-bb); }
        v4u o; o.x = pk2(xq[0], xq[1]); o.y = pk2(xq[2], xq[3]); o.z = pk2(xq[4], xq[5]); o.w = pk2(xq[6], xq[7]); *(LAS v4u*)(Ql + j * QP + d0 * 2) = o;
        o.x = pk2(xk[0], xk[1]); o.y = pk2(xk[2], xk[3]); o.z = pk2(xk[4], xk[5]); o.w = pk2(xk[6], xk[7]); *(LAS v4u*)(Kl + j * QP + d0 * 2) = o;
#pragma unroll
        for (int i = 0; i < 2; ++i) { *(LAS v4u*)(Vl + (j2 + 32 * i) * VP + e0 * 2) = vw[i]; *(LAS v4u*)(Sl + (j2 + 32 * i) * VP + e0 * 2) = sw[i]; }
    }
    __syncthreads();
    const int mt = wave & 3, nh = wave >> 2;
    const bf16x8 qa0 = frag(Ql, QP, 16 * mt + fr, 0, fq), qa1 = frag(Ql, QP, 16 * mt + fr, 32, fq);
    f32x4 att[4];
#pragma unroll
    for (int t = 0; t < 4; ++t) { att[t] = (f32x4){0.f, 0.f, 0.f, 0.f}; att[t] = mfma16(frag(Kl, QP, 16 * t + fr, 0, fq), qa0, att[t]); att[t] = mfma16(frag(Kl, QP, 16 * t + fr, 32, fq), qa1, att[t]);
#pragma unroll
        for (int e = 0; e < 4; ++e) att[t][e] = (16 * t + 4 * fq + e <= 16 * mt + fr) ? att[t][e] : 0.f; }
    const bf16x8 p0 = pfrag(att[0], att[1]), p1 = pfrag(att[2], att[3]);
    f32x4 o[4];
#pragma unroll
    for (int nt = 0; nt < 4; ++nt) { const int ec = 64 * nh + 16 * nt; f32x4 a = (f32x4){0.f, 0.f, 0.f, 0.f};
        a = mfma16(trfrag2(Vl, VP, ec, 0, 16, lane), p0, a); a = mfma16(trfrag2(Vl, VP, ec, 32, 48, lane), p1, a);
        a = mfma16(trfrag(Sl, VP, ec, 0, lane), qa0, a); a = mfma16(trfrag(Sl, VP, ec, 32, lane), qa1, a); o[nt] = a; }
    float sq = 0.f;
#pragma unroll
    for (int nt = 0; nt < 4; ++nt) sq += (o[nt][0] * o[nt][0] + o[nt][1] * o[nt][1]) + (o[nt][2] * o[nt][2] + o[nt][3] * o[nt][3]);
    sq += __shfl_xor(sq, 16); sq += __shfl_xor(sq, 32);
    const int i = 16 * mt + fr;
    if (fq == 0) ssq[2 * i + nh] = sq;
    __syncthreads();
    const float rs = 1.f / sqrtf((ssq[2 * i] + ssq[2 * i + 1]) * (1.f / 128.f) + LN_EPS_);
    const float* ng = C.in[5] + l * 512 + h * 128; const size_t t = t0 + i;
#pragma unroll
    for (int nt = 0; nt < 4; ++nt) { const int e = 64 * nh + 16 * nt + 4 * fq; const f32x4 gv = *(const f32x4*)(ng + e); const v2u rw = *(const v2u*)(Y + t * YP + Y_AR + h * 128 + e);
        const float r0 = bflo(rw.x), r1 = bfhi(rw.x), r2 = bflo(rw.y), r3 = bfhi(rw.y);
        v2u w; w.x = pk2(o[nt][0] * rs * gv[0] * r0 * fsigmoid(r0), o[nt][1] * rs * gv[1] * r1 * fsigmoid(r1)); w.y = pk2(o[nt][2] * rs * gv[2] * r2 * fsigmoid(r2), o[nt][3] * rs * gv[3] * r3 * fsigmoid(r3));
        *(v2u*)(YM + t * 2048 + YM_A + h * 128 + e) = w; }
    __syncthreads();
}

__device__ __forceinline__ void ml_prep(Ctx& C, int l, int h, int b, int n, LAS float* gl, ldsp Ql, ldsp Kl, int QP, bool need_q) {
    const int tid = C.tid, lane = C.lane; const size_t t0 = (size_t)b * SEQ_ + n * 64;
    const bf16* Y = WSP(bf16, WS_Y); const float* YSM = WSP(float, WS_YSM);
    if (tid < 64) { const float lf = flogsigmoid(YSM[(t0 + lane) * 32 + 20 + h] + C.in[9][l * 4 + h]); float run = lf;
#pragma unroll
        for (int o = 1; o < 64; o <<= 1) { const float v = __shfl_up(run, o); if (lane >= o) run += v; }
        gl[lane] = run; gl[64 + lane] = YSM[(t0 + lane) * 32 + 16 + h] + C.in[8][l * 4 + h]; }
    const float* cw = C.in[6] + l * 4096; const float* cb = C.in[7] + l * 1024;
    {   const int c0 = (tid & 15) * 8, j0 = tid >> 4;
#pragma unroll
        for (int qk = 0; qk < 2; ++qk) { if (qk == 0 && !need_q) continue;
            const int cc = (qk == 0 ? 0 : 512) + h * 128 + c0, ycol = (qk == 0 ? Y_DQ : Y_DK) + h * 128 + c0;
            v4u xw[2][4]; f32x4 w4[4][2], b4[2];
#pragma unroll
            for (int i = 0; i < 2; ++i)
#pragma unroll
                for (int jj = 0; jj < 4; ++jj) { const int j = j0 + 32 * i, rel = j - 3 + jj, ok = (n * 64 + rel) >= 0; xw[i][jj] = *(const v4u*)(Y + (t0 + (ok ? rel : j)) * YP + ycol); }
#pragma unroll
            for (int jj = 0; jj < 4; ++jj) { w4[jj][0] = *(const f32x4*)(cw + jj * 1024 + cc); w4[jj][1] = *(const f32x4*)(cw + jj * 1024 + cc + 4); }
            b4[0] = *(const f32x4*)(cb + cc); b4[1] = *(const f32x4*)(cb + cc + 4);
#pragma unroll
            for (int i = 0; i < 2; ++i) { const int j = j0 + 32 * i; float a[8] = {b4[0][0], b4[0][1], b4[0][2], b4[0][3], b4[1][0], b4[1][1], b4[1][2], b4[1][3]};
#pragma unroll
                for (int jj = 0; jj < 4; ++jj) { const float mk = (n * 64 + j - 3 + jj) >= 0 ? 1.f : 0.f; float x[8]; unpack8(xw[i][jj], x);
#pragma unroll
                    for (int k = 0; k < 8; ++k) a[k] += (w4[jj][k >> 2][k & 3] * mk) * x[k]; }
                const float sc = qk == 0 ? 1.f : 0.08838834764831845f;
#pragma unroll
                for (int k = 0; k < 8; ++k) a[k] = a[k] * fsigmoid(a[k]) * sc;
                v4u o; o.x = pk2(a[0], a[1]); o.y = pk2(a[2], a[3]); o.z = pk2(a[4], a[5]); o.w = pk2(a[6], a[7]); *(LAS v4u*)((qk == 0 ? Ql : Kl) + j * QP + c0 * 2) = o; } }
    }
    __syncthreads();
}
__device__ __forceinline__ void ml_local_unit(Ctx& C, int l, int u) {
    const int tid = C.tid, lane = C.lane, wave = C.wave, fr = lane & 15, fq = lane >> 4;
    const int n = u & 31, h = (u >> 5) & 3, b = u >> 7; const size_t t0 = (size_t)b * SEQ_ + n * 64;
    const bf16* Y = WSP(bf16, WS_Y);
    constexpr int KP = 288, TP = 288;
    LAS float* gl = (LAS float*)C.lds; LAS float* wk = gl + 128; LAS float* red = wk + 64;
    ldsp Kl = (ldsp)(red + 512), Vl = Kl + 64 * KP;
    ml_prep(C, l, h, b, n, gl, Kl, Kl, KP, false);
    if (tid < 64) { const float bl = gl[63], dec = bl - gl[lane] + gl[64 + lane], a = wave_max(dec); wk[lane] = __expf(dec - a);
        if (lane == 0) { float* SC = WSP(float, WS_MSC) + (size_t)u * 2; SC[0] = bl; SC[1] = a; } }
    __syncthreads();
    { const int d = tid & 127, sg = tid >> 7; float s = 0.f;
        for (int j = 16 * sg; j < 16 * sg + 16; ++j) s += wk[j] * bflo((unsigned)*(const LAS unsigned short*)(Kl + j * KP + d * 2));
        red[sg * 128 + d] = s; }
    {   const int c0 = (tid & 15) * 8, j0 = tid >> 4; v4u vw[2];
#pragma unroll
        for (int i = 0; i < 2; ++i) vw[i] = *(const v4u*)(Y + (t0 + j0 + 32 * i) * YP + Y_DV + h * 128 + c0);
#pragma unroll
        for (int i = 0; i < 2; ++i) *(LAS v4u*)(Vl + (j0 + 32 * i) * TP + c0 * 2) = vw[i];
    }
    __syncthreads();
    {   const int c0 = (tid & 15) * 8, j0 = tid >> 4;
#pragma unroll
        for (int i = 0; i < 2; ++i) { const int j = j0 + 32 * i; float x[8]; unpack8(*(const LAS v4u*)(Kl + j * KP + c0 * 2), x); const float w = wk[j];
            v4u o; o.x = pk2(x[0] * w, x[1] * w); o.y = pk2(x[2] * w, x[3] * w); o.z = pk2(x[4] * w, x[5] * w); o.w = pk2(x[6] * w, x[7] * w); *(LAS v4u*)(Kl + j * KP + c0 * 2) = o; }
    }
    if (tid < 128) WSP(float, WS_MNLOC)[(size_t)u * 128 + tid] = (red[tid] + red[128 + tid]) + (red[256 + tid] + red[384 + tid]);
    __syncthreads();
    float* LOC = WSP(float, WS_MLOC) + (size_t)u * 16384;
#pragma unroll
    for (int mt = 0; mt < 8; ++mt) { f32x4 acc = (f32x4){0.f, 0.f, 0.f, 0.f};
#pragma unroll
        for (int ks = 0; ks < 2; ++ks) acc = mfma16(trfrag2(Vl, TP, 16 * wave, 32 * ks, 32 * ks + 16, lane), trfrag2(Kl, KP, 16 * mt, 32 * ks, 32 * ks + 16, lane), acc);
        *(f32x4*)(LOC + (size_t)(16 * mt + fr) * 128 + 16 * wave + 4 * fq) = acc; }
    __syncthreads();
}
__device__ __forceinline__ void ml_scan(Ctx& C) {
    const float* LOC = WSP(float, WS_MLOC); const float* NL = WSP(float, WS_MNLOC); const float* SC = WSP(float, WS_MSC);
    bf16* MC = WSP(bf16, WS_MC); float* MN = WSP(float, WS_MN); float* MM = WSP(float, WS_MM);
    for (int i = C.bid * 512 + C.tid; i < 16 * (16384 + 128); i += C.G * 512) { const int bh = i / (16384 + 128), r = i % (16384 + 128); float S = 0.f, m = 0.f;
        float lc[32], bl_[32], a_[32];
#pragma unroll
        for (int n = 0; n < 32; ++n) { const size_t uu = (size_t)bh * 32 + n; lc[n] = r < 16384 ? LOC[uu * 16384 + r] : NL[uu * 128 + (r - 16384)]; bl_[n] = SC[uu * 2]; a_[n] = SC[uu * 2 + 1]; }
#pragma unroll
        for (int n = 0; n < 32; ++n) { const size_t uu = (size_t)bh * 32 + n; const float bl = bl_[n], a = a_[n], mn = fmaxf(bl + m, a), keep = __expf(bl + m - mn), sc = __expf(a - mn);
            if (r < 16384) MC[uu * 16384 + r] = bf1(S);
            else { const int d = r - 16384; MN[uu * 128 + d] = S; if (d == 0) MM[uu] = m; }
            S = keep * S + sc * lc[n]; m = mn; } }
}
__device__ __forceinline__ void ml_out_unit(Ctx& C, int l, int u, bf16* YM) {
    const int tid = C.tid, lane = C.lane, wave = C.wave, fr = lane & 15, fq = lane >> 4;
    const int n = u & 31, h = (u >> 5) & 3, b = u >> 7; const size_t t0 = (size_t)b * SEQ_ + n * 64;
    const bf16* Y = WSP(bf16, WS_Y); const bf16* MC = WSP(bf16, WS_MC) + (size_t)u * 16384; const float* MN = WSP(float, WS_MN) + (size_t)u * 128; const float m0 = WSP(float, WS_MM)[u];
    constexpr int QP = 272, TP = 288;
    LAS float* gl = (LAS float*)C.lds; LAS float* mt_ = gl + 128; LAS float* wst = mt_ + 64; LAS float* qn = wst + 64; LAS float* ssq = qn + 64;
    ldsp Ql = (ldsp)(ssq + 128), Kl = Ql + 64 * QP, Vl = Kl + 64 * QP, Cl = Vl + 64 * TP;
    ml_prep(C, l, h, b, n, gl, Ql, Kl, QP, true);
    if (tid < 64) { float pm = gl[64 + lane] - gl[lane];
#pragma unroll
        for (int o = 1; o < 64; o <<= 1) { const float v = __shfl_up(pm, o); if (lane >= o) pm = fmaxf(pm, v); }
        const float mt = gl[lane] + fmaxf(m0, pm); mt_[lane] = mt; wst[lane] = __expf(gl[lane] + m0 - mt); }
    {   const int c0 = (tid & 15) * 8, j0 = tid >> 4; v4u vw[2], cw4[4];
#pragma unroll
        for (int i = 0; i < 2; ++i) vw[i] = *(const v4u*)(Y + (t0 + j0 + 32 * i) * YP + Y_DV + h * 128 + c0);
#pragma unroll
        for (int i = 0; i < 4; ++i) cw4[i] = *(const v4u*)(MC + (j0 + 32 * i) * 128 + c0);
#pragma unroll
        for (int i = 0; i < 2; ++i) *(LAS v4u*)(Vl + (j0 + 32 * i) * TP + c0 * 2) = vw[i];
#pragma unroll
        for (int i = 0; i < 4; ++i) *(LAS v4u*)(Cl + (j0 + 32 * i) * TP + c0 * 2) = cw4[i];
    }
    { const int i = tid >> 3, d0 = (tid & 7) * 16; float s = 0.f;
#pragma unroll
        for (int k2 = 0; k2 < 2; ++k2) { float x[8]; unpack8(*(const LAS v4u*)(Ql + i * QP + (d0 + 8 * k2) * 2), x);
#pragma unroll
            for (int k = 0; k < 8; ++k) s += x[k] * MN[d0 + 8 * k2 + k]; }
        s += __shfl_xor(s, 1); s += __shfl_xor(s, 2); s += __shfl_xor(s, 4);
        if ((tid & 7) == 0) qn[i] = s; }
    __syncthreads();
    const int mt = wave & 3, nh = wave >> 2, i = 16 * mt + fr;
    bf16x8 qa[4];
#pragma unroll
    for (int ks = 0; ks < 4; ++ks) qa[ks] = frag(Ql, QP, i, 32 * ks, fq);
    const float bi_ = gl[i], mti = mt_[i], wsti = wst[i];
    f32x4 sc[4]; float rsum = 0.f;
#pragma unroll
    for (int t = 0; t < 4; ++t) { sc[t] = (f32x4){0.f, 0.f, 0.f, 0.f};
#pragma unroll
        for (int ks = 0; ks < 4; ++ks) sc[t] = mfma16(frag(Kl, QP, 16 * t + fr, 32 * ks, fq), qa[ks], sc[t]);
#pragma unroll
        for (int e = 0; e < 4; ++e) { const int j = 16 * t + 4 * fq + e; const float w = (j <= i) ? __expf(bi_ - gl[j] + gl[64 + j] - mti) : 0.f; sc[t][e] *= w; rsum += sc[t][e]; } }
    rsum += __shfl_xor(rsum, 16); rsum += __shfl_xor(rsum, 32);
    const float den = rsum + wsti * qn[i], rden = 1.f / fmaxf(fabsf(den), __expf(-mti));
    const bf16x8 p0 = pfrag(sc[0], sc[1]), p1 = pfrag(sc[2], sc[3]);
    f32x4 o[4]; float sq = 0.f;
    const size_t t = t0 + i;
#pragma unroll
    for (int nt = 0; nt < 4; ++nt) { const int ec = 64 * nh + 16 * nt; f32x4 a1 = (f32x4){0.f, 0.f, 0.f, 0.f}, a2 = a1;
        a1 = mfma16(trfrag2(Vl, TP, ec, 0, 16, lane), p0, a1); a1 = mfma16(trfrag2(Vl, TP, ec, 32, 48, lane), p1, a1);
#pragma unroll
        for (int ks = 0; ks < 4; ++ks) a2 = mfma16(trfrag(Cl, TP, ec, 32 * ks, lane), qa[ks], a2);
        const v2u ow = *(const v2u*)(Y + t * YP + Y_DO + h * 128 + 64 * nh + 16 * nt + 4 * fq);
        f32x4 hv = (a1 + a2 * wsti) * rden; hv[0] *= fsigmoid(bflo(ow.x)); hv[1] *= fsigmoid(bfhi(ow.x)); hv[2] *= fsigmoid(bflo(ow.y)); hv[3] *= fsigmoid(bfhi(ow.y));
        o[nt] = hv; sq += (hv[0] * hv[0] + hv[1] * hv[1]) + (hv[2] * hv[2] + hv[3] * hv[3]); }
    sq += __shfl_xor(sq, 16); sq += __shfl_xor(sq, 32);
    if (fq == 0) ssq[2 * i + nh] = sq;
    __syncthreads();
    const float rs = 1.f / sqrtf((ssq[2 * i] + ssq[2 * i + 1]) * (1.f / 128.f) + LN_EPS_);
    const float* ng = C.in[10] + l * 512 + h * 128;
#pragma unroll
    for (int nt = 0; nt < 4; ++nt) { const int e = 64 * nh + 16 * nt + 4 * fq; const f32x4 gv = *(const f32x4*)(ng + e);
        v2u w; w.x = pk2(o[nt][0] * rs * gv[0], o[nt][1] * rs * gv[1]); w.y = pk2(o[nt][2] * rs * gv[2], o[nt][3] * rs * gv[3]);
        *(v2u*)(YM + t * 2048 + YM_D + h * 128 + e) = w; }
    __syncthreads();
}

#ifndef MIXREP
#define MIXREP 0
#endif
#define RELAUNDER(C) do { int zv_ = 0; asm volatile("" : "+v"(zv_)); unsigned long long zw_ = (unsigned long long)(C).ws; asm volatile("" : "+s"(zw_)); (C).ws = (unsigned char*)(GAS unsigned char*)zw_;     \
    (C).tid = (int)threadIdx.x + zv_; (C).lane = (C).tid & 63; (C).wave = __builtin_amdgcn_readfirstlane((C).tid >> 6); } while (0)
__device__ __forceinline__ void phase_mix_a(Ctx& C, int l, bf16* YM) {
    const bool std_grid = C.G == 256;
    if (std_grid) {
        const int nd = C.bid < 128 ? 2 : 4, d0 = C.bid < 128 ? C.bid : 256 + (C.bid - 128);
        for (int k = 0; k < nd; ++k) { RELAUNDER(C); const int u = d0 + 128 * k; dil_unit(C, u); if (MIXREP & 1) dil_unit(C, u); }
    } else for (int u = C.bid; u < 768; u += C.G) { RELAUNDER(C); dil_unit(C, u); }
    for (int u = C.bid; u < 384; u += C.G) { RELAUNDER(C); sgu_unit(C, l, u, YM); if (MIXREP & 2) sgu_unit(C, l, u, YM); }
    for (int u = C.bid; u < 512; u += C.G) { RELAUNDER(C); gla_local_unit(C, l, u); if (MIXREP & 4) gla_local_unit(C, l, u); }
    for (int u = C.bid; u < 512; u += C.G) { RELAUNDER(C); ml_local_unit(C, l, u); if (MIXREP & 8) ml_local_unit(C, l, u); }
}
__device__ __forceinline__ void phase_mix_b(Ctx& C, bf16* YM) { gla_scan(C); ml_scan(C); dil_merge(C, YM); }
__device__ __forceinline__ void phase_mix_c(Ctx& C, int l, bf16* YM) {
    for (int u = C.bid; u < 1024; u += C.G) { RELAUNDER(C); if (u < 512) { gla_out_unit(C, l, u, YM); if (MIXREP & 16) gla_out_unit(C, l, u, YM); } else { ml_out_unit(C, l, u - 512, YM); if (MIXREP & 32) ml_out_unit(C, l, u - 512, YM); } }
}
#ifndef EARLY_WIN
#define EARLY_WIN 0
#endif
#ifndef STEAL_ON
#define STEAL_ON 0
#endif
#ifndef Y_WGM
#define Y_WGM 8
#endif
#ifndef NCONV
#define NCONV 72
#endif
#ifndef REPEAT_MASK
#define REPEAT_MASK 0
#endif
#define REP(k) (((REPEAT_MASK) >> (k)) & 1)
#define RELAUNDER_T(C) do { int zv_ = 0; asm volatile("" : "+v"(zv_)); (C).tid = (int)threadIdx.x + zv_; (C).lane = (C).tid & 63; (C).wave = __builtin_amdgcn_readfirstlane((C).tid >> 6); } while (0)
#define IN(k) (lo <= (k) && (k) < hi)
#define SEAM(k) do { if (IN(k) && IN((k) + 1)) xcd_barrier(bar); } while (0)
#define STEAL(k) do { if (STEAL_ON && FP8_LAST && l + 2 == NL_ && IN(k) && IN((k) + 1)) { unsigned* arr_ = WSP(unsigned, WS_CTL) + CW_ARR + 64 * (k); __syncthreads(); if (C.tid == 0) atomicAdd(arr_, 1u); \
        phase_convert(C, l + 1, 1, C.bid, C.G, arr_); } } while (0)
template <int l>
__device__ __forceinline__ void layer_program(Ctx& C, const XcdBarrier& bar, const int lo, const int hi) {
    constexpr int p0 = l * 12;
    const float* Xin = l == 0 ? C.in[0] : WSP(float, WS_XA);
    if (l == 0) { if (IN(p0 + 0)) for (int rep_ = 0; rep_ < 1 + REP(0); ++rep_) { RELAUNDER_T(C); phase_convert(C, l, 0, C.bid, C.G); }
        SEAM(p0 + 0); }
    if (IN(p0 + 1)) for (int rep_ = 0; rep_ < 1 + REP(1); ++rep_) { RELAUNDER_T(C);
        if (C.bid < NCONV) phase_convert(C, l, 1, C.bid, NCONV);
        else {
        if constexpr (GATES8(l)) {
            { pg8::Gemm g{WSP(bf16, WS_XB), WSP(bf16, WS_WIN), T_, 7680, 2048, 2048, 2048, nullptr}; pg8::StaticOrder S; S.init(T_, 7680, C.G - NCONV, C.bid - NCONV, Y_WGM);
              EpiY E{WSP(bf16, WS_Y), WSP(float, WS_YSM), 0}; pg8::gemm_phase<EpiY, pg8::StaticOrder, true>(C.lds, g, S, E, C.tid); }
            { pg8::Gemm g{WSP(bf16, WS_XB8), WSP(bf16, WS_WIN8), T_, 8192, 1024, 1024, 1024, nullptr}; pg8::StaticOrder S; S.init(T_, 8192, C.G - NCONV, C.bid - NCONV, Y_WGM);
              EpiY E{WSP(bf16, WS_Y), WSP(float, WS_YSM), 30}; pg8::gemm_phase<EpiY, pg8::StaticOrder, true, false, 2, 1>(C.lds, g, S, E, C.tid); }
        } else {
        pg8::Gemm g{WSP(bf16, WS_XB), WSP(bf16, WS_WIN), T_, YP, 2048, 2048, 2048, nullptr}; pg8::StaticOrder S; S.init(T_, YP, C.G - NCONV, C.bid - NCONV, Y_WGM);
        EpiY E{WSP(bf16, WS_Y), WSP(float, WS_YSM), 0};
        pg8::gemm_phase<EpiY, pg8::StaticOrder, true>(C.lds, g, S, E, C.tid); }
        phase_convert(C, l, 1, C.bid, NCONV); }
    }
    SEAM(p0 + 1);
    bf16* YMo = WSP(bf16, MK_MODE == 1 ? WS_MRG : WS_YM);
    if (IN(p0 + 2)) for (int rep_ = 0; rep_ < 1 + REP(2); ++rep_) { RELAUNDER_T(C); phase_mix_a(C, l, YMo); }
    SEAM(p0 + 2);
    if (IN(p0 + 3)) for (int rep_ = 0; rep_ < 1 + REP(3); ++rep_) { RELAUNDER_T(C); phase_mix_b(C, YMo); }
    SEAM(p0 + 3);
    if (IN(p0 + 4)) for (int rep_ = 0; rep_ < 1 + REP(4); ++rep_) { RELAUNDER_T(C); phase_mix_c(C, l, YMo); }
    SEAM(p0 + 4);
    if (IN(p0 + 5)) for (int rep_ = 0; rep_ < 1 + REP(5); ++rep_) { RELAUNDER_T(C);
        pg8::StaticOrder S; S.init(T_, 4096, C.G, C.bid);
        pg8::Gemm g{WSP(bf16, WS_YM), WSP(bf16, WS_WP), T_, 2048, 2048, 2048, 2048, nullptr}; EpiMerge E; E.Y = WSP(bf16, WS_Y); E.MB = WSP(bf16, WS_MB);
        if (MERGE3) pg8::gemm_phase_n1s3<EpiMerge, pg8::StaticOrder>(C.lds, g, S, E, C.tid); else pg8::gemm_phase<EpiMerge, pg8::StaticOrder, true, false, 1>(C.lds, g, S, E, C.tid);
    }
    SEAM(p0 + 5);
    if (IN(p0 + 6)) for (int rep_ = 0; rep_ < 1 + REP(6); ++rep_) { RELAUNDER_T(C);
        pg8::Gemm g{WSP(bf16, WS_MB), WSP(bf16, WS_WOUT), T_, 2048, 2048, 2048, 2048, nullptr}; pg8::StaticOrder S; S.init(T_, 2048, C.G, C.bid);
        EpiOut E{Xin, WSP(float, WS_HB)};
        pg8::gemm_phase<EpiOut, pg8::StaticOrder, true>(C.lds, g, S, E, C.tid);
    }
    SEAM(p0 + 6);
    if (IN(p0 + 7)) for (int rep_ = 0; rep_ < 1 + REP(7); ++rep_) { RELAUNDER_T(C); phase_ln1_router(C, l); }
    SEAM(p0 + 7);
    if (IN(p0 + 8)) for (int rep_ = 0; rep_ < 1 + REP(8); ++rep_) { RELAUNDER_T(C); phase_scatter(C, l); }
    SEAM(p0 + 8);
    if (IN(p0 + 9)) for (int rep_ = 0; rep_ < 1 + REP(9); ++rep_) { RELAUNDER_T(C);
        MoeOrder S; S.init(WSP(int, WS_CTL) + CW_TST + l * 128, 4, C.G, C.bid, C.lane);
        if constexpr (MOE8(l)) {
            pg8::Gemm g{WSP(bf16, WS_XS8), WSP(bf16, l == NL_ - 1 ? WS_W13B : WS_W13), MAXROWS, 65 * 1024, 1024, 1024, 1024, WSP(int, WS_ROWMAP)};
            EpiMoe1F8 E{WSP(unsigned char, WS_H), WSP(float, WS_ROWW)};
            pg8::gemm_phase<EpiMoe1F8, MoeOrder, true, true, 2, 1>(C.lds, g, S, E, C.tid);
        } else {
            pg8::Gemm g{WSP(bf16, WS_XS), WSP(bf16, WS_W13), MAXROWS, 65 * 1024, 2048, 2048, 2048, WSP(int, WS_ROWMAP)};
            EpiMoe1 E{WSP(bf16, WS_H), WSP(float, WS_ROWW), 4};
            pg8::gemm_phase<EpiMoe1, MoeOrder, true, true>(C.lds, g, S, E, C.tid);
        }
    }
    if (STEAL_ON & 1) STEAL(p0 + 9);
    SEAM(p0 + 9);
    if (IN(p0 + 10)) for (int rep_ = 0; rep_ < 1 + REP(10); ++rep_) { RELAUNDER_T(C);
        MoeOrder S; S.init(WSP(int, WS_CTL) + CW_TST + l * 128, 8, C.G, C.bid, C.lane);
        EpiMoe2 E{WSP(bf16, WS_YBUF)};
        if constexpr (MOE8(l)) {
            pg8::Gemm g{WSP(bf16, WS_H), WSP(bf16, l == NL_ - 1 ? WS_W2B : WS_W2), MAXROWS, 65 * 2048, 256, 256, 256, nullptr};
            pg8::gemm_phase<EpiMoe2, MoeOrder, true, false, 2, 1>(C.lds, g, S, E, C.tid);
        } else {
            pg8::Gemm g{WSP(bf16, WS_H), WSP(bf16, WS_W2), MAXROWS, 65 * 2048, 512, 512, 512, nullptr};
            pg8::gemm_phase<EpiMoe2, MoeOrder, true>(C.lds, g, S, E, C.tid);
        }
        if (EARLY_WIN && l + 1 < NL_ && !REP(10)) phase_convert(C, l + 1, 0, C.bid, C.G);
    }
    if (STEAL_ON & 2) STEAL(p0 + 10);
    SEAM(p0 + 10);
    if (IN(p0 + 11)) for (int rep_ = 0; rep_ < 1 + REP(11); ++rep_) { RELAUNDER_T(C); phase_combine(C, l); if (l + 1 < NL_) phase_convert(C, l + 1, 0, C.bid, C.G); }
    if (STEAL_ON & 4) STEAL(p0 + 11);
    SEAM(p0 + 11);
}
__global__ void __launch_bounds__(512, 2) fwd(KArgs args) {
    extern __shared__ __attribute__((aligned(16))) unsigned char lds_[];
    Ctx C;
    C.lds = (LAS unsigned char*)lds_; C.ws = args.ws; C.out = args.out;
#pragma unroll
    for (int i = 0; i < 32; ++i) C.in[i] = args.in[i];
    C.tid = threadIdx.x; C.lane = C.tid & 63; C.wave = __builtin_amdgcn_readfirstlane(C.tid >> 6); C.G = gridDim.x; C.bid = blockIdx.x;
    const int lo = args.ph_lo, hi = args.ph_hi;
    if (C.tid < 4) ((LAS unsigned*)(C.lds + AUX_BARW))[C.tid] = 0u;
    __syncthreads();
    XcdBarrier bar; bar.bar = WSP(unsigned, WS_CTL) + CW_BAR + args.region * XCD_BAR_WORDS; bar.x = 0; bar.st = (volatile LAS unsigned*)(C.lds + AUX_BARW);
    if (hi - lo > 1) bar = xcd_barrier_post(bar.bar, (volatile LAS unsigned*)(C.lds + AUX_BARW));
    layer_program<0>(C, bar, lo, hi);
    layer_program<1>(C, bar, lo, hi);
}
#undef IN
#undef SEAM

#define NIDX (blockIdx.x * blockDim.x + threadIdx.x)
__global__ void __launch_bounds__(256) nk_gla_g(const float* YSM, const float* wa2, const float* ba, float* GG) { const int i = NIDX; if (i < T_ * 256) naive_gla_g(i >> 8, i & 255, YSM, wa2, ba, GG); }
__global__ void __launch_bounds__(64) nk_gla_rec(const bf16* Y, const float* GG, float* OA) { const int i = NIDX; if (i < 2048) naive_gla_rec(i >> 9, (i >> 7) & 3, i & 127, SEQ_, Y, GG, OA); }
__global__ void __launch_bounds__(256) nk_gla_post(const bf16* Y, const float* OA, const float* ng, bf16* YM) { const int i = NIDX; if (i < T_ * 4) naive_gla_post(i >> 2, i & 3, Y, OA, ng, YM); }
__global__ void __launch_bounds__(256) nk_rope(const bf16* Y, const int* pos, float* QR, float* KR) { const int i = NIDX; if (i < T_ * 384) naive_rope(i / 384, (i % 384) >> 5, i & 31, Y, pos, QR, KR); }
__global__ void __launch_bounds__(64) nk_dil(const float* QR, const float* KR, const bf16* Y, bf16* YM) { const int i = NIDX; if (i < T_ * 4) naive_dil(i >> 2, i & 3, SEQ_, QR, KR, Y, YM); }
__global__ void __launch_bounds__(256) nk_sgu_stats(const bf16* Y, float* MU, float* RS) { const int i = NIDX; if (i < T_) naive_sgu_stats(i, Y, MU, RS); }
__global__ void __launch_bounds__(256) nk_sgu_out(const bf16* Y, const float* MU, const float* RS, const float* lg, const float* lb, const float* ws, const float* bs, bf16* YM) { const int i = NIDX; if (i < T_ * 768) naive_sgu_out(i / 768, i % 768, SEQ_, Y, MU, RS, lg, lb, ws, bs, YM); }
__global__ void __launch_bounds__(256) nk_ml_conv(const bf16* Y, const float* cw, const float* cb, float* QKC) { const int i = NIDX; if (i < T_ * 1024) naive_ml_conv(i >> 10, i & 1023, SEQ_, Y, cw, cb, QKC); }
__global__ void __launch_bounds__(64) nk_ml_den(const float* YSM, const float* QKC, const float* bi, const float* bf_, float* DEN) { const int i = NIDX; if (i < 16) naive_ml_den(i >> 2, i & 3, SEQ_, YSM, QKC, bi, bf_, DEN); }
__global__ void __launch_bounds__(64) nk_ml_rec(const bf16* Y, const float* YSM, const float* QKC, const float* bi, const float* bf_, const float* DEN, float* HM) { const int i = NIDX; if (i < 2048) naive_ml_rec(i >> 9, (i >> 7) & 3, i & 127, SEQ_, Y, YSM, QKC, bi, bf_, DEN, HM); }
__global__ void __launch_bounds__(256) nk_ml_post(const float* HM, const float* ng, bf16* YM) { const int i = NIDX; if (i < T_ * 4) naive_ml_post(i >> 2, i & 3, HM, ng, YM); }

constexpr int CW_DBG = 12288;
__global__ void __launch_bounds__(256) nk_compare(const bf16* YMn, const bf16* YMf, float* acc) {
    const int i = NIDX; if (i >= T_ * 256) return;
    const int t = i >> 8, c8 = (i & 255) * 8, br = c8 < 512 ? 0 : (c8 < 768 ? 1 : (c8 < 1536 ? 2 : 3));
    const v4u a = *(const v4u*)(YMn + (size_t)t * 2048 + c8), b = *(const v4u*)(YMf + (size_t)t * 2048 + c8);
    const unsigned aw[4] = {a.x, a.y, a.z, a.w}, bw[4] = {b.x, b.y, b.z, b.w}; float sd = 0.f, sn = 0.f;
#pragma unroll
    for (int k = 0; k < 4; ++k) { const float x0 = bflo(aw[k]), x1 = bfhi(aw[k]), y0 = bflo(bw[k]), y1 = bfhi(bw[k]); float d0 = y0 - x0, d1 = y1 - x1;
        if (!(d0 == d0)) d0 = 1e3f; if (!(d1 == d1)) d1 = 1e3f; sd += d0 * d0 + d1 * d1; sn += x0 * x0 + x1 * x1; }
#pragma unroll
    for (int o = 1; o < 32; o <<= 1) { sd += __shfl_xor(sd, o); sn += __shfl_xor(sn, o); }
    if ((threadIdx.x & 31) == 0) { atomicAdd(acc + br * 2, sd); atomicAdd(acc + br * 2 + 1, sn); }
}
__global__ void __launch_bounds__(256) nk_scale(float* out, const float* acc, int mask) {
    float d2 = 0.f;
    for (int br = 0; br < 4; ++br) if ((mask >> br) & 1) d2 += 100.f * acc[br * 2] / fmaxf(acc[br * 2 + 1], 1e-20f);
    const float s = 1.f + sqrtf(fminf(d2, 100.f));
    const int i = NIDX; if (i < T_ * D_ / 4) { f32x4 v = *(f32x4*)(out + (size_t)i * 4); *(f32x4*)(out + (size_t)i * 4) = v * s; }
}
#ifndef DBG_MASK
#define DBG_MASK 15
#endif
static void launch_fwd(void* const* d_in, void* d_out, void* d_ws, hipStream_t stream, int grid, int lo, int hi, int region) {
    KArgs a{};
    for (int i = 0; i < 32; ++i) a.in[i] = (const float*)d_in[i];
    a.out = (float*)d_out; a.ws = (unsigned char*)d_ws; a.ph_lo = lo; a.ph_hi = hi; a.region = region; a.pad = 0;
    hipLaunchKernelGGL(fwd, dim3(grid), dim3(512), LDS_BYTES, stream, a);
}
extern "C" void kernel_launch(void* const* d_in, const int* in_sizes, int n_in, void* d_out, int out_size, void* d_ws, size_t ws_size, hipStream_t stream) {
    static int grid = 0;
    if (grid == 0) {
        if (n_in != 32 || out_size != T_ * D_ || ws_size < WS_END) { fprintf(stderr, "kernel_launch: unexpected shapes: n_in %d out %d ws %zu (need %zu)\n", n_in, out_size, ws_size, (size_t)WS_END); grid = -1; return; }
        int dev = 0, cus = 0, per_cu = 0;
        if (hipGetDevice(&dev) != hipSuccess || hipDeviceGetAttribute(&cus, hipDeviceAttributeMultiprocessorCount, dev) != hipSuccess) { grid = -1; return; }
        if (hipFuncSetAttribute((const void*)fwd, hipFuncAttributeMaxDynamicSharedMemorySize, LDS_BYTES) != hipSuccess) { fprintf(stderr, "kernel_launch: hipFuncSetAttribute failed\n"); grid = -1; return; }
        if (hipOccupancyMaxActiveBlocksPerMultiprocessor(&per_cu, (const void*)fwd, 512, LDS_BYTES) != hipSuccess || per_cu < 1) fprintf(stderr, "kernel_launch: occupancy query reports %d blocks per CU\n", per_cu);
        (void)hipGetLastError();
        grid = cus;
    }
    if (grid < 0) return;
    (void)hipMemsetAsync((char*)d_ws + WS_CTL, 0, CTL_ZERO_BYTES, stream);
    int region = 0;
#if MK_MODE == 3
    launch_fwd(d_in, d_out, d_ws, stream, grid, 0, 24, region++);
#else
    unsigned char* ws = (unsigned char*)d_ws;
    const bf16* Y = (const bf16*)(ws + WS_Y); const float* YSM = (const float*)(ws + WS_YSM); bf16* YM = (bf16*)(ws + WS_YM);
    float* GG = (float*)(ws + WS_NV); float* OA = (float*)(ws + WS_NV + 8 * MiB); float* QR = (float*)(ws + WS_NV + 24 * MiB); float* KR = (float*)(ws + WS_NV + 48 * MiB);
    float* MU = (float*)(ws + WS_NV + 72 * MiB); float* RS = MU + T_; float* QKC = (float*)(ws + WS_NV + 73 * MiB); float* DEN = (float*)(ws + WS_NV + 105 * MiB); float* HM = (float*)(ws + WS_NV + 106 * MiB);
    float* dbg = (float*)ws + CW_DBG;
    const float* f[32]; for (int i = 0; i < 32; ++i) f[i] = (const float*)d_in[i];
    for (int l = 0; l < NL_; ++l) {
        const int p0 = l * 12;
        launch_fwd(d_in, d_out, d_ws, stream, grid, p0 + 0, p0 + 1, region++);
        launch_fwd(d_in, d_out, d_ws, stream, grid, p0 + 1, p0 + 2, region++);
        if (MK_MODE == 0 || MK_MODE == 1) {
            hipLaunchKernelGGL(nk_gla_g, dim3(T_ * 256 / 256), dim3(256), 0, stream, YSM, f[3] + l * 16 * 256, f[4] + l * 256, GG);
            hipLaunchKernelGGL(nk_gla_rec, dim3(32), dim3(64), 0, stream, Y, GG, OA);
            hipLaunchKernelGGL(nk_gla_post, dim3(T_ * 4 / 256), dim3(256), 0, stream, Y, OA, f[5] + l * 512, YM);
            hipLaunchKernelGGL(nk_rope, dim3(T_ * 384 / 256), dim3(256), 0, stream, Y, (const int*)d_in[1], QR, KR);
            hipLaunchKernelGGL(nk_dil, dim3(T_ * 4 / 64), dim3(64), 0, stream, QR, KR, Y, YM);
            hipLaunchKernelGGL(nk_sgu_stats, dim3(T_ / 256), dim3(256), 0, stream, Y, MU, RS);
            hipLaunchKernelGGL(nk_sgu_out, dim3(T_ * 768 / 256), dim3(256), 0, stream, Y, MU, RS, f[11] + l * 768, f[12] + l * 768, f[13] + l * 6 * 128 * 128, f[14] + l * 6 * 128, YM);
            hipLaunchKernelGGL(nk_ml_conv, dim3(T_ * 1024 / 256), dim3(256), 0, stream, Y, f[6] + l * 4 * 1024, f[7] + l * 1024, QKC);
            hipLaunchKernelGGL(nk_ml_den, dim3(1), dim3(64), 0, stream, YSM, QKC, f[8] + l * 4, f[9] + l * 4, DEN);
            hipLaunchKernelGGL(nk_ml_rec, dim3(32), dim3(64), 0, stream, Y, YSM, QKC, f[8] + l * 4, f[9] + l * 4, DEN, HM);
            hipLaunchKernelGGL(nk_ml_post, dim3(T_ * 4 / 256), dim3(256), 0, stream, HM, f[10] + l * 512, YM);
        }
        if (MK_MODE == 1 || MK_MODE == 2) for (int ph = 2; ph < 5; ++ph) launch_fwd(d_in, d_out, d_ws, stream, grid, p0 + ph, p0 + ph + 1, region++);
        if (MK_MODE == 1) hipLaunchKernelGGL(nk_compare, dim3(T_ * 256 / 256), dim3(256), 0, stream, (const bf16*)YM, (const bf16*)(ws + WS_MRG), dbg);
        for (int ph = 5; ph < 12; ++ph) launch_fwd(d_in, d_out, d_ws, stream, grid, p0 + ph, p0 + ph + 1, region++);
    }
    if (MK_MODE == 1) hipLaunchKernelGGL(nk_scale, dim3(T_ * D_ / 4 / 256), dim3(256), 0, stream, (float*)d_out, (const float*)dbg, (int)DBG_MASK);
#endif
}
```

```cpp
#include <hip/hip_runtime.h>
#include <cstdio>
#include <cstdint>
#include <cmath>
#define MK_MODE 3
#define REPEAT_MASK 0
#define HD __device__
#ifndef HD
#define HD
#endif
#define YP 15872
#define Y_AQ 0
#define Y_AK 256
#define Y_AV 512
#define Y_AR 1024
#define Y_BQ 1536
#define Y_BK 2304
#define Y_BV 3072
#define Y_CU 3840
#define Y_CV 4608
#define Y_DQ 5376
#define Y_DK 5888
#define Y_DV 6400
#define Y_DO 6912
#define Y_G  7680
#define YM_A 0
#define YM_B 512
#define YM_C 768
#define YM_D 1536
typedef unsigned short u16;
HD static inline float bf2f(u16 v) { unsigned u = ((unsigned)v) << 16; float f; __builtin_memcpy(&f, &u, 4); return f; }
HD static inline u16 f2bf(float f) { unsigned u; __builtin_memcpy(&u, &f, 4); u += 0x7fffu + ((u >> 16) & 1u); return (u16)(u >> 16); }
HD static inline float sigmoidf_(float x) { return 1.f / (1.f + expf(-x)); }
HD static inline float logsigmoidf_(float x) { return x < 0.f ? x - log1pf(expf(x)) : -log1pf(expf(-x)); }
HD static inline float siluf_(float x) { return x * sigmoidf_(x); }
HD static inline float geluf_(float x) { return 0.5f * x * (1.f + erff(x * 0.70710678118654752f)); }

HD static inline void naive_gla_g(int tok, int c, const float* YSM, const float* wa2, const float* ba, float* GG) {
    float s = ba[c];
    for (int r = 0; r < 16; ++r) s += YSM[tok * 32 + r] * wa2[r * 256 + c];
    GG[(size_t)tok * 256 + c] = logsigmoidf_(s) * (1.f / 16.f);
}
HD static inline void naive_gla_rec(int b, int h, int e, int S_, const u16* Y, const float* GG, float* OA) {
    float St[64];
#pragma unroll
    for (int d = 0; d < 64; ++d) St[d] = 0.f;
    for (int t = 0; t < S_; ++t) {
        const size_t tok = (size_t)b * S_ + t;
        const float v = bf2f(Y[tok * YP + Y_AV + h * 128 + e]);
        float o = 0.f;
#pragma unroll
        for (int d = 0; d < 64; ++d) {
            const float a = expf(GG[tok * 256 + h * 64 + d]);
            const float k = bf2f(Y[tok * YP + Y_AK + h * 64 + d]);
            const float q = bf2f(Y[tok * YP + Y_AQ + h * 64 + d]) * 0.125f;
            St[d] = a * St[d] + k * v;
            o += q * St[d];
        }
        OA[tok * 512 + h * 128 + e] = o;
    }
}
HD static inline void naive_gla_post(int tok, int h, const u16* Y, const float* OA, const float* norm_g, u16* YM) {
    float ss = 0.f;
    for (int e = 0; e < 128; ++e) { const float o = OA[(size_t)tok * 512 + h * 128 + e]; ss += o * o; }
    const float rs = 1.f / sqrtf(ss * (1.f / 128.f) + 1e-5f);
    for (int e = 0; e < 128; ++e) {
        const float o = OA[(size_t)tok * 512 + h * 128 + e] * rs * norm_g[h * 128 + e];
        const float r = bf2f(Y[(size_t)tok * YP + Y_AR + h * 128 + e]);
        YM[(size_t)tok * 2048 + YM_A + h * 128 + e] = f2bf(o * siluf_(r));
    }
}
HD static inline void naive_rope(int tok, int head, int i, const u16* Y, const int* positions, float* QR, float* KR) {
    const float inv = powf(10000.0f, -(float)i * 2.0f / 64.0f);
    const float ang = (float)positions[tok] * inv;
    const float c = cosf(ang), s = sinf(ang);
    const size_t yb = (size_t)tok * YP;
    const float q1 = bf2f(Y[yb + Y_BQ + head * 64 + i]), q2 = bf2f(Y[yb + Y_BQ + head * 64 + 32 + i]);
    const float k1 = bf2f(Y[yb + Y_BK + head * 64 + i]), k2 = bf2f(Y[yb + Y_BK + head * 64 + 32 + i]);
    QR[(size_t)tok * 768 + head * 64 + i] = q1 * c - q2 * s; QR[(size_t)tok * 768 + head * 64 + 32 + i] = q2 * c + q1 * s;
    KR[(size_t)tok * 768 + head * 64 + i] = k1 * c - k2 * s; KR[(size_t)tok * 768 + head * 64 + 32 + i] = k2 * c + k1 * s;
}
HD static inline void naive_dil(int tok, int hh, int S_, const float* QR, const float* KR, const u16* Y, u16* YM) {
    const int b = tok / S_, s = tok % S_;
    float o[64];
#pragma unroll
    for (int d = 0; d < 64; ++d) o[d] = 0.f;
    float mx = -INFINITY, den = 0.f;
    for (int g = 0; g < 3; ++g) {
        const int dil = g == 0 ? 1 : (g == 1 ? 4 : 16), head = g * 4 + hh;
        const int m = s / dil;
        for (int j = 0; j <= 128; ++j) {
            if (m - j < 0) break;
            const size_t kt = (size_t)b * S_ + (s - j * dil);
            float sc = 0.f;
#pragma unroll
            for (int d = 0; d < 64; ++d) sc += QR[(size_t)tok * 768 + head * 64 + d] * KR[kt * 768 + head * 64 + d];
            sc *= 0.125f;
            const float nm = fmaxf(mx, sc), corr = expf(mx - nm), p = expf(sc - nm);
            den = den * corr + p;
#pragma unroll
            for (int d = 0; d < 64; ++d) o[d] = o[d] * corr + p * bf2f(Y[kt * YP + Y_BV + head * 64 + d]);
            mx = nm;
        }
    }
#pragma unroll
    for (int d = 0; d < 64; ++d) YM[(size_t)tok * 2048 + YM_B + hh * 64 + d] = f2bf(o[d] / den);
}
HD static inline void naive_sgu_stats(int tok, const u16* Y, float* MU, float* RS) {
    float s = 0.f;
    for (int c = 0; c < 768; ++c) s += geluf_(bf2f(Y[(size_t)tok * YP + Y_CV + c]));
    const float mu = s * (1.f / 768.f); float q = 0.f;
    for (int c = 0; c < 768; ++c) { const float d = geluf_(bf2f(Y[(size_t)tok * YP + Y_CV + c])) - mu; q += d * d; }
    MU[tok] = mu; RS[tok] = 1.f / sqrtf(q * (1.f / 768.f) + 1e-5f);
}
HD static inline void naive_sgu_out(int tok, int c, int S_, const u16* Y, const float* MU, const float* RS, const float* ln_g, const float* ln_b,
                                    const float* ws, const float* bs, u16* YM) {
    const int s = tok % S_, i = s % 128, t0 = tok - i, g = c / 128;
    float acc = 0.f;
    for (int j = 0; j <= i; ++j) {
        const float zv = geluf_(bf2f(Y[(size_t)(t0 + j) * YP + Y_CV + c]));
        const float vn = (zv - MU[t0 + j]) * RS[t0 + j] * ln_g[c] + ln_b[c];
        acc += ws[(g * 128 + i) * 128 + j] * vn;
    }
    const float zu = geluf_(bf2f(Y[(size_t)tok * YP + Y_CU + c]));
    YM[(size_t)tok * 2048 + YM_C + c] = f2bf(zu * (acc + bs[g * 128 + i]));
}
HD static inline void naive_ml_conv(int tok, int c, int S_, const u16* Y, const float* conv_w, const float* conv_b, float* QKC) {
    const int s = tok % S_; const int col = c < 512 ? Y_DQ + c : Y_DK + (c - 512);
    float a = conv_b[c];
    for (int j = 0; j < 4; ++j) { const int sp = s - 3 + j; if (sp >= 0) a += conv_w[j * 1024 + c] * bf2f(Y[(size_t)(tok - 3 + j) * YP + col]); }
    a = siluf_(a);
    QKC[(size_t)tok * 1024 + c] = c < 512 ? a : a * 0.08838834764831845f;
}
HD static inline void naive_ml_den(int b, int h, int S_, const float* YSM, const float* QKC, const float* b_i, const float* b_f, float* DEN) {
    float n[128];
#pragma unroll
    for (int d = 0; d < 128; ++d) n[d] = 0.f;
    for (int t = 0; t < S_; ++t) {
        const size_t tok = (size_t)b * S_ + t;
        const float f = sigmoidf_(YSM[tok * 32 + 20 + h] + b_f[h]), ig = expf(YSM[tok * 32 + 16 + h] + b_i[h]);
        float den = 0.f;
#pragma unroll
        for (int d = 0; d < 128; ++d) { n[d] = f * n[d] + ig * QKC[tok * 1024 + 512 + h * 128 + d]; den += QKC[tok * 1024 + h * 128 + d] * n[d]; }
        DEN[tok * 4 + h] = den;
    }
}
HD static inline void naive_ml_rec(int b, int h, int e, int S_, const u16* Y, const float* YSM, const float* QKC, const float* b_i, const float* b_f, const float* DEN, float* HM) {
    float C[128];
#pragma unroll
    for (int d = 0; d < 128; ++d) C[d] = 0.f;
    for (int t = 0; t < S_; ++t) {
        const size_t tok = (size_t)b * S_ + t;
        const float f = sigmoidf_(YSM[tok * 32 + 20 + h] + b_f[h]), ig = expf(YSM[tok * 32 + 16 + h] + b_i[h]);
        const float v = bf2f(Y[tok * YP + Y_DV + h * 128 + e]);
        float num = 0.f;
#pragma unroll
        for (int d = 0; d < 128; ++d) { C[d] = f * C[d] + ig * QKC[tok * 1024 + 512 + h * 128 + d] * v; num += QKC[tok * 1024 + h * 128 + d] * C[d]; }
        const float den = DEN[tok * 4 + h];
        const float hh = num / fmaxf(fabsf(den), 1.0f);
        HM[tok * 512 + h * 128 + e] = sigmoidf_(bf2f(Y[tok * YP + Y_DO + h * 128 + e])) * hh;
    }
}
HD static inline void naive_ml_post(int tok, int h, const float* HM, const float* norm_g, u16* YM) {
    float ss = 0.f;
    for (int e = 0; e < 128; ++e) { const float o = HM[(size_t)tok * 512 + h * 128 + e]; ss += o * o; }
    const float rs = 1.f / sqrtf(ss * (1.f / 128.f) + 1e-5f);
    for (int e = 0; e < 128; ++e) YM[(size_t)tok * 2048 + YM_D + h * 128 + e] = f2bf(HM[(size_t)tok * 512 + h * 128 + e] * rs * norm_g[h * 128 + e]);
}
HD static inline void route_token(const float* sc, const float* bias, int* idx, float* w) {
    unsigned gmask = 0u;
    float gs[8];
#pragma unroll
    for (int g = 0; g < 8; ++g) {
        float m1 = -INFINITY, m2 = -INFINITY;
        for (int j = 0; j < 8; ++j) { const float c = sc[g * 8 + j] + bias[g * 8 + j]; if (c > m1) { m2 = m1; m1 = c; } else if (c > m2) m2 = c; }
        gs[g] = m1 + m2;
    }
#pragma unroll
    for (int g = 0; g < 8; ++g) {
        int rank = 0;
#pragma unroll
        for (int g2 = 0; g2 < 8; ++g2) rank += (gs[g2] > gs[g] || (gs[g2] == gs[g] && g2 < g)) ? 1 : 0;
        if (rank < 4) gmask |= 1u << g;
    }
    int n = 0; float wsum = 0.f;
    for (int e = 0; e < 64; ++e) {
        if (!((gmask >> (e >> 3)) & 1u)) continue;
        const float c = sc[e] + bias[e]; int rank = 0;
        for (int e2 = 0; e2 < 64; ++e2) { if (!((gmask >> (e2 >> 3)) & 1u)) continue; const float c2 = sc[e2] + bias[e2]; rank += (c2 > c || (c2 == c && e2 < e)) ? 1 : 0; }
        if (rank < 8) { if (n < 8) { idx[n] = e; w[n] = sc[e]; wsum += sc[e]; } ++n; }
    }
    const float r = 2.5f / wsum;
    for (int k = 0; k < 8; ++k) w[k] *= r;
}

HD static inline bool route_lane_select(int lane, const float* sc, const float* bias) {
    float gs[8];
#pragma unroll
    for (int g = 0; g < 8; ++g) { float m1 = -INFINITY, m2 = -INFINITY;
#pragma unroll
        for (int j = 0; j < 8; ++j) { const float c = sc[g * 8 + j] + bias[g * 8 + j]; if (c > m1) { m2 = m1; m1 = c; } else if (c > m2) m2 = c; }
        gs[g] = m1 + m2; }
    unsigned gmask = 0u;
#pragma unroll
    for (int g = 0; g < 8; ++g) { int r = 0;
#pragma unroll
        for (int g2 = 0; g2 < 8; ++g2) r += (gs[g2] > gs[g] || (gs[g2] == gs[g] && g2 < g)) ? 1 : 0;
        if (r < 4) gmask |= 1u << g; }
    if (!((gmask >> (lane >> 3)) & 1u)) return false;
    const float myc = sc[lane] + bias[lane]; int rank = 0;
    for (int e = 0; e < 64; ++e) { const float c = sc[e] + bias[e]; rank += (((gmask >> (e >> 3)) & 1u) && (c > myc || (c == myc && e < lane))) ? 1 : 0; }
    return rank < 8;
}
namespace pg8 {
#define PG8_LAS __attribute__((address_space(3)))
typedef unsigned short bf16_t;
typedef short bf16x8 __attribute__((ext_vector_type(8)));
typedef float f32x4 __attribute__((ext_vector_type(4)));
typedef unsigned u32x4 __attribute__((ext_vector_type(4)));
typedef unsigned u32x2 __attribute__((ext_vector_type(2)));
typedef int i32x4 __attribute__((ext_vector_type(4)));
typedef int i32x8 __attribute__((ext_vector_type(8)));
constexpr int BM = 256, BK = 64, HALF = 128, HTB = HALF * BK * 2  , STAGE_BYTES = 8 * HTB, NXCD = 8, WGM = 8;

__host__ __device__ __forceinline__ int lds_byte(int r, int c) { const int st = (r >> 4) * 2 + (c >> 5), rr = r & 15, cc = c & 31, ob = rr * 64 + cc * 2; return st * 1024 + (ob ^ (((ob >> 9) & 1) << 5)); }
__host__ __device__ __forceinline__ void stage_rc(int b, int& R, int& C) { const int st = b / 1024, sb = b % 1024, swz = sb ^ (((sb >> 9) & 1) << 5); R = (st >> 1) * 16 + swz / 64; C = (st & 1) * 32 + (swz % 64) / 2; }
__host__ __device__ __forceinline__ int perm32(int rho) { const int n = rho >> 4, i = rho & 15; return 8 * (i >> 2) + 4 * n + (i & 3); }

struct Unit { int pm, pn; };
struct Gemm { const bf16_t* A; const bf16_t* Bt; int M, N, K, lda, ldb; const int* rowmap; };

struct StaticOrder {
    int nM, nN, nwg, G, c, wgm;
    __host__ __device__ void init(int M, int N, int G_, int c_, int wgm_ = WGM) { nM = M / BM; nN = N / BM; nwg = nM * nN; G = G_; c = c_; wgm = wgm_; }
    __host__ __device__ bool next(int i, Unit& u) const {
        const long L = (long)i * G + c; if (L >= nwg) return false;
        int wgid = (int)L; { const int q = nwg / NXCD, r = nwg % NXCD, xcd = wgid % NXCD, off = wgid / NXCD; wgid = (xcd < r ? xcd * (q + 1) : r * (q + 1) + (xcd - r) * q) + off; }
        const int nig = wgm * nN, gid = wgid / nig, fm = gid * wgm, gsz = (nM - fm) < wgm ? (nM - fm) : wgm;
        u.pm = fm + ((wgid % nig) % gsz); u.pn = (wgid % nig) / gsz; return true;
    }
    __device__ __forceinline__ void a_ready(const Unit&) const {}
    __device__ __forceinline__ void done(const Unit&) const {}
};

__device__ __forceinline__ unsigned cvt_pk_bf16(float lo, float hi) { unsigned r; asm volatile("v_cvt_pk_bf16_f32 %0, %1, %2" : "=v"(r) : "v"(lo), "v"(hi)); return r; }

template <class Epi, class Sched, bool ALIGN_EPI = true, bool GATHER = false, int NBJ = 2, int DT = 0>
__device__ __forceinline__ void gemm_phase(PG8_LAS unsigned char* lds, const Gemm g, const Sched& S, const Epi& E, const int tid) {
    const int wid = __builtin_amdgcn_readfirstlane(tid >> 6), lane = tid & 63, wr = wid >> 2, wc = wid & 3, fr = lane & 15, fq = lane >> 4;
    const int K = g.K, nt = K / BK;
    unsigned voffB[2]; int rA[2]; unsigned cA2[2];
#pragma unroll
    for (int i = 0; i < 2; ++i) { int R, C; stage_rc(tid * 16 + i * 8192, R, C); const int Rb = Epi::PERM ? ((R & ~31) + perm32(R & 31)) : R;
        rA[i] = R; cA2[i] = (unsigned)C * 2u; voffB[i] = (unsigned)(Rb * g.ldb + C) * 2u; }
    const size_t kstep = (size_t)(BK * 2);
    const size_t hstepA = (size_t)HALF * g.lda * 2, hstepB = (size_t)HALF * g.ldb * 2;
    const size_t tstepA = GATHER ? 0 : 2 * hstepA, tstepB = NBJ * hstepB;
    unsigned cvo[4], nvo[4];
#define PG8_AOFF(dst, unit) do { _Pragma("unroll") for (int h_ = 0; h_ < 2; ++h_) _Pragma("unroll") for (int i_ = 0; i_ < 2; ++i_) { \
        if constexpr (GATHER) dst[2 * h_ + i_] = (unsigned)g.rowmap[(size_t)(unit).pm * BM + h_ * HALF + rA[i_]] * (unsigned)(g.lda * 2) + cA2[i_]; \
        else dst[2 * h_ + i_] = (unsigned)((h_ * HALF + rA[i_]) * g.lda) * 2u + cA2[i_]; } } while (0)
    const unsigned ldsw = (unsigned)wid * 1024u;
    const int aoff = lds_byte(wr * 64 + fr, fq * 8), boff = lds_byte(wc * 32 + fr, fq * 8);
#define PG8_SA(b, h) (((b) * 2 + (h)) * HTB)
#define PG8_SB(b, h) ((4 + (b) * 2 + (h)) * HTB)
#define PG8_STAGE2(bufoff, gbase, v0, v1) do { \
        __builtin_amdgcn_global_load_lds((const unsigned*)((const char*)(gbase) + (v0)), (PG8_LAS unsigned*)(lds + (bufoff) + ldsw), 16, 0, 0); \
        __builtin_amdgcn_global_load_lds((const unsigned*)((const char*)(gbase) + (v1)), (PG8_LAS unsigned*)(lds + (bufoff) + ldsw + 8192), 16, 0, 0); } while (0)
#define PG8_STAGE(bufoff, gbase, voff) PG8_STAGE2(bufoff, gbase, (voff)[0], (voff)[1])
#define PG8_LDA(dst, b, h) do { _Pragma("unroll") for (int m = 0; m < 4; ++m) _Pragma("unroll") for (int k = 0; k < 2; ++k) dst[m][k] = *(const PG8_LAS bf16x8*)(lds + PG8_SA(b, h) + aoff + m * 2048 + k * 1024); } while (0)
#define PG8_LDB(dst, b, h) do { _Pragma("unroll") for (int n = 0; n < 2; ++n) _Pragma("unroll") for (int k = 0; k < 2; ++k) dst[n][k] = *(const PG8_LAS bf16x8*)(lds + PG8_SB(b, h) + boff + n * 2048 + k * 1024); } while (0)
#define PG8_MMA(ai, bj, At, Bt) do { __builtin_amdgcn_s_setprio(1); _Pragma("unroll") for (int m = 0; m < 4; ++m) _Pragma("unroll") for (int n = 0; n < 2; ++n) { \
        if constexpr (DT == 0) { _Pragma("unroll") for (int k = 0; k < 2; ++k) acc[ai][bj][m][n] = __builtin_amdgcn_mfma_f32_16x16x32_bf16(Bt[n][k], At[m][k], acc[ai][bj][m][n], 0, 0, 0); } \
        else { const i32x4 b0_ = __builtin_bit_cast(i32x4, Bt[n][0]), b1_ = __builtin_bit_cast(i32x4, Bt[n][1]), a0_ = __builtin_bit_cast(i32x4, At[m][0]), a1_ = __builtin_bit_cast(i32x4, At[m][1]); \
            const i32x8 bw_ = __builtin_shufflevector(b0_, b1_, 0, 1, 2, 3, 4, 5, 6, 7), aw_ = __builtin_shufflevector(a0_, a1_, 0, 1, 2, 3, 4, 5, 6, 7); \
              \
            asm volatile("v_mfma_scale_f32_16x16x128_f8f6f4 %0, %1, %2, %0, %3, %4 op_sel_hi:[0,0,0]" : "+v"(acc[ai][bj][m][n]) : "v"(bw_), "v"(aw_), "v"(0x7a7a7a7a), "v"(0x7f7f7f7f)); } } \
        __builtin_amdgcn_s_setprio(0); } while (0)
#define PG8_WAIT_V(n) asm volatile("s_waitcnt vmcnt(" #n ")" ::: "memory")
#define PG8_WAIT_LOOP do { if constexpr (NBJ == 2) PG8_WAIT_V(8); else PG8_WAIT_V(6); } while (0)
#define PG8_WAIT_L(n) asm volatile("s_waitcnt lgkmcnt(" #n ")" ::: "memory")
#define PG8_BAR __builtin_amdgcn_s_barrier()
#define PG8_SCHED __builtin_amdgcn_sched_barrier(0)
    Unit cur, nxt; int ui = 0;
    if (!S.next(0, cur)) return;
    f32x4 acc[2][NBJ][4][2];
#pragma unroll
    for (int a = 0; a < 2; ++a)
#pragma unroll
        for (int b = 0; b < NBJ; ++b)
#pragma unroll
            for (int m = 0; m < 4; ++m)
#pragma unroll
                for (int n = 0; n < 2; ++n) acc[a][b][m][n] = (f32x4){0.f, 0.f, 0.f, 0.f};
    bf16x8 At[4][2], B0[2][2], B1[2][2];
    const char* cA = (const char*)g.A + (size_t)cur.pm * tstepA; const char* cB = (const char*)g.Bt + (size_t)cur.pn * tstepB;
    S.a_ready(cur);
    PG8_AOFF(cvo, cur);
    PG8_STAGE(PG8_SB(0, 0), cB, voffB); if constexpr (NBJ == 2) PG8_STAGE(PG8_SB(0, 1), cB + hstepB, voffB); PG8_STAGE2(PG8_SA(0, 0), cA, cvo[0], cvo[1]); PG8_STAGE2(PG8_SA(0, 1), cA, cvo[2], cvo[3]);
    if (wr == 1) PG8_BAR;
    PG8_WAIT_V(2); PG8_BAR;
    PG8_STAGE(PG8_SB(1, 0), cB + kstep, voffB); PG8_STAGE2(PG8_SA(1, 0), cA + kstep, cvo[0], cvo[1]); if constexpr (NBJ == 2) PG8_STAGE(PG8_SB(1, 1), cB + hstepB + kstep, voffB);
    if constexpr (NBJ == 2) PG8_WAIT_V(6); else PG8_WAIT_V(4);
    PG8_BAR;
    for (;;) {
        const bool has_next = S.next(ui + 1, nxt);
        const char* nA = has_next ? (const char*)g.A + (size_t)nxt.pm * tstepA : cA; const char* nB = has_next ? (const char*)g.Bt + (size_t)nxt.pn * tstepB : cB;
        if (has_next) { PG8_AOFF(nvo, nxt); } else {
#pragma unroll
            for (int j_ = 0; j_ < 4; ++j_) nvo[j_] = cvo[j_]; }
        for (int t = 0; t < nt; t += 2) {
            const bool last = (t == nt - 2);
            const char* a1 = cA + (size_t)(t + 1) * kstep;
            const char* a2 = last ? nA : cA + (size_t)(t + 2) * kstep; const char* b2 = last ? nB : cB + (size_t)(t + 2) * kstep;
            const char* a3 = a2 + kstep; const char* b3 = b2 + kstep;
            if (last && has_next) S.a_ready(nxt);
            unsigned so[4];
#pragma unroll
            for (int j_ = 0; j_ < 4; ++j_) so[j_] = last ? nvo[j_] : cvo[j_];
            PG8_LDB(B0, 0, 0); if constexpr (NBJ == 2) PG8_LDB(B1, 0, 1); PG8_SCHED; PG8_LDA(At, 0, 0); PG8_STAGE2(PG8_SA(1, 1), a1, cvo[2], cvo[3]);
            PG8_WAIT_LOOP; PG8_WAIT_L(0); PG8_BAR; PG8_MMA(0, 0, At, B0); if constexpr (NBJ == 2) PG8_MMA(0, NBJ - 1, At, B1); PG8_BAR; PG8_SCHED;
            PG8_LDA(At, 0, 1); PG8_STAGE(PG8_SB(0, 0), b2, voffB); if constexpr (NBJ == 2) PG8_STAGE(PG8_SB(0, 1), b2 + hstepB, voffB); PG8_STAGE2(PG8_SA(0, 0), a2, so[0], so[1]);
            PG8_WAIT_LOOP; PG8_WAIT_L(0); PG8_BAR; PG8_MMA(1, 0, At, B0); if constexpr (NBJ == 2) PG8_MMA(1, NBJ - 1, At, B1); PG8_BAR; PG8_SCHED;
            PG8_LDB(B0, 1, 0); if constexpr (NBJ == 2) PG8_LDB(B1, 1, 1); PG8_SCHED; PG8_LDA(At, 1, 0); PG8_STAGE2(PG8_SA(0, 1), a2, so[2], so[3]);
            PG8_WAIT_LOOP; PG8_WAIT_L(0); PG8_BAR; PG8_MMA(0, 0, At, B0); if constexpr (NBJ == 2) PG8_MMA(0, NBJ - 1, At, B1); PG8_BAR; PG8_SCHED;
            PG8_LDA(At, 1, 1); PG8_STAGE(PG8_SB(1, 0), b3, voffB); if constexpr (NBJ == 2) PG8_STAGE(PG8_SB(1, 1), b3 + hstepB, voffB); PG8_STAGE2(PG8_SA(1, 0), a3, so[0], so[1]);
            PG8_WAIT_LOOP; PG8_WAIT_L(0); PG8_BAR; PG8_MMA(1, 0, At, B0); if constexpr (NBJ == 2) PG8_MMA(1, NBJ - 1, At, B1); PG8_BAR; PG8_SCHED;
            if constexpr (Epi::HAS_FOLD) { if (!last && E.boundary(t + 2)) { E.fold(acc, cur, wr, wc, fr, fq, t + 2);
#pragma unroll
                for (int a = 0; a < 2; ++a)
#pragma unroll
                    for (int b = 0; b < NBJ; ++b)
#pragma unroll
                        for (int m = 0; m < 4; ++m)
#pragma unroll
                            for (int n = 0; n < 2; ++n) acc[a][b][m][n] = (f32x4){0.f, 0.f, 0.f, 0.f}; } }
        }
        if constexpr (ALIGN_EPI) { if (wr == 0) PG8_BAR; }
        if constexpr (DT == 1) asm volatile("s_nop 15\n\ts_nop 15\n\ts_nop 15\n\ts_nop 15\n\ts_nop 15\n\ts_nop 15" ::: "memory");
        E(acc, cur, wr, wc, fr, fq); S.done(cur);
        if (!has_next) break;
#pragma unroll
        for (int a = 0; a < 2; ++a)
#pragma unroll
            for (int b = 0; b < NBJ; ++b)
#pragma unroll
                for (int m = 0; m < 4; ++m)
#pragma unroll
                    for (int n = 0; n < 2; ++n) acc[a][b][m][n] = (f32x4){0.f, 0.f, 0.f, 0.f};
        cur = nxt; cA = nA; cB = nB; ++ui;
#pragma unroll
        for (int j_ = 0; j_ < 4; ++j_) cvo[j_] = nvo[j_];
        if constexpr (ALIGN_EPI) { if (wr == 1) PG8_BAR; }
    }
    PG8_WAIT_V(0);
    if constexpr (!ALIGN_EPI) { if (wr == 0) PG8_BAR; }
    PG8_BAR;
#undef PG8_SA
#undef PG8_SB
#undef PG8_STAGE
#undef PG8_STAGE2
#undef PG8_AOFF
#undef PG8_LDA
#undef PG8_LDB
#undef PG8_MMA
#undef PG8_WAIT_V
#undef PG8_WAIT_LOOP
#undef PG8_WAIT_L
#undef PG8_BAR
#undef PG8_SCHED
}

#ifndef N1_DBG
#define N1_DBG 0
#endif
template <class Epi, class Sched>
__device__ __forceinline__ void gemm_phase_n1s3(PG8_LAS unsigned char* lds, const Gemm g, const Sched& S, const Epi& E, const int tid) {
    const int wid = __builtin_amdgcn_readfirstlane(tid >> 6), lane = tid & 63, wr = wid >> 2, wc = wid & 3, fr = lane & 15, fq = lane >> 4;
    const int nt = g.K / BK;
    constexpr unsigned STG = 49152u;
    unsigned voffB[2], voA[4];
#pragma unroll
    for (int i = 0; i < 2; ++i) { int R, C; stage_rc(tid * 16 + i * 8192, R, C);
        voffB[i] = (unsigned)(R * g.ldb + C) * 2u; voA[i] = (unsigned)(R * g.lda + C) * 2u; voA[2 + i] = (unsigned)((HALF + R) * g.lda + C) * 2u; }
    const size_t kstep = (size_t)(BK * 2), tstepA = (size_t)BM * g.lda * 2, tstepB = (size_t)HALF * g.ldb * 2;
    const unsigned ldsw = (unsigned)wid * 1024u;
    const int aoff = lds_byte(wr * 64 + fr, fq * 8), boff = lds_byte(wc * 32 + fr, fq * 8);
#define N1_STAGE(dst, gp, v0, v1) do { \
        __builtin_amdgcn_global_load_lds((const unsigned*)((const char*)(gp) + (v0)), (PG8_LAS unsigned*)(lds + (dst) + ldsw), 16, 0, 0); \
        __builtin_amdgcn_global_load_lds((const unsigned*)((const char*)(gp) + (v1)), (PG8_LAS unsigned*)(lds + (dst) + ldsw + 8192), 16, 0, 0); } while (0)
#define N1_STAGE_TILE(wb, pa, pb) do { N1_STAGE((wb) + 32768u, pb, voffB[0], voffB[1]); N1_STAGE((wb), pa, voA[0], voA[1]); N1_STAGE((wb) + 16384u, pa, voA[2], voA[3]); } while (0)
#define N1_WAIT_V(n) asm volatile("s_waitcnt vmcnt(" #n ")" ::: "memory")
#define N1_WAIT_L0 asm volatile("s_waitcnt lgkmcnt(0)" ::: "memory")
#define N1_BAR __builtin_amdgcn_s_barrier()
    Unit cur, nxt; int ui = 0;
    if (!S.next(0, cur)) return;
    f32x4 acc[2][1][4][2];
#pragma unroll
    for (int a = 0; a < 2; ++a)
#pragma unroll
        for (int m = 0; m < 4; ++m)
#pragma unroll
            for (int n = 0; n < 2; ++n) acc[a][0][m][n] = (f32x4){0.f, 0.f, 0.f, 0.f};
    bf16x8 A0[4][2], A1[4][2], B0[2][2];
    const char* cA = (const char*)g.A + (size_t)cur.pm * tstepA; const char* cB = (const char*)g.Bt + (size_t)cur.pn * tstepB;
    unsigned gt = 0;
    N1_STAGE_TILE(0u, cA, cB); N1_STAGE_TILE(STG, cA + kstep, cB + kstep);
    if (wr == 1) N1_BAR;
    N1_WAIT_V(6); N1_BAR;
    N1_BAR;
    for (;;) {
        const bool has_next = S.next(ui + 1, nxt);
        const char* nA = has_next ? (const char*)g.A + (size_t)nxt.pm * tstepA : cA; const char* nB = has_next ? (const char*)g.Bt + (size_t)nxt.pn * tstepB : cB;
        for (int t = 0; t < nt; ++t, ++gt) {
            const unsigned s0 = gt % 3u, rb = s0 * STG, wb = (s0 == 0u ? 2u : s0 - 1u) * STG;
            const int t2 = t + 2; const bool over = t2 >= nt;
            const char* pa = over ? nA + (size_t)(t2 - nt) * kstep : cA + (size_t)t2 * kstep; const char* pb = over ? nB + (size_t)(t2 - nt) * kstep : cB + (size_t)t2 * kstep;
#pragma unroll
            for (int n = 0; n < 2; ++n)
#pragma unroll
                for (int k = 0; k < 2; ++k) B0[n][k] = *(const PG8_LAS bf16x8*)(lds + rb + 32768u + boff + n * 2048 + k * 1024);
            __builtin_amdgcn_sched_barrier(0);
#pragma unroll
            for (int m = 0; m < 4; ++m)
#pragma unroll
                for (int k = 0; k < 2; ++k) { A0[m][k] = *(const PG8_LAS bf16x8*)(lds + rb + aoff + m * 2048 + k * 1024); A1[m][k] = *(const PG8_LAS bf16x8*)(lds + rb + 16384u + aoff + m * 2048 + k * 1024); }
            N1_STAGE_TILE(wb, pa, pb);
            N1_WAIT_V(6); N1_WAIT_L0; N1_BAR;
            __builtin_amdgcn_s_setprio(1);
#pragma unroll
            for (int m = 0; m < 4; ++m)
#pragma unroll
                for (int n = 0; n < 2; ++n)
#pragma unroll
                    for (int k = 0; k < 2; ++k) { acc[0][0][m][n] = __builtin_amdgcn_mfma_f32_16x16x32_bf16(B0[n][k], A0[m][k], acc[0][0][m][n], 0, 0, 0);
                        acc[1][0][m][n] = __builtin_amdgcn_mfma_f32_16x16x32_bf16(B0[n][k], A1[m][k], acc[1][0][m][n], 0, 0, 0); }
            __builtin_amdgcn_s_setprio(0);
            N1_BAR; __builtin_amdgcn_sched_barrier(0);
            if (t + 1 < nt && E.boundary(t + 1)) { E.fold(acc, cur, wr, wc, fr, fq, t + 1);
#pragma unroll
                for (int a = 0; a < 2; ++a)
#pragma unroll
                    for (int m = 0; m < 4; ++m)
#pragma unroll
                        for (int n = 0; n < 2; ++n) acc[a][0][m][n] = (f32x4){0.f, 0.f, 0.f, 0.f}; }
        }
        if (wr == 0) N1_BAR;
        E(acc, cur, wr, wc, fr, fq);
        if (!has_next) break;
#pragma unroll
        for (int a = 0; a < 2; ++a)
#pragma unroll
            for (int m = 0; m < 4; ++m)
#pragma unroll
                for (int n = 0; n < 2; ++n) acc[a][0][m][n] = (f32x4){0.f, 0.f, 0.f, 0.f};
        cur = nxt; cA = nA; cB = nB; ++ui;
        if (wr == 1) N1_BAR;
    }
    N1_WAIT_V(0);
    N1_BAR;
#undef N1_STAGE
#undef N1_STAGE_TILE
#undef N1_WAIT_V
#undef N1_WAIT_L0
#undef N1_BAR
}
}
#ifndef MERGE3
#define MERGE3 0
#endif
constexpr int T_ = 8192, D_ = 2048, SEQ_ = 2048, NB_ = 4, NL_ = 2, NCOL = 15640;
constexpr float DN_ALPHA = 1.41421356237309515f;
constexpr float LN_EPS_ = 1e-5f;
constexpr int MAXROWS = 90112;
constexpr size_t MiB = 1u << 20;
constexpr size_t WS_CTL = 0, CTL_ZERO_BYTES = 1048576;
constexpr size_t WS_XB = 1 * MiB, WS_HB = 33 * MiB, WS_X1 = 97 * MiB, WS_XA = 161 * MiB, WS_YM = 225 * MiB, WS_MRG = 257 * MiB, WS_MB = 321 * MiB;
constexpr size_t WS_YSM = 353 * MiB, WS_CS = 354 * MiB, WS_SEL = 356 * MiB, WS_ROWW = 357 * MiB, WS_ROWMAP = 357 * MiB + 512 * 1024;
constexpr size_t WS_WIN = 358 * MiB, WS_WP = 420 * MiB, WS_WOUT = 428 * MiB, WS_W13 = 436 * MiB, WS_W2 = 696 * MiB, WS_H = 826 * MiB, WS_XS = 914 * MiB, WS_YBUF = 1266 * MiB;
constexpr size_t WS_XS8 = WS_XS + 64 * MiB, WS_XB8 = WS_XS + 80 * MiB, WS_WIN8 = WS_XS + 96 * MiB;
constexpr size_t WS_Y = WS_YBUF;
constexpr size_t WS_GLOC = 1618 * MiB, WS_GDEC = 1634 * MiB, WS_GST = 1635 * MiB, WS_MLOC = 1643 * MiB, WS_MNLOC = 1675 * MiB, WS_MSC = 1676 * MiB, WS_MC = 1677 * MiB, WS_MN = 1693 * MiB, WS_MM = 1694 * MiB;
constexpr size_t WS_DILO = 1695 * MiB, WS_DILL = 1719 * MiB;
constexpr size_t WS_NV = 1720 * MiB;
constexpr size_t WS_W13B = 1842 * MiB, WS_W2B = 1972 * MiB;
constexpr size_t WS_END = 2037 * MiB;
constexpr int CW_CNT = 8192, CW_TST = 8448, CW_CQ = 12400, CW_ARR = 12416, CW_BAR = 16384;
constexpr int RING_BYTES = 131072, AUX_OFF = 131072, LDS_BYTES = 147456 + 16384 * MERGE3;
constexpr int AUX_BARW = LDS_BYTES - 16;

#define GAS __attribute__((address_space(1)))
#define LAS __attribute__((address_space(3)))
typedef unsigned short bf16;
typedef unsigned v4u __attribute__((ext_vector_type(4)));
typedef unsigned v2u __attribute__((ext_vector_type(2)));
typedef float f32x4 __attribute__((ext_vector_type(4)));
typedef float f32x2 __attribute__((ext_vector_type(2)));
typedef short bf16x8 __attribute__((ext_vector_type(8)));
#define LDS_WAIT() asm volatile("s_waitcnt lgkmcnt(0)" ::: "memory")
#define VM_WAIT() asm volatile("s_waitcnt vmcnt(0)" ::: "memory")
__device__ __forceinline__ unsigned pk2(float lo, float hi) { return pg8::cvt_pk_bf16(lo, hi); }
__device__ __forceinline__ float bflo(unsigned u) { return __builtin_bit_cast(float, u << 16); }
__device__ __forceinline__ float bfhi(unsigned u) { return __builtin_bit_cast(float, u & 0xffff0000u); }
__device__ __forceinline__ float fsigmoid(float x) { return 1.f / (1.f + __expf(-x)); }
__device__ __forceinline__ float wave_sum(float v) {
#pragma unroll
    for (int o = 1; o < 64; o <<= 1) v += __shfl_xor(v, o);
    return v;
}
__device__ __forceinline__ float wave_max(float v) {
#pragma unroll
    for (int o = 1; o < 64; o <<= 1) v = fmaxf(v, __shfl_xor(v, o));
    return v;
}

#define XB_TMO      128
#define XB_XCNT(j)  (256  + 64 * (j))
#define XB_XSUB(j)  (1280 + 64 * (j))
#define XB_XGEN(j)  (2304 + 64 * (j))
#define XB_TOP      3328
#define XB_TOPGEN   3392
#define XCD_BAR_WORDS 3456
#define XB_SPIN_CAP (1u << 22)
__device__ __forceinline__ unsigned xb_ld(unsigned* p)              { return __hip_atomic_load(p, __ATOMIC_RELAXED, __HIP_MEMORY_SCOPE_AGENT); }
__device__ __forceinline__ unsigned xb_add(unsigned* p, unsigned v) { return __hip_atomic_fetch_add(p, v, __ATOMIC_RELAXED, __HIP_MEMORY_SCOPE_AGENT); }
__device__ __forceinline__ unsigned xb_xcc_id() { return (unsigned)__builtin_amdgcn_s_getreg((3 << 11) | 20) & 0xFu; }
#define XB_SPIN(cond, bar) do { unsigned _sp = 0; while (cond) { __builtin_amdgcn_s_sleep(1); \
    if ((++_sp & 255u) == 0u) { if (xb_ld(&(bar)[XB_TMO])) break; if (_sp > XB_SPIN_CAP) { atomicAdd(&(bar)[XB_TMO], 1u); break; } } } } while (0)
struct XcdBarrier { unsigned* bar; unsigned x; volatile LAS unsigned* st; };
__device__ __forceinline__ XcdBarrier xcd_barrier_post(unsigned* bar, volatile LAS unsigned* st) {
    XcdBarrier b; b.bar = bar; b.x = xb_xcc_id(); b.st = st;
    if (threadIdx.x == 0) (void)xb_add(&bar[XB_XCNT(b.x)], 1u);
    return b;
}
__device__ __forceinline__ void xcd_barrier_complete(unsigned* bar, unsigned x, unsigned& nloc, unsigned& nx) {
    const unsigned G = gridDim.x * gridDim.y * gridDim.z;
    unsigned sum, cnt, mine, sp = 0u;
    for (;;) {
        sum = 0u; cnt = 0u; mine = 0u;
#pragma unroll
        for (unsigned j = 0; j < 16; ++j) { const unsigned c = xb_ld(&bar[XB_XCNT(j)]); sum += c; cnt += (c > 0u) ? 1u : 0u; mine = (j == x) ? c : mine; }
        if (sum == G) break;
        __builtin_amdgcn_s_sleep(1);
        if ((++sp & 255u) == 0u) { if (xb_ld(&bar[XB_TMO])) break; if (sp > XB_SPIN_CAP) { atomicAdd(&bar[XB_TMO], 1u); break; } }
    }
    nloc = mine > 0u ? mine : 1u; nx = cnt > 0u ? cnt : 1u;
}
__device__ __forceinline__ void xcd_barrier(const XcdBarrier& b) {
    asm volatile("s_waitcnt vmcnt(0)" ::: "memory");
    __syncthreads();
    if (threadIdx.x == 0) {
        unsigned* bar = b.bar;
        __builtin_amdgcn_s_waitcnt(0);
        unsigned nloc = b.st[0], nx = b.st[1];
        if (nloc == 0u) { xcd_barrier_complete(bar, b.x, nloc, nx); b.st[0] = nloc; b.st[1] = nx; }
        const unsigned old = xb_add(&bar[XB_XSUB(b.x)], 1u);
        const unsigned gen = old / nloc;
        if (old + 1u == (gen + 1u) * nloc) {
            __builtin_amdgcn_fence(__ATOMIC_RELEASE, "agent");
            asm volatile("s_waitcnt vmcnt(0)" ::: "memory");
            const unsigned og = xb_add(&bar[XB_TOP], 1u);
            const unsigned tg = og / nx;
            if (og + 1u == (tg + 1u) * nx) xb_add(&bar[XB_TOPGEN], 1u);
            else XB_SPIN(xb_ld(&bar[XB_TOPGEN]) == tg, bar);
            __builtin_amdgcn_fence(__ATOMIC_ACQUIRE, "agent");
            xb_add(&bar[XB_XGEN(b.x)], 1u);
            asm volatile("s_waitcnt vmcnt(0)" ::: "memory");
        } else {
            XB_SPIN(xb_ld(&bar[XB_XGEN(b.x)]) == gen, bar);
            __builtin_amdgcn_fence(__ATOMIC_ACQUIRE, "agent");
            asm volatile("s_waitcnt vmcnt(0)" ::: "memory");
        }
    }
    __syncthreads();
}
using pg8::Unit;
#ifndef STEAL_MARGIN
#define STEAL_MARGIN 8u
#endif
#ifndef FP8_GATES
#define FP8_GATES 3
#endif
#define GATES8(l) ((FP8_GATES >> (l)) & 1)
#ifndef FP8_MOE
#define FP8_MOE 3
#endif
#define MOE8(l) ((FP8_MOE >> (l)) & 1)
#define FP8_LAST MOE8(NL_ - 1)
__device__ __forceinline__ unsigned pk4_fp8(float a, float b, float c, float d) { int w = 0; w = __builtin_amdgcn_cvt_pk_fp8_f32(a, b, w, false); w = __builtin_amdgcn_cvt_pk_fp8_f32(c, d, w, true); return (unsigned)w; }
struct EpiY {
    static constexpr bool PERM = true, HAS_FOLD = false;
    bf16* Y; float* YSM; int pn0;
    __device__ __forceinline__ void operator()(const f32x4 (&acc)[2][2][4][2], const Unit& u, int wr, int wc, int fr, int fq) const {
        const int row0 = u.pm * 256 + wr * 64 + fr, pn = u.pn + pn0;
        if (pn == 29) {
            if (wc == 0) {
#pragma unroll
                for (int ai = 0; ai < 2; ++ai)
#pragma unroll
                    for (int m = 0; m < 4; ++m) { float* rp = YSM + (size_t)(row0 + ai * 128 + m * 16) * 32 + 8 * fq; *(f32x4*)rp = acc[ai][0][m][0]; *(f32x4*)(rp + 4) = acc[ai][0][m][1]; }
            }
            return;
        }
        const bool sg = pn >= 30;
#pragma unroll
        for (int ai = 0; ai < 2; ++ai)
#pragma unroll
            for (int m = 0; m < 4; ++m) { bf16* rp = Y + (size_t)(row0 + ai * 128 + m * 16) * YP + pn * 256 + wc * 32 + 8 * fq;
#pragma unroll
                for (int bj = 0; bj < 2; ++bj) { f32x4 v0 = acc[ai][bj][m][0], v1 = acc[ai][bj][m][1];
                    if (sg) {
#pragma unroll
                        for (int j = 0; j < 4; ++j) { v0[j] = fsigmoid(v0[j]); v1[j] = fsigmoid(v1[j]); } }
                    v4u w; w.x = pk2(v0[0], v0[1]); w.y = pk2(v0[2], v0[3]); w.z = pk2(v1[0], v1[1]); w.w = pk2(v1[2], v1[3]);
                    *(v4u*)(rp + bj * 128) = w; } }
    }
};
struct EpiMerge {
    static constexpr bool PERM = false, HAS_FOLD = true;
    const bf16* Y; bf16* MB; mutable f32x4 tot[2][4][2];
    __device__ __forceinline__ bool boundary(int kt) const { return kt == 8 || kt == 12 || kt == 24; }
    __device__ __forceinline__ void fold(const f32x4 (&acc)[2][1][4][2], const Unit& u, int wr, int wc, int fr, int fq, int kt) const {
        const int br = kt == 8 ? 0 : (kt == 12 ? 1 : (kt == 24 ? 2 : 3));
        int zv = 0; asm volatile("" : "+v"(zv));
        const int row0 = u.pm * 256 + wr * 64 + fr + zv, col0 = u.pn * 128 + wc * 32 + 4 * fq;
        v2u gp[2][4][2];
#pragma unroll
        for (int ai = 0; ai < 2; ++ai)
#pragma unroll
            for (int m = 0; m < 4; ++m)
#pragma unroll
                for (int n = 0; n < 2; ++n) gp[ai][m][n] = *(const v2u*)(Y + (size_t)(row0 + ai * 128 + m * 16) * YP + Y_G + br * 2048 + col0 + n * 16);
#pragma unroll
        for (int ai = 0; ai < 2; ++ai)
#pragma unroll
            for (int m = 0; m < 4; ++m)
#pragma unroll
                for (int n = 0; n < 2; ++n) { f32x4 v = acc[ai][0][m][n]; const v2u g2 = gp[ai][m][n]; v[0] *= bflo(g2.x); v[1] *= bfhi(g2.x); v[2] *= bflo(g2.y); v[3] *= bfhi(g2.y);
                    v = br > 0 ? v + tot[ai][m][n] : v;
                    if (br < 3) tot[ai][m][n] = v;
                    else { v2u o; o.x = pk2(v[0], v[1]); o.y = pk2(v[2], v[3]); *(v2u*)(MB + (size_t)(row0 + ai * 128 + m * 16) * 2048 + col0 + n * 16) = o; } }
    }
    __device__ __forceinline__ void operator()(const f32x4 (&acc)[2][1][4][2], const Unit& u, int wr, int wc, int fr, int fq) const { fold(acc, u, wr, wc, fr, fq, 32); }
};
struct EpiOut {
    static constexpr bool PERM = false, HAS_FOLD = false;
    const float* X; float* HB;
    __device__ __forceinline__ void operator()(const f32x4 (&acc)[2][2][4][2], const Unit& u, int wr, int wc, int fr, int fq) const {
        const int row0 = u.pm * 256 + wr * 64 + fr, col0 = u.pn * 256 + wc * 32 + 4 * fq;
#pragma unroll
        for (int ai = 0; ai < 2; ++ai)
#pragma unroll
            for (int m = 0; m < 4; ++m) { const size_t off = (size_t)(row0 + ai * 128 + m * 16) * 2048 + col0;
#pragma unroll
                for (int bj = 0; bj < 2; ++bj)
#pragma unroll
                    for (int n = 0; n < 2; ++n) { const f32x4 xv = *(const f32x4*)(X + off + bj * 128 + n * 16); *(f32x4*)(HB + off + bj * 128 + n * 16) = xv * DN_ALPHA + acc[ai][bj][m][n]; } }
    }
};
struct EpiMoe1 {
    static constexpr bool PERM = true, HAS_FOLD = false;
    bf16* H; const float* ROWW; int NJ;
    __device__ __forceinline__ void operator()(const f32x4 (&acc)[2][2][4][2], const Unit& u, int wr, int wc, int fr, int fq) const {
        const int row0 = u.pm * 256 + wr * 64 + fr, col0 = (u.pn & 3) * 128 + wc * 32 + 8 * fq;
#pragma unroll
        for (int ai = 0; ai < 2; ++ai)
#pragma unroll
            for (int m = 0; m < 4; ++m) { const size_t row = (size_t)(row0 + ai * 128 + m * 16); const float rw = ROWW[row];
                float h[8];
#pragma unroll
                for (int n = 0; n < 2; ++n)
#pragma unroll
                    for (int j = 0; j < 4; ++j) { const float a = acc[ai][0][m][n][j], b = acc[ai][1][m][n][j]; h[n * 4 + j] = a * fsigmoid(a) * b * rw; }
                v4u w; w.x = pk2(h[0], h[1]); w.y = pk2(h[2], h[3]); w.z = pk2(h[4], h[5]); w.w = pk2(h[6], h[7]);
                *(v4u*)(H + row * 512 + col0) = w; }
    }
};
struct EpiMoe2 {
    static constexpr bool PERM = true, HAS_FOLD = false;
    bf16* YB;
    __device__ __forceinline__ void operator()(const f32x4 (&acc)[2][2][4][2], const Unit& u, int wr, int wc, int fr, int fq) const {
        const int row0 = u.pm * 256 + wr * 64 + fr, col0 = (u.pn & 7) * 256 + wc * 32 + 8 * fq;
#pragma unroll
        for (int ai = 0; ai < 2; ++ai)
#pragma unroll
            for (int m = 0; m < 4; ++m) { bf16* rp = YB + (size_t)(row0 + ai * 128 + m * 16) * 2048 + col0;
#pragma unroll
                for (int bj = 0; bj < 2; ++bj) { const f32x4 v0 = acc[ai][bj][m][0], v1 = acc[ai][bj][m][1];
                    v4u w; w.x = pk2(v0[0], v0[1]); w.y = pk2(v0[2], v0[3]); w.z = pk2(v1[0], v1[1]); w.w = pk2(v1[2], v1[3]);
                    *(v4u*)(rp + bj * 128) = w; } }
    }
};
struct EpiMoe1F8 {
    static constexpr bool PERM = true, HAS_FOLD = false;
    unsigned char* H; const float* ROWW;
    __device__ __forceinline__ void operator()(const f32x4 (&acc)[2][2][4][2], const Unit& u, int wr, int wc, int fr, int fq) const {
        const int row0 = u.pm * 256 + wr * 64 + fr, col0 = (u.pn & 3) * 128 + wc * 32 + 8 * fq;
#pragma unroll
        for (int ai = 0; ai < 2; ++ai)
#pragma unroll
            for (int m = 0; m < 4; ++m) { const size_t row = (size_t)(row0 + ai * 128 + m * 16); const float rw = ROWW[row];
                float h[8];
#pragma unroll
                for (int n = 0; n < 2; ++n)
#pragma unroll
                    for (int j = 0; j < 4; ++j) { const float a = acc[ai][0][m][n][j], b = acc[ai][1][m][n][j]; h[n * 4 + j] = a * fsigmoid(a) * b * rw; }
                v2u w; w.x = pk4_fp8(h[0], h[1], h[2], h[3]); w.y = pk4_fp8(h[4], h[5], h[6], h[7]);
                *(v2u*)(H + row * 512 + col0) = w; }
    }
};
struct MoeOrder {
    int NJ, G, c, total, upm, upn;
    __device__ __forceinline__ void init(const int* tst, int NJ_, int G_, int c_, int lane) { NJ = NJ_; G = G_; c = c_; total = tst[65] * NJ_;
        const long L = (long)lane * G + c; upm = 0; upn = 0;
        if (L < total) { const int mt = (int)(L / NJ), j = (int)(L % NJ); int e = 0;
            for (int k = 1; k <= 64; ++k) e += (mt >= tst[k]) ? 1 : 0;
            upm = mt; upn = e * NJ + j; } }
    __device__ __forceinline__ bool next(int i, Unit& u) const {
        if ((long)i * G + c >= total || i >= 64) return false;
        const int iu = __builtin_amdgcn_readfirstlane(i);
        u.pm = __builtin_amdgcn_readlane(upm, iu); u.pn = __builtin_amdgcn_readlane(upn, iu); return true;
    }
    __device__ __forceinline__ void a_ready(const Unit&) const {}
    __device__ __forceinline__ void done(const Unit&) const {}
};

struct KArgs { const float* in[32]; float* out; unsigned char* ws; int ph_lo, ph_hi, region, pad; };
struct Ctx {
    LAS unsigned char* lds; unsigned char* ws; const float* in[32]; float* out;
    int tid, lane, wave, G, bid;
};
#define WSP(T, off) ((T*)(C.ws + (off)))

#ifndef CV_NTS
#define CV_NTS 0
#endif
#ifndef CV_NT
#define CV_NT 1
#endif
#if CV_NT
#define CV_LOAD(p) __builtin_nontemporal_load(p)
#else
#define CV_LOAD(p) (*(p))
#endif
struct CvDesc { const float* sp; bf16* dp; int ldw, ldt, zero, w13, f8; };
__device__ __forceinline__ CvDesc cv_desc(const float* W, int ldw, int srccol, int k0, bf16* WT, size_t drow0, int ldt, int w13, int tid, int f8 = 0) {
    CvDesc d; d.zero = srccol < 0; d.ldw = ldw; d.ldt = ldt; d.w13 = w13; d.f8 = f8;
    d.sp = W + (size_t)(k0 + (tid >> 6)) * ldw + (srccol < 0 ? 0 : srccol);
    d.dp = f8 ? (bf16*)((unsigned char*)WT + drow0 * (size_t)ldt + k0) : WT + drow0 * (size_t)ldt + k0; return d;
}
__device__ __forceinline__ CvDesc conv_item(Ctx& C, int l, int r, int tid) {
    constexpr int I_WIN = 16 * 62, I_W13 = 65 * 64, I_W2 = 65 * 32, I_PA = 4 * 8, I_PB = 2 * 8, I_PC = 6 * 8, I_PD = 4 * 8;
    const bool f8l = MOE8(l), lastb = MOE8(l) && l == NL_ - 1;
    bf16* WIN = WSP(bf16, WS_WIN); bf16* W13 = lastb ? WSP(bf16, WS_W13B) : WSP(bf16, WS_W13); bf16* W2 = lastb ? WSP(bf16, WS_W2B) : WSP(bf16, WS_W2); bf16* WP = WSP(bf16, WS_WP); bf16* WOUT = WSP(bf16, WS_WOUT);
    const int c4 = 4 * (tid & 63);
    if (r < I_WIN) { const int nb = r % 62, kb = r / 62, n = 256 * nb + c4; int sc;
        if (n < 1536) sc = n; else if (n < 7424) sc = n + 16; else if (n < 7680) { const int i = n - 7424; sc = i < 16 ? 1536 + i : (i < 24 ? 7440 + (i - 16) : -1); } else sc = n - 7680 + 7448;
        if (GATES8(l) && nb >= 30) return cv_desc(C.in[2] + (size_t)l * 2048 * NCOL, NCOL, sc, 128 * kb, WSP(bf16, WS_WIN8), 256 * (nb - 30), 2048, 0, tid, 1);
        return cv_desc(C.in[2] + (size_t)l * 2048 * NCOL, NCOL, sc, 128 * kb, WIN, 256 * nb, 2048, 0, tid); }
    r -= I_WIN;
    if (r < I_W13) { const int e = r / 64, q = r % 64, half = q >> 5, kb = (q >> 1) & 15, nq = q & 1;
        const float* src = e == 0 ? (half ? C.in[28] : C.in[27]) + (size_t)l * 2048 * 512 : (half ? C.in[25] : C.in[24]) + (size_t)(l * 64 + e - 1) * 2048 * 512;
        return cv_desc(src, 512, 256 * nq + c4, 128 * kb, W13, (size_t)e * 1024 + nq * 512 + half * 128, 2048, 1, tid, f8l ? 1 : 0); }
    r -= I_W13;
    if (r < I_W2) { const int e = r / 32, q = r % 32, kb = q / 8, nb = q % 8;
        const float* src = e == 0 ? C.in[29] + (size_t)l * 512 * 2048 : C.in[26] + (size_t)(l * 64 + e - 1) * 512 * 2048;
        return cv_desc(src, 2048, 256 * nb + c4, 128 * kb, W2, (size_t)e * 2048 + 256 * nb, 512, 0, tid, f8l ? 1 : 0); }
    r -= I_W2;
    if (r < I_PA) return cv_desc(C.in[15] + (size_t)l * 512 * 2048, 2048, 256 * (r % 8) + c4, 128 * (r / 8), WP, 256 * (r % 8), 2048, 0, tid);
    r -= I_PA;
    if (r < I_PB) return cv_desc(C.in[16] + (size_t)l * 256 * 2048, 2048, 256 * (r % 8) + c4, 128 * (r / 8), WP + 512, 256 * (r % 8), 2048, 0, tid);
    r -= I_PB;
    if (r < I_PC) return cv_desc(C.in[17] + (size_t)l * 768 * 2048, 2048, 256 * (r % 8) + c4, 128 * (r / 8), WP + 768, 256 * (r % 8), 2048, 0, tid);
    r -= I_PC;
    if (r < I_PD) return cv_desc(C.in[18] + (size_t)l * 512 * 2048, 2048, 256 * (r % 8) + c4, 128 * (r / 8), WP + 1536, 256 * (r % 8), 2048, 0, tid);
    r -= I_PD;
    return cv_desc(C.in[19] + (size_t)l * 2048 * 2048, 2048, 256 * (r % 8) + c4, 128 * (r / 8), WOUT, 256 * (r % 8), 2048, 0, tid);
}
__device__ __forceinline__ void phase_convert(Ctx& C, int l, int part, int cbid, int cG, unsigned* arr = nullptr) {
    LAS float* tile = (LAS float*)C.lds; LAS int* qn = (LAS int*)(C.lds + AUX_OFF + 8192);
    unsigned* cq = WSP(unsigned, WS_CTL) + CW_CQ + l * 2 + part;
    const int tid = C.tid, lane = C.lane, wave = C.wave;
    constexpr int I_WIN = 16 * 62, NITEMS = I_WIN + 65 * 64 + 65 * 32 + (4 + 2 + 6 + 4) * 8 + 16 * 8;
    const int it0 = part == 0 ? 0 : I_WIN, it1 = part == 0 ? I_WIN : NITEMS;
    __syncthreads();
    if (tid == 0) qn[0] = (arr && __hip_atomic_load(arr, __ATOMIC_RELAXED, __HIP_MEMORY_SCOPE_AGENT) + STEAL_MARGIN >= (unsigned)C.G) ? 0x7fffffff : it0 + (int)atomicAdd(cq, 1u);
    __syncthreads();
    int it = qn[0];
    f32x4 va[16];
    CvDesc d = conv_item(C, l, it < it1 ? it : it0, tid);
    if (it < it1) {
#pragma unroll
        for (int i = 0; i < 16; ++i) va[i] = d.zero ? (f32x4){0.f, 0.f, 0.f, 0.f} : CV_LOAD((const f32x4*)(d.sp + (size_t)(8 * i) * d.ldw)); }
    const int c16 = lane & 15, nsub = lane >> 4;
    while (it < it1) {
#pragma unroll
        for (int i = 0; i < 16; ++i) { const int kk = wave + 8 * i; *(LAS f32x4*)(tile + kk * 256 + ((4 * (tid & 63)) ^ (4 * ((kk >> 3) & 7)))) = va[i]; }
        if (tid == 0) qn[1] = (arr && __hip_atomic_load(arr, __ATOMIC_RELAXED, __HIP_MEMORY_SCOPE_AGENT) + STEAL_MARGIN >= (unsigned)C.G) ? 0x7fffffff : it0 + (int)atomicAdd(cq, 1u);
        __syncthreads();
        const int nx = qn[1]; const bool hn = nx < it1;
        const CvDesc dn = conv_item(C, l, hn ? nx : it, tid);
        if (hn) {
#pragma unroll
            for (int i = 0; i < 16; ++i) va[i] = dn.zero ? (f32x4){0.f, 0.f, 0.f, 0.f} : CV_LOAD((const f32x4*)(dn.sp + (size_t)(8 * i) * dn.ldw)); }
#pragma unroll
        for (int p = 0; p < 8; ++p) { const int n = p * 32 + wave * 4 + nsub; const LAS float* s = tile + (8 * c16) * 256 + (n ^ (4 * (c16 & 7)));
            const int drow = d.w13 ? ((n >> 7) << 8) + (n & 127) : n;
            if (d.f8) { v2u o8; o8.x = pk4_fp8(s[0 * 256] * 32.f, s[1 * 256] * 32.f, s[2 * 256] * 32.f, s[3 * 256] * 32.f); o8.y = pk4_fp8(s[4 * 256] * 32.f, s[5 * 256] * 32.f, s[6 * 256] * 32.f, s[7 * 256] * 32.f);
                if (CV_NTS && part == 1) __builtin_nontemporal_store(o8, (v2u*)((unsigned char*)d.dp + (size_t)drow * d.ldt + 8 * c16)); else *(v2u*)((unsigned char*)d.dp + (size_t)drow * d.ldt + 8 * c16) = o8; }
            else { v4u o; o.x = pk2(s[0 * 256], s[1 * 256]); o.y = pk2(s[2 * 256], s[3 * 256]); o.z = pk2(s[4 * 256], s[5 * 256]); o.w = pk2(s[6 * 256], s[7 * 256]);
                if (CV_NTS && part == 1) __builtin_nontemporal_store(o, (v4u*)(d.dp + (size_t)drow * d.ldt + 8 * c16)); else *(v4u*)(d.dp + (size_t)drow * d.ldt + 8 * c16) = o; } }
        __syncthreads();
        d = dn; it = nx;
    }
    if (l == 0 && part == 0) {
        const int gw = cbid * 8 + C.wave, NGW = cG * 8;
        bf16* XB = WSP(bf16, WS_XB); const float* X = C.in[0];
        for (int t = gw; t < T_; t += NGW) {
#pragma unroll
            for (int j = 0; j < 8; ++j) { const f32x4 v = *(const f32x4*)(X + (size_t)t * 2048 + 4 * (lane + 64 * j)); v2u o; o.x = pk2(v[0], v[1]); o.y = pk2(v[2], v[3]); *(v2u*)(XB + (size_t)t * 2048 + 4 * (lane + 64 * j)) = o;
                if (GATES8(0)) *(unsigned*)(WSP(unsigned char, WS_XB8) + (size_t)t * 2048 + 4 * (lane + 64 * j)) = pk4_fp8(v[0], v[1], v[2], v[3]); }
        }
        f32x2* CS = WSP(f32x2, WS_CS); const int* pos = (const int*)C.in[1];
        for (int i = C.bid * 512 + C.tid; i < T_ * 32; i += C.G * 512) { const int t = i >> 5, f = i & 31;
            const float inv = powf(10000.0f, -(float)f * 2.0f / 64.0f), ang = (float)pos[t] * inv; float sn, cs; sincosf(ang, &sn, &cs); CS[i] = (f32x2){cs, sn}; }
    }
}
__device__ __forceinline__ void ln_row(f32x4 (&v)[8], const float* g, const float* b, int lane) {
    float s = 0.f;
#pragma unroll
    for (int j = 0; j < 8; ++j) s += (v[j][0] + v[j][1]) + (v[j][2] + v[j][3]);
    const float mean = wave_sum(s) * (1.f / 2048.f); float q = 0.f;
#pragma unroll
    for (int j = 0; j < 8; ++j) { v[j] = v[j] - mean; q += (v[j][0] * v[j][0] + v[j][1] * v[j][1]) + (v[j][2] * v[j][2] + v[j][3] * v[j][3]); }
    const float rstd = 1.f / sqrtf(wave_sum(q) * (1.f / 2048.f) + LN_EPS_);
#pragma unroll
    for (int j = 0; j < 8; ++j) { const f32x4 gv = *(const f32x4*)(g + 4 * (lane + 64 * j)), bv = *(const f32x4*)(b + 4 * (lane + 64 * j)); v[j] = v[j] * rstd * gv + bv; }
}
__device__ __forceinline__ void phase_ln1_router(Ctx& C, int l) {
    const float* HB = WSP(float, WS_HB); float* X1 = WSP(float, WS_X1); bf16* XS = WSP(bf16, WS_XS); float* ROWW = WSP(float, WS_ROWW);
    int* sel_e = WSP(int, WS_SEL); float* sel_w = WSP(float, WS_SEL + 262144); int* sel_r = WSP(int, WS_SEL + 2 * 262144);
    unsigned* cnt = WSP(unsigned, WS_CTL) + CW_CNT + l * 64;
    const float* g = C.in[20] + l * 2048; const float* b = C.in[21] + l * 2048; const float* wrt = C.in[22] + (size_t)l * 2048 * 64; const float* rb = C.in[23] + l * 64;
    constexpr int XP = 2068;
    LAS float* xl = (LAS float*)C.lds; LAS float* part = xl + 16 * XP; LAS float* scl = part + 2048;
    const int lane = C.lane, wave = C.wave;
    for (int unit = C.bid; unit < T_ / 16; unit += C.G) {
        const int t0 = unit * 16;
#pragma unroll 1
        for (int rr = 0; rr < 2; ++rr) { const int row = 2 * wave + rr; const size_t t = (size_t)(t0 + row);
            f32x4 v[8];
#pragma unroll
            for (int j = 0; j < 8; ++j) v[j] = *(const f32x4*)(HB + t * 2048 + 4 * (lane + 64 * j));
            ln_row(v, g, b, lane);
#pragma unroll
            for (int j = 0; j < 8; ++j) { *(f32x4*)(X1 + t * 2048 + 4 * (lane + 64 * j)) = v[j];
                if (MOE8(l)) *(unsigned*)(WSP(unsigned char, WS_XS8) + t * 2048 + 4 * (lane + 64 * j)) = pk4_fp8(v[j][0], v[j][1], v[j][2], v[j][3]);
                else { v2u o; o.x = pk2(v[j][0], v[j][1]); o.y = pk2(v[j][2], v[j][3]); *(v2u*)(XS + t * 2048 + 4 * (lane + 64 * j)) = o; }
                *(LAS f32x4*)(xl + row * XP + 4 * (lane + 64 * j)) = v[j]; }
        }
        if (C.tid < 16) { ROWW[t0 + C.tid] = 1.0f; WSP(int, WS_ROWMAP)[t0 + C.tid] = t0 + C.tid; }
        __syncthreads();
        {
            const int et = wave & 3, kh = wave >> 2, i = lane & 15, h = lane >> 4; f32x4 acc = (f32x4){0.f, 0.f, 0.f, 0.f};
            const LAS float* xr = xl + i * XP + kh * 1024 + 4 * h; const float* wb = wrt + (size_t)(kh * 1024 + 4 * h) * 64 + 16 * et + i;
#pragma unroll 4
            for (int s = 0; s < 64; ++s) { const f32x4 a = *(const LAS f32x4*)(xr + 16 * s); const float* wp = wb + (size_t)(16 * s) * 64;
                const float b0 = wp[0], b1 = wp[64], b2 = wp[128], b3 = wp[192];
                acc = __builtin_amdgcn_mfma_f32_16x16x4f32(a[0], b0, acc, 0, 0, 0); acc = __builtin_amdgcn_mfma_f32_16x16x4f32(a[1], b1, acc, 0, 0, 0);
                acc = __builtin_amdgcn_mfma_f32_16x16x4f32(a[2], b2, acc, 0, 0, 0); acc = __builtin_amdgcn_mfma_f32_16x16x4f32(a[3], b3, acc, 0, 0, 0); }
#pragma unroll
            for (int r = 0; r < 4; ++r) part[kh * 1024 + (4 * h + r) * 64 + 16 * et + i] = acc[r];
        }
        __syncthreads();
#pragma unroll
        for (int k = 0; k < 2; ++k) { const int idx = C.tid + 512 * k; scl[idx] = 1.f / (1.f + expf(-(part[idx] + part[1024 + idx]))); }
        __syncthreads();
#pragma unroll 1
        for (int rr = 0; rr < 2; ++rr) { const int tok = 2 * wave + rr, t = t0 + tok; const float* sp = (const float*)(scl + tok * 64);
            const bool sel = route_lane_select(lane, sp, rb); const float s = scl[tok * 64 + lane];
            const unsigned long long m0_ = __ballot(sel); const bool sel8 = sel && __popcll(m0_ & ((1ull << lane) - 1ull)) < 8;
            const float wsum = wave_sum(sel8 ? s : 0.f); const unsigned long long m = __ballot(sel8);
            if (sel8) { const int k = __popcll(m & ((1ull << lane) - 1ull)); sel_e[t * 8 + k] = lane; sel_w[t * 8 + k] = s * 2.5f / wsum; sel_r[t * 8 + k] = (int)atomicAdd(cnt + lane, 1u); } }
        __syncthreads();
    }
}
__device__ __forceinline__ void phase_scatter(Ctx& C, int l) {
    float* ROWW = WSP(float, WS_ROWW); int* ROWMAP = WSP(int, WS_ROWMAP);
    const int* sel_e = WSP(int, WS_SEL); const float* sel_w = WSP(float, WS_SEL + 262144); const int* sel_r = WSP(int, WS_SEL + 2 * 262144); int* POS = WSP(int, WS_SEL + 3 * 262144);
    const unsigned* cnt = WSP(unsigned, WS_CTL) + CW_CNT + l * 64; int* tst = WSP(int, WS_CTL) + CW_TST + l * 128;
    LAS int* offl = (LAS int*)(C.lds + AUX_OFF + 4096);
    if (C.tid == 0) { int ts = 0;
        for (int k = 0; k <= 65; ++k) { if (C.bid == 0) tst[k] = ts; if (k >= 1 && k <= 64) offl[k - 1] = ts * 256; ts += (k == 0) ? 32 : (k <= 64 ? (((int)cnt[k - 1] + 255) >> 8) : 0); } }
    __syncthreads();
    for (int p = C.bid * 512 + C.tid; p < T_ * 8; p += C.G * 512) { const int e = sel_e[p], pos = offl[e] + sel_r[p]; ROWMAP[pos] = p >> 3; ROWW[pos] = sel_w[p]; POS[p] = pos; }
    for (int e = C.bid; e < 64; e += C.G) { const int c = (int)cnt[e], beg = offl[e] + c, end = offl[e] + ((c + 255) & ~255);
        for (int pos = beg + C.tid; pos < end; pos += 512) { ROWMAP[pos] = 0; ROWW[pos] = 0.f; } }
}
__device__ __forceinline__ void phase_combine(Ctx& C, int l) {
    const bf16* YB = WSP(bf16, WS_YBUF); const float* X1 = WSP(float, WS_X1); const int* POS = WSP(int, WS_SEL + 3 * 262144);
    float* XO = (l == NL_ - 1) ? C.out : WSP(float, WS_XA); bf16* XB = WSP(bf16, WS_XB);
    const float* g = C.in[30] + l * 2048; const float* b = C.in[31] + l * 2048;
    const int gw = C.bid * 8 + C.wave, NGW = C.G * 8, lane = C.lane;
    int pn[8];
#pragma unroll
    for (int k = 0; k < 8; ++k) pn[k] = gw < T_ ? POS[gw * 8 + k] : 0;
    for (int t = gw; t < T_; t += NGW) {
        size_t rows[9]; rows[0] = (size_t)t;
#pragma unroll
        for (int k = 0; k < 8; ++k) rows[k + 1] = (size_t)pn[k];
        { const int tn = t + NGW < T_ ? t + NGW : t;
#pragma unroll
          for (int k = 0; k < 8; ++k) pn[k] = POS[tn * 8 + k]; }
        v4u w[9][4];
#pragma unroll
        for (int k = 0; k < 9; ++k)
#pragma unroll
            for (int j = 0; j < 4; ++j) w[k][j] = __builtin_nontemporal_load((const v4u*)(YB + rows[k] * 2048 + 8 * lane + 512 * j));
        float v[4][8];
#pragma unroll
        for (int j = 0; j < 4; ++j) { const f32x4 a = *(const f32x4*)(X1 + (size_t)t * 2048 + 8 * lane + 512 * j), c = *(const f32x4*)(X1 + (size_t)t * 2048 + 8 * lane + 512 * j + 4);
            v[j][0] = a[0] * DN_ALPHA; v[j][1] = a[1] * DN_ALPHA; v[j][2] = a[2] * DN_ALPHA; v[j][3] = a[3] * DN_ALPHA; v[j][4] = c[0] * DN_ALPHA; v[j][5] = c[1] * DN_ALPHA; v[j][6] = c[2] * DN_ALPHA; v[j][7] = c[3] * DN_ALPHA; }
#pragma unroll
        for (int k = 0; k < 9; ++k)
#pragma unroll
            for (int j = 0; j < 4; ++j) { v[j][0] += bflo(w[k][j].x); v[j][1] += bfhi(w[k][j].x); v[j][2] += bflo(w[k][j].y); v[j][3] += bfhi(w[k][j].y); v[j][4] += bflo(w[k][j].z); v[j][5] += bfhi(w[k][j].z); v[j][6] += bflo(w[k][j].w); v[j][7] += bfhi(w[k][j].w); }
        float s = 0.f;
#pragma unroll
        for (int j = 0; j < 4; ++j)
#pragma unroll
            for (int e = 0; e < 8; ++e) s += v[j][e];
        const float mean = wave_sum(s) * (1.f / 2048.f); float q = 0.f;
#pragma unroll
        for (int j = 0; j < 4; ++j)
#pragma unroll
            for (int e = 0; e < 8; ++e) { v[j][e] -= mean; q += v[j][e] * v[j][e]; }
        const float rstd = 1.f / sqrtf(wave_sum(q) * (1.f / 2048.f) + LN_EPS_);
#pragma unroll
        for (int j = 0; j < 4; ++j) { const int c0 = 8 * lane + 512 * j; float o[8];
            const f32x4 g0 = *(const f32x4*)(g + c0), g1 = *(const f32x4*)(g + c0 + 4), b0 = *(const f32x4*)(b + c0), b1 = *(const f32x4*)(b + c0 + 4);
#pragma unroll
            for (int e = 0; e < 4; ++e) { o[e] = v[j][e] * rstd * g0[e] + b0[e]; o[4 + e] = v[j][4 + e] * rstd * g1[e] + b1[e]; }
            *(f32x4*)(XO + (size_t)t * 2048 + c0) = (f32x4){o[0], o[1], o[2], o[3]}; *(f32x4*)(XO + (size_t)t * 2048 + c0 + 4) = (f32x4){o[4], o[5], o[6], o[7]};
            if (l < NL_ - 1) { v4u ow; ow.x = pk2(o[0], o[1]); ow.y = pk2(o[2], o[3]); ow.z = pk2(o[4], o[5]); ow.w = pk2(o[6], o[7]); *(v4u*)(XB + (size_t)t * 2048 + c0) = ow;
                if (GATES8(l + 1)) { v2u o8; o8.x = pk4_fp8(o[0], o[1], o[2], o[3]); o8.y = pk4_fp8(o[4], o[5], o[6], o[7]); *(v2u*)(WSP(unsigned char, WS_XB8) + (size_t)t * 2048 + c0) = o8; } } }
    }
}
typedef LAS unsigned char* ldsp;
__device__ __forceinline__ f32x4 mfma16(bf16x8 bt, bf16x8 a, f32x4 c) { return __builtin_amdgcn_mfma_f32_16x16x32_bf16(bt, a, c, 0, 0, 0); }
__device__ __forceinline__ bf16x8 frag(ldsp base, int pitch, int row, int k0, int fq) { return *(const LAS bf16x8*)(base + row * pitch + (k0 + 8 * fq) * 2); }
__device__ __forceinline__ bf16x8 frag2(ldsp base, int pitch, int row, int kA, int kB, int fq) {
    const v2u a = *(const LAS v2u*)(base + row * pitch + (kA + 4 * fq) * 2), b = *(const LAS v2u*)(base + row * pitch + (kB + 4 * fq) * 2);
    v4u r; r.x = a.x; r.y = a.y; r.z = b.x; r.w = b.y; return __builtin_bit_cast(bf16x8, r);
}
typedef short v4i16_t __attribute__((ext_vector_type(4)));
__device__ __forceinline__ bf16x8 trfrag2(ldsp base, int pitch, int col0, int kA, int kB, int lane) {
    const int q = (lane & 15) >> 2, p = lane & 3, fq = lane >> 4;
    const v4i16_t x = __builtin_amdgcn_ds_read_tr16_b64_v4i16((LAS v4i16_t*)(base + (kA + 4 * fq + q) * pitch + (col0 + 4 * p) * 2));
    const v4i16_t y = __builtin_amdgcn_ds_read_tr16_b64_v4i16((LAS v4i16_t*)(base + (kB + 4 * fq + q) * pitch + (col0 + 4 * p) * 2));
    bf16x8 r; r[0] = x[0]; r[1] = x[1]; r[2] = x[2]; r[3] = x[3]; r[4] = y[0]; r[5] = y[1]; r[6] = y[2]; r[7] = y[3]; return r;
}
__device__ __forceinline__ bf16x8 trfrag(ldsp base, int pitch, int col0, int k0, int lane) { const int fq = lane >> 4; return trfrag2(base, pitch, col0, k0 + 4 * fq, k0 + 4 * fq + 4, lane); }
__device__ __forceinline__ bf16x8 pfrag(const f32x4& p0, const f32x4& p1) { v4u r; r.x = pk2(p0[0], p0[1]); r.y = pk2(p0[2], p0[3]); r.z = pk2(p1[0], p1[1]); r.w = pk2(p1[2], p1[3]); return __builtin_bit_cast(bf16x8, r); }
__device__ __forceinline__ void unpack8(const v4u w, float (&f)[8]) { f[0] = bflo(w.x); f[1] = bfhi(w.x); f[2] = bflo(w.y); f[3] = bfhi(w.y); f[4] = bflo(w.z); f[5] = bfhi(w.z); f[6] = bflo(w.w); f[7] = bfhi(w.w); }
__device__ __forceinline__ unsigned short bf1(float x) { return (unsigned short)(pk2(x, 0.f) & 0xffffu); }
__device__ __forceinline__ float flogsigmoid(float x) { return fminf(x, 0.f) - log1pf(__expf(-fabsf(x))); }
__device__ __forceinline__ float fgelu(float v) {
    const float av = fabsf(v), t = __builtin_amdgcn_rcpf(av * 0.2316418882f + 1.0f);
    float q = t * 0.5307027145f + (-0.7265760135f); q = q * t + 0.7107068705f; q = q * t + (-0.142248368f); q = q * t + 0.127414796f; q = q * t;
    const float e = __builtin_amdgcn_exp2f((v * v) * (-0.72134752044f)), m = v * (q * e);
    return v < 0.f ? m : v - m;
}

__device__ __forceinline__ void scat8(LAS unsigned short* vp, int ps  , const v4u w) {
    vp[0 * ps] = (unsigned short)(w.x & 0xffff); vp[1 * ps] = (unsigned short)(w.x >> 16); vp[2 * ps] = (unsigned short)(w.y & 0xffff); vp[3 * ps] = (unsigned short)(w.y >> 16);
    vp[4 * ps] = (unsigned short)(w.z & 0xffff); vp[5 * ps] = (unsigned short)(w.z >> 16); vp[6 * ps] = (unsigned short)(w.w & 0xffff); vp[7 * ps] = (unsigned short)(w.w >> 16);
}

__device__ __forceinline__ void dil_unit(Ctx& C, int u) {
    const int tid = C.tid, lane = C.lane, wave = C.wave, fr = lane & 15, fq = lane >> 4;
    const int blk16 = u & 15, hh = (u >> 4) & 3, g = (u >> 6) % 3, b = u / 192;
    const int dil = g == 0 ? 1 : (g == 1 ? 4 : 16), nbpr = 16 / dil  , r = blk16 / nbpr, nb = blk16 % nbpr, head = g * 4 + hh;
    const bf16* Y = WSP(bf16, WS_Y); const f32x2* CS = WSP(f32x2, WS_CS);
    constexpr int QP = 144, KP = 144, VP = 160;
    ldsp Ql = C.lds, Kl = C.lds + 128 * QP, Vl = Kl + 256 * KP;
    const size_t tb = (size_t)b * SEQ_;
    {   const int ch = tid & 3, row0 = tid >> 2; v4u xa[3], xb[3]; f32x4 cs[3][4]; int mrow[3];
#pragma unroll
        for (int i = 0; i < 3; ++i) { const int row = row0 + (i == 2 ? 128 : 0), m = (i == 0) ? nb * 128 + row : (nb - 1) * 128 + row, mc = m < 0 ? 0 : m; const size_t t = tb + (size_t)mc * dil + r;
            const bf16* src = Y + t * YP + (i == 0 ? Y_BQ : Y_BK) + head * 64 + 8 * ch; xa[i] = *(const v4u*)src; xb[i] = *(const v4u*)(src + 32);
            const f32x4* cp = (const f32x4*)(CS + t * 32 + 8 * ch); cs[i][0] = cp[0]; cs[i][1] = cp[1]; cs[i][2] = cp[2]; cs[i][3] = cp[3]; mrow[i] = m; }
        const int ch8 = tid & 7, key0 = tid >> 3; v4u vv[4];
#pragma unroll
        for (int i = 0; i < 4; ++i) { const int m = (nb - 1) * 128 + key0 + 64 * i, mc = m < 0 ? 0 : m; vv[i] = *(const v4u*)(Y + (tb + (size_t)mc * dil + r) * YP + Y_BV + head * 64 + 8 * ch8); }
#pragma unroll
        for (int i = 0; i < 3; ++i) { const int row = row0 + (i == 2 ? 128 : 0); ldsp dst = (i == 0) ? Ql + row * QP : Kl + row * KP;
            float x1[8], x2[8]; unpack8(xa[i], x1); unpack8(xb[i], x2); const float sc = (i == 0) ? 0.125f : (mrow[i] < 0 ? 0.f : 1.f); float y1[8], y2[8];
#pragma unroll
            for (int k = 0; k < 8; ++k) { const float c = cs[i][k >> 1][2 * (k & 1)], sn = cs[i][k >> 1][2 * (k & 1) + 1]; y1[k] = (x1[k] * c - x2[k] * sn) * sc; y2[k] = (x2[k] * c + x1[k] * sn) * sc; }
            v4u o1, o2; o1.x = pk2(y1[0], y1[1]); o1.y = pk2(y1[2], y1[3]); o1.z = pk2(y1[4], y1[5]); o1.w = pk2(y1[6], y1[7]);
            o2.x = pk2(y2[0], y2[1]); o2.y = pk2(y2[2], y2[3]); o2.z = pk2(y2[4], y2[5]); o2.w = pk2(y2[6], y2[7]);
            *(LAS v4u*)(dst + 16 * ch) = o1; *(LAS v4u*)(dst + 64 + 16 * ch) = o2; }
#pragma unroll
        for (int i = 0; i < 4; ++i) { const int key = key0 + 64 * i; v4u w = vv[i]; if ((nb - 1) * 128 + key < 0) w = (v4u){0u, 0u, 0u, 0u};
            *(LAS v4u*)(Vl + key * VP + 16 * ch8) = w; }
    }
    __syncthreads();
    const int ts = wave < 6 ? wave : 6;
    const bf16x8 q0 = frag(Ql, QP, 16 * wave + fr, 0, fq), q1 = frag(Ql, QP, 16 * wave + fr, 32, fq);
    f32x4 s[10];
#pragma unroll
    for (int t = 0; t < 10; ++t) { s[t] = (f32x4){0.f, 0.f, 0.f, 0.f};
        s[t] = mfma16(frag(Kl, KP, 16 * (ts + t) + fr, 0, fq), q0, s[t]); s[t] = mfma16(frag(Kl, KP, 16 * (ts + t) + fr, 32, fq), q1, s[t]); }
    const int qi = 16 * wave + fr; float mx = -INFINITY;
#pragma unroll
    for (int t = 0; t < 10; ++t)
#pragma unroll
        for (int e = 0; e < 4; ++e) { const int j = 16 * (ts + t) + 4 * fq + e; const bool ok = (j >= qi) && (j <= qi + 128) && ((nb - 1) * 128 + j >= 0); s[t][e] = ok ? s[t][e] : -INFINITY; mx = fmaxf(mx, s[t][e]); }
    mx = fmaxf(mx, __shfl_xor(mx, 16)); mx = fmaxf(mx, __shfl_xor(mx, 32));
    float den = 0.f;
#pragma unroll
    for (int t = 0; t < 10; ++t)
#pragma unroll
        for (int e = 0; e < 4; ++e) { const float p = __expf(s[t][e] - mx); s[t][e] = p; den += p; }
    den += __shfl_xor(den, 16); den += __shfl_xor(den, 32);
    f32x4 o[4];
#pragma unroll
    for (int n = 0; n < 4; ++n) o[n] = (f32x4){0.f, 0.f, 0.f, 0.f};
#pragma unroll
    for (int tp = 0; tp < 5; ++tp) { const bf16x8 pf = pfrag(s[2 * tp], s[2 * tp + 1]);
#pragma unroll
        for (int n = 0; n < 4; ++n) o[n] = mfma16(trfrag2(Vl, VP, 16 * n, 16 * (ts + 2 * tp), 16 * (ts + 2 * tp + 1), lane), pf, o[n]); }
    const size_t t = tb + (size_t)(nb * 128 + qi) * dil + r; const float rden = 1.f / den;
    float* DO = WSP(float, WS_DILO) + t * 768 + head * 64;
#pragma unroll
    for (int n = 0; n < 4; ++n) *(f32x4*)(DO + 16 * n + 4 * fq) = o[n] * rden;
    if (fq == 0) WSP(float, WS_DILL)[t * 12 + head] = mx + __logf(den);
    __syncthreads();
}
__device__ __forceinline__ void dil_merge(Ctx& C, bf16* YM) {
    const float* DO = WSP(float, WS_DILO); const float* DL = WSP(float, WS_DILL);
    for (int i = C.bid * 512 + C.tid; i < T_ * 64; i += C.G * 512) { const int t = i >> 6, hh = (i >> 4) & 3, d4 = (i & 15) * 4;
        const float l0 = DL[t * 12 + hh], l1 = DL[t * 12 + 4 + hh], l2 = DL[t * 12 + 8 + hh], m = fmaxf(l0, fmaxf(l1, l2));
        const float w0 = __expf(l0 - m), w1 = __expf(l1 - m), w2 = __expf(l2 - m), rs = 1.f / (w0 + w1 + w2);
        const f32x4 a = *(const f32x4*)(DO + (size_t)t * 768 + hh * 64 + d4), bb = *(const f32x4*)(DO + (size_t)t * 768 + (4 + hh) * 64 + d4), c = *(const f32x4*)(DO + (size_t)t * 768 + (8 + hh) * 64 + d4);
        const f32x4 o = (a * w0 + bb * w1 + c * w2) * rs; v2u w; w.x = pk2(o[0], o[1]); w.y = pk2(o[2], o[3]);
        *(v2u*)(YM + (size_t)t * 2048 + YM_B + hh * 64 + d4) = w; }
}

__device__ __forceinline__ void sgu_unit(Ctx& C, int l, int u, bf16* YM) {
    const int tid = C.tid, lane = C.lane, wave = C.wave, fr = lane & 15, fq = lane >> 4;
    const int g = u % 6, cn = u / 6; const size_t t0 = (size_t)cn * 128;
    const bf16* Y = WSP(bf16, WS_Y);
    const float* lng = C.in[11] + l * 768; const float* lnb = C.in[12] + l * 768; const float* ws = C.in[13] + (size_t)(l * 6 + g) * 128 * 128; const float* bs = C.in[14] + (l * 6 + g) * 128;
    constexpr int AP = 272, VP = 288;
    ldsp Al = C.lds, Vl = C.lds + 128 * AP; LAS float* st = (LAS float*)(Vl + 128 * VP);
    {   const int j = tid >> 2, qd = tid & 3; const bf16* src = Y + (t0 + j) * YP + Y_CV + qd * 192; float s1 = 0.f, s2 = 0.f;
        { v4u w[24];
#pragma unroll
            for (int k = 0; k < 24; ++k) w[k] = *(const v4u*)(src + 8 * k);
#pragma unroll
            for (int k = 0; k < 24; ++k) { float x[8]; unpack8(w[k], x);
#pragma unroll
                for (int q2 = 0; q2 < 8; ++q2) { const float z = fgelu(x[q2]); s1 += z; s2 += z * z; } } }
        s1 += __shfl_xor(s1, 1); s2 += __shfl_xor(s2, 1); s1 += __shfl_xor(s1, 2); s2 += __shfl_xor(s2, 2);
        if (qd == 0) { const float mu = s1 * (1.f / 768.f), var = fmaxf(s2 * (1.f / 768.f) - mu * mu, 0.f); st[2 * j] = mu; st[2 * j + 1] = 1.f / sqrtf(var + LN_EPS_); } }
    {   const int c8 = (tid & 15) * 8; f32x4 a[4], bq[4];
#pragma unroll
        for (int k4 = 0; k4 < 4; ++k4) { const int i = (tid >> 4) + 32 * k4; const float* src = ws + i * 128 + c8; a[k4] = *(const f32x4*)src; bq[k4] = *(const f32x4*)(src + 4); }
#pragma unroll
        for (int k4 = 0; k4 < 4; ++k4) { const int i = (tid >> 4) + 32 * k4; float v[8] = {a[k4][0], a[k4][1], a[k4][2], a[k4][3], bq[k4][0], bq[k4][1], bq[k4][2], bq[k4][3]};
#pragma unroll
            for (int k = 0; k < 8; ++k) v[k] = (c8 + k <= i) ? v[k] : 0.f;
            v4u o; o.x = pk2(v[0], v[1]); o.y = pk2(v[2], v[3]); o.z = pk2(v[4], v[5]); o.w = pk2(v[6], v[7]); *(LAS v4u*)(Al + i * AP + c8 * 2) = o; } }
    {   const int c8 = (tid & 15) * 8; v4u w[4];
#pragma unroll
        for (int k4 = 0; k4 < 4; ++k4) { const int j = (tid >> 4) + 32 * k4; w[k4] = *(const v4u*)(Y + (t0 + j) * YP + Y_CV + g * 128 + c8); }
        const f32x4 g0 = *(const f32x4*)(lng + g * 128 + c8), g1 = *(const f32x4*)(lng + g * 128 + c8 + 4), b0 = *(const f32x4*)(lnb + g * 128 + c8), b1 = *(const f32x4*)(lnb + g * 128 + c8 + 4);
        const float gg[8] = {g0[0], g0[1], g0[2], g0[3], g1[0], g1[1], g1[2], g1[3]}, bb[8] = {b0[0], b0[1], b0[2], b0[3], b1[0], b1[1], b1[2], b1[3]};
        __syncthreads();
#pragma unroll
        for (int k4 = 0; k4 < 4; ++k4) { const int j = (tid >> 4) + 32 * k4; float x[8]; unpack8(w[k4], x); const float mu = st[2 * j], rs = st[2 * j + 1];
#pragma unroll
            for (int k = 0; k < 8; ++k) x[k] = (fgelu(x[k]) - mu) * rs * gg[k] + bb[k];
            v4u o; o.x = pk2(x[0], x[1]); o.y = pk2(x[2], x[3]); o.z = pk2(x[4], x[5]); o.w = pk2(x[6], x[7]); *(LAS v4u*)(Vl + j * VP + c8 * 2) = o; } }
    __syncthreads();
    f32x4 acc[8];
#pragma unroll
    for (int n = 0; n < 8; ++n) acc[n] = (f32x4){0.f, 0.f, 0.f, 0.f};
    const int nks = (16 * wave + 15) / 32 + 1;
    for (int ks = 0; ks < nks; ++ks) { const bf16x8 a = frag(Al, AP, 16 * wave + fr, 32 * ks, fq);
#pragma unroll
        for (int n = 0; n < 8; ++n) acc[n] = mfma16(trfrag(Vl, VP, 16 * n, 32 * ks, lane), a, acc[n]); }
    const int i = 16 * wave + fr; const float bsi = bs[i]; const size_t t = t0 + i;
#pragma unroll
    for (int n = 0; n < 8; ++n) { const int c = 16 * n + 4 * fq; const v2u w = *(const v2u*)(Y + t * YP + Y_CU + g * 128 + c);
        const float o0 = fgelu(bflo(w.x)) * (acc[n][0] + bsi), o1 = fgelu(bfhi(w.x)) * (acc[n][1] + bsi), o2 = fgelu(bflo(w.y)) * (acc[n][2] + bsi), o3 = fgelu(bfhi(w.y)) * (acc[n][3] + bsi);
        v2u o; o.x = pk2(o0, o1); o.y = pk2(o2, o3); *(v2u*)(YM + t * 2048 + YM_C + g * 128 + c) = o; }
    __syncthreads();
}

__device__ __forceinline__ void gla_decay(Ctx& C, int l, int h, size_t t0, LAS float* Bl, LAS float* tmp  ) {
    const int tid = C.tid; const float* YSM = WSP(float, WS_YSM); const float* wa2 = C.in[3] + l * 16 * 256 + h * 64; const float* ba = C.in[4] + l * 256 + h * 64;
    { const int j = tid >> 3, d0 = (tid & 7) * 8; float a[16];
#pragma unroll
        for (int r4 = 0; r4 < 4; ++r4) { const f32x4 v = *(const f32x4*)(YSM + (t0 + j) * 32 + 4 * r4); a[4 * r4] = v[0]; a[4 * r4 + 1] = v[1]; a[4 * r4 + 2] = v[2]; a[4 * r4 + 3] = v[3]; }
#pragma unroll
        for (int k = 0; k < 8; ++k) { float s = ba[d0 + k];
#pragma unroll
            for (int r = 0; r < 16; ++r) s += a[r] * wa2[r * 256 + d0 + k];
            Bl[j * 65 + d0 + k] = flogsigmoid(s) * (1.f / 16.f); } }
    __syncthreads();
    { const int d = tid & 63, sg = tid >> 6; float run = 0.f;
#pragma unroll
        for (int k = 0; k < 8; ++k) { run += Bl[(8 * sg + k) * 65 + d]; Bl[(8 * sg + k) * 65 + d] = run; }
        tmp[sg * 64 + d] = run;
        __syncthreads();
        float off = 0.f;
        for (int s2 = 0; s2 < sg; ++s2) off += tmp[s2 * 64 + d];
#pragma unroll
        for (int k = 0; k < 8; ++k) Bl[(8 * sg + k) * 65 + d] += off; }
    __syncthreads();
}
__device__ __forceinline__ void gla_local_unit(Ctx& C, int l, int u) {
    const int tid = C.tid, lane = C.lane, wave = C.wave, fr = lane & 15, fq = lane >> 4;
    const int n = u & 31, h = (u >> 5) & 3, b = u >> 7; const size_t t0 = (size_t)b * SEQ_ + n * 64;
    const bf16* Y = WSP(bf16, WS_Y);
    constexpr int KP = 160, VP = 288;
    LAS float* Bl = (LAS float*)C.lds; LAS float* tmp = Bl + 64 * 65; ldsp Kl = (ldsp)(tmp + 512), Vl = Kl + 64 * KP;
    gla_decay(C, l, h, t0, Bl, tmp);
    {   const int j = tid >> 3, d0 = (tid & 7) * 8, e0 = (tid & 15) * 8;
        const v4u kw = *(const v4u*)(Y + (t0 + j) * YP + Y_AK + h * 64 + d0); v4u vw[2];
#pragma unroll
        for (int i = 0; i < 2; ++i) vw[i] = *(const v4u*)(Y + (t0 + (tid >> 4) + 32 * i) * YP + Y_AV + h * 128 + e0);
        float x[8]; unpack8(kw, x);
#pragma unroll
        for (int k = 0; k < 8; ++k) x[k] = x[k] * __expf(Bl[63 * 65 + d0 + k] - Bl[j * 65 + d0 + k]);
        v4u o; o.x = pk2(x[0], x[1]); o.y = pk2(x[2], x[3]); o.z = pk2(x[4], x[5]); o.w = pk2(x[6], x[7]); *(LAS v4u*)(Kl + j * KP + d0 * 2) = o;
#pragma unroll
        for (int i = 0; i < 2; ++i) *(LAS v4u*)(Vl + ((tid >> 4) + 32 * i) * VP + e0 * 2) = vw[i];
    }
    __syncthreads();
    float* LOC = WSP(float, WS_GLOC) + (size_t)u * 64 * 128; float* DEC = WSP(float, WS_GDEC) + (size_t)u * 64;
    if (tid < 64) DEC[tid] = __expf(Bl[63 * 65 + tid]);
#pragma unroll
    for (int mt = 0; mt < 4; ++mt) { f32x4 acc = (f32x4){0.f, 0.f, 0.f, 0.f};
#pragma unroll
        for (int ks = 0; ks < 2; ++ks) acc = mfma16(trfrag2(Vl, VP, 16 * wave, 32 * ks, 32 * ks + 16, lane), trfrag2(Kl, KP, 16 * mt, 32 * ks, 32 * ks + 16, lane), acc);
        *(f32x4*)(LOC + (size_t)(16 * mt + fr) * 128 + 16 * wave + 4 * fq) = acc; }
    __syncthreads();
}
__device__ __forceinline__ void gla_scan(Ctx& C) {
    const float* LOC = WSP(float, WS_GLOC); const float* DEC = WSP(float, WS_GDEC); bf16* ST = WSP(bf16, WS_GST);
    for (int i = C.bid * 512 + C.tid; i < 16 * 8192; i += C.G * 512) { const int bh = i >> 13, de = i & 8191, d = de >> 7; float S = 0.f;
        float lc[32], dc[32];
#pragma unroll
        for (int n = 0; n < 32; ++n) { const size_t uu = (size_t)bh * 32 + n; lc[n] = LOC[uu * 8192 + de]; dc[n] = DEC[uu * 64 + d]; }
#pragma unroll
        for (int n = 0; n < 32; ++n) { const size_t uu = (size_t)bh * 32 + n; ST[uu * 8192 + de] = bf1(S); S = dc[n] * S + lc[n]; } }
}
__device__ __forceinline__ void gla_out_unit(Ctx& C, int l, int u, bf16* YM) {
    const int tid = C.tid, lane = C.lane, wave = C.wave, fr = lane & 15, fq = lane >> 4;
    const int n = u & 31, h = (u >> 5) & 3, b = u >> 7; const size_t t0 = (size_t)b * SEQ_ + n * 64;
    const bf16* Y = WSP(bf16, WS_Y); const bf16* ST = WSP(bf16, WS_GST) + (size_t)u * 8192;
    constexpr int QP = 144, VP = 288;
    LAS float* Bl = (LAS float*)C.lds; LAS float* tmp = Bl + 64 * 65; ldsp Ql = (ldsp)(tmp + 512), Kl = Ql + 64 * QP, Vl = Kl + 64 * QP, Sl = Vl + 64 * VP; LAS float* ssq = (LAS float*)(Sl + 64 * VP);
    gla_decay(C, l, h, t0, Bl, tmp);
    {   const int j = tid >> 3, d0 = (tid & 7) * 8, e0 = (tid & 15) * 8, j2 = tid >> 4;
        const v4u qw = *(const v4u*)(Y + (t0 + j) * YP + Y_AQ + h * 64 + d0), kw = *(const v4u*)(Y + (t0 + j) * YP + Y_AK + h * 64 + d0); v4u vw[2], sw[2];
#pragma unroll
        for (int i = 0; i < 2; ++i) { vw[i] = *(const v4u*)(Y + (t0 + j2 + 32 * i) * YP + Y_AV + h * 128 + e0); sw[i] = *(const v4u*)(ST + (j2 + 32 * i) * 128 + e0); }
        float xq[8], xk[8]; unpack8(qw, xq); unpack8(kw, xk);
#pragma unroll
        for (int k = 0; k < 8; ++k) { const float bb = Bl[j * 65 + d0 + k]; xq[k] = xq[k] * 0.125f * __expf(bb); xk[k] = xk[k] * __expf(-bb); }
        v4u o; o.x = pk2(xq[0], xq[1]); o.y = pk2(xq[2], xq[3]); o.z = pk2(xq[4], xq[5]); o.w = pk2(xq[6], xq[7]); *(LAS v4u*)(Ql + j * QP + d0 * 2) = o;
        o.x = pk2(xk[0], xk[1]); o.y = pk2(xk[2], xk[3]); o.z = pk2(xk[4], xk[5]); o.w = pk2(xk[6], xk[7]); *(LAS v4u*)(Kl + j * QP + d0 * 2) = o;
#pragma unroll
        for (int i = 0; i < 2; ++i) { *(LAS v4u*)(Vl + (j2 + 32 * i) * VP + e0 * 2) = vw[i]; *(LAS v4u*)(Sl + (j2 + 32 * i) * VP + e0 * 2) = sw[i]; }
    }
    __syncthreads();
    const int mt = wave & 3, nh = wave >> 2;
    const bf16x8 qa0 = frag(Ql, QP, 16 * mt + fr, 0, fq), qa1 = frag(Ql, QP, 16 * mt + fr, 32, fq);
    f32x4 att[4];
#pragma unroll
    for (int t = 0; t < 4; ++t) { att[t] = (f32x4){0.f, 0.f, 0.f, 0.f}; att[t] = mfma16(frag(Kl, QP, 16 * t + fr, 0, fq), qa0, att[t]); att[t] = mfma16(frag(Kl, QP, 16 * t + fr, 32, fq), qa1, att[t]);
#pragma unroll
        for (int e = 0; e < 4; ++e) att[t][e] = (16 * t + 4 * fq + e <= 16 * mt + fr) ? att[t][e] : 0.f; }
    const bf16x8 p0 = pfrag(att[0], att[1]), p1 = pfrag(att[2], att[3]);
    f32x4 o[4];
#pragma unroll
    for (int nt = 0; nt < 4; ++nt) { const int ec = 64 * nh + 16 * nt; f32x4 a = (f32x4){0.f, 0.f, 0.f, 0.f};
        a = mfma16(trfrag2(Vl, VP, ec, 0, 16, lane), p0, a); a = mfma16(trfrag2(Vl, VP, ec, 32, 48, lane), p1, a);
        a = mfma16(trfrag(Sl, VP, ec, 0, lane), qa0, a); a = mfma16(trfrag(Sl, VP, ec, 32, lane), qa1, a); o[nt] = a; }
    float sq = 0.f;
#pragma unroll
    for (int nt = 0; nt < 4; ++nt) sq += (o[nt][0] * o[nt][0] + o[nt][1] * o[nt][1]) + (o[nt][2] * o[nt][2] + o[nt][3] * o[nt][3]);
    sq += __shfl_xor(sq, 16); sq += __shfl_xor(sq, 32);
    const int i = 16 * mt + fr;
    if (fq == 0) ssq[2 * i + nh] = sq;
    __syncthreads();
    const float rs = 1.f / sqrtf((ssq[2 * i] + ssq[2 * i + 1]) * (1.f / 128.f) + LN_EPS_);
    const float* ng = C.in[5] + l * 512 + h * 128; const size_t t = t0 + i;
#pragma unroll
    for (int nt = 0; nt < 4; ++nt) { const int e = 64 * nh + 16 * nt + 4 * fq; const f32x4 gv = *(const f32x4*)(ng + e); const v2u rw = *(const v2u*)(Y + t * YP + Y_AR + h * 128 + e);
        const float r0 = bflo(rw.x), r1 = bfhi(rw.x), r2 = bflo(rw.y), r3 = bfhi(rw.y);
        v2u w; w.x = pk2(o[nt][0] * rs * gv[0] * r0 * fsigmoid(r0), o[nt][1] * rs * gv[1] * r1 * fsigmoid(r1)); w.y = pk2(o[nt][2] * rs * gv[2] * r2 * fsigmoid(r2), o[nt][3] * rs * gv[3] * r3 * fsigmoid(r3));
        *(v2u*)(YM + t * 2048 + YM_A + h * 128 + e) = w; }
    __syncthreads();
}

__device__ __forceinline__ void ml_prep(Ctx& C, int l, int h, int b, int n, LAS float* gl, ldsp Ql, ldsp Kl, int QP, bool need_q) {
    const int tid = C.tid, lane = C.lane; const size_t t0 = (size_t)b * SEQ_ + n * 64;
    const bf16* Y = WSP(bf16, WS_Y); const float* YSM = WSP(float, WS_YSM);
    if (tid < 64) { const float lf = flogsigmoid(YSM[(t0 + lane) * 32 + 20 + h] + C.in[9][l * 4 + h]); float run = lf;
#pragma unroll
        for (int o = 1; o < 64; o <<= 1) { const float v = __shfl_up(run, o); if (lane >= o) run += v; }
        gl[lane] = run; gl[64 + lane] = YSM[(t0 + lane) * 32 + 16 + h] + C.in[8][l * 4 + h]; }
    const float* cw = C.in[6] + l * 4096; const float* cb = C.in[7] + l * 1024;
    {   const int c0 = (tid & 15) * 8, j0 = tid >> 4;
#pragma unroll
        for (int qk = 0; qk < 2; ++qk) { if (qk == 0 && !need_q) continue;
            const int cc = (qk == 0 ? 0 : 512) + h * 128 + c0, ycol = (qk == 0 ? Y_DQ : Y_DK) + h * 128 + c0;
            v4u xw[2][4]; f32x4 w4[4][2], b4[2];
#pragma unroll
            for (int i = 0; i < 2; ++i)
#pragma unroll
                for (int jj = 0; jj < 4; ++jj) { const int j = j0 + 32 * i, rel = j - 3 + jj, ok = (n * 64 + rel) >= 0; xw[i][jj] = *(const v4u*)(Y + (t0 + (ok ? rel : j)) * YP + ycol); }
#pragma unroll
            for (int jj = 0; jj < 4; ++jj) { w4[jj][0] = *(const f32x4*)(cw + jj * 1024 + cc); w4[jj][1] = *(const f32x4*)(cw + jj * 1024 + cc + 4); }
            b4[0] = *(const f32x4*)(cb + cc); b4[1] = *(const f32x4*)(cb + cc + 4);
#pragma unroll
            for (int i = 0; i < 2; ++i) { const int j = j0 + 32 * i; float a[8] = {b4[0][0], b4[0][1], b4[0][2], b4[0][3], b4[1][0], b4[1][1], b4[1][2], b4[1][3]};
#pragma unroll
                for (int jj = 0; jj < 4; ++jj) { const float mk = (n * 64 + j - 3 + jj) >= 0 ? 1.f : 0.f; float x[8]; unpack8(xw[i][jj], x);
#pragma unroll
                    for (int k = 0; k < 8; ++k) a[k] += (w4[jj][k >> 2][k & 3] * mk) * x[k]; }
                const float sc = qk == 0 ? 1.f : 0.08838834764831845f;
#pragma unroll
                for (int k = 0; k < 8; ++k) a[k] = a[k] * fsigmoid(a[k]) * sc;
                v4u o; o.x = pk2(a[0], a[1]); o.y = pk2(a[2], a[3]); o.z = pk2(a[4], a[5]); o.w = pk2(a[6], a[7]); *(LAS v4u*)((qk == 0 ? Ql : Kl) + j * QP + c0 * 2) = o; } }
    }
    __syncthreads();
}
__device__ __forceinline__ void ml_local_unit(Ctx& C, int l, int u) {
    const int tid = C.tid, lane = C.lane, wave = C.wave, fr = lane & 15, fq = lane >> 4;
    const int n = u & 31, h = (u >> 5) & 3, b = u >> 7; const size_t t0 = (size_t)b * SEQ_ + n * 64;
    const bf16* Y = WSP(bf16, WS_Y);
    constexpr int KP = 288, TP = 288;
    LAS float* gl = (LAS float*)C.lds; LAS float* wk = gl + 128; LAS float* red = wk + 64;
    ldsp Kl = (ldsp)(red + 512), Vl = Kl + 64 * KP;
    ml_prep(C, l, h, b, n, gl, Kl, Kl, KP, false);
    if (tid < 64) { const float bl = gl[63], dec = bl - gl[lane] + gl[64 + lane], a = wave_max(dec); wk[lane] = __expf(dec - a);
        if (lane == 0) { float* SC = WSP(float, WS_MSC) + (size_t)u * 2; SC[0] = bl; SC[1] = a; } }
    __syncthreads();
    { const int d = tid & 127, sg = tid >> 7; float s = 0.f;
        for (int j = 16 * sg; j < 16 * sg + 16; ++j) s += wk[j] * bflo((unsigned)*(const LAS unsigned short*)(Kl + j * KP + d * 2));
        red[sg * 128 + d] = s; }
    {   const int c0 = (tid & 15) * 8, j0 = tid >> 4; v4u vw[2];
#pragma unroll
        for (int i = 0; i < 2; ++i) vw[i] = *(const v4u*)(Y + (t0 + j0 + 32 * i) * YP + Y_DV + h * 128 + c0);
#pragma unroll
        for (int i = 0; i < 2; ++i) *(LAS v4u*)(Vl + (j0 + 32 * i) * TP + c0 * 2) = vw[i];
    }
    __syncthreads();
    {   const int c0 = (tid & 15) * 8, j0 = tid >> 4;
#pragma unroll
        for (int i = 0; i < 2; ++i) { const int j = j0 + 32 * i; float x[8]; unpack8(*(const LAS v4u*)(Kl + j * KP + c0 * 2), x); const float w = wk[j];
            v4u o; o.x = pk2(x[0] * w, x[1] * w); o.y = pk2(x[2] * w, x[3] * w); o.z = pk2(x[4] * w, x[5] * w); o.w = pk2(x[6] * w, x[7] * w); *(LAS v4u*)(Kl + j * KP + c0 * 2) = o; }
    }
    if (tid < 128) WSP(float, WS_MNLOC)[(size_t)u * 128 + tid] = (red[tid] + red[128 + tid]) + (red[256 + tid] + red[384 + tid]);
    __syncthreads();
    float* LOC = WSP(float, WS_MLOC) + (size_t)u * 16384;
#pragma unroll
    for (int mt = 0; mt < 8; ++mt) { f32x4 acc = (f32x4){0.f, 0.f, 0.f, 0.f};
#pragma unroll
        for (int ks = 0; ks < 2; ++ks) acc = mfma16(trfrag2(Vl, TP, 16 * wave, 32 * ks, 32 * ks + 16, lane), trfrag2(Kl, KP, 16 * mt, 32 * ks, 32 * ks + 16, lane), acc);
        *(f32x4*)(LOC + (size_t)(16 * mt + fr) * 128 + 16 * wave + 4 * fq) = acc; }
    __syncthreads();
}
__device__ __forceinline__ void ml_scan(Ctx& C) {
    const float* LOC = WSP(float, WS_MLOC); const float* NL = WSP(float, WS_MNLOC); const float* SC = WSP(float, WS_MSC);
    bf16* MC = WSP(bf16, WS_MC); float* MN = WSP(float, WS_MN); float* MM = WSP(float, WS_MM);
    for (int i = C.bid * 512 + C.tid; i < 16 * (16384 + 128); i += C.G * 512) { const int bh = i / (16384 + 128), r = i % (16384 + 128); float S = 0.f, m = 0.f;
        float lc[32], bl_[32], a_[32];
#pragma unroll
        for (int n = 0; n < 32; ++n) { const size_t uu = (size_t)bh * 32 + n; lc[n] = r < 16384 ? LOC[uu * 16384 + r] : NL[uu * 128 + (r - 16384)]; bl_[n] = SC[uu * 2]; a_[n] = SC[uu * 2 + 1]; }
#pragma unroll
        for (int n = 0; n < 32; ++n) { const size_t uu = (size_t)bh * 32 + n; const float bl = bl_[n], a = a_[n], mn = fmaxf(bl + m, a), keep = __expf(bl + m - mn), sc = __expf(a - mn);
            if (r < 16384) MC[uu * 16384 + r] = bf1(S);
            else { const int d = r - 16384; MN[uu * 128 + d] = S; if (d == 0) MM[uu] = m; }
            S = keep * S + sc * lc[n]; m = mn; } }
}
__device__ __forceinline__ void ml_out_unit(Ctx& C, int l, int u, bf16* YM) {
    const int tid = C.tid, lane = C.lane, wave = C.wave, fr = lane & 15, fq = lane >> 4;
    const int n = u & 31, h = (u >> 5) & 3, b = u >> 7; const size_t t0 = (size_t)b * SEQ_ + n * 64;
    const bf16* Y = WSP(bf16, WS_Y); const bf16* MC = WSP(bf16, WS_MC) + (size_t)u * 16384; const float* MN = WSP(float, WS_MN) + (size_t)u * 128; const float m0 = WSP(float, WS_MM)[u];
    constexpr int QP = 272, TP = 288;
    LAS float* gl = (LAS float*)C.lds; LAS float* mt_ = gl + 128; LAS float* wst = mt_ + 64; LAS float* qn = wst + 64; LAS float* ssq = qn + 64;
    ldsp Ql = (ldsp)(ssq + 128), Kl = Ql + 64 * QP, Vl = Kl + 64 * QP, Cl = Vl + 64 * TP;
    ml_prep(C, l, h, b, n, gl, Ql, Kl, QP, true);
    if (tid < 64) { float pm = gl[64 + lane] - gl[lane];
#pragma unroll
        for (int o = 1; o < 64; o <<= 1) { const float v = __shfl_up(pm, o); if (lane >= o) pm = fmaxf(pm, v); }
        const float mt = gl[lane] + fmaxf(m0, pm); mt_[lane] = mt; wst[lane] = __expf(gl[lane] + m0 - mt); }
    {   const int c0 = (tid & 15) * 8, j0 = tid >> 4; v4u vw[2], cw4[4];
#pragma unroll
        for (int i = 0; i < 2; ++i) vw[i] = *(const v4u*)(Y + (t0 + j0 + 32 * i) * YP + Y_DV + h * 128 + c0);
#pragma unroll
        for (int i = 0; i < 4; ++i) cw4[i] = *(const v4u*)(MC + (j0 + 32 * i) * 128 + c0);
#pragma unroll
        for (int i = 0; i < 2; ++i) *(LAS v4u*)(Vl + (j0 + 32 * i) * TP + c0 * 2) = vw[i];
#pragma unroll
        for (int i = 0; i < 4; ++i) *(LAS v4u*)(Cl + (j0 + 32 * i) * TP + c0 * 2) = cw4[i];
    }
    { const int i = tid >> 3, d0 = (tid & 7) * 16; float s = 0.f;
#pragma unroll
        for (int k2 = 0; k2 < 2; ++k2) { float x[8]; unpack8(*(const LAS v4u*)(Ql + i * QP + (d0 + 8 * k2) * 2), x);
#pragma unroll
            for (int k = 0; k < 8; ++k) s += x[k] * MN[d0 + 8 * k2 + k]; }
        s += __shfl_xor(s, 1); s += __shfl_xor(s, 2); s += __shfl_xor(s, 4);
        if ((tid & 7) == 0) qn[i] = s; }
    __syncthreads();
    const int mt = wave & 3, nh = wave >> 2, i = 16 * mt + fr;
    bf16x8 qa[4];
#pragma unroll
    for (int ks = 0; ks < 4; ++ks) qa[ks] = frag(Ql, QP, i, 32 * ks, fq);
    const float bi_ = gl[i], mti = mt_[i], wsti = wst[i];
    f32x4 sc[4]; float rsum = 0.f;
#pragma unroll
    for (int t = 0; t < 4; ++t) { sc[t] = (f32x4){0.f, 0.f, 0.f, 0.f};
#pragma unroll
        for (int ks = 0; ks < 4; ++ks) sc[t] = mfma16(frag(Kl, QP, 16 * t + fr, 32 * ks, fq), qa[ks], sc[t]);
#pragma unroll
        for (int e = 0; e < 4; ++e) { const int j = 16 * t + 4 * fq + e; const float w = (j <= i) ? __expf(bi_ - gl[j] + gl[64 + j] - mti) : 0.f; sc[t][e] *= w; rsum += sc[t][e]; } }
    rsum += __shfl_xor(rsum, 16); rsum += __shfl_xor(rsum, 32);
    const float den = rsum + wsti * qn[i], rden = 1.f / fmaxf(fabsf(den), __expf(-mti));
    const bf16x8 p0 = pfrag(sc[0], sc[1]), p1 = pfrag(sc[2], sc[3]);
    f32x4 o[4]; float sq = 0.f;
    const size_t t = t0 + i;
#pragma unroll
    for (int nt = 0; nt < 4; ++nt) { const int ec = 64 * nh + 16 * nt; f32x4 a1 = (f32x4){0.f, 0.f, 0.f, 0.f}, a2 = a1;
        a1 = mfma16(trfrag2(Vl, TP, ec, 0, 16, lane), p0, a1); a1 = mfma16(trfrag2(Vl, TP, ec, 32, 48, lane), p1, a1);
#pragma unroll
        for (int ks = 0; ks < 4; ++ks) a2 = mfma16(trfrag(Cl, TP, ec, 32 * ks, lane), qa[ks], a2);
        const v2u ow = *(const v2u*)(Y + t * YP + Y_DO + h * 128 + 64 * nh + 16 * nt + 4 * fq);
        f32x4 hv = (a1 + a2 * wsti) * rden; hv[0] *= fsigmoid(bflo(ow.x)); hv[1] *= fsigmoid(bfhi(ow.x)); hv[2] *= fsigmoid(bflo(ow.y)); hv[3] *= fsigmoid(bfhi(ow.y));
        o[nt] = hv; sq += (hv[0] * hv[0] + hv[1] * hv[1]) + (hv[2] * hv[2] + hv[3] * hv[3]); }
    sq += __shfl_xor(sq, 16); sq += __shfl_xor(sq, 32);
    if (fq == 0) ssq[2 * i + nh] = sq;
    __syncthreads();
    const float rs = 1.f / sqrtf((ssq[2 * i] + ssq[2 * i + 1]) * (1.f / 128.f) + LN_EPS_);
    const float* ng = C.in[10] + l * 512 + h * 128;
#pragma unroll
    for (int nt = 0; nt < 4; ++nt) { const int e = 64 * nh + 16 * nt + 4 * fq; const f32x4 gv = *(const f32x4*)(ng + e);
        v2u w; w.x = pk2(o[nt][0] * rs * gv[0], o[nt][1] * rs * gv[1]); w.y = pk2(o[nt][2] * rs * gv[2], o[nt][3] * rs * gv[3]);
        *(v2u*)(YM + t * 2048 + YM_D + h * 128 + e) = w; }
    __syncthreads();
}

#ifndef MIXREP
#define MIXREP 0
#endif
#define RELAUNDER(C) do { int zv_ = 0; asm volatile("" : "+v"(zv_)); unsigned long long zw_ = (unsigned long long)(C).ws; asm volatile("" : "+s"(zw_)); (C).ws = (unsigned char*)(GAS unsigned char*)zw_;     \
    (C).tid = (int)threadIdx.x + zv_; (C).lane = (C).tid & 63; (C).wave = __builtin_amdgcn_readfirstlane((C).tid >> 6); } while (0)
__device__ __forceinline__ void phase_mix_a(Ctx& C, int l, bf16* YM) {
    const bool std_grid = C.G == 256;
    if (std_grid) {
        const int nd = C.bid < 128 ? 2 : 4, d0 = C.bid < 128 ? C.bid : 256 + (C.bid - 128);
        for (int k = 0; k < nd; ++k) { RELAUNDER(C); const int u = d0 + 128 * k; dil_unit(C, u); if (MIXREP & 1) dil_unit(C, u); }
    } else for (int u = C.bid; u < 768; u += C.G) { RELAUNDER(C); dil_unit(C, u); }
    for (int u = C.bid; u < 384; u += C.G) { RELAUNDER(C); sgu_unit(C, l, u, YM); if (MIXREP & 2) sgu_unit(C, l, u, YM); }
    for (int u = C.bid; u < 512; u += C.G) { RELAUNDER(C); gla_local_unit(C, l, u); if (MIXREP & 4) gla_local_unit(C, l, u); }
    for (int u = C.bid; u < 512; u += C.G) { RELAUNDER(C); ml_local_unit(C, l, u); if (MIXREP & 8) ml_local_unit(C, l, u); }
}
__device__ __forceinline__ void phase_mix_b(Ctx& C, bf16* YM) { gla_scan(C); ml_scan(C); dil_merge(C, YM); }
__device__ __forceinline__ void phase_mix_c(Ctx& C, int l, bf16* YM) {
    for (int u = C.bid; u < 1024; u += C.G) { RELAUNDER(C); if (u < 512) { gla_out_unit(C, l, u, YM); if (MIXREP & 16) gla_out_unit(C, l, u, YM); } else { ml_out_unit(C, l, u - 512, YM); if (MIXREP & 32) ml_out_unit(C, l, u - 512, YM); } }
}
#ifndef EARLY_WIN
#define EARLY_WIN 0
#endif
#ifndef STEAL_ON
#define STEAL_ON 0
#endif
#ifndef Y_WGM
#define Y_WGM 8
#endif
#ifndef NCONV
#define NCONV 72
#endif
#ifndef REPEAT_MASK
#define REPEAT_MASK 0
#endif
#define REP(k) (((REPEAT_MASK) >> (k)) & 1)
#define RELAUNDER_T(C) do { int zv_ = 0; asm volatile("" : "+v"(zv_)); (C).tid = (int)threadIdx.x + zv_; (C).lane = (C).tid & 63; (C).wave = __builtin_amdgcn_readfirstlane((C).tid >> 6); } while (0)
#define IN(k) (lo <= (k) && (k) < hi)
#define SEAM(k) do { if (IN(k) && IN((k) + 1)) xcd_barrier(bar); } while (0)
#define STEAL(k) do { if (STEAL_ON && FP8_LAST && l + 2 == NL_ && IN(k) && IN((k) + 1)) { unsigned* arr_ = WSP(unsigned, WS_CTL) + CW_ARR + 64 * (k); __syncthreads(); if (C.tid == 0) atomicAdd(arr_, 1u); \
        phase_convert(C, l + 1, 1, C.bid, C.G, arr_); } } while (0)
template <int l>
__device__ __forceinline__ void layer_program(Ctx& C, const XcdBarrier& bar, const int lo, const int hi) {
    constexpr int p0 = l * 12;
    const float* Xin = l == 0 ? C.in[0] : WSP(float, WS_XA);
    if (l == 0) { if (IN(p0 + 0)) for (int rep_ = 0; rep_ < 1 + REP(0); ++rep_) { RELAUNDER_T(C); phase_convert(C, l, 0, C.bid, C.G); }
        SEAM(p0 + 0); }
    if (IN(p0 + 1)) for (int rep_ = 0; rep_ < 1 + REP(1); ++rep_) { RELAUNDER_T(C);
        if (C.bid < NCONV) phase_convert(C, l, 1, C.bid, NCONV);
        else {
        if constexpr (GATES8(l)) {
            { pg8::Gemm g{WSP(bf16, WS_XB), WSP(bf16, WS_WIN), T_, 7680, 2048, 2048, 2048, nullptr}; pg8::StaticOrder S; S.init(T_, 7680, C.G - NCONV, C.bid - NCONV, Y_WGM);
              EpiY E{WSP(bf16, WS_Y), WSP(float, WS_YSM), 0}; pg8::gemm_phase<EpiY, pg8::StaticOrder, true>(C.lds, g, S, E, C.tid); }
            { pg8::Gemm g{WSP(bf16, WS_XB8), WSP(bf16, WS_WIN8), T_, 8192, 1024, 1024, 1024, nullptr}; pg8::StaticOrder S; S.init(T_, 8192, C.G - NCONV, C.bid - NCONV, Y_WGM);
              EpiY E{WSP(bf16, WS_Y), WSP(float, WS_YSM), 30}; pg8::gemm_phase<EpiY, pg8::StaticOrder, true, false, 2, 1>(C.lds, g, S, E, C.tid); }
        } else {
        pg8::Gemm g{WSP(bf16, WS_XB), WSP(bf16, WS_WIN), T_, YP, 2048, 2048, 2048, nullptr}; pg8::StaticOrder S; S.init(T_, YP, C.G - NCONV, C.bid - NCONV, Y_WGM);
        EpiY E{WSP(bf16, WS_Y), WSP(float, WS_YSM), 0};
        pg8::gemm_phase<EpiY, pg8::StaticOrder, true>(C.lds, g, S, E, C.tid); }
        phase_convert(C, l, 1, C.bid, NCONV); }
    }
    SEAM(p0 + 1);
    bf16* YMo = WSP(bf16, MK_MODE == 1 ? WS_MRG : WS_YM);
    if (IN(p0 + 2)) for (int rep_ = 0; rep_ < 1 + REP(2); ++rep_) { RELAUNDER_T(C); phase_mix_a(C, l, YMo); }
    SEAM(p0 + 2);
    if (IN(p0 + 3)) for (int rep_ = 0; rep_ < 1 + REP(3); ++rep_) { RELAUNDER_T(C); phase_mix_b(C, YMo); }
    SEAM(p0 + 3);
    if (IN(p0 + 4)) for (int rep_ = 0; rep_ < 1 + REP(4); ++rep_) { RELAUNDER_T(C); phase_mix_c(C, l, YMo); }
    SEAM(p0 + 4);
    if (IN(p0 + 5)) for (int rep_ = 0; rep_ < 1 + REP(5); ++rep_) { RELAUNDER_T(C);
        pg8::StaticOrder S; S.init(T_, 4096, C.G, C.bid);
        pg8::Gemm g{WSP(bf16, WS_YM), WSP(bf16, WS_WP), T_, 2048, 2048, 2048, 2048, nullptr}; EpiMerge E; E.Y = WSP(bf16, WS_Y); E.MB = WSP(bf16, WS_MB);
        if (MERGE3) pg8::gemm_phase_n1s3<EpiMerge, pg8::StaticOrder>(C.lds, g, S, E, C.tid); else pg8::gemm_phase<EpiMerge, pg8::StaticOrder, true, false, 1>(C.lds, g, S, E, C.tid);
    }
    SEAM(p0 + 5);
    if (IN(p0 + 6)) for (int rep_ = 0; rep_ < 1 + REP(6); ++rep_) { RELAUNDER_T(C);
        pg8::Gemm g{WSP(bf16, WS_MB), WSP(bf16, WS_WOUT), T_, 2048, 2048, 2048, 2048, nullptr}; pg8::StaticOrder S; S.init(T_, 2048, C.G, C.bid);
        EpiOut E{Xin, WSP(float, WS_HB)};
        pg8::gemm_phase<EpiOut, pg8::StaticOrder, true>(C.lds, g, S, E, C.tid);
    }
    SEAM(p0 + 6);
    if (IN(p0 + 7)) for (int rep_ = 0; rep_ < 1 + REP(7); ++rep_) { RELAUNDER_T(C); phase_ln1_router(C, l); }
    SEAM(p0 + 7);
    if (IN(p0 + 8)) for (int rep_ = 0; rep_ < 1 + REP(8); ++rep_) { RELAUNDER_T(C); phase_scatter(C, l); }
    SEAM(p0 + 8);
    if (IN(p0 + 9)) for (int rep_ = 0; rep_ < 1 + REP(9); ++rep_) { RELAUNDER_T(C);
        MoeOrder S; S.init(WSP(int, WS_CTL) + CW_TST + l * 128, 4, C.G, C.bid, C.lane);
        if constexpr (MOE8(l)) {
            pg8::Gemm g{WSP(bf16, WS_XS8), WSP(bf16, l == NL_ - 1 ? WS_W13B : WS_W13), MAXROWS, 65 * 1024, 1024, 1024, 1024, WSP(int, WS_ROWMAP)};
            EpiMoe1F8 E{WSP(unsigned char, WS_H), WSP(float, WS_ROWW)};
            pg8::gemm_phase<EpiMoe1F8, MoeOrder, true, true, 2, 1>(C.lds, g, S, E, C.tid);
        } else {
            pg8::Gemm g{WSP(bf16, WS_XS), WSP(bf16, WS_W13), MAXROWS, 65 * 1024, 2048, 2048, 2048, WSP(int, WS_ROWMAP)};
            EpiMoe1 E{WSP(bf16, WS_H), WSP(float, WS_ROWW), 4};
            pg8::gemm_phase<EpiMoe1, MoeOrder, true, true>(C.lds, g, S, E, C.tid);
        }
    }
    if (STEAL_ON & 1) STEAL(p0 + 9);
    SEAM(p0 + 9);
    if (IN(p0 + 10)) for (int rep_ = 0; rep_ < 1 + REP(10); ++rep_) { RELAUNDER_T(C);
        MoeOrder S; S.init(WSP(int, WS_CTL) + CW_TST + l * 128, 8, C.G, C.bid, C.lane);
        EpiMoe2 E{WSP(bf16, WS_YBUF)};
        if constexpr (MOE8(l)) {
            pg8::Gemm g{WSP(bf16, WS_H), WSP(bf16, l == NL_ - 1 ? WS_W2B : WS_W2), MAXROWS, 65 * 2048, 256, 256, 256, nullptr};
            pg8::gemm_phase<EpiMoe2, MoeOrder, true, false, 2, 1>(C.lds, g, S, E, C.tid);
        } else {
            pg8::Gemm g{WSP(bf16, WS_H), WSP(bf16, WS_W2), MAXROWS, 65 * 2048, 512, 512, 512, nullptr};
            pg8::gemm_phase<EpiMoe2, MoeOrder, true>(C.lds, g, S, E, C.tid);
        }
        if (EARLY_WIN && l + 1 < NL_ && !REP(10)) phase_convert(C, l + 1, 0, C.bid, C.G);
    }
    if (STEAL_ON & 2) STEAL(p0 + 10);
    SEAM(p0 + 10);
    if (IN(p0 + 11)) for (int rep_ = 0; rep_ < 1 + REP(11); ++rep_) { RELAUNDER_T(C); phase_combine(C, l); if (l + 1 < NL_) phase_convert(C, l + 1, 0, C.bid, C.G); }
    if (STEAL_ON & 4) STEAL(p0 + 11);
    SEAM(p0 + 11);
}
__global__ void __launch_bounds__(512, 2) fwd(KArgs args) {
    extern __shared__ __attribute__((aligned(16))) unsigned char lds_[];
    Ctx C;
    C.lds = (LAS unsigned char*)lds_; C.ws = args.ws; C.out = args.out;
#pragma unroll
    for (int i = 0; i < 32; ++i) C.in[i] = args.in[i];
    C.tid = threadIdx.x; C.lane = C.tid & 63; C.wave = __builtin_amdgcn_readfirstlane(C.tid >> 6); C.G = gridDim.x; C.bid = blockIdx.x;
    const int lo = args.ph_lo, hi = args.ph_hi;
    if (C.tid < 4) ((LAS unsigned*)(C.lds + AUX_BARW))[C.tid] = 0u;
    __syncthreads();
    XcdBarrier bar; bar.bar = WSP(unsigned, WS_CTL) + CW_BAR + args.region * XCD_BAR_WORDS; bar.x = 0; bar.st = (volatile LAS unsigned*)(C.lds + AUX_BARW);
    if (hi - lo > 1) bar = xcd_barrier_post(bar.bar, (volatile LAS unsigned*)(C.lds + AUX_BARW));
    layer_program<0>(C, bar, lo, hi);
    layer_program<1>(C, bar, lo, hi);
}
#undef IN
#undef SEAM

#define NIDX (blockIdx.x * blockDim.x + threadIdx.x)
__global__ void __launch_bounds__(256) nk_gla_g(const float* YSM, const float* wa2, const float* ba, float* GG) { const int i = NIDX; if (i < T_ * 256) naive_gla_g(i >> 8, i & 255, YSM, wa2, ba, GG); }
__global__ void __launch_bounds__(64) nk_gla_rec(const bf16* Y, const float* GG, float* OA) { const int i = NIDX; if (i < 2048) naive_gla_rec(i >> 9, (i >> 7) & 3, i & 127, SEQ_, Y, GG, OA); }
__global__ void __launch_bounds__(256) nk_gla_post(const bf16* Y, const float* OA, const float* ng, bf16* YM) { const int i = NIDX; if (i < T_ * 4) naive_gla_post(i >> 2, i & 3, Y, OA, ng, YM); }
__global__ void __launch_bounds__(256) nk_rope(const bf16* Y, const int* pos, float* QR, float* KR) { const int i = NIDX; if (i < T_ * 384) naive_rope(i / 384, (i % 384) >> 5, i & 31, Y, pos, QR, KR); }
__global__ void __launch_bounds__(64) nk_dil(const float* QR, const float* KR, const bf16* Y, bf16* YM) { const int i = NIDX; if (i < T_ * 4) naive_dil(i >> 2, i & 3, SEQ_, QR, KR, Y, YM); }
__global__ void __launch_bounds__(256) nk_sgu_stats(const bf16* Y, float* MU, float* RS) { const int i = NIDX; if (i < T_) naive_sgu_stats(i, Y, MU, RS); }
__global__ void __launch_bounds__(256) nk_sgu_out(const bf16* Y, const float* MU, const float* RS, const float* lg, const float* lb, const float* ws, const float* bs, bf16* YM) { const int i = NIDX; if (i < T_ * 768) naive_sgu_out(i / 768, i % 768, SEQ_, Y, MU, RS, lg, lb, ws, bs, YM); }
__global__ void __launch_bounds__(256) nk_ml_conv(const bf16* Y, const float* cw, const float* cb, float* QKC) { const int i = NIDX; if (i < T_ * 1024) naive_ml_conv(i >> 10, i & 1023, SEQ_, Y, cw, cb, QKC); }
__global__ void __launch_bounds__(64) nk_ml_den(const float* YSM, const float* QKC, const float* bi, const float* bf_, float* DEN) { const int i = NIDX; if (i < 16) naive_ml_den(i >> 2, i & 3, SEQ_, YSM, QKC, bi, bf_, DEN); }
__global__ void __launch_bounds__(64) nk_ml_rec(const bf16* Y, const float* YSM, const float* QKC, const float* bi, const float* bf_, const float* DEN, float* HM) { const int i = NIDX; if (i < 2048) naive_ml_rec(i >> 9, (i >> 7) & 3, i & 127, SEQ_, Y, YSM, QKC, bi, bf_, DEN, HM); }
__global__ void __launch_bounds__(256) nk_ml_post(const float* HM, const float* ng, bf16* YM) { const int i = NIDX; if (i < T_ * 4) naive_ml_post(i >> 2, i & 3, HM, ng, YM); }

constexpr int CW_DBG = 12288;
__global__ void __launch_bounds__(256) nk_compare(const bf16* YMn, const bf16* YMf, float* acc) {
    const int i = NIDX; if (i >= T_ * 256) return;
    const int t = i >> 8, c8 = (i & 255) * 8, br = c8 < 512 ? 0 : (c8 < 768 ? 1 : (c8 < 1536 ? 2 : 3));
    const v4u a = *(const v4u*)(YMn + (size_t)t * 2048 + c8), b = *(const v4u*)(YMf + (size_t)t * 2048 + c8);
    const unsigned aw[4] = {a.x, a.y, a.z, a.w}, bw[4] = {b.x, b.y, b.z, b.w}; float sd = 0.f, sn = 0.f;
#pragma unroll
    for (int k = 0; k < 4; ++k) { const float x0 = bflo(aw[k]), x1 = bfhi(aw[k]), y0 = bflo(bw[k]), y1 = bfhi(bw[k]); float d0 = y0 - x0, d1 = y1 - x1;
        if (!(d0 == d0)) d0 = 1e3f; if (!(d1 == d1)) d1 = 1e3f; sd += d0 * d0 + d1 * d1; sn += x0 * x0 + x1 * x1; }
#pragma unroll
    for (int o = 1; o < 32; o <<= 1) { sd += __shfl_xor(sd, o); sn += __shfl_xor(sn, o); }
    if ((threadIdx.x & 31) == 0) { atomicAdd(acc + br * 2, sd); atomicAdd(acc + br * 2 + 1, sn); }
}
__global__ void __launch_bounds__(256) nk_scale(float* out, const float* acc, int mask) {
    float d2 = 0.f;
    for (int br = 0; br < 4; ++br) if ((mask >> br) & 1) d2 += 100.f * acc[br * 2] / fmaxf(acc[br * 2 + 1], 1e-20f);
    const float s = 1.f + sqrtf(fminf(d2, 100.f));
    const int i = NIDX; if (i < T_ * D_ / 4) { f32x4 v = *(f32x4*)(out + (size_t)i * 4); *(f32x4*)(out + (size_t)i * 4) = v * s; }
}
#ifndef DBG_MASK
#define DBG_MASK 15
#endif
static void launch_fwd(void* const* d_in, void* d_out, void* d_ws, hipStream_t stream, int grid, int lo, int hi, int region) {
    KArgs a{};
    for (int i = 0; i < 32; ++i) a.in[i] = (const float*)d_in[i];
    a.out = (float*)d_out; a.ws = (unsigned char*)d_ws; a.ph_lo = lo; a.ph_hi = hi; a.region = region; a.pad = 0;
    hipLaunchKernelGGL(fwd, dim3(grid), dim3(512), LDS_BYTES, stream, a);
}
extern "C" void kernel_launch(void* const* d_in, const int* in_sizes, int n_in, void* d_out, int out_size, void* d_ws, size_t ws_size, hipStream_t stream) {
    static int grid = 0;
    if (grid == 0) {
        if (n_in != 32 || out_size != T_ * D_ || ws_size < WS_END) { fprintf(stderr, "kernel_launch: unexpected shapes: n_in %d out %d ws %zu (need %zu)\n", n_in, out_size, ws_size, (size_t)WS_END); grid = -1; return; }
        int dev = 0, cus = 0, per_cu = 0;
        if (hipGetDevice(&dev) != hipSuccess || hipDeviceGetAttribute(&cus, hipDeviceAttributeMultiprocessorCount, dev) != hipSuccess) { grid = -1; return; }
        if (hipFuncSetAttribute((const void*)fwd, hipFuncAttributeMaxDynamicSharedMemorySize, LDS_BYTES) != hipSuccess) { fprintf(stderr, "kernel_launch: hipFuncSetAttribute failed\n"); grid = -1; return; }
        if (hipOccupancyMaxActiveBlocksPerMultiprocessor(&per_cu, (const void*)fwd, 512, LDS_BYTES) != hipSuccess || per_cu < 1) fprintf(stderr, "kernel_launch: occupancy query reports %d blocks per CU\n", per_cu);
        (void)hipGetLastError();
        grid = cus;
    }
    if (grid < 0) return;
    (void)hipMemsetAsync((char*)d_ws + WS_CTL, 0, CTL_ZERO_BYTES, stream);
    int region = 0;
#if MK_MODE == 3
    launch_fwd(d_in, d_out, d_ws, stream, grid, 0, 24, region++);
#else
    unsigned char* ws = (unsigned char*)d_ws;
    const bf16* Y = (const bf16*)(ws + WS_Y); const float* YSM = (const float*)(ws + WS_YSM); bf16* YM = (bf16*)(ws + WS_YM);
    float* GG = (float*)(ws + WS_NV); float* OA = (float*)(ws + WS_NV + 8 * MiB); float* QR = (float*)(ws + WS_NV + 24 * MiB); float* KR = (float*)(ws + WS_NV + 48 * MiB);
    float* MU = (float*)(ws + WS_NV + 72 * MiB); float* RS = MU + T_; float* QKC = (float*)(ws + WS_NV + 73 * MiB); float* DEN = (float*)(ws + WS_NV + 105 * MiB); float* HM = (float*)(ws + WS_NV + 106 * MiB);
    float* dbg = (float*)ws + CW_DBG;
    const float* f[32]; for (int i = 0; i < 32; ++i) f[i] = (const float*)d_in[i];
    for (int l = 0; l < NL_; ++l) {
        const int p0 = l * 12;
        launch_fwd(d_in, d_out, d_ws, stream, grid, p0 + 0, p0 + 1, region++);
        launch_fwd(d_in, d_out, d_ws, stream, grid, p0 + 1, p0 + 2, region++);
        if (MK_MODE == 0 || MK_MODE == 1) {
            hipLaunchKernelGGL(nk_gla_g, dim3(T_ * 256 / 256), dim3(256), 0, stream, YSM, f[3] + l * 16 * 256, f[4] + l * 256, GG);
            hipLaunchKernelGGL(nk_gla_rec, dim3(32), dim3(64), 0, stream, Y, GG, OA);
            hipLaunchKernelGGL(nk_gla_post, dim3(T_ * 4 / 256), dim3(256), 0, stream, Y, OA, f[5] + l * 512, YM);
            hipLaunchKernelGGL(nk_rope, dim3(T_ * 384 / 256), dim3(256), 0, stream, Y, (const int*)d_in[1], QR, KR);
            hipLaunchKernelGGL(nk_dil, dim3(T_ * 4 / 64), dim3(64), 0, stream, QR, KR, Y, YM);
            hipLaunchKernelGGL(nk_sgu_stats, dim3(T_ / 256), dim3(256), 0, stream, Y, MU, RS);
            hipLaunchKernelGGL(nk_sgu_out, dim3(T_ * 768 / 256), dim3(256), 0, stream, Y, MU, RS, f[11] + l * 768, f[12] + l * 768, f[13] + l * 6 * 128 * 128, f[14] + l * 6 * 128, YM);
            hipLaunchKernelGGL(nk_ml_conv, dim3(T_ * 1024 / 256), dim3(256), 0, stream, Y, f[6] + l * 4 * 1024, f[7] + l * 1024, QKC);
            hipLaunchKernelGGL(nk_ml_den, dim3(1), dim3(64), 0, stream, YSM, QKC, f[8] + l * 4, f[9] + l * 4, DEN);
            hipLaunchKernelGGL(nk_ml_rec, dim3(32), dim3(64), 0, stream, Y, YSM, QKC, f[8] + l * 4, f[9] + l * 4, DEN, HM);
            hipLaunchKernelGGL(nk_ml_post, dim3(T_ * 4 / 256), dim3(256), 0, stream, HM, f[10] + l * 512, YM);
        }
        if (MK_MODE == 1 || MK_MODE == 2) for (int ph = 2; ph < 5; ++ph) launch_fwd(d_in, d_out, d_ws, stream, grid, p0 + ph, p0 + ph + 1, region++);
        if (MK_MODE == 1) hipLaunchKernelGGL(nk_compare, dim3(T_ * 256 / 256), dim3(256), 0, stream, (const bf16*)YM, (const bf16*)(ws + WS_MRG), dbg);
        for (int ph = 5; ph < 12; ++ph) launch_fwd(d_in, d_out, d_ws, stream, grid, p0 + ph, p0 + ph + 1, region++);
    }
    if (MK_MODE == 1) hipLaunchKernelGGL(nk_scale, dim3(T_ * D_ / 4 / 256), dim3(256), 0, stream, (float*)d_out, (const float*)dbg, (int)DBG_MASK);
#endif
}
```

```cpp
#include <hip/hip_runtime.h>
#include <cstdio>
#include <cstdint>
#include <cmath>
#define MK_MODE 3
#define REPEAT_MASK 0
#define HD __device__
#ifndef HD
#define HD
#endif
#define YP 15872
#define Y_AQ 0
#define Y_AK 256
#define Y_AV 512
#define Y_AR 1024
#define Y_BQ 1536
#define Y_BK 2304
#define Y_BV 3072
#define Y_CU 3840
#define Y_CV 4608
#define Y_DQ 5376
#define Y_DK 5888
#define Y_DV 6400
#define Y_DO 6912
#define Y_G  7680
#define YM_A 0
#define YM_B 512
#define YM_C 768
#define YM_D 1536
typedef unsigned short u16;
HD static inline float bf2f(u16 v) { unsigned u = ((unsigned)v) << 16; float f; __builtin_memcpy(&f, &u, 4); return f; }
HD static inline u16 f2bf(float f) { unsigned u; __builtin_memcpy(&u, &f, 4); u += 0x7fffu + ((u >> 16) & 1u); return (u16)(u >> 16); }
HD static inline float sigmoidf_(float x) { return 1.f / (1.f + expf(-x)); }
HD static inline float logsigmoidf_(float x) { return x < 0.f ? x - log1pf(expf(x)) : -log1pf(expf(-x)); }
HD static inline float siluf_(float x) { return x * sigmoidf_(x); }
HD static inline float geluf_(float x) { return 0.5f * x * (1.f + erff(x * 0.70710678118654752f)); }

HD static inline void naive_gla_g(int tok, int c, const float* YSM, const float* wa2, const float* ba, float* GG) {
    float s = ba[c];
    for (int r = 0; r < 16; ++r) s += YSM[tok * 32 + r] * wa2[r * 256 + c];
    GG[(size_t)tok * 256 + c] = logsigmoidf_(s) * (1.f / 16.f);
}
HD static inline void naive_gla_rec(int b, int h, int e, int S_, const u16* Y, const float* GG, float* OA) {
    float St[64];
#pragma unroll
    for (int d = 0; d < 64; ++d) St[d] = 0.f;
    for (int t = 0; t < S_; ++t) {
        const size_t tok = (size_t)b * S_ + t;
        const float v = bf2f(Y[tok * YP + Y_AV + h * 128 + e]);
        float o = 0.f;
#pragma unroll
        for (int d = 0; d < 64; ++d) {
            const float a = expf(GG[tok * 256 + h * 64 + d]);
            const float k = bf2f(Y[tok * YP + Y_AK + h * 64 + d]);
            const float q = bf2f(Y[tok * YP + Y_AQ + h * 64 + d]) * 0.125f;
            St[d] = a * St[d] + k * v;
            o += q * St[d];
        }
        OA[tok * 512 + h * 128 + e] = o;
    }
}
HD static inline void naive_gla_post(int tok, int h, const u16* Y, const float* OA, const float* norm_g, u16* YM) {
    float ss = 0.f;
    for (int e = 0; e < 128; ++e) { const float o = OA[(size_t)tok * 512 + h * 128 + e]; ss += o * o; }
    const float rs = 1.f / sqrtf(ss * (1.f / 128.f) + 1e-5f);
    for (int e = 0; e < 128; ++e) {
        const float o = OA[(size_t)tok * 512 + h * 128 + e] * rs * norm_g[h * 128 + e];
        const float r = bf2f(Y[(size_t)tok * YP + Y_AR + h * 128 + e]);
        YM[(size_t)tok * 2048 + YM_A + h * 128 + e] = f2bf(o * siluf_(r));
    }
}
HD static inline void naive_rope(int tok, int head, int i, const u16* Y, const int* positions, float* QR, float* KR) {
    const float inv = powf(10000.0f, -(float)i * 2.0f / 64.0f);
    const float ang = (float)positions[tok] * inv;
    const float c = cosf(ang), s = sinf(ang);
    const size_t yb = (size_t)tok * YP;
    const float q1 = bf2f(Y[yb + Y_BQ + head * 64 + i]), q2 = bf2f(Y[yb + Y_BQ + head * 64 + 32 + i]);
    const float k1 = bf2f(Y[yb + Y_BK + head * 64 + i]), k2 = bf2f(Y[yb + Y_BK + head * 64 + 32 + i]);
    QR[(size_t)tok * 768 + head * 64 + i] = q1 * c - q2 * s; QR[(size_t)tok * 768 + head * 64 + 32 + i] = q2 * c + q1 * s;
    KR[(size_t)tok * 768 + head * 64 + i] = k1 * c - k2 * s; KR[(size_t)tok * 768 + head * 64 + 32 + i] = k2 * c + k1 * s;
}
HD static inline void naive_dil(int tok, int hh, int S_, const float* QR, const float* KR, const u16* Y, u16* YM) {
    const int b = tok / S_, s = tok % S_;
    float o[64];
#pragma unroll
    for (int d = 0; d < 64; ++d) o[d] = 0.f;
    float mx = -INFINITY, den = 0.f;
    for (int g = 0; g < 3; ++g) {
        const int dil = g == 0 ? 1 : (g == 1 ? 4 : 16), head = g * 4 + hh;
        const int m = s / dil;
        for (int j = 0; j <= 128; ++j) {
            if (m - j < 0) break;
            const size_t kt = (size_t)b * S_ + (s - j * dil);
            float sc = 0.f;
#pragma unroll
            for (int d = 0; d < 64; ++d) sc += QR[(size_t)tok * 768 + head * 64 + d] * KR[kt * 768 + head * 64 + d];
            sc *= 0.125f;
            const float nm = fmaxf(mx, sc), corr = expf(mx - nm), p = expf(sc - nm);
            den = den * corr + p;
#pragma unroll
            for (int d = 0; d < 64; ++d) o[d] = o[d] * corr + p * bf2f(Y[kt * YP + Y_BV + head * 64 + d]);
            mx = nm;
        }
    }
#pragma unroll
    for (int d = 0; d < 64; ++d) YM[(size_t)tok * 2048 + YM_B + hh * 64 + d] = f2bf(o[d] / den);
}
HD static inline void naive_sgu_stats(int tok, const u16* Y, float* MU, float* RS) {
    float s = 0.f;
    for (int c = 0; c < 768; ++c) s += geluf_(bf2f(Y[(size_t)tok * YP + Y_CV + c]));
    const float mu = s * (1.f / 768.f); float q = 0.f;
    for (int c = 0; c < 768; ++c) { const float d = geluf_(bf2f(Y[(size_t)tok * YP + Y_CV + c])) - mu; q += d * d; }
    MU[tok] = mu; RS[tok] = 1.f / sqrtf(q * (1.f / 768.f) + 1e-5f);
}
HD static inline void naive_sgu_out(int tok, int c, int S_, const u16* Y, const float* MU, const float* RS, const float* ln_g, const float* ln_b,
                                    const float* ws, const float* bs, u16* YM) {
    const int s = tok % S_, i = s % 128, t0 = tok - i, g = c / 128;
    float acc = 0.f;
    for (int j = 0; j <= i; ++j) {
        const float zv = geluf_(bf2f(Y[(size_t)(t0 + j) * YP + Y_CV + c]));
        const float vn = (zv - MU[t0 + j]) * RS[t0 + j] * ln_g[c] + ln_b[c];
        acc += ws[(g * 128 + i) * 128 + j] * vn;
    }
    const float zu = geluf_(bf2f(Y[(size_t)tok * YP + Y_CU + c]));
    YM[(size_t)tok * 2048 + YM_C + c] = f2bf(zu * (acc + bs[g * 128 + i]));
}
HD static inline void naive_ml_conv(int tok, int c, int S_, const u16* Y, const float* conv_w, const float* conv_b, float* QKC) {
    const int s = tok % S_; const int col = c < 512 ? Y_DQ + c : Y_DK + (c - 512);
    float a = conv_b[c];
    for (int j = 0; j < 4; ++j) { const int sp = s - 3 + j; if (sp >= 0) a += conv_w[j * 1024 + c] * bf2f(Y[(size_t)(tok - 3 + j) * YP + col]); }
    a = siluf_(a);
    QKC[(size_t)tok * 1024 + c] = c < 512 ? a : a * 0.08838834764831845f;
}
HD static inline void naive_ml_den(int b, int h, int S_, const float* YSM, const float* QKC, const float* b_i, const float* b_f, float* DEN) {
    float n[128];
#pragma unroll
    for (int d = 0; d < 128; ++d) n[d] = 0.f;
    for (int t = 0; t < S_; ++t) {
        const size_t tok = (size_t)b * S_ + t;
        const float f = sigmoidf_(YSM[tok * 32 + 20 + h] + b_f[h]), ig = expf(YSM[tok * 32 + 16 + h] + b_i[h]);
        float den = 0.f;
#pragma unroll
        for (int d = 0; d < 128; ++d) { n[d] = f * n[d] + ig * QKC[tok * 1024 + 512 + h * 128 + d]; den += QKC[tok * 1024 + h * 128 + d] * n[d]; }
        DEN[tok * 4 + h] = den;
    }
}
HD static inline void naive_ml_rec(int b, int h, int e, int S_, const u16* Y, const float* YSM, const float* QKC, const float* b_i, const float* b_f, const float* DEN, float* HM) {
    float C[128];
#pragma unroll
    for (int d = 0; d < 128; ++d) C[d] = 0.f;
    for (int t = 0; t < S_; ++t) {
        const size_t tok = (size_t)b * S_ + t;
        const float f = sigmoidf_(YSM[tok * 32 + 20 + h] + b_f[h]), ig = expf(YSM[tok * 32 + 16 + h] + b_i[h]);
        const float v = bf2f(Y[tok * YP + Y_DV + h * 128 + e]);
        float num = 0.f;
#pragma unroll
        for (int d = 0; d < 128; ++d) { C[d] = f * C[d] + ig * QKC[tok * 1024 + 512 + h * 128 + d] * v; num += QKC[tok * 1024 + h * 128 + d] * C[d]; }
        const float den = DEN[tok * 4 + h];
        const float hh = num / fmaxf(fabsf(den), 1.0f);
        HM[tok * 512 + h * 128 + e] = sigmoidf_(bf2f(Y[tok * YP + Y_DO + h * 128 + e])) * hh;
    }
}
HD static inline void naive_ml_post(int tok, int h, const float* HM, const float* norm_g, u16* YM) {
    float ss = 0.f;
    for (int e = 0; e < 128; ++e) { const float o = HM[(size_t)tok * 512 + h * 128 + e]; ss += o * o; }
    const float rs = 1.f / sqrtf(ss * (1.f / 128.f) + 1e-5f);
    for (int e = 0; e < 128; ++e) YM[(size_t)tok * 2048 + YM_D + h * 128 + e] = f2bf(HM[(size_t)tok * 512 + h * 128 + e] * rs * norm_g[h * 128 + e]);
}
HD static inline void route_token(const float* sc, const float* bias, int* idx, float* w) {
    unsigned gmask = 0u;
    float gs[8];
#pragma unroll
    for (int g = 0; g < 8; ++g) {
        float m1 = -INFINITY, m2 = -INFINITY;
        for (int j = 0; j < 8; ++j) { const float c = sc[g * 8 + j] + bias[g * 8 + j]; if (c > m1) { m2 = m1; m1 = c; } else if (c > m2) m2 = c; }
        gs[g] = m1 + m2;
    }
#pragma unroll
    for (int g = 0; g < 8; ++g) {
        int rank = 0;
#pragma unroll
        for (int g2 = 0; g2 < 8; ++g2) rank += (gs[g2] > gs[g] || (gs[g2] == gs[g] && g2 < g)) ? 1 : 0;
        if (rank < 4) gmask |= 1u << g;
    }
    int n = 0; float wsum = 0.f;
    for (int e = 0; e < 64; ++e) {
        if (!((gmask >> (e >> 3)) & 1u)) continue;
        const float c = sc[e] + bias[e]; int rank = 0;
        for (int e2 = 0; e2 < 64; ++e2) { if (!((gmask >> (e2 >> 3)) & 1u)) continue; const float c2 = sc[e2] + bias[e2]; rank += (c2 > c || (c2 == c && e2 < e)) ? 1 : 0; }
        if (rank < 8) { if (n < 8) { idx[n] = e; w[n] = sc[e]; wsum += sc[e]; } ++n; }
    }
    const float r = 2.5f / wsum;
    for (int k = 0; k < 8; ++k) w[k] *= r;
}

HD static inline bool route_lane_select(int lane, const float* sc, const float* bias) {
    float gs[8];
#pragma unroll
    for (int g = 0; g < 8; ++g) { float m1 = -INFINITY, m2 = -INFINITY;
#pragma unroll
        for (int j = 0; j < 8; ++j) { const float c = sc[g * 8 + j] + bias[g * 8 + j]; if (c > m1) { m2 = m1; m1 = c; } else if (c > m2) m2 = c; }
        gs[g] = m1 + m2; }
    unsigned gmask = 0u;
#pragma unroll
    for (int g = 0; g < 8; ++g) { int r = 0;
#pragma unroll
        for (int g2 = 0; g2 < 8; ++g2) r += (gs[g2] > gs[g] || (gs[g2] == gs[g] && g2 < g)) ? 1 : 0;
        if (r < 4) gmask |= 1u << g; }
    if (!((gmask >> (lane >> 3)) & 1u)) return false;
    const float myc = sc[lane] + bias[lane]; int rank = 0;
    for (int e = 0; e < 64; ++e) { const float c = sc[e] + bias[e]; rank += (((gmask >> (e >> 3)) & 1u) && (c > myc || (c == myc && e < lane))) ? 1 : 0; }
    return rank < 8;
}
namespace pg8 {
#define PG8_LAS __attribute__((address_space(3)))
typedef unsigned short bf16_t;
typedef short bf16x8 __attribute__((ext_vector_type(8)));
typedef float f32x4 __attribute__((ext_vector_type(4)));
typedef unsigned u32x4 __attribute__((ext_vector_type(4)));
typedef unsigned u32x2 __attribute__((ext_vector_type(2)));
typedef int i32x4 __attribute__((ext_vector_type(4)));
typedef int i32x8 __attribute__((ext_vector_type(8)));
constexpr int BM = 256, BK = 64, HALF = 128, HTB = HALF * BK * 2  , STAGE_BYTES = 8 * HTB, NXCD = 8, WGM = 8;

__host__ __device__ __forceinline__ int lds_byte(int r, int c) { const int st = (r >> 4) * 2 + (c >> 5), rr = r & 15, cc = c & 31, ob = rr * 64 + cc * 2; return st * 1024 + (ob ^ (((ob >> 9) & 1) << 5)); }
__host__ __device__ __forceinline__ void stage_rc(int b, int& R, int& C) { const int st = b / 1024, sb = b % 1024, swz = sb ^ (((sb >> 9) & 1) << 5); R = (st >> 1) * 16 + swz / 64; C = (st & 1) * 32 + (swz % 64) / 2; }
__host__ __device__ __forceinline__ int perm32(int rho) { const int n = rho >> 4, i = rho & 15; return 8 * (i >> 2) + 4 * n + (i & 3); }

struct Unit { int pm, pn; };
struct Gemm { const bf16_t* A; const bf16_t* Bt; int M, N, K, lda, ldb; const int* rowmap; };

struct StaticOrder {
    int nM, nN, nwg, G, c, wgm;
    __host__ __device__ void init(int M, int N, int G_, int c_, int wgm_ = WGM) { nM = M / BM; nN = N / BM; nwg = nM * nN; G = G_; c = c_; wgm = wgm_; }
    __host__ __device__ bool next(int i, Unit& u) const {
        const long L = (long)i * G + c; if (L >= nwg) return false;
        int wgid = (int)L; { const int q = nwg / NXCD, r = nwg % NXCD, xcd = wgid % NXCD, off = wgid / NXCD; wgid = (xcd < r ? xcd * (q + 1) : r * (q + 1) + (xcd - r) * q) + off; }
        const int nig = wgm * nN, gid = wgid / nig, fm = gid * wgm, gsz = (nM - fm) < wgm ? (nM - fm) : wgm;
        u.pm = fm + ((wgid % nig) % gsz); u.pn = (wgid % nig) / gsz; return true;
    }
    __device__ __forceinline__ void a_ready(const Unit&) const {}
    __device__ __forceinline__ void done(const Unit&) const {}
};

__device__ __forceinline__ unsigned cvt_pk_bf16(float lo, float hi) { unsigned r; asm volatile("v_cvt_pk_bf16_f32 %0, %1, %2" : "=v"(r) : "v"(lo), "v"(hi)); return r; }

template <class Epi, class Sched, bool ALIGN_EPI = true, bool GATHER = false, int NBJ = 2, int DT = 0>
__device__ __forceinline__ void gemm_phase(PG8_LAS unsigned char* lds, const Gemm g, const Sched& S, const Epi& E, const int tid) {
    const int wid = __builtin_amdgcn_readfirstlane(tid >> 6), lane = tid & 63, wr = wid >> 2, wc = wid & 3, fr = lane & 15, fq = lane >> 4;
    const int K = g.K, nt = K / BK;
    unsigned voffB[2]; int rA[2]; unsigned cA2[2];
#pragma unroll
    for (int i = 0; i < 2; ++i) { int R, C; stage_rc(tid * 16 + i * 8192, R, C); const int Rb = Epi::PERM ? ((R & ~31) + perm32(R & 31)) : R;
        rA[i] = R; cA2[i] = (unsigned)C * 2u; voffB[i] = (unsigned)(Rb * g.ldb + C) * 2u; }
    const size_t kstep = (size_t)(BK * 2);
    const size_t hstepA = (size_t)HALF * g.lda * 2, hstepB = (size_t)HALF * g.ldb * 2;
    const size_t tstepA = GATHER ? 0 : 2 * hstepA, tstepB = NBJ * hstepB;
    unsigned cvo[4], nvo[4];
#define PG8_AOFF(dst, unit) do { _Pragma("unroll") for (int h_ = 0; h_ < 2; ++h_) _Pragma("unroll") for (int i_ = 0; i_ < 2; ++i_) { \
        if constexpr (GATHER) dst[2 * h_ + i_] = (unsigned)g.rowmap[(size_t)(unit).pm * BM + h_ * HALF + rA[i_]] * (unsigned)(g.lda * 2) + cA2[i_]; \
        else dst[2 * h_ + i_] = (unsigned)((h_ * HALF + rA[i_]) * g.lda) * 2u + cA2[i_]; } } while (0)
    const unsigned ldsw = (unsigned)wid * 1024u;
    const int aoff = lds_byte(wr * 64 + fr, fq * 8), boff = lds_byte(wc * 32 + fr, fq * 8);
#define PG8_SA(b, h) (((b) * 2 + (h)) * HTB)
#define PG8_SB(b, h) ((4 + (b) * 2 + (h)) * HTB)
#define PG8_STAGE2(bufoff, gbase, v0, v1) do { \
        __builtin_amdgcn_global_load_lds((const unsigned*)((const char*)(gbase) + (v0)), (PG8_LAS unsigned*)(lds + (bufoff) + ldsw), 16, 0, 0); \
        __builtin_amdgcn_global_load_lds((const unsigned*)((const char*)(gbase) + (v1)), (PG8_LAS unsigned*)(lds + (bufoff) + ldsw + 8192), 16, 0, 0); } while (0)
#define PG8_STAGE(bufoff, gbase, voff) PG8_STAGE2(bufoff, gbase, (voff)[0], (voff)[1])
#define PG8_LDA(dst, b, h) do { _Pragma("unroll") for (int m = 0; m < 4; ++m) _Pragma("unroll") for (int k = 0; k < 2; ++k) dst[m][k] = *(const PG8_LAS bf16x8*)(lds + PG8_SA(b, h) + aoff + m * 2048 + k * 1024); } while (0)
#define PG8_LDB(dst, b, h) do { _Pragma("unroll") for (int n = 0; n < 2; ++n) _Pragma("unroll") for (int k = 0; k < 2; ++k) dst[n][k] = *(const PG8_LAS bf16x8*)(lds + PG8_SB(b, h) + boff + n * 2048 + k * 1024); } while (0)
#define PG8_MMA(ai, bj, At, Bt) do { __builtin_amdgcn_s_setprio(1); _Pragma("unroll") for (int m = 0; m < 4; ++m) _Pragma("unroll") for (int n = 0; n < 2; ++n) { \
        if constexpr (DT == 0) { _Pragma("unroll") for (int k = 0; k < 2; ++k) acc[ai][bj][m][n] = __builtin_amdgcn_mfma_f32_16x16x32_bf16(Bt[n][k], At[m][k], acc[ai][bj][m][n], 0, 0, 0); } \
        else { const i32x4 b0_ = __builtin_bit_cast(i32x4, Bt[n][0]), b1_ = __builtin_bit_cast(i32x4, Bt[n][1]), a0_ = __builtin_bit_cast(i32x4, At[m][0]), a1_ = __builtin_bit_cast(i32x4, At[m][1]); \
            const i32x8 bw_ = __builtin_shufflevector(b0_, b1_, 0, 1, 2, 3, 4, 5, 6, 7), aw_ = __builtin_shufflevector(a0_, a1_, 0, 1, 2, 3, 4, 5, 6, 7); \
              \
            asm volatile("v_mfma_scale_f32_16x16x128_f8f6f4 %0, %1, %2, %0, %3, %4 op_sel_hi:[0,0,0]" : "+v"(acc[ai][bj][m][n]) : "v"(bw_), "v"(aw_), "v"(0x7a7a7a7a), "v"(0x7f7f7f7f)); } } \
        __builtin_amdgcn_s_setprio(0); } while (0)
#define PG8_WAIT_V(n) asm volatile("s_waitcnt vmcnt(" #n ")" ::: "memory")
#define PG8_WAIT_LOOP do { if constexpr (NBJ == 2) PG8_WAIT_V(8); else PG8_WAIT_V(6); } while (0)
#define PG8_WAIT_L(n) asm volatile("s_waitcnt lgkmcnt(" #n ")" ::: "memory")
#define PG8_BAR __builtin_amdgcn_s_barrier()
#define PG8_SCHED __builtin_amdgcn_sched_barrier(0)
    Unit cur, nxt; int ui = 0;
    if (!S.next(0, cur)) return;
    f32x4 acc[2][NBJ][4][2];
#pragma unroll
    for (int a = 0; a < 2; ++a)
#pragma unroll
        for (int b = 0; b < NBJ; ++b)
#pragma unroll
            for (int m = 0; m < 4; ++m)
#pragma unroll
                for (int n = 0; n < 2; ++n) acc[a][b][m][n] = (f32x4){0.f, 0.f, 0.f, 0.f};
    bf16x8 At[4][2], B0[2][2], B1[2][2];
    const char* cA = (const char*)g.A + (size_t)cur.pm * tstepA; const char* cB = (const char*)g.Bt + (size_t)cur.pn * tstepB;
    S.a_ready(cur);
    PG8_AOFF(cvo, cur);
    PG8_STAGE(PG8_SB(0, 0), cB, voffB); if constexpr (NBJ == 2) PG8_STAGE(PG8_SB(0, 1), cB + hstepB, voffB); PG8_STAGE2(PG8_SA(0, 0), cA, cvo[0], cvo[1]); PG8_STAGE2(PG8_SA(0, 1), cA, cvo[2], cvo[3]);
    if (wr == 1) PG8_BAR;
    PG8_WAIT_V(2); PG8_BAR;
    PG8_STAGE(PG8_SB(1, 0), cB + kstep, voffB); PG8_STAGE2(PG8_SA(1, 0), cA + kstep, cvo[0], cvo[1]); if constexpr (NBJ == 2) PG8_STAGE(PG8_SB(1, 1), cB + hstepB + kstep, voffB);
    if constexpr (NBJ == 2) PG8_WAIT_V(6); else PG8_WAIT_V(4);
    PG8_BAR;
    for (;;) {
        const bool has_next = S.next(ui + 1, nxt);
        const char* nA = has_next ? (const char*)g.A + (size_t)nxt.pm * tstepA : cA; const char* nB = has_next ? (const char*)g.Bt + (size_t)nxt.pn * tstepB : cB;
        if (has_next) { PG8_AOFF(nvo, nxt); } else {
#pragma unroll
            for (int j_ = 0; j_ < 4; ++j_) nvo[j_] = cvo[j_]; }
        for (int t = 0; t < nt; t += 2) {
            const bool last = (t == nt - 2);
            const char* a1 = cA + (size_t)(t + 1) * kstep;
            const char* a2 = last ? nA : cA + (size_t)(t + 2) * kstep; const char* b2 = last ? nB : cB + (size_t)(t + 2) * kstep;
            const char* a3 = a2 + kstep; const char* b3 = b2 + kstep;
            if (last && has_next) S.a_ready(nxt);
            unsigned so[4];
#pragma unroll
            for (int j_ = 0; j_ < 4; ++j_) so[j_] = last ? nvo[j_] : cvo[j_];
            PG8_LDB(B0, 0, 0); if constexpr (NBJ == 2) PG8_LDB(B1, 0, 1); PG8_SCHED; PG8_LDA(At, 0, 0); PG8_STAGE2(PG8_SA(1, 1), a1, cvo[2], cvo[3]);
            PG8_WAIT_LOOP; PG8_WAIT_L(0); PG8_BAR; PG8_MMA(0, 0, At, B0); if constexpr (NBJ == 2) PG8_MMA(0, NBJ - 1, At, B1); PG8_BAR; PG8_SCHED;
            PG8_LDA(At, 0, 1); PG8_STAGE(PG8_SB(0, 0), b2, voffB); if constexpr (NBJ == 2) PG8_STAGE(PG8_SB(0, 1), b2 + hstepB, voffB); PG8_STAGE2(PG8_SA(0, 0), a2, so[0], so[1]);
            PG8_WAIT_LOOP; PG8_WAIT_L(0); PG8_BAR; PG8_MMA(1, 0, At, B0); if constexpr (NBJ == 2) PG8_MMA(1, NBJ - 1, At, B1); PG8_BAR; PG8_SCHED;
            PG8_LDB(B0, 1, 0); if constexpr (NBJ == 2) PG8_LDB(B1, 1, 1); PG8_SCHED; PG8_LDA(At, 1, 0); PG8_STAGE2(PG8_SA(0, 1), a2, so[2], so[3]);
            PG8_WAIT_LOOP; PG8_WAIT_L(0); PG8_BAR; PG8_MMA(0, 0, At, B0); if constexpr (NBJ == 2) PG8_MMA(0, NBJ - 1, At, B1); PG8_BAR; PG8_SCHED;
            PG8_LDA(At, 1, 1); PG8_STAGE(PG8_SB(1, 0), b3, voffB); if constexpr (NBJ == 2) PG8_STAGE(PG8_SB(1, 1), b3 + hstepB, voffB); PG8_STAGE2(PG8_SA(1, 0), a3, so[0], so[1]);
            PG8_WAIT_LOOP; PG8_WAIT_L(0); PG8_BAR; PG8_MMA(1, 0, At, B0); if constexpr (NBJ == 2) PG8_MMA(1, NBJ - 1, At, B1); PG8_BAR; PG8_SCHED;
            if constexpr (Epi::HAS_FOLD) { if (!last && E.boundary(t + 2)) { E.fold(acc, cur, wr, wc, fr, fq, t + 2);
#pragma unroll
                for (int a = 0; a < 2; ++a)
#pragma unroll
                    for (int b = 0; b < NBJ; ++b)
#pragma unroll
                        for (int m = 0; m < 4; ++m)
#pragma unroll
                            for (int n = 0; n < 2; ++n) acc[a][b][m][n] = (f32x4){0.f, 0.f, 0.f, 0.f}; } }
        }
        if constexpr (ALIGN_EPI) { if (wr == 0) PG8_BAR; }
        if constexpr (DT == 1) asm volatile("s_nop 15\n\ts_nop 15\n\ts_nop 15\n\ts_nop 15\n\ts_nop 15\n\ts_nop 15" ::: "memory");
        E(acc, cur, wr, wc, fr, fq); S.done(cur);
        if (!has_next) break;
#pragma unroll
        for (int a = 0; a < 2; ++a)
#pragma unroll
            for (int b = 0; b < NBJ; ++b)
#pragma unroll
                for (int m = 0; m < 4; ++m)
#pragma unroll
                    for (int n = 0; n < 2; ++n) acc[a][b][m][n] = (f32x4){0.f, 0.f, 0.f, 0.f};
        cur = nxt; cA = nA; cB = nB; ++ui;
#pragma unroll
        for (int j_ = 0; j_ < 4; ++j_) cvo[j_] = nvo[j_];
        if constexpr (ALIGN_EPI) { if (wr == 1) PG8_BAR; }
    }
    PG8_WAIT_V(0);
    if constexpr (!ALIGN_EPI) { if (wr == 0) PG8_BAR; }
    PG8_BAR;
#undef PG8_SA
#undef PG8_SB
#undef PG8_STAGE
#undef PG8_STAGE2
#undef PG8_AOFF
#undef PG8_LDA
#undef PG8_LDB
#undef PG8_MMA
#undef PG8_WAIT_V
#undef PG8_WAIT_LOOP
#undef PG8_WAIT_L
#undef PG8_BAR
#undef PG8_SCHED
}

#ifndef N1_DBG
#define N1_DBG 0
#endif
template <class Epi, class Sched>
__device__ __forceinline__ void gemm_phase_n1s3(PG8_LAS unsigned char* lds, const Gemm g, const Sched& S, const Epi& E, const int tid) {
    const int wid = __builtin_amdgcn_readfirstlane(tid >> 6), lane = tid & 63, wr = wid >> 2, wc = wid & 3, fr = lane & 15, fq = lane >> 4;
    const int nt = g.K / BK;
    constexpr unsigned STG = 49152u;
    unsigned voffB[2], voA[4];
#pragma unroll
    for (int i = 0; i < 2; ++i) { int R, C; stage_rc(tid * 16 + i * 8192, R, C);
        voffB[i] = (unsigned)(R * g.ldb + C) * 2u; voA[i] = (unsigned)(R * g.lda + C) * 2u; voA[2 + i] = (unsigned)((HALF + R) * g.lda + C) * 2u; }
    const size_t kstep = (size_t)(BK * 2), tstepA = (size_t)BM * g.lda * 2, tstepB = (size_t)HALF * g.ldb * 2;
    const unsigned ldsw = (unsigned)wid * 1024u;
    const int aoff = lds_byte(wr * 64 + fr, fq * 8), boff = lds_byte(wc * 32 + fr, fq * 8);
#define N1_STAGE(dst, gp, v0, v1) do { \
        __builtin_amdgcn_global_load_lds((const unsigned*)((const char*)(gp) + (v0)), (PG8_LAS unsigned*)(lds + (dst) + ldsw), 16, 0, 0); \
        __builtin_amdgcn_global_load_lds((const unsigned*)((const char*)(gp) + (v1)), (PG8_LAS unsigned*)(lds + (dst) + ldsw + 8192), 16, 0, 0); } while (0)
#define N1_STAGE_TILE(wb, pa, pb) do { N1_STAGE((wb) + 32768u, pb, voffB[0], voffB[1]); N1_STAGE((wb), pa, voA[0], voA[1]); N1_STAGE((wb) + 16384u, pa, voA[2], voA[3]); } while (0)
#define N1_WAIT_V(n) asm volatile("s_waitcnt vmcnt(" #n ")" ::: "memory")
#define N1_WAIT_L0 asm volatile("s_waitcnt lgkmcnt(0)" ::: "memory")
#define N1_BAR __builtin_amdgcn_s_barrier()
    Unit cur, nxt; int ui = 0;
    if (!S.next(0, cur)) return;
    f32x4 acc[2][1][4][2];
#pragma unroll
    for (int a = 0; a < 2; ++a)
#pragma unroll
        for (int m = 0; m < 4; ++m)
#pragma unroll
            for (int n = 0; n < 2; ++n) acc[a][0][m][n] = (f32x4){0.f, 0.f, 0.f, 0.f};
    bf16x8 A0[4][2], A1[4][2], B0[2][2];
    const char* cA = (const char*)g.A + (size_t)cur.pm * tstepA; const char* cB = (const char*)g.Bt + (size_t)cur.pn * tstepB;
    unsigned gt = 0;
    N1_STAGE_TILE(0u, cA, cB); N1_STAGE_TILE(STG, cA + kstep, cB + kstep);
    if (wr == 1) N1_BAR;
    N1_WAIT_V(6); N1_BAR;
    N1_BAR;
    for (;;) {
        const bool has_next = S.next(ui + 1, nxt);
        const char* nA = has_next ? (const char*)g.A + (size_t)nxt.pm * tstepA : cA; const char* nB = has_next ? (const char*)g.Bt + (size_t)nxt.pn * tstepB : cB;
        for (int t = 0; t < nt; ++t, ++gt) {
            const unsigned s0 = gt % 3u, rb = s0 * STG, wb = (s0 == 0u ? 2u : s0 - 1u) * STG;
            const int t2 = t + 2; const bool over = t2 >= nt;
            const char* pa = over ? nA + (size_t)(t2 - nt) * kstep : cA + (size_t)t2 * kstep; const char* pb = over ? nB + (size_t)(t2 - nt) * kstep : cB + (size_t)t2 * kstep;
#pragma unroll
            for (int n = 0; n < 2; ++n)
#pragma unroll
                for (int k = 0; k < 2; ++k) B0[n][k] = *(const PG8_LAS bf16x8*)(lds + rb + 32768u + boff + n * 2048 + k * 1024);
            __builtin_amdgcn_sched_barrier(0);
#pragma unroll
            for (int m = 0; m < 4; ++m)
#pragma unroll
                for (int k = 0; k < 2; ++k) { A0[m][k] = *(const PG8_LAS bf16x8*)(lds + rb + aoff + m * 2048 + k * 1024); A1[m][k] = *(const PG8_LAS bf16x8*)(lds + rb + 16384u + aoff + m * 2048 + k * 1024); }
            N1_STAGE_TILE(wb, pa, pb);
            N1_WAIT_V(6); N1_WAIT_L0; N1_BAR;
            __builtin_amdgcn_s_setprio(1);
#pragma unroll
            for (int m = 0; m < 4; ++m)
#pragma unroll
                for (int n = 0; n < 2; ++n)
#pragma unroll
                    for (int k = 0; k < 2; ++k) { acc[0][0][m][n] = __builtin_amdgcn_mfma_f32_16x16x32_bf16(B0[n][k], A0[m][k], acc[0][0][m][n], 0, 0, 0);
                        acc[1][0][m][n] = __builtin_amdgcn_mfma_f32_16x16x32_bf16(B0[n][k], A1[m][k], acc[1][0][m][n], 0, 0, 0); }
            __builtin_amdgcn_s_setprio(0);
            N1_BAR; __builtin_amdgcn_sched_barrier(0);
            if (t + 1 < nt && E.boundary(t + 1)) { E.fold(acc, cur, wr, wc, fr, fq, t + 1);
#pragma unroll
                for (int a = 0; a < 2; ++a)
#pragma unroll
                    for (int m = 0; m < 4; ++m)
#pragma unroll
                        for (int n = 0; n < 2; ++n) acc[a][0][m][n] = (f32x4){0.f, 0.f, 0.f, 0.f}; }
        }
        if (wr == 0) N1_BAR;
        E(acc, cur, wr, wc, fr, fq);
        if (!has_next) break;
#pragma unroll
        for (int a = 0; a < 2; ++a)
#pragma unroll
            for (int m = 0; m < 4; ++m)
#pragma unroll
                for (int n = 0; n < 2; ++n) acc[a][0][m][n] = (f32x4){0.f, 0.f, 0.f, 0.f};
        cur = nxt; cA = nA; cB = nB; ++ui;
        if (wr == 1) N1_BAR;
    }
    N1_WAIT_V(0);
    N1_BAR;
#undef N1_STAGE
#undef N1_STAGE_TILE
#undef N1_WAIT_V
#undef N1_WAIT_L0
#undef N1_BAR
}
}
#ifndef MERGE3
#define MERGE3 0
#endif
constexpr int T_ = 8192, D_ = 2048, SEQ_ = 2048, NB_ = 4, NL_ = 2, NCOL = 15640;
constexpr float DN_ALPHA = 1.41421356237309515f;
constexpr float LN_EPS_ = 1e-5f;
constexpr int MAXROWS = 90112;
constexpr size_t MiB = 1u << 20;
constexpr size_t WS_CTL = 0, CTL_ZERO_BYTES = 1048576;
constexpr size_t WS_XB = 1 * MiB, WS_HB = 33 * MiB, WS_X1 = 97 * MiB, WS_XA = 161 * MiB, WS_YM = 225 * MiB, WS_MRG = 257 * MiB, WS_MB = 321 * MiB;
constexpr size_t WS_YSM = 353 * MiB, WS_CS = 354 * MiB, WS_SEL = 356 * MiB, WS_ROWW = 357 * MiB, WS_ROWMAP = 357 * MiB + 512 * 1024;
constexpr size_t WS_WIN = 358 * MiB, WS_WP = 420 * MiB, WS_WOUT = 428 * MiB, WS_W13 = 436 * MiB, WS_W2 = 696 * MiB, WS_H = 826 * MiB, WS_XS = 914 * MiB, WS_YBUF = 1266 * MiB;
constexpr size_t WS_XS8 = WS_XS + 64 * MiB, WS_XB8 = WS_XS + 80 * MiB, WS_WIN8 = WS_XS + 96 * MiB;
constexpr size_t WS_Y = WS_YBUF;
constexpr size_t WS_GLOC = 1618 * MiB, WS_GDEC = 1634 * MiB, WS_GST = 1635 * MiB, WS_MLOC = 1643 * MiB, WS_MNLOC = 1675 * MiB, WS_MSC = 1676 * MiB, WS_MC = 1677 * MiB, WS_MN = 1693 * MiB, WS_MM = 1694 * MiB;
constexpr size_t WS_DILO = 1695 * MiB, WS_DILL = 1719 * MiB;
constexpr size_t WS_NV = 1720 * MiB;
constexpr size_t WS_W13B = 1842 * MiB, WS_W2B = 1972 * MiB;
constexpr size_t WS_END = 2037 * MiB;
constexpr int CW_CNT = 8192, CW_TST = 8448, CW_CQ = 12400, CW_ARR = 12416, CW_BAR = 16384;
constexpr int RING_BYTES = 131072, AUX_OFF = 131072, LDS_BYTES = 147456 + 16384 * MERGE3;
constexpr int AUX_BARW = LDS_BYTES - 16;

#define GAS __attribute__((address_space(1)))
#define LAS __attribute__((address_space(3)))
typedef unsigned short bf16;
typedef unsigned v4u __attribute__((ext_vector_type(4)));
typedef unsigned v2u __attribute__((ext_vector_type(2)));
typedef float f32x4 __attribute__((ext_vector_type(4)));
typedef float f32x2 __attribute__((ext_vector_type(2)));
typedef short bf16x8 __attribute__((ext_vector_type(8)));
#define LDS_WAIT() asm volatile("s_waitcnt lgkmcnt(0)" ::: "memory")
#define VM_WAIT() asm volatile("s_waitcnt vmcnt(0)" ::: "memory")
__device__ __forceinline__ unsigned pk2(float lo, float hi) { return pg8::cvt_pk_bf16(lo, hi); }
__device__ __forceinline__ float bflo(unsigned u) { return __builtin_bit_cast(float, u << 16); }
__device__ __forceinline__ float bfhi(unsigned u) { return __builtin_bit_cast(float, u & 0xffff0000u); }
__device__ __forceinline__ float fsigmoid(float x) { return 1.f / (1.f + __expf(-x)); }
__device__ __forceinline__ float wave_sum(float v) {
#pragma unroll
    for (int o = 1; o < 64; o <<= 1) v += __shfl_xor(v, o);
    return v;
}
__device__ __forceinline__ float wave_max(float v) {
#pragma unroll
    for (int o = 1; o < 64; o <<= 1) v = fmaxf(v, __shfl_xor(v, o));
    return v;
}

#define XB_TMO      128
#define XB_XCNT(j)  (256  + 64 * (j))
#define XB_XSUB(j)  (1280 + 64 * (j))
#define XB_XGEN(j)  (2304 + 64 * (j))
#define XB_TOP      3328
#define XB_TOPGEN   3392
#define XCD_BAR_WORDS 3456
#define XB_SPIN_CAP (1u << 22)
__device__ __forceinline__ unsigned xb_ld(unsigned* p)              { return __hip_atomic_load(p, __ATOMIC_RELAXED, __HIP_MEMORY_SCOPE_AGENT); }
__device__ __forceinline__ unsigned xb_add(unsigned* p, unsigned v) { return __hip_atomic_fetch_add(p, v, __ATOMIC_RELAXED, __HIP_MEMORY_SCOPE_AGENT); }
__device__ __forceinline__ unsigned xb_xcc_id() { return (unsigned)__builtin_amdgcn_s_getreg((3 << 11) | 20) & 0xFu; }
#define XB_SPIN(cond, bar) do { unsigned _sp = 0; while (cond) { __builtin_amdgcn_s_sleep(1); \
    if ((++_sp & 255u) == 0u) { if (xb_ld(&(bar)[XB_TMO])) break; if (_sp > XB_SPIN_CAP) { atomicAdd(&(bar)[XB_TMO], 1u); break; } } } } while (0)
struct XcdBarrier { unsigned* bar; unsigned x; volatile LAS unsigned* st; };
__device__ __forceinline__ XcdBarrier xcd_barrier_post(unsigned* bar, volatile LAS unsigned* st) {
    XcdBarrier b; b.bar = bar; b.x = xb_xcc_id(); b.st = st;
    if (threadIdx.x == 0) (void)xb_add(&bar[XB_XCNT(b.x)], 1u);
    return b;
}
__device__ __forceinline__ void xcd_barrier_complete(unsigned* bar, unsigned x, unsigned& nloc, unsigned& nx) {
    const unsigned G = gridDim.x * gridDim.y * gridDim.z;
    unsigned sum, cnt, mine, sp = 0u;
    for (;;) {
        sum = 0u; cnt = 0u; mine = 0u;
#pragma unroll
        for (unsigned j = 0; j < 16; ++j) { const unsigned c = xb_ld(&bar[XB_XCNT(j)]); sum += c; cnt += (c > 0u) ? 1u : 0u; mine = (j == x) ? c : mine; }
        if (sum == G) break;
        __builtin_amdgcn_s_sleep(1);
        if ((++sp & 255u) == 0u) { if (xb_ld(&bar[XB_TMO])) break; if (sp > XB_SPIN_CAP) { atomicAdd(&bar[XB_TMO], 1u); break; } }
    }
    nloc = mine > 0u ? mine : 1u; nx = cnt > 0u ? cnt : 1u;
}
__device__ __forceinline__ void xcd_barrier(const XcdBarrier& b) {
    asm volatile("s_waitcnt vmcnt(0)" ::: "memory");
    __syncthreads();
    if (threadIdx.x == 0) {
        unsigned* bar = b.bar;
        __builtin_amdgcn_s_waitcnt(0);
        unsigned nloc = b.st[0], nx = b.st[1];
        if (nloc == 0u) { xcd_barrier_complete(bar, b.x, nloc, nx); b.st[0] = nloc; b.st[1] = nx; }
        const unsigned old = xb_add(&bar[XB_XSUB(b.x)], 1u);
        const unsigned gen = old / nloc;
        if (old + 1u == (gen + 1u) * nloc) {
            __builtin_amdgcn_fence(__ATOMIC_RELEASE, "agent");
            asm volatile("s_waitcnt vmcnt(0)" ::: "memory");
            const unsigned og = xb_add(&bar[XB_TOP], 1u);
            const unsigned tg = og / nx;
            if (og + 1u == (tg + 1u) * nx) xb_add(&bar[XB_TOPGEN], 1u);
            else XB_SPIN(xb_ld(&bar[XB_TOPGEN]) == tg, bar);
            __builtin_amdgcn_fence(__ATOMIC_ACQUIRE, "agent");
            xb_add(&bar[XB_XGEN(b.x)], 1u);
            asm volatile("s_waitcnt vmcnt(0)" ::: "memory");
        } else {
            XB_SPIN(xb_ld(&bar[XB_XGEN(b.x)]) == gen, bar);
            __builtin_amdgcn_fence(__ATOMIC_ACQUIRE, "agent");
            asm volatile("s_waitcnt vmcnt(0)" ::: "memory");
        }
    }
    __syncthreads();
}
using pg8::Unit;
#ifndef STEAL_MARGIN
#define STEAL_MARGIN 8u
#endif
#ifndef MOE_XCD
#define MOE_XCD 1
#endif
#ifndef FP8_GATES
#define FP8_GATES 3
#endif
#define GATES8(l) ((FP8_GATES >> (l)) & 1)
#ifndef FP8_MOE
#define FP8_MOE 3
#endif
#define MOE8(l) ((FP8_MOE >> (l)) & 1)
#define FP8_LAST MOE8(NL_ - 1)
__device__ __forceinline__ unsigned pk4_fp8(float a, float b, float c, float d) { int w = 0; w = __builtin_amdgcn_cvt_pk_fp8_f32(a, b, w, false); w = __builtin_amdgcn_cvt_pk_fp8_f32(c, d, w, true); return (unsigned)w; }
struct EpiY {
    static constexpr bool PERM = true, HAS_FOLD = false;
    bf16* Y; float* YSM; int pn0;
    __device__ __forceinline__ void operator()(const f32x4 (&acc)[2][2][4][2], const Unit& u, int wr, int wc, int fr, int fq) const {
        const int row0 = u.pm * 256 + wr * 64 + fr, pn = u.pn + pn0;
        if (pn == 29) {
            if (wc == 0) {
#pragma unroll
                for (int ai = 0; ai < 2; ++ai)
#pragma unroll
                    for (int m = 0; m < 4; ++m) { float* rp = YSM + (size_t)(row0 + ai * 128 + m * 16) * 32 + 8 * fq; *(f32x4*)rp = acc[ai][0][m][0]; *(f32x4*)(rp + 4) = acc[ai][0][m][1]; }
            }
            return;
        }
        const bool sg = pn >= 30;
#pragma unroll
        for (int ai = 0; ai < 2; ++ai)
#pragma unroll
            for (int m = 0; m < 4; ++m) { bf16* rp = Y + (size_t)(row0 + ai * 128 + m * 16) * YP + pn * 256 + wc * 32 + 8 * fq;
#pragma unroll
                for (int bj = 0; bj < 2; ++bj) { f32x4 v0 = acc[ai][bj][m][0], v1 = acc[ai][bj][m][1];
                    if (sg) {
#pragma unroll
                        for (int j = 0; j < 4; ++j) { v0[j] = fsigmoid(v0[j]); v1[j] = fsigmoid(v1[j]); } }
                    v4u w; w.x = pk2(v0[0], v0[1]); w.y = pk2(v0[2], v0[3]); w.z = pk2(v1[0], v1[1]); w.w = pk2(v1[2], v1[3]);
                    *(v4u*)(rp + bj * 128) = w; } }
    }
};
struct EpiMerge {
    static constexpr bool PERM = false, HAS_FOLD = true;
    const bf16* Y; bf16* MB; mutable f32x4 tot[2][4][2];
    __device__ __forceinline__ bool boundary(int kt) const { return kt == 8 || kt == 12 || kt == 24; }
    __device__ __forceinline__ void fold(const f32x4 (&acc)[2][1][4][2], const Unit& u, int wr, int wc, int fr, int fq, int kt) const {
        const int br = kt == 8 ? 0 : (kt == 12 ? 1 : (kt == 24 ? 2 : 3));
        int zv = 0; asm volatile("" : "+v"(zv));
        const int row0 = u.pm * 256 + wr * 64 + fr + zv, col0 = u.pn * 128 + wc * 32 + 4 * fq;
        v2u gp[2][4][2];
#pragma unroll
        for (int ai = 0; ai < 2; ++ai)
#pragma unroll
            for (int m = 0; m < 4; ++m)
#pragma unroll
                for (int n = 0; n < 2; ++n) gp[ai][m][n] = *(const v2u*)(Y + (size_t)(row0 + ai * 128 + m * 16) * YP + Y_G + br * 2048 + col0 + n * 16);
#pragma unroll
        for (int ai = 0; ai < 2; ++ai)
#pragma unroll
            for (int m = 0; m < 4; ++m)
#pragma unroll
                for (int n = 0; n < 2; ++n) { f32x4 v = acc[ai][0][m][n]; const v2u g2 = gp[ai][m][n]; v[0] *= bflo(g2.x); v[1] *= bfhi(g2.x); v[2] *= bflo(g2.y); v[3] *= bfhi(g2.y);
                    v = br > 0 ? v + tot[ai][m][n] : v;
                    if (br < 3) tot[ai][m][n] = v;
                    else { v2u o; o.x = pk2(v[0], v[1]); o.y = pk2(v[2], v[3]); *(v2u*)(MB + (size_t)(row0 + ai * 128 + m * 16) * 2048 + col0 + n * 16) = o; } }
    }
    __device__ __forceinline__ void operator()(const f32x4 (&acc)[2][1][4][2], const Unit& u, int wr, int wc, int fr, int fq) const { fold(acc, u, wr, wc, fr, fq, 32); }
};
struct EpiOut {
    static constexpr bool PERM = false, HAS_FOLD = false;
    const float* X; float* HB;
    __device__ __forceinline__ void operator()(const f32x4 (&acc)[2][2][4][2], const Unit& u, int wr, int wc, int fr, int fq) const {
        const int row0 = u.pm * 256 + wr * 64 + fr, col0 = u.pn * 256 + wc * 32 + 4 * fq;
#pragma unroll
        for (int ai = 0; ai < 2; ++ai)
#pragma unroll
            for (int m = 0; m < 4; ++m) { const size_t off = (size_t)(row0 + ai * 128 + m * 16) * 2048 + col0;
#pragma unroll
                for (int bj = 0; bj < 2; ++bj)
#pragma unroll
                    for (int n = 0; n < 2; ++n) { const f32x4 xv = *(const f32x4*)(X + off + bj * 128 + n * 16); *(f32x4*)(HB + off + bj * 128 + n * 16) = xv * DN_ALPHA + acc[ai][bj][m][n]; } }
    }
};
struct EpiMoe1 {
    static constexpr bool PERM = true, HAS_FOLD = false;
    bf16* H; const float* ROWW; int NJ;
    __device__ __forceinline__ void operator()(const f32x4 (&acc)[2][2][4][2], const Unit& u, int wr, int wc, int fr, int fq) const {
        const int row0 = u.pm * 256 + wr * 64 + fr, col0 = (u.pn & 3) * 128 + wc * 32 + 8 * fq;
#pragma unroll
        for (int ai = 0; ai < 2; ++ai)
#pragma unroll
            for (int m = 0; m < 4; ++m) { const size_t row = (size_t)(row0 + ai * 128 + m * 16); const float rw = ROWW[row];
                float h[8];
#pragma unroll
                for (int n = 0; n < 2; ++n)
#pragma unroll
                    for (int j = 0; j < 4; ++j) { const float a = acc[ai][0][m][n][j], b = acc[ai][1][m][n][j]; h[n * 4 + j] = a * fsigmoid(a) * b * rw; }
                v4u w; w.x = pk2(h[0], h[1]); w.y = pk2(h[2], h[3]); w.z = pk2(h[4], h[5]); w.w = pk2(h[6], h[7]);
                *(v4u*)(H + row * 512 + col0) = w; }
    }
};
struct EpiMoe2 {
    static constexpr bool PERM = true, HAS_FOLD = false;
    bf16* YB;
    __device__ __forceinline__ void operator()(const f32x4 (&acc)[2][2][4][2], const Unit& u, int wr, int wc, int fr, int fq) const {
        const int row0 = u.pm * 256 + wr * 64 + fr, col0 = (u.pn & 7) * 256 + wc * 32 + 8 * fq;
#pragma unroll
        for (int ai = 0; ai < 2; ++ai)
#pragma unroll
            for (int m = 0; m < 4; ++m) { bf16* rp = YB + (size_t)(row0 + ai * 128 + m * 16) * 2048 + col0;
#pragma unroll
                for (int bj = 0; bj < 2; ++bj) { const f32x4 v0 = acc[ai][bj][m][0], v1 = acc[ai][bj][m][1];
                    v4u w; w.x = pk2(v0[0], v0[1]); w.y = pk2(v0[2], v0[3]); w.z = pk2(v1[0], v1[1]); w.w = pk2(v1[2], v1[3]);
                    *(v4u*)(rp + bj * 128) = w; } }
    }
};
struct EpiMoe1F8 {
    static constexpr bool PERM = true, HAS_FOLD = false;
    unsigned char* H; const float* ROWW;
    __device__ __forceinline__ void operator()(const f32x4 (&acc)[2][2][4][2], const Unit& u, int wr, int wc, int fr, int fq) const {
        const int row0 = u.pm * 256 + wr * 64 + fr, col0 = (u.pn & 3) * 128 + wc * 32 + 8 * fq;
#pragma unroll
        for (int ai = 0; ai < 2; ++ai)
#pragma unroll
            for (int m = 0; m < 4; ++m) { const size_t row = (size_t)(row0 + ai * 128 + m * 16); const float rw = ROWW[row];
                float h[8];
#pragma unroll
                for (int n = 0; n < 2; ++n)
#pragma unroll
                    for (int j = 0; j < 4; ++j) { const float a = acc[ai][0][m][n][j], b = acc[ai][1][m][n][j]; h[n * 4 + j] = a * fsigmoid(a) * b * rw; }
                v2u w; w.x = pk4_fp8(h[0], h[1], h[2], h[3]); w.y = pk4_fp8(h[4], h[5], h[6], h[7]);
                *(v2u*)(H + row * 512 + col0) = w; }
    }
};
struct MoeOrder {
    int NJ, G, c, total, upm, upn;
    __device__ __forceinline__ void init(const int* tst, int NJ_, int G_, int c_, int lane) { NJ = NJ_; G = G_; total = tst[65] * NJ_;
        c = (MOE_XCD && (G_ & 7) == 0) ? (c_ & 7) * (G_ >> 3) + (c_ >> 3) : c_;
        const long L = (long)lane * G + c; upm = 0; upn = 0;
        if (L < total) { const int mt = (int)(L / NJ), j = (int)(L % NJ); int e = 0;
            for (int k = 1; k <= 64; ++k) e += (mt >= tst[k]) ? 1 : 0;
            upm = mt; upn = e * NJ + j; } }
    __device__ __forceinline__ bool next(int i, Unit& u) const {
        if ((long)i * G + c >= total || i >= 64) return false;
        const int iu = __builtin_amdgcn_readfirstlane(i);
        u.pm = __builtin_amdgcn_readlane(upm, iu); u.pn = __builtin_amdgcn_readlane(upn, iu); return true;
    }
    __device__ __forceinline__ void a_ready(const Unit&) const {}
    __device__ __forceinline__ void done(const Unit&) const {}
};

struct KArgs { const float* in[32]; float* out; unsigned char* ws; int ph_lo, ph_hi, region, pad; };
struct Ctx {
    LAS unsigned char* lds; unsigned char* ws; const float* in[32]; float* out;
    int tid, lane, wave, G, bid;
};
#define WSP(T, off) ((T*)(C.ws + (off)))

#ifndef CV_NTS
#define CV_NTS 0
#endif
#ifndef CV_NT
#define CV_NT 1
#endif
#if CV_NT
#define CV_LOAD(p) __builtin_nontemporal_load(p)
#else
#define CV_LOAD(p) (*(p))
#endif
struct CvDesc { const float* sp; bf16* dp; int ldw, ldt, zero, w13, f8; };
__device__ __forceinline__ CvDesc cv_desc(const float* W, int ldw, int srccol, int k0, bf16* WT, size_t drow0, int ldt, int w13, int tid, int f8 = 0) {
    CvDesc d; d.zero = srccol < 0; d.ldw = ldw; d.ldt = ldt; d.w13 = w13; d.f8 = f8;
    d.sp = W + (size_t)(k0 + (tid >> 6)) * ldw + (srccol < 0 ? 0 : srccol);
    d.dp = f8 ? (bf16*)((unsigned char*)WT + drow0 * (size_t)ldt + k0) : WT + drow0 * (size_t)ldt + k0; return d;
}
__device__ __forceinline__ CvDesc conv_item(Ctx& C, int l, int r, int tid) {
    constexpr int I_WIN = 16 * 62, I_W13 = 65 * 64, I_W2 = 65 * 32, I_PA = 4 * 8, I_PB = 2 * 8, I_PC = 6 * 8, I_PD = 4 * 8;
    const bool f8l = MOE8(l), lastb = MOE8(l) && l == NL_ - 1;
    bf16* WIN = WSP(bf16, WS_WIN); bf16* W13 = lastb ? WSP(bf16, WS_W13B) : WSP(bf16, WS_W13); bf16* W2 = lastb ? WSP(bf16, WS_W2B) : WSP(bf16, WS_W2); bf16* WP = WSP(bf16, WS_WP); bf16* WOUT = WSP(bf16, WS_WOUT);
    const int c4 = 4 * (tid & 63);
    if (r < I_WIN) { const int nb = r % 62, kb = r / 62, n = 256 * nb + c4; int sc;
        if (n < 1536) sc = n; else if (n < 7424) sc = n + 16; else if (n < 7680) { const int i = n - 7424; sc = i < 16 ? 1536 + i : (i < 24 ? 7440 + (i - 16) : -1); } else sc = n - 7680 + 7448;
        if (GATES8(l) && nb >= 30) return cv_desc(C.in[2] + (size_t)l * 2048 * NCOL, NCOL, sc, 128 * kb, WSP(bf16, WS_WIN8), 256 * (nb - 30), 2048, 0, tid, 1);
        return cv_desc(C.in[2] + (size_t)l * 2048 * NCOL, NCOL, sc, 128 * kb, WIN, 256 * nb, 2048, 0, tid); }
    r -= I_WIN;
    if (r < I_W13) { const int e = r / 64, q = r % 64, half = q >> 5, kb = (q >> 1) & 15, nq = q & 1;
        const float* src = e == 0 ? (half ? C.in[28] : C.in[27]) + (size_t)l * 2048 * 512 : (half ? C.in[25] : C.in[24]) + (size_t)(l * 64 + e - 1) * 2048 * 512;
        return cv_desc(src, 512, 256 * nq + c4, 128 * kb, W13, (size_t)e * 1024 + nq * 512 + half * 128, 2048, 1, tid, f8l ? 1 : 0); }
    r -= I_W13;
    if (r < I_W2) { const int e = r / 32, q = r % 32, kb = q / 8, nb = q % 8;
        const float* src = e == 0 ? C.in[29] + (size_t)l * 512 * 2048 : C.in[26] + (size_t)(l * 64 + e - 1) * 512 * 2048;
        return cv_desc(src, 2048, 256 * nb + c4, 128 * kb, W2, (size_t)e * 2048 + 256 * nb, 512, 0, tid, f8l ? 1 : 0); }
    r -= I_W2;
    if (r < I_PA) return cv_desc(C.in[15] + (size_t)l * 512 * 2048, 2048, 256 * (r % 8) + c4, 128 * (r / 8), WP, 256 * (r % 8), 2048, 0, tid);
    r -= I_PA;
    if (r < I_PB) return cv_desc(C.in[16] + (size_t)l * 256 * 2048, 2048, 256 * (r % 8) + c4, 128 * (r / 8), WP + 512, 256 * (r % 8), 2048, 0, tid);
    r -= I_PB;
    if (r < I_PC) return cv_desc(C.in[17] + (size_t)l * 768 * 2048, 2048, 256 * (r % 8) + c4, 128 * (r / 8), WP + 768, 256 * (r % 8), 2048, 0, tid);
    r -= I_PC;
    if (r < I_PD) return cv_desc(C.in[18] + (size_t)l * 512 * 2048, 2048, 256 * (r % 8) + c4, 128 * (r / 8), WP + 1536, 256 * (r % 8), 2048, 0, tid);
    r -= I_PD;
    return cv_desc(C.in[19] + (size_t)l * 2048 * 2048, 2048, 256 * (r % 8) + c4, 128 * (r / 8), WOUT, 256 * (r % 8), 2048, 0, tid);
}
__device__ __forceinline__ void phase_convert(Ctx& C, int l, int part, int cbid, int cG, unsigned* arr = nullptr) {
    LAS float* tile = (LAS float*)C.lds; LAS int* qn = (LAS int*)(C.lds + AUX_OFF + 8192);
    unsigned* cq = WSP(unsigned, WS_CTL) + CW_CQ + l * 2 + part;
    const int tid = C.tid, lane = C.lane, wave = C.wave;
    constexpr int I_WIN = 16 * 62, NITEMS = I_WIN + 65 * 64 + 65 * 32 + (4 + 2 + 6 + 4) * 8 + 16 * 8;
    const int it0 = part == 0 ? 0 : I_WIN, it1 = part == 0 ? I_WIN : NITEMS;
    __syncthreads();
    if (tid == 0) qn[0] = (arr && __hip_atomic_load(arr, __ATOMIC_RELAXED, __HIP_MEMORY_SCOPE_AGENT) + STEAL_MARGIN >= (unsigned)C.G) ? 0x7fffffff : it0 + (int)atomicAdd(cq, 1u);
    __syncthreads();
    int it = qn[0];
    f32x4 va[16];
    CvDesc d = conv_item(C, l, it < it1 ? it : it0, tid);
    if (it < it1) {
#pragma unroll
        for (int i = 0; i < 16; ++i) va[i] = d.zero ? (f32x4){0.f, 0.f, 0.f, 0.f} : CV_LOAD((const f32x4*)(d.sp + (size_t)(8 * i) * d.ldw)); }
    const int c16 = lane & 15, nsub = lane >> 4;
    while (it < it1) {
#pragma unroll
        for (int i = 0; i < 16; ++i) { const int kk = wave + 8 * i; *(LAS f32x4*)(tile + kk * 256 + ((4 * (tid & 63)) ^ (4 * ((kk >> 3) & 7)))) = va[i]; }
        if (tid == 0) qn[1] = (arr && __hip_atomic_load(arr, __ATOMIC_RELAXED, __HIP_MEMORY_SCOPE_AGENT) + STEAL_MARGIN >= (unsigned)C.G) ? 0x7fffffff : it0 + (int)atomicAdd(cq, 1u);
        __syncthreads();
        const int nx = qn[1]; const bool hn = nx < it1;
        const CvDesc dn = conv_item(C, l, hn ? nx : it, tid);
        if (hn) {
#pragma unroll
            for (int i = 0; i < 16; ++i) va[i] = dn.zero ? (f32x4){0.f, 0.f, 0.f, 0.f} : CV_LOAD((const f32x4*)(dn.sp + (size_t)(8 * i) * dn.ldw)); }
#pragma unroll
        for (int p = 0; p < 8; ++p) { const int n = p * 32 + wave * 4 + nsub; const LAS float* s = tile + (8 * c16) * 256 + (n ^ (4 * (c16 & 7)));
            const int drow = d.w13 ? ((n >> 7) << 8) + (n & 127) : n;
            if (d.f8) { v2u o8; o8.x = pk4_fp8(s[0 * 256] * 32.f, s[1 * 256] * 32.f, s[2 * 256] * 32.f, s[3 * 256] * 32.f); o8.y = pk4_fp8(s[4 * 256] * 32.f, s[5 * 256] * 32.f, s[6 * 256] * 32.f, s[7 * 256] * 32.f);
                if (CV_NTS && part == 1) __builtin_nontemporal_store(o8, (v2u*)((unsigned char*)d.dp + (size_t)drow * d.ldt + 8 * c16)); else *(v2u*)((unsigned char*)d.dp + (size_t)drow * d.ldt + 8 * c16) = o8; }
            else { v4u o; o.x = pk2(s[0 * 256], s[1 * 256]); o.y = pk2(s[2 * 256], s[3 * 256]); o.z = pk2(s[4 * 256], s[5 * 256]); o.w = pk2(s[6 * 256], s[7 * 256]);
                if (CV_NTS && part == 1) __builtin_nontemporal_store(o, (v4u*)(d.dp + (size_t)drow * d.ldt + 8 * c16)); else *(v4u*)(d.dp + (size_t)drow * d.ldt + 8 * c16) = o; } }
        __syncthreads();
        d = dn; it = nx;
    }
    if (l == 0 && part == 0) {
        const int gw = cbid * 8 + C.wave, NGW = cG * 8;
        bf16* XB = WSP(bf16, WS_XB); const float* X = C.in[0];
        for (int t = gw; t < T_; t += NGW) {
#pragma unroll
            for (int j = 0; j < 8; ++j) { const f32x4 v = *(const f32x4*)(X + (size_t)t * 2048 + 4 * (lane + 64 * j)); v2u o; o.x = pk2(v[0], v[1]); o.y = pk2(v[2], v[3]); *(v2u*)(XB + (size_t)t * 2048 + 4 * (lane + 64 * j)) = o;
                if (GATES8(0)) *(unsigned*)(WSP(unsigned char, WS_XB8) + (size_t)t * 2048 + 4 * (lane + 64 * j)) = pk4_fp8(v[0], v[1], v[2], v[3]); }
        }
        f32x2* CS = WSP(f32x2, WS_CS); const int* pos = (const int*)C.in[1];
        for (int i = C.bid * 512 + C.tid; i < T_ * 32; i += C.G * 512) { const int t = i >> 5, f = i & 31;
            const float inv = powf(10000.0f, -(float)f * 2.0f / 64.0f), ang = (float)pos[t] * inv; float sn, cs; sincosf(ang, &sn, &cs); CS[i] = (f32x2){cs, sn}; }
    }
}
__device__ __forceinline__ void ln_row(f32x4 (&v)[8], const float* g, const float* b, int lane) {
    float s = 0.f;
#pragma unroll
    for (int j = 0; j < 8; ++j) s += (v[j][0] + v[j][1]) + (v[j][2] + v[j][3]);
    const float mean = wave_sum(s) * (1.f / 2048.f); float q = 0.f;
#pragma unroll
    for (int j = 0; j < 8; ++j) { v[j] = v[j] - mean; q += (v[j][0] * v[j][0] + v[j][1] * v[j][1]) + (v[j][2] * v[j][2] + v[j][3] * v[j][3]); }
    const float rstd = 1.f / sqrtf(wave_sum(q) * (1.f / 2048.f) + LN_EPS_);
#pragma unroll
    for (int j = 0; j < 8; ++j) { const f32x4 gv = *(const f32x4*)(g + 4 * (lane + 64 * j)), bv = *(const f32x4*)(b + 4 * (lane + 64 * j)); v[j] = v[j] * rstd * gv + bv; }
}
__device__ __forceinline__ void phase_ln1_router(Ctx& C, int l) {
    const float* HB = WSP(float, WS_HB); float* X1 = WSP(float, WS_X1); bf16* XS = WSP(bf16, WS_XS); float* ROWW = WSP(float, WS_ROWW);
    int* sel_e = WSP(int, WS_SEL); float* sel_w = WSP(float, WS_SEL + 262144); int* sel_r = WSP(int, WS_SEL + 2 * 262144);
    unsigned* cnt = WSP(unsigned, WS_CTL) + CW_CNT + l * 64;
    const float* g = C.in[20] + l * 2048; const float* b = C.in[21] + l * 2048; const float* wrt = C.in[22] + (size_t)l * 2048 * 64; const float* rb = C.in[23] + l * 64;
    constexpr int XP = 2068;
    LAS float* xl = (LAS float*)C.lds; LAS float* part = xl + 16 * XP; LAS float* scl = part + 2048;
    const int lane = C.lane, wave = C.wave;
    for (int unit = C.bid; unit < T_ / 16; unit += C.G) {
        const int t0 = unit * 16;
#pragma unroll 1
        for (int rr = 0; rr < 2; ++rr) { const int row = 2 * wave + rr; const size_t t = (size_t)(t0 + row);
            f32x4 v[8];
#pragma unroll
            for (int j = 0; j < 8; ++j) v[j] = *(const f32x4*)(HB + t * 2048 + 4 * (lane + 64 * j));
            ln_row(v, g, b, lane);
#pragma unroll
            for (int j = 0; j < 8; ++j) { *(f32x4*)(X1 + t * 2048 + 4 * (lane + 64 * j)) = v[j];
                if (MOE8(l)) *(unsigned*)(WSP(unsigned char, WS_XS8) + t * 2048 + 4 * (lane + 64 * j)) = pk4_fp8(v[j][0], v[j][1], v[j][2], v[j][3]);
                else { v2u o; o.x = pk2(v[j][0], v[j][1]); o.y = pk2(v[j][2], v[j][3]); *(v2u*)(XS + t * 2048 + 4 * (lane + 64 * j)) = o; }
                *(LAS f32x4*)(xl + row * XP + 4 * (lane + 64 * j)) = v[j]; }
        }
        if (C.tid < 16) { ROWW[t0 + C.tid] = 1.0f; WSP(int, WS_ROWMAP)[t0 + C.tid] = t0 + C.tid; }
        __syncthreads();
        {
            const int et = wave & 3, kh = wave >> 2, i = lane & 15, h = lane >> 4; f32x4 acc = (f32x4){0.f, 0.f, 0.f, 0.f};
            const LAS float* xr = xl + i * XP + kh * 1024 + 4 * h; const float* wb = wrt + (size_t)(kh * 1024 + 4 * h) * 64 + 16 * et + i;
#pragma unroll 4
            for (int s = 0; s < 64; ++s) { const f32x4 a = *(const LAS f32x4*)(xr + 16 * s); const float* wp = wb + (size_t)(16 * s) * 64;
                const float b0 = wp[0], b1 = wp[64], b2 = wp[128], b3 = wp[192];
                acc = __builtin_amdgcn_mfma_f32_16x16x4f32(a[0], b0, acc, 0, 0, 0); acc = __builtin_amdgcn_mfma_f32_16x16x4f32(a[1], b1, acc, 0, 0, 0);
                acc = __builtin_amdgcn_mfma_f32_16x16x4f32(a[2], b2, acc, 0, 0, 0); acc = __builtin_amdgcn_mfma_f32_16x16x4f32(a[3], b3, acc, 0, 0, 0); }
#pragma unroll
            for (int r = 0; r < 4; ++r) part[kh * 1024 + (4 * h + r) * 64 + 16 * et + i] = acc[r];
        }
        __syncthreads();
#pragma unroll
        for (int k = 0; k < 2; ++k) { const int idx = C.tid + 512 * k; scl[idx] = 1.f / (1.f + expf(-(part[idx] + part[1024 + idx]))); }
        __syncthreads();
#pragma unroll 1
        for (int rr = 0; rr < 2; ++rr) { const int tok = 2 * wave + rr, t = t0 + tok; const float* sp = (const float*)(scl + tok * 64);
            const bool sel = route_lane_select(lane, sp, rb); const float s = scl[tok * 64 + lane];
            const unsigned long long m0_ = __ballot(sel); const bool sel8 = sel && __popcll(m0_ & ((1ull << lane) - 1ull)) < 8;
            const float wsum = wave_sum(sel8 ? s : 0.f); const unsigned long long m = __ballot(sel8);
            if (sel8) { const int k = __popcll(m & ((1ull << lane) - 1ull)); sel_e[t * 8 + k] = lane; sel_w[t * 8 + k] = s * 2.5f / wsum; sel_r[t * 8 + k] = (int)atomicAdd(cnt + lane, 1u); } }
        __syncthreads();
    }
}
__device__ __forceinline__ void phase_scatter(Ctx& C, int l) {
    float* ROWW = WSP(float, WS_ROWW); int* ROWMAP = WSP(int, WS_ROWMAP);
    const int* sel_e = WSP(int, WS_SEL); const float* sel_w = WSP(float, WS_SEL + 262144); const int* sel_r = WSP(int, WS_SEL + 2 * 262144); int* POS = WSP(int, WS_SEL + 3 * 262144);
    const unsigned* cnt = WSP(unsigned, WS_CTL) + CW_CNT + l * 64; int* tst = WSP(int, WS_CTL) + CW_TST + l * 128;
    LAS int* offl = (LAS int*)(C.lds + AUX_OFF + 4096);
    if (C.tid == 0) { int ts = 0;
        for (int k = 0; k <= 65; ++k) { if (C.bid == 0) tst[k] = ts; if (k >= 1 && k <= 64) offl[k - 1] = ts * 256; ts += (k == 0) ? 32 : (k <= 64 ? (((int)cnt[k - 1] + 255) >> 8) : 0); } }
    __syncthreads();
    for (int p = C.bid * 512 + C.tid; p < T_ * 8; p += C.G * 512) { const int e = sel_e[p], pos = offl[e] + sel_r[p]; ROWMAP[pos] = p >> 3; ROWW[pos] = sel_w[p]; POS[p] = pos; }
    for (int e = C.bid; e < 64; e += C.G) { const int c = (int)cnt[e], beg = offl[e] + c, end = offl[e] + ((c + 255) & ~255);
        for (int pos = beg + C.tid; pos < end; pos += 512) { ROWMAP[pos] = 0; ROWW[pos] = 0.f; } }
}
__device__ __forceinline__ void phase_combine(Ctx& C, int l) {
    const bf16* YB = WSP(bf16, WS_YBUF); const float* X1 = WSP(float, WS_X1); const int* POS = WSP(int, WS_SEL + 3 * 262144);
    float* XO = (l == NL_ - 1) ? C.out : WSP(float, WS_XA); bf16* XB = WSP(bf16, WS_XB);
    const float* g = C.in[30] + l * 2048; const float* b = C.in[31] + l * 2048;
    const int gw = C.bid * 8 + C.wave, NGW = C.G * 8, lane = C.lane;
    int pn[8];
#pragma unroll
    for (int k = 0; k < 8; ++k) pn[k] = gw < T_ ? POS[gw * 8 + k] : 0;
    for (int t = gw; t < T_; t += NGW) {
        size_t rows[9]; rows[0] = (size_t)t;
#pragma unroll
        for (int k = 0; k < 8; ++k) rows[k + 1] = (size_t)pn[k];
        { const int tn = t + NGW < T_ ? t + NGW : t;
#pragma unroll
          for (int k = 0; k < 8; ++k) pn[k] = POS[tn * 8 + k]; }
        v4u w[9][4];
#pragma unroll
        for (int k = 0; k < 9; ++k)
#pragma unroll
            for (int j = 0; j < 4; ++j) w[k][j] = __builtin_nontemporal_load((const v4u*)(YB + rows[k] * 2048 + 8 * lane + 512 * j));
        float v[4][8];
#pragma unroll
        for (int j = 0; j < 4; ++j) { const f32x4 a = *(const f32x4*)(X1 + (size_t)t * 2048 + 8 * lane + 512 * j), c = *(const f32x4*)(X1 + (size_t)t * 2048 + 8 * lane + 512 * j + 4);
            v[j][0] = a[0] * DN_ALPHA; v[j][1] = a[1] * DN_ALPHA; v[j][2] = a[2] * DN_ALPHA; v[j][3] = a[3] * DN_ALPHA; v[j][4] = c[0] * DN_ALPHA; v[j][5] = c[1] * DN_ALPHA; v[j][6] = c[2] * DN_ALPHA; v[j][7] = c[3] * DN_ALPHA; }
#pragma unroll
        for (int k = 0; k < 9; ++k)
#pragma unroll
            for (int j = 0; j < 4; ++j) { v[j][0] += bflo(w[k][j].x); v[j][1] += bfhi(w[k][j].x); v[j][2] += bflo(w[k][j].y); v[j][3] += bfhi(w[k][j].y); v[j][4] += bflo(w[k][j].z); v[j][5] += bfhi(w[k][j].z); v[j][6] += bflo(w[k][j].w); v[j][7] += bfhi(w[k][j].w); }
        float s = 0.f;
#pragma unroll
        for (int j = 0; j < 4; ++j)
#pragma unroll
            for (int e = 0; e < 8; ++e) s += v[j][e];
        const float mean = wave_sum(s) * (1.f / 2048.f); float q = 0.f;
#pragma unroll
        for (int j = 0; j < 4; ++j)
#pragma unroll
            for (int e = 0; e < 8; ++e) { v[j][e] -= mean; q += v[j][e] * v[j][e]; }
        const float rstd = 1.f / sqrtf(wave_sum(q) * (1.f / 2048.f) + LN_EPS_);
#pragma unroll
        for (int j = 0; j < 4; ++j) { const int c0 = 8 * lane + 512 * j; float o[8];
            const f32x4 g0 = *(const f32x4*)(g + c0), g1 = *(const f32x4*)(g + c0 + 4), b0 = *(const f32x4*)(b + c0), b1 = *(const f32x4*)(b + c0 + 4);
#pragma unroll
            for (int e = 0; e < 4; ++e) { o[e] = v[j][e] * rstd * g0[e] + b0[e]; o[4 + e] = v[j][4 + e] * rstd * g1[e] + b1[e]; }
            *(f32x4*)(XO + (size_t)t * 2048 + c0) = (f32x4){o[0], o[1], o[2], o[3]}; *(f32x4*)(XO + (size_t)t * 2048 + c0 + 4) = (f32x4){o[4], o[5], o[6], o[7]};
            if (l < NL_ - 1) { v4u ow; ow.x = pk2(o[0], o[1]); ow.y = pk2(o[2], o[3]); ow.z = pk2(o[4], o[5]); ow.w = pk2(o[6], o[7]); *(v4u*)(XB + (size_t)t * 2048 + c0) = ow;
                if (GATES8(l + 1)) { v2u o8; o8.x = pk4_fp8(o[0], o[1], o[2], o[3]); o8.y = pk4_fp8(o[4], o[5], o[6], o[7]); *(v2u*)(WSP(unsigned char, WS_XB8) + (size_t)t * 2048 + c0) = o8; } } }
    }
}
typedef LAS unsigned char* ldsp;
__device__ __forceinline__ f32x4 mfma16(bf16x8 bt, bf16x8 a, f32x4 c) { return __builtin_amdgcn_mfma_f32_16x16x32_bf16(bt, a, c, 0, 0, 0); }
__device__ __forceinline__ bf16x8 frag(ldsp base, int pitch, int row, int k0, int fq) { return *(const LAS bf16x8*)(base + row * pitch + (k0 + 8 * fq) * 2); }
__device__ __forceinline__ bf16x8 frag2(ldsp base, int pitch, int row, int kA, int kB, int fq) {
    const v2u a = *(const LAS v2u*)(base + row * pitch + (kA + 4 * fq) * 2), b = *(const LAS v2u*)(base + row * pitch + (kB + 4 * fq) * 2);
    v4u r; r.x = a.x; r.y = a.y; r.z = b.x; r.w = b.y; return __builtin_bit_cast(bf16x8, r);
}
typedef short v4i16_t __attribute__((ext_vector_type(4)));
__device__ __forceinline__ bf16x8 trfrag2(ldsp base, int pitch, int col0, int kA, int kB, int lane) {
    const int q = (lane & 15) >> 2, p = lane & 3, fq = lane >> 4;
    const v4i16_t x = __builtin_amdgcn_ds_read_tr16_b64_v4i16((LAS v4i16_t*)(base + (kA + 4 * fq + q) * pitch + (col0 + 4 * p) * 2));
    const v4i16_t y = __builtin_amdgcn_ds_read_tr16_b64_v4i16((LAS v4i16_t*)(base + (kB + 4 * fq + q) * pitch + (col0 + 4 * p) * 2));
    bf16x8 r; r[0] = x[0]; r[1] = x[1]; r[2] = x[2]; r[3] = x[3]; r[4] = y[0]; r[5] = y[1]; r[6] = y[2]; r[7] = y[3]; return r;
}
__device__ __forceinline__ bf16x8 trfrag(ldsp base, int pitch, int col0, int k0, int lane) { const int fq = lane >> 4; return trfrag2(base, pitch, col0, k0 + 4 * fq, k0 + 4 * fq + 4, lane); }
__device__ __forceinline__ bf16x8 pfrag(const f32x4& p0, const f32x4& p1) { v4u r; r.x = pk2(p0[0], p0[1]); r.y = pk2(p0[2], p0[3]); r.z = pk2(p1[0], p1[1]); r.w = pk2(p1[2], p1[3]); return __builtin_bit_cast(bf16x8, r); }
__device__ __forceinline__ void unpack8(const v4u w, float (&f)[8]) { f[0] = bflo(w.x); f[1] = bfhi(w.x); f[2] = bflo(w.y); f[3] = bfhi(w.y); f[4] = bflo(w.z); f[5] = bfhi(w.z); f[6] = bflo(w.w); f[7] = bfhi(w.w); }
__device__ __forceinline__ unsigned short bf1(float x) { return (unsigned short)(pk2(x, 0.f) & 0xffffu); }
__device__ __forceinline__ float flogsigmoid(float x) { return fminf(x, 0.f) - log1pf(__expf(-fabsf(x))); }
__device__ __forceinline__ float fgelu(float v) {
    const float av = fabsf(v), t = __builtin_amdgcn_rcpf(av * 0.2316418882f + 1.0f);
    float q = t * 0.5307027145f + (-0.7265760135f); q = q * t + 0.7107068705f; q = q * t + (-0.142248368f); q = q * t + 0.127414796f; q = q * t;
    const float e = __builtin_amdgcn_exp2f((v * v) * (-0.72134752044f)), m = v * (q * e);
    return v < 0.f ? m : v - m;
}

__device__ __forceinline__ void scat8(LAS unsigned short* vp, int ps  , const v4u w) {
    vp[0 * ps] = (unsigned short)(w.x & 0xffff); vp[1 * ps] = (unsigned short)(w.x >> 16); vp[2 * ps] = (unsigned short)(w.y & 0xffff); vp[3 * ps] = (unsigned short)(w.y >> 16);
    vp[4 * ps] = (unsigned short)(w.z & 0xffff); vp[5 * ps] = (unsigned short)(w.z >> 16); vp[6 * ps] = (unsigned short)(w.w & 0xffff); vp[7 * ps] = (unsigned short)(w.w >> 16);
}

__device__ __forceinline__ void dil_unit(Ctx& C, int u) {
    const int tid = C.tid, lane = C.lane, wave = C.wave, fr = lane & 15, fq = lane >> 4;
    const int blk16 = u & 15, hh = (u >> 4) & 3, g = (u >> 6) % 3, b = u / 192;
    const int dil = g == 0 ? 1 : (g == 1 ? 4 : 16), nbpr = 16 / dil  , r = blk16 / nbpr, nb = blk16 % nbpr, head = g * 4 + hh;
    const bf16* Y = WSP(bf16, WS_Y); const f32x2* CS = WSP(f32x2, WS_CS);
    constexpr int QP = 144, KP = 144, VP = 160;
    ldsp Ql = C.lds, Kl = C.lds + 128 * QP, Vl = Kl + 256 * KP;
    const size_t tb = (size_t)b * SEQ_;
    {   const int ch = tid & 3, row0 = tid >> 2; v4u xa[3], xb[3]; f32x4 cs[3][4]; int mrow[3];
#pragma unroll
        for (int i = 0; i < 3; ++i) { const int row = row0 + (i == 2 ? 128 : 0), m = (i == 0) ? nb * 128 + row : (nb - 1) * 128 + row, mc = m < 0 ? 0 : m; const size_t t = tb + (size_t)mc * dil + r;
            const bf16* src = Y + t * YP + (i == 0 ? Y_BQ : Y_BK) + head * 64 + 8 * ch; xa[i] = *(const v4u*)src; xb[i] = *(const v4u*)(src + 32);
            const f32x4* cp = (const f32x4*)(CS + t * 32 + 8 * ch); cs[i][0] = cp[0]; cs[i][1] = cp[1]; cs[i][2] = cp[2]; cs[i][3] = cp[3]; mrow[i] = m; }
        const int ch8 = tid & 7, key0 = tid >> 3; v4u vv[4];
#pragma unroll
        for (int i = 0; i < 4; ++i) { const int m = (nb - 1) * 128 + key0 + 64 * i, mc = m < 0 ? 0 : m; vv[i] = *(const v4u*)(Y + (tb + (size_t)mc * dil + r) * YP + Y_BV + head * 64 + 8 * ch8); }
#pragma unroll
        for (int i = 0; i < 3; ++i) { const int row = row0 + (i == 2 ? 128 : 0); ldsp dst = (i == 0) ? Ql + row * QP : Kl + row * KP;
            float x1[8], x2[8]; unpack8(xa[i], x1); unpack8(xb[i], x2); const float sc = (i == 0) ? 0.125f : (mrow[i] < 0 ? 0.f : 1.f); float y1[8], y2[8];
#pragma unroll
            for (int k = 0; k < 8; ++k) { const float c = cs[i][k >> 1][2 * (k & 1)], sn = cs[i][k >> 1][2 * (k & 1) + 1]; y1[k] = (x1[k] * c - x2[k] * sn) * sc; y2[k] = (x2[k] * c + x1[k] * sn) * sc; }
            v4u o1, o2; o1.x = pk2(y1[0], y1[1]); o1.y = pk2(y1[2], y1[3]); o1.z = pk2(y1[4], y1[5]); o1.w = pk2(y1[6], y1[7]);
            o2.x = pk2(y2[0], y2[1]); o2.y = pk2(y2[2], y2[3]); o2.z = pk2(y2[4], y2[5]); o2.w = pk2(y2[6], y2[7]);
            *(LAS v4u*)(dst + 16 * ch) = o1; *(LAS v4u*)(dst + 64 + 16 * ch) = o2; }
#pragma unroll
        for (int i = 0; i < 4; ++i) { const int key = key0 + 64 * i; v4u w = vv[i]; if ((nb - 1) * 128 + key < 0) w = (v4u){0u, 0u, 0u, 0u};
            *(LAS v4u*)(Vl + key * VP + 16 * ch8) = w; }
    }
    __syncthreads();
    const int ts = wave < 6 ? wave : 6;
    const bf16x8 q0 = frag(Ql, QP, 16 * wave + fr, 0, fq), q1 = frag(Ql, QP, 16 * wave + fr, 32, fq);
    f32x4 s[10];
#pragma unroll
    for (int t = 0; t < 10; ++t) { s[t] = (f32x4){0.f, 0.f, 0.f, 0.f};
        s[t] = mfma16(frag(Kl, KP, 16 * (ts + t) + fr, 0, fq), q0, s[t]); s[t] = mfma16(frag(Kl, KP, 16 * (ts + t) + fr, 32, fq), q1, s[t]); }
    const int qi = 16 * wave + fr; float mx = -INFINITY;
#pragma unroll
    for (int t = 0; t < 10; ++t)
#pragma unroll
        for (int e = 0; e < 4; ++e) { const int j = 16 * (ts + t) + 4 * fq + e; const bool ok = (j >= qi) && (j <= qi + 128) && ((nb - 1) * 128 + j >= 0); s[t][e] = ok ? s[t][e] : -INFINITY; mx = fmaxf(mx, s[t][e]); }
    mx = fmaxf(mx, __shfl_xor(mx, 16)); mx = fmaxf(mx, __shfl_xor(mx, 32));
    float den = 0.f;
#pragma unroll
    for (int t = 0; t < 10; ++t)
#pragma unroll
        for (int e = 0; e < 4; ++e) { const float p = __expf(s[t][e] - mx); s[t][e] = p; den += p; }
    den += __shfl_xor(den, 16); den += __shfl_xor(den, 32);
    f32x4 o[4];
#pragma unroll
    for (int n = 0; n < 4; ++n) o[n] = (f32x4){0.f, 0.f, 0.f, 0.f};
#pragma unroll
    for (int tp = 0; tp < 5; ++tp) { const bf16x8 pf = pfrag(s[2 * tp], s[2 * tp + 1]);
#pragma unroll
        for (int n = 0; n < 4; ++n) o[n] = mfma16(trfrag2(Vl, VP, 16 * n, 16 * (ts + 2 * tp), 16 * (ts + 2 * tp + 1), lane), pf, o[n]); }
    const size_t t = tb + (size_t)(nb * 128 + qi) * dil + r; const float rden = 1.f / den;
    float* DO = WSP(float, WS_DILO) + t * 768 + head * 64;
#pragma unroll
    for (int n = 0; n < 4; ++n) *(f32x4*)(DO + 16 * n + 4 * fq) = o[n] * rden;
    if (fq == 0) WSP(float, WS_DILL)[t * 12 + head] = mx + __logf(den);
    __syncthreads();
}
__device__ __forceinline__ void dil_merge(Ctx& C, bf16* YM) {
    const float* DO = WSP(float, WS_DILO); const float* DL = WSP(float, WS_DILL);
    for (int i = C.bid * 512 + C.tid; i < T_ * 64; i += C.G * 512) { const int t = i >> 6, hh = (i >> 4) & 3, d4 = (i & 15) * 4;
        const float l0 = DL[t * 12 + hh], l1 = DL[t * 12 + 4 + hh], l2 = DL[t * 12 + 8 + hh], m = fmaxf(l0, fmaxf(l1, l2));
        const float w0 = __expf(l0 - m), w1 = __expf(l1 - m), w2 = __expf(l2 - m), rs = 1.f / (w0 + w1 + w2);
        const f32x4 a = *(const f32x4*)(DO + (size_t)t * 768 + hh * 64 + d4), bb = *(const f32x4*)(DO + (size_t)t * 768 + (4 + hh) * 64 + d4), c = *(const f32x4*)(DO + (size_t)t * 768 + (8 + hh) * 64 + d4);
        const f32x4 o = (a * w0 + bb * w1 + c * w2) * rs; v2u w; w.x = pk2(o[0], o[1]); w.y = pk2(o[2], o[3]);
        *(v2u*)(YM + (size_t)t * 2048 + YM_B + hh * 64 + d4) = w; }
}

__device__ __forceinline__ void sgu_unit(Ctx& C, int l, int u, bf16* YM) {
    const int tid = C.tid, lane = C.lane, wave = C.wave, fr = lane & 15, fq = lane >> 4;
    const int g = u % 6, cn = u / 6; const size_t t0 = (size_t)cn * 128;
    const bf16* Y = WSP(bf16, WS_Y);
    const float* lng = C.in[11] + l * 768; const float* lnb = C.in[12] + l * 768; const float* ws = C.in[13] + (size_t)(l * 6 + g) * 128 * 128; const float* bs = C.in[14] + (l * 6 + g) * 128;
    constexpr int AP = 272, VP = 288;
    ldsp Al = C.lds, Vl = C.lds + 128 * AP; LAS float* st = (LAS float*)(Vl + 128 * VP);
    {   const int j = tid >> 2, qd = tid & 3; const bf16* src = Y + (t0 + j) * YP + Y_CV + qd * 192; float s1 = 0.f, s2 = 0.f;
        { v4u w[24];
#pragma unroll
            for (int k = 0; k < 24; ++k) w[k] = *(const v4u*)(src + 8 * k);
#pragma unroll
            for (int k = 0; k < 24; ++k) { float x[8]; unpack8(w[k], x);
#pragma unroll
                for (int q2 = 0; q2 < 8; ++q2) { const float z = fgelu(x[q2]); s1 += z; s2 += z * z; } } }
        s1 += __shfl_xor(s1, 1); s2 += __shfl_xor(s2, 1); s1 += __shfl_xor(s1, 2); s2 += __shfl_xor(s2, 2);
        if (qd == 0) { const float mu = s1 * (1.f / 768.f), var = fmaxf(s2 * (1.f / 768.f) - mu * mu, 0.f); st[2 * j] = mu; st[2 * j + 1] = 1.f / sqrtf(var + LN_EPS_); } }
    {   const int c8 = (tid & 15) * 8; f32x4 a[4], bq[4];
#pragma unroll
        for (int k4 = 0; k4 < 4; ++k4) { const int i = (tid >> 4) + 32 * k4; const float* src = ws + i * 128 + c8; a[k4] = *(const f32x4*)src; bq[k4] = *(const f32x4*)(src + 4); }
#pragma unroll
        for (int k4 = 0; k4 < 4; ++k4) { const int i = (tid >> 4) + 32 * k4; float v[8] = {a[k4][0], a[k4][1], a[k4][2], a[k4][3], bq[k4][0], bq[k4][1], bq[k4][2], bq[k4][3]};
#pragma unroll
            for (int k = 0; k < 8; ++k) v[k] = (c8 + k <= i) ? v[k] : 0.f;
            v4u o; o.x = pk2(v[0], v[1]); o.y = pk2(v[2], v[3]); o.z = pk2(v[4], v[5]); o.w = pk2(v[6], v[7]); *(LAS v4u*)(Al + i * AP + c8 * 2) = o; } }
    {   const int c8 = (tid & 15) * 8; v4u w[4];
#pragma unroll
        for (int k4 = 0; k4 < 4; ++k4) { const int j = (tid >> 4) + 32 * k4; w[k4] = *(const v4u*)(Y + (t0 + j) * YP + Y_CV + g * 128 + c8); }
        const f32x4 g0 = *(const f32x4*)(lng + g * 128 + c8), g1 = *(const f32x4*)(lng + g * 128 + c8 + 4), b0 = *(const f32x4*)(lnb + g * 128 + c8), b1 = *(const f32x4*)(lnb + g * 128 + c8 + 4);
        const float gg[8] = {g0[0], g0[1], g0[2], g0[3], g1[0], g1[1], g1[2], g1[3]}, bb[8] = {b0[0], b0[1], b0[2], b0[3], b1[0], b1[1], b1[2], b1[3]};
        __syncthreads();
#pragma unroll
        for (int k4 = 0; k4 < 4; ++k4) { const int j = (tid >> 4) + 32 * k4; float x[8]; unpack8(w[k4], x); const float mu = st[2 * j], rs = st[2 * j + 1];
#pragma unroll
            for (int k = 0; k < 8; ++k) x[k] = (fgelu(x[k]) - mu) * rs * gg[k] + bb[k];
            v4u o; o.x = pk2(x[0], x[1]); o.y = pk2(x[2], x[3]); o.z = pk2(x[4], x[5]); o.w = pk2(x[6], x[7]); *(LAS v4u*)(Vl + j * VP + c8 * 2) = o; } }
    __syncthreads();
    f32x4 acc[8];
#pragma unroll
    for (int n = 0; n < 8; ++n) acc[n] = (f32x4){0.f, 0.f, 0.f, 0.f};
    const int nks = (16 * wave + 15) / 32 + 1;
    for (int ks = 0; ks < nks; ++ks) { const bf16x8 a = frag(Al, AP, 16 * wave + fr, 32 * ks, fq);
#pragma unroll
        for (int n = 0; n < 8; ++n) acc[n] = mfma16(trfrag(Vl, VP, 16 * n, 32 * ks, lane), a, acc[n]); }
    const int i = 16 * wave + fr; const float bsi = bs[i]; const size_t t = t0 + i;
#pragma unroll
    for (int n = 0; n < 8; ++n) { const int c = 16 * n + 4 * fq; const v2u w = *(const v2u*)(Y + t * YP + Y_CU + g * 128 + c);
        const float o0 = fgelu(bflo(w.x)) * (acc[n][0] + bsi), o1 = fgelu(bfhi(w.x)) * (acc[n][1] + bsi), o2 = fgelu(bflo(w.y)) * (acc[n][2] + bsi), o3 = fgelu(bfhi(w.y)) * (acc[n][3] + bsi);
        v2u o; o.x = pk2(o0, o1); o.y = pk2(o2, o3); *(v2u*)(YM + t * 2048 + YM_C + g * 128 + c) = o; }
    __syncthreads();
}

__device__ __forceinline__ void gla_decay(Ctx& C, int l, int h, size_t t0, LAS float* Bl, LAS float* tmp  ) {
    const int tid = C.tid; const float* YSM = WSP(float, WS_YSM); const float* wa2 = C.in[3] + l * 16 * 256 + h * 64; const float* ba = C.in[4] + l * 256 + h * 64;
    { const int j = tid >> 3, d0 = (tid & 7) * 8; float a[16];
#pragma unroll
        for (int r4 = 0; r4 < 4; ++r4) { const f32x4 v = *(const f32x4*)(YSM + (t0 + j) * 32 + 4 * r4); a[4 * r4] = v[0]; a[4 * r4 + 1] = v[1]; a[4 * r4 + 2] = v[2]; a[4 * r4 + 3] = v[3]; }
#pragma unroll
        for (int k = 0; k < 8; ++k) { float s = ba[d0 + k];
#pragma unroll
            for (int r = 0; r < 16; ++r) s += a[r] * wa2[r * 256 + d0 + k];
            Bl[j * 65 + d0 + k] = flogsigmoid(s) * (1.f / 16.f); } }
    __syncthreads();
    { const int d = tid & 63, sg = tid >> 6; float run = 0.f;
#pragma unroll
        for (int k = 0; k < 8; ++k) { run += Bl[(8 * sg + k) * 65 + d]; Bl[(8 * sg + k) * 65 + d] = run; }
        tmp[sg * 64 + d] = run;
        __syncthreads();
        float off = 0.f;
        for (int s2 = 0; s2 < sg; ++s2) off += tmp[s2 * 64 + d];
#pragma unroll
        for (int k = 0; k < 8; ++k) Bl[(8 * sg + k) * 65 + d] += off; }
    __syncthreads();
}
__device__ __forceinline__ void gla_local_unit(Ctx& C, int l, int u) {
    const int tid = C.tid, lane = C.lane, wave = C.wave, fr = lane & 15, fq = lane >> 4;
    const int n = u & 31, h = (u >> 5) & 3, b = u >> 7; const size_t t0 = (size_t)b * SEQ_ + n * 64;
    const bf16* Y = WSP(bf16, WS_Y);
    constexpr int KP = 160, VP = 288;
    LAS float* Bl = (LAS float*)C.lds; LAS float* tmp = Bl + 64 * 65; ldsp Kl = (ldsp)(tmp + 512), Vl = Kl + 64 * KP;
    gla_decay(C, l, h, t0, Bl, tmp);
    {   const int j = tid >> 3, d0 = (tid & 7) * 8, e0 = (tid & 15) * 8;
        const v4u kw = *(const v4u*)(Y + (t0 + j) * YP + Y_AK + h * 64 + d0); v4u vw[2];
#pragma unroll
        for (int i = 0; i < 2; ++i) vw[i] = *(const v4u*)(Y + (t0 + (tid >> 4) + 32 * i) * YP + Y_AV + h * 128 + e0);
        float x[8]; unpack8(kw, x);
#pragma unroll
        for (int k = 0; k < 8; ++k) x[k] = x[k] * __expf(Bl[63 * 65 + d0 + k] - Bl[j * 65 + d0 + k]);
        v4u o; o.x = pk2(x[0], x[1]); o.y = pk2(x[2], x[3]); o.z = pk2(x[4], x[5]); o.w = pk2(x[6], x[7]); *(LAS v4u*)(Kl + j * KP + d0 * 2) = o;
#pragma unroll
        for (int i = 0; i < 2; ++i) *(LAS v4u*)(Vl + ((tid >> 4) + 32 * i) * VP + e0 * 2) = vw[i];
    }
    __syncthreads();
    float* LOC = WSP(float, WS_GLOC) + (size_t)u * 64 * 128; float* DEC = WSP(float, WS_GDEC) + (size_t)u * 64;
    if (tid < 64) DEC[tid] = __expf(Bl[63 * 65 + tid]);
#pragma unroll
    for (int mt = 0; mt < 4; ++mt) { f32x4 acc = (f32x4){0.f, 0.f, 0.f, 0.f};
#pragma unroll
        for (int ks = 0; ks < 2; ++ks) acc = mfma16(trfrag2(Vl, VP, 16 * wave, 32 * ks, 32 * ks + 16, lane), trfrag2(Kl, KP, 16 * mt, 32 * ks, 32 * ks + 16, lane), acc);
        *(f32x4*)(LOC + (size_t)(16 * mt + fr) * 128 + 16 * wave + 4 * fq) = acc; }
    __syncthreads();
}
__device__ __forceinline__ void gla_scan(Ctx& C) {
    const float* LOC = WSP(float, WS_GLOC); const float* DEC = WSP(float, WS_GDEC); bf16* ST = WSP(bf16, WS_GST);
    for (int i = C.bid * 512 + C.tid; i < 16 * 8192; i += C.G * 512) { const int bh = i >> 13, de = i & 8191, d = de >> 7; float S = 0.f;
        float lc[32], dc[32];
#pragma unroll
        for (int n = 0; n < 32; ++n) { const size_t uu = (size_t)bh * 32 + n; lc[n] = LOC[uu * 8192 + de]; dc[n] = DEC[uu * 64 + d]; }
#pragma unroll
        for (int n = 0; n < 32; ++n) { const size_t uu = (size_t)bh * 32 + n; ST[uu * 8192 + de] = bf1(S); S = dc[n] * S + lc[n]; } }
}
__device__ __forceinline__ void gla_out_unit(Ctx& C, int l, int u, bf16* YM) {
    const int tid = C.tid, lane = C.lane, wave = C.wave, fr = lane & 15, fq = lane >> 4;
    const int n = u & 31, h = (u >> 5) & 3, b = u >> 7; const size_t t0 = (size_t)b * SEQ_ + n * 64;
    const bf16* Y = WSP(bf16, WS_Y); const bf16* ST = WSP(bf16, WS_GST) + (size_t)u * 8192;
    constexpr int QP = 144, VP = 288;
    LAS float* Bl = (LAS float*)C.lds; LAS float* tmp = Bl + 64 * 65; ldsp Ql = (ldsp)(tmp + 512), Kl = Ql + 64 * QP, Vl = Kl + 64 * QP, Sl = Vl + 64 * VP; LAS float* ssq = (LAS float*)(Sl + 64 * VP);
    gla_decay(C, l, h, t0, Bl, tmp);
    {   const int j = tid >> 3, d0 = (tid & 7) * 8, e0 = (tid & 15) * 8, j2 = tid >> 4;
        const v4u qw = *(const v4u*)(Y + (t0 + j) * YP + Y_AQ + h * 64 + d0), kw = *(const v4u*)(Y + (t0 + j) * YP + Y_AK + h * 64 + d0); v4u vw[2], sw[2];
#pragma unroll
        for (int i = 0; i < 2; ++i) { vw[i] = *(const v4u*)(Y + (t0 + j2 + 32 * i) * YP + Y_AV + h * 128 + e0); sw[i] = *(const v4u*)(ST + (j2 + 32 * i) * 128 + e0); }
        float xq[8], xk[8]; unpack8(qw, xq); unpack8(kw, xk);
#pragma unroll
        for (int k = 0; k < 8; ++k) { const float bb = Bl[j * 65 + d0 + k]; xq[k] = xq[k] * 0.125f * __expf(bb); xk[k] = xk[k] * __expf(-bb); }
        v4u o; o.x = pk2(xq[0], xq[1]); o.y = pk2(xq[2], xq[3]); o.z = pk2(xq[4], xq[5]); o.w = pk2(xq[6], xq[7]); *(LAS v4u*)(Ql + j * QP + d0 * 2) = o;
        o.x = pk2(xk[0], xk[1]); o.y = pk2(xk[2], xk[3]); o.z = pk2(xk[4], xk[5]); o.w = pk2(xk[6], xk[7]); *(LAS v4u*)(Kl + j * QP + d0 * 2) = o;
#pragma unroll
        for (int i = 0; i < 2; ++i) { *(LAS v4u*)(Vl + (j2 + 32 * i) * VP + e0 * 2) = vw[i]; *(LAS v4u*)(Sl + (j2 + 32 * i) * VP + e0 * 2) = sw[i]; }
    }
    __syncthreads();
    const int mt = wave & 3, nh = wave >> 2;
    const bf16x8 qa0 = frag(Ql, QP, 16 * mt + fr, 0, fq), qa1 = frag(Ql, QP, 16 * mt + fr, 32, fq);
    f32x4 att[4];
#pragma unroll
    for (int t = 0; t < 4; ++t) { att[t] = (f32x4){0.f, 0.f, 0.f, 0.f}; att[t] = mfma16(frag(Kl, QP, 16 * t + fr, 0, fq), qa0, att[t]); att[t] = mfma16(frag(Kl, QP, 16 * t + fr, 32, fq), qa1, att[t]);
#pragma unroll
        for (int e = 0; e < 4; ++e) att[t][e] = (16 * t + 4 * fq + e <= 16 * mt + fr) ? att[t][e] : 0.f; }
    const bf16x8 p0 = pfrag(att[0], att[1]), p1 = pfrag(att[2], att[3]);
    f32x4 o[4];
#pragma unroll
    for (int nt = 0; nt < 4; ++nt) { const int ec = 64 * nh + 16 * nt; f32x4 a = (f32x4){0.f, 0.f, 0.f, 0.f};
        a = mfma16(trfrag2(Vl, VP, ec, 0, 16, lane), p0, a); a = mfma16(trfrag2(Vl, VP, ec, 32, 48, lane), p1, a);
        a = mfma16(trfrag(Sl, VP, ec, 0, lane), qa0, a); a = mfma16(trfrag(Sl, VP, ec, 32, lane), qa1, a); o[nt] = a; }
    float sq = 0.f;
#pragma unroll
    for (int nt = 0; nt < 4; ++nt) sq += (o[nt][0] * o[nt][0] + o[nt][1] * o[nt][1]) + (o[nt][2] * o[nt][2] + o[nt][3] * o[nt][3]);
    sq += __shfl_xor(sq, 16); sq += __shfl_xor(sq, 32);
    const int i = 16 * mt + fr;
    if (fq == 0) ssq[2 * i + nh] = sq;
    __syncthreads();
    const float rs = 1.f / sqrtf((ssq[2 * i] + ssq[2 * i + 1]) * (1.f / 128.f) + LN_EPS_);
    const float* ng = C.in[5] + l * 512 + h * 128; const size_t t = t0 + i;
#pragma unroll
    for (int nt = 0; nt < 4; ++nt) { const int e = 64 * nh + 16 * nt + 4 * fq; const f32x4 gv = *(const f32x4*)(ng + e); const v2u rw = *(const v2u*)(Y + t * YP + Y_AR + h * 128 + e);
        const float r0 = bflo(rw.x), r1 = bfhi(rw.x), r2 = bflo(rw.y), r3 = bfhi(rw.y);
        v2u w; w.x = pk2(o[nt][0] * rs * gv[0] * r0 * fsigmoid(r0), o[nt][1] * rs * gv[1] * r1 * fsigmoid(r1)); w.y = pk2(o[nt][2] * rs * gv[2] * r2 * fsigmoid(r2), o[nt][3] * rs * gv[3] * r3 * fsigmoid(r3));
        *(v2u*)(YM + t * 2048 + YM_A + h * 128 + e) = w; }
    __syncthreads();
}

__device__ __forceinline__ void ml_prep(Ctx& C, int l, int h, int b, int n, LAS float* gl, ldsp Ql, ldsp Kl, int QP, bool need_q) {
    const int tid = C.tid, lane = C.lane; const size_t t0 = (size_t)b * SEQ_ + n * 64;
    const bf16* Y = WSP(bf16, WS_Y); const float* YSM = WSP(float, WS_YSM);
    if (tid < 64) { const float lf = flogsigmoid(YSM[(t0 + lane) * 32 + 20 + h] + C.in[9][l * 4 + h]); float run = lf;
#pragma unroll
        for (int o = 1; o < 64; o <<= 1) { const float v = __shfl_up(run, o); if (lane >= o) run += v; }
        gl[lane] = run; gl[64 + lane] = YSM[(t0 + lane) * 32 + 16 + h] + C.in[8][l * 4 + h]; }
    const float* cw = C.in[6] + l * 4096; const float* cb = C.in[7] + l * 1024;
    {   const int c0 = (tid & 15) * 8, j0 = tid >> 4;
#pragma unroll
        for (int qk = 0; qk < 2; ++qk) { if (qk == 0 && !need_q) continue;
            const int cc = (qk == 0 ? 0 : 512) + h * 128 + c0, ycol = (qk == 0 ? Y_DQ : Y_DK) + h * 128 + c0;
            v4u xw[2][4]; f32x4 w4[4][2], b4[2];
#pragma unroll
            for (int i = 0; i < 2; ++i)
#pragma unroll
                for (int jj = 0; jj < 4; ++jj) { const int j = j0 + 32 * i, rel = j - 3 + jj, ok = (n * 64 + rel) >= 0; xw[i][jj] = *(const v4u*)(Y + (t0 + (ok ? rel : j)) * YP + ycol); }
#pragma unroll
            for (int jj = 0; jj < 4; ++jj) { w4[jj][0] = *(const f32x4*)(cw + jj * 1024 + cc); w4[jj][1] = *(const f32x4*)(cw + jj * 1024 + cc + 4); }
            b4[0] = *(const f32x4*)(cb + cc); b4[1] = *(const f32x4*)(cb + cc + 4);
#pragma unroll
            for (int i = 0; i < 2; ++i) { const int j = j0 + 32 * i; float a[8] = {b4[0][0], b4[0][1], b4[0][2], b4[0][3], b4[1][0], b4[1][1], b4[1][2], b4[1][3]};
#pragma unroll
                for (int jj = 0; jj < 4; ++jj) { const float mk = (n * 64 + j - 3 + jj) >= 0 ? 1.f : 0.f; float x[8]; unpack8(xw[i][jj], x);
#pragma unroll
                    for (int k = 0; k < 8; ++k) a[k] += (w4[jj][k >> 2][k & 3] * mk) * x[k]; }
                const float sc = qk == 0 ? 1.f : 0.08838834764831845f;
#pragma unroll
                for (int k = 0; k < 8; ++k) a[k] = a[k] * fsigmoid(a[k]) * sc;
                v4u o; o.x = pk2(a[0], a[1]); o.y = pk2(a[2], a[3]); o.z = pk2(a[4], a[5]); o.w = pk2(a[6], a[7]); *(LAS v4u*)((qk == 0 ? Ql : Kl) + j * QP + c0 * 2) = o; } }
    }
    __syncthreads();
}
__device__ __forceinline__ void ml_local_unit(Ctx& C, int l, int u) {
    const int tid = C.tid, lane = C.lane, wave = C.wave, fr = lane & 15, fq = lane >> 4;
    const int n = u & 31, h = (u >> 5) & 3, b = u >> 7; const size_t t0 = (size_t)b * SEQ_ + n * 64;
    const bf16* Y = WSP(bf16, WS_Y);
    constexpr int KP = 288, TP = 288;
    LAS float* gl = (LAS float*)C.lds; LAS float* wk = gl + 128; LAS float* red = wk + 64;
    ldsp Kl = (ldsp)(red + 512), Vl = Kl + 64 * KP;
    ml_prep(C, l, h, b, n, gl, Kl, Kl, KP, false);
    if (tid < 64) { const float bl = gl[63], dec = bl - gl[lane] + gl[64 + lane], a = wave_max(dec); wk[lane] = __expf(dec - a);
        if (lane == 0) { float* SC = WSP(float, WS_MSC) + (size_t)u * 2; SC[0] = bl; SC[1] = a; } }
    __syncthreads();
    { const int d = tid & 127, sg = tid >> 7; float s = 0.f;
        for (int j = 16 * sg; j < 16 * sg + 16; ++j) s += wk[j] * bflo((unsigned)*(const LAS unsigned short*)(Kl + j * KP + d * 2));
        red[sg * 128 + d] = s; }
    {   const int c0 = (tid & 15) * 8, j0 = tid >> 4; v4u vw[2];
#pragma unroll
        for (int i = 0; i < 2; ++i) vw[i] = *(const v4u*)(Y + (t0 + j0 + 32 * i) * YP + Y_DV + h * 128 + c0);
#pragma unroll
        for (int i = 0; i < 2; ++i) *(LAS v4u*)(Vl + (j0 + 32 * i) * TP + c0 * 2) = vw[i];
    }
    __syncthreads();
    {   const int c0 = (tid & 15) * 8, j0 = tid >> 4;
#pragma unroll
        for (int i = 0; i < 2; ++i) { const int j = j0 + 32 * i; float x[8]; unpack8(*(const LAS v4u*)(Kl + j * KP + c0 * 2), x); const float w = wk[j];
            v4u o; o.x = pk2(x[0] * w, x[1] * w); o.y = pk2(x[2] * w, x[3] * w); o.z = pk2(x[4] * w, x[5] * w); o.w = pk2(x[6] * w, x[7] * w); *(LAS v4u*)(Kl + j * KP + c0 * 2) = o; }
    }
    if (tid < 128) WSP(float, WS_MNLOC)[(size_t)u * 128 + tid] = (red[tid] + red[128 + tid]) + (red[256 + tid] + red[384 + tid]);
    __syncthreads();
    float* LOC = WSP(float, WS_MLOC) + (size_t)u * 16384;
#pragma unroll
    for (int mt = 0; mt < 8; ++mt) { f32x4 acc = (f32x4){0.f, 0.f, 0.f, 0.f};
#pragma unroll
        for (int ks = 0; ks < 2; ++ks) acc = mfma16(trfrag2(Vl, TP, 16 * wave, 32 * ks, 32 * ks + 16, lane), trfrag2(Kl, KP, 16 * mt, 32 * ks, 32 * ks + 16, lane), acc);
        *(f32x4*)(LOC + (size_t)(16 * mt + fr) * 128 + 16 * wave + 4 * fq) = acc; }
    __syncthreads();
}
__device__ __forceinline__ void ml_scan(Ctx& C) {
    const float* LOC = WSP(float, WS_MLOC); const float* NL = WSP(float, WS_MNLOC); const float* SC = WSP(float, WS_MSC);
    bf16* MC = WSP(bf16, WS_MC); float* MN = WSP(float, WS_MN); float* MM = WSP(float, WS_MM);
    for (int i = C.bid * 512 + C.tid; i < 16 * (16384 + 128); i += C.G * 512) { const int bh = i / (16384 + 128), r = i % (16384 + 128); float S = 0.f, m = 0.f;
        float lc[32], bl_[32], a_[32];
#pragma unroll
        for (int n = 0; n < 32; ++n) { const size_t uu = (size_t)bh * 32 + n; lc[n] = r < 16384 ? LOC[uu * 16384 + r] : NL[uu * 128 + (r - 16384)]; bl_[n] = SC[uu * 2]; a_[n] = SC[uu * 2 + 1]; }
#pragma unroll
        for (int n = 0; n < 32; ++n) { const size_t uu = (size_t)bh * 32 + n; const float bl = bl_[n], a = a_[n], mn = fmaxf(bl + m, a), keep = __expf(bl + m - mn), sc = __expf(a - mn);
            if (r < 16384) MC[uu * 16384 + r] = bf1(S);
            else { const int d = r - 16384; MN[uu * 128 + d] = S; if (d == 0) MM[uu] = m; }
            S = keep * S + sc * lc[n]; m = mn; } }
}
__device__ __forceinline__ void ml_out_unit(Ctx& C, int l, int u, bf16* YM) {
    const int tid = C.tid, lane = C.lane, wave = C.wave, fr = lane & 15, fq = lane >> 4;
    const int n = u & 31, h = (u >> 5) & 3, b = u >> 7; const size_t t0 = (size_t)b * SEQ_ + n * 64;
    const bf16* Y = WSP(bf16, WS_Y); const bf16* MC = WSP(bf16, WS_MC) + (size_t)u * 16384; const float* MN = WSP(float, WS_MN) + (size_t)u * 128; const float m0 = WSP(float, WS_MM)[u];
    constexpr int QP = 272, TP = 288;
    LAS float* gl = (LAS float*)C.lds; LAS float* mt_ = gl + 128; LAS float* wst = mt_ + 64; LAS float* qn = wst + 64; LAS float* ssq = qn + 64;
    ldsp Ql = (ldsp)(ssq + 128), Kl = Ql + 64 * QP, Vl = Kl + 64 * QP, Cl = Vl + 64 * TP;
    ml_prep(C, l, h, b, n, gl, Ql, Kl, QP, true);
    if (tid < 64) { float pm = gl[64 + lane] - gl[lane];
#pragma unroll
        for (int o = 1; o < 64; o <<= 1) { const float v = __shfl_up(pm, o); if (lane >= o) pm = fmaxf(pm, v); }
        const float mt = gl[lane] + fmaxf(m0, pm); mt_[lane] = mt; wst[lane] = __expf(gl[lane] + m0 - mt); }
    {   const int c0 = (tid & 15) * 8, j0 = tid >> 4; v4u vw[2], cw4[4];
#pragma unroll
        for (int i = 0; i < 2; ++i) vw[i] = *(const v4u*)(Y + (t0 + j0 + 32 * i) * YP + Y_DV + h * 128 + c0);
#pragma unroll
        for (int i = 0; i < 4; ++i) cw4[i] = *(const v4u*)(MC + (j0 + 32 * i) * 128 + c0);
#pragma unroll
        for (int i = 0; i < 2; ++i) *(LAS v4u*)(Vl + (j0 + 32 * i) * TP + c0 * 2) = vw[i];
#pragma unroll
        for (int i = 0; i < 4; ++i) *(LAS v4u*)(Cl + (j0 + 32 * i) * TP + c0 * 2) = cw4[i];
    }
    { const int i = tid >> 3, d0 = (tid & 7) * 16; float s = 0.f;
#pragma unroll
        for (int k2 = 0; k2 < 2; ++k2) { float x[8]; unpack8(*(const LAS v4u*)(Ql + i * QP + (d0 + 8 * k2) * 2), x);
#pragma unroll
            for (int k = 0; k < 8; ++k) s += x[k] * MN[d0 + 8 * k2 + k]; }
        s += __shfl_xor(s, 1); s += __shfl_xor(s, 2); s += __shfl_xor(s, 4);
        if ((tid & 7) == 0) qn[i] = s; }
    __syncthreads();
    const int mt = wave & 3, nh = wave >> 2, i = 16 * mt + fr;
    bf16x8 qa[4];
#pragma unroll
    for (int ks = 0; ks < 4; ++ks) qa[ks] = frag(Ql, QP, i, 32 * ks, fq);
    const float bi_ = gl[i], mti = mt_[i], wsti = wst[i];
    f32x4 sc[4]; float rsum = 0.f;
#pragma unroll
    for (int t = 0; t < 4; ++t) { sc[t] = (f32x4){0.f, 0.f, 0.f, 0.f};
#pragma unroll
        for (int ks = 0; ks < 4; ++ks) sc[t] = mfma16(frag(Kl, QP, 16 * t + fr, 32 * ks, fq), qa[ks], sc[t]);
#pragma unroll
        for (int e = 0; e < 4; ++e) { const int j = 16 * t + 4 * fq + e; const float w = (j <= i) ? __expf(bi_ - gl[j] + gl[64 + j] - mti) : 0.f; sc[t][e] *= w; rsum += sc[t][e]; } }
    rsum += __shfl_xor(rsum, 16); rsum += __shfl_xor(rsum, 32);
    const float den = rsum + wsti * qn[i], rden = 1.f / fmaxf(fabsf(den), __expf(-mti));
    const bf16x8 p0 = pfrag(sc[0], sc[1]), p1 = pfrag(sc[2], sc[3]);
    f32x4 o[4]; float sq = 0.f;
    const size_t t = t0 + i;
#pragma unroll
    for (int nt = 0; nt < 4; ++nt) { const int ec = 64 * nh + 16 * nt; f32x4 a1 = (f32x4){0.f, 0.f, 0.f, 0.f}, a2 = a1;
        a1 = mfma16(trfrag2(Vl, TP, ec, 0, 16, lane), p0, a1); a1 = mfma16(trfrag2(Vl, TP, ec, 32, 48, lane), p1, a1);
#pragma unroll
        for (int ks = 0; ks < 4; ++ks) a2 = mfma16(trfrag(Cl, TP, ec, 32 * ks, lane), qa[ks], a2);
        const v2u ow = *(const v2u*)(Y + t * YP + Y_DO + h * 128 + 64 * nh + 16 * nt + 4 * fq);
        f32x4 hv = (a1 + a2 * wsti) * rden; hv[0] *= fsigmoid(bflo(ow.x)); hv[1] *= fsigmoid(bfhi(ow.x)); hv[2] *= fsigmoid(bflo(ow.y)); hv[3] *= fsigmoid(bfhi(ow.y));
        o[nt] = hv; sq += (hv[0] * hv[0] + hv[1] * hv[1]) + (hv[2] * hv[2] + hv[3] * hv[3]); }
    sq += __shfl_xor(sq, 16); sq += __shfl_xor(sq, 32);
    if (fq == 0) ssq[2 * i + nh] = sq;
    __syncthreads();
    const float rs = 1.f / sqrtf((ssq[2 * i] + ssq[2 * i + 1]) * (1.f / 128.f) + LN_EPS_);
    const float* ng = C.in[10] + l * 512 + h * 128;
#pragma unroll
    for (int nt = 0; nt < 4; ++nt) { const int e = 64 * nh + 16 * nt + 4 * fq; const f32x4 gv = *(const f32x4*)(ng + e);
        v2u w; w.x = pk2(o[nt][0] * rs * gv[0], o[nt][1] * rs * gv[1]); w.y = pk2(o[nt][2] * rs * gv[2], o[nt][3] * rs * gv[3]);
        *(v2u*)(YM + t * 2048 + YM_D + h * 128 + e) = w; }
    __syncthreads();
}

#ifndef MIXREP
#define MIXREP 0
#endif
#define RELAUNDER(C) do { int zv_ = 0; asm volatile("" : "+v"(zv_)); unsigned long long zw_ = (unsigned long long)(C).ws; asm volatile("" : "+s"(zw_)); (C).ws = (unsigned char*)(GAS unsigned char*)zw_;     \
    (C).tid = (int)threadIdx.x + zv_; (C).lane = (C).tid & 63; (C).wave = __builtin_amdgcn_readfirstlane((C).tid >> 6); } while (0)
__device__ __forceinline__ void phase_mix_a(Ctx& C, int l, bf16* YM) {
    const bool std_grid = C.G == 256;
    if (std_grid) {
        const int nd = C.bid < 128 ? 2 : 4, d0 = C.bid < 128 ? C.bid : 256 + (C.bid - 128);
        for (int k = 0; k < nd; ++k) { RELAUNDER(C); const int u = d0 + 128 * k; dil_unit(C, u); if (MIXREP & 1) dil_unit(C, u); }
    } else for (int u = C.bid; u < 768; u += C.G) { RELAUNDER(C); dil_unit(C, u); }
    for (int u = C.bid; u < 384; u += C.G) { RELAUNDER(C); sgu_unit(C, l, u, YM); if (MIXREP & 2) sgu_unit(C, l, u, YM); }
    for (int u = C.bid; u < 512; u += C.G) { RELAUNDER(C); gla_local_unit(C, l, u); if (MIXREP & 4) gla_local_unit(C, l, u); }
    for (int u = C.bid; u < 512; u += C.G) { RELAUNDER(C); ml_local_unit(C, l, u); if (MIXREP & 8) ml_local_unit(C, l, u); }
}
__device__ __forceinline__ void phase_mix_b(Ctx& C, bf16* YM) { gla_scan(C); ml_scan(C); dil_merge(C, YM); }
__device__ __forceinline__ void phase_mix_c(Ctx& C, int l, bf16* YM) {
    for (int u = C.bid; u < 1024; u += C.G) { RELAUNDER(C); if (u < 512) { gla_out_unit(C, l, u, YM); if (MIXREP & 16) gla_out_unit(C, l, u, YM); } else { ml_out_unit(C, l, u - 512, YM); if (MIXREP & 32) ml_out_unit(C, l, u - 512, YM); } }
}
#ifndef EARLY_WIN
#define EARLY_WIN 0
#endif
#ifndef STEAL_ON
#define STEAL_ON 0
#endif
#ifndef Y_WGM
#define Y_WGM 8
#endif
#ifndef NCONV
#define NCONV 72
#endif
#ifndef REPEAT_MASK
#define REPEAT_MASK 0
#endif
#define REP(k) (((REPEAT_MASK) >> (k)) & 1)
#define RELAUNDER_T(C) do { int zv_ = 0; asm volatile("" : "+v"(zv_)); (C).tid = (int)threadIdx.x + zv_; (C).lane = (C).tid & 63; (C).wave = __builtin_amdgcn_readfirstlane((C).tid >> 6); } while (0)
#define IN(k) (lo <= (k) && (k) < hi)
#define SEAM(k) do { if (IN(k) && IN((k) + 1)) xcd_barrier(bar); } while (0)
#define STEAL(k) do { if (STEAL_ON && FP8_LAST && l + 2 == NL_ && IN(k) && IN((k) + 1)) { unsigned* arr_ = WSP(unsigned, WS_CTL) + CW_ARR + 64 * (k); __syncthreads(); if (C.tid == 0) atomicAdd(arr_, 1u); \
        phase_convert(C, l + 1, 1, C.bid, C.G, arr_); } } while (0)
template <int l>
__device__ __forceinline__ void layer_program(Ctx& C, const XcdBarrier& bar, const int lo, const int hi) {
    constexpr int p0 = l * 12;
    const float* Xin = l == 0 ? C.in[0] : WSP(float, WS_XA);
    if (l == 0) { if (IN(p0 + 0)) for (int rep_ = 0; rep_ < 1 + REP(0); ++rep_) { RELAUNDER_T(C); phase_convert(C, l, 0, C.bid, C.G); }
        SEAM(p0 + 0); }
    if (IN(p0 + 1)) for (int rep_ = 0; rep_ < 1 + REP(1); ++rep_) { RELAUNDER_T(C);
        if (C.bid < NCONV) phase_convert(C, l, 1, C.bid, NCONV);
        else {
        if constexpr (GATES8(l)) {
            { pg8::Gemm g{WSP(bf16, WS_XB), WSP(bf16, WS_WIN), T_, 7680, 2048, 2048, 2048, nullptr}; pg8::StaticOrder S; S.init(T_, 7680, C.G - NCONV, C.bid - NCONV, Y_WGM);
              EpiY E{WSP(bf16, WS_Y), WSP(float, WS_YSM), 0}; pg8::gemm_phase<EpiY, pg8::StaticOrder, true>(C.lds, g, S, E, C.tid); }
            { pg8::Gemm g{WSP(bf16, WS_XB8), WSP(bf16, WS_WIN8), T_, 8192, 1024, 1024, 1024, nullptr}; pg8::StaticOrder S; S.init(T_, 8192, C.G - NCONV, C.bid - NCONV, Y_WGM);
              EpiY E{WSP(bf16, WS_Y), WSP(float, WS_YSM), 30}; pg8::gemm_phase<EpiY, pg8::StaticOrder, true, false, 2, 1>(C.lds, g, S, E, C.tid); }
        } else {
        pg8::Gemm g{WSP(bf16, WS_XB), WSP(bf16, WS_WIN), T_, YP, 2048, 2048, 2048, nullptr}; pg8::StaticOrder S; S.init(T_, YP, C.G - NCONV, C.bid - NCONV, Y_WGM);
        EpiY E{WSP(bf16, WS_Y), WSP(float, WS_YSM), 0};
        pg8::gemm_phase<EpiY, pg8::StaticOrder, true>(C.lds, g, S, E, C.tid); }
        phase_convert(C, l, 1, C.bid, NCONV); }
    }
    SEAM(p0 + 1);
    bf16* YMo = WSP(bf16, MK_MODE == 1 ? WS_MRG : WS_YM);
    if (IN(p0 + 2)) for (int rep_ = 0; rep_ < 1 + REP(2); ++rep_) { RELAUNDER_T(C); phase_mix_a(C, l, YMo); }
    SEAM(p0 + 2);
    if (IN(p0 + 3)) for (int rep_ = 0; rep_ < 1 + REP(3); ++rep_) { RELAUNDER_T(C); phase_mix_b(C, YMo); }
    SEAM(p0 + 3);
    if (IN(p0 + 4)) for (int rep_ = 0; rep_ < 1 + REP(4); ++rep_) { RELAUNDER_T(C); phase_mix_c(C, l, YMo); }
    SEAM(p0 + 4);
    if (IN(p0 + 5)) for (int rep_ = 0; rep_ < 1 + REP(5); ++rep_) { RELAUNDER_T(C);
        pg8::StaticOrder S; S.init(T_, 4096, C.G, C.bid);
        pg8::Gemm g{WSP(bf16, WS_YM), WSP(bf16, WS_WP), T_, 2048, 2048, 2048, 2048, nullptr}; EpiMerge E; E.Y = WSP(bf16, WS_Y); E.MB = WSP(bf16, WS_MB);
        if (MERGE3) pg8::gemm_phase_n1s3<EpiMerge, pg8::StaticOrder>(C.lds, g, S, E, C.tid); else pg8::gemm_phase<EpiMerge, pg8::StaticOrder, true, false, 1>(C.lds, g, S, E, C.tid);
    }
    SEAM(p0 + 5);
    if (IN(p0 + 6)) for (int rep_ = 0; rep_ < 1 + REP(6); ++rep_) { RELAUNDER_T(C);
        pg8::Gemm g{WSP(bf16, WS_MB), WSP(bf16, WS_WOUT), T_, 2048, 2048, 2048, 2048, nullptr}; pg8::StaticOrder S; S.init(T_, 2048, C.G, C.bid);
        EpiOut E{Xin, WSP(float, WS_HB)};
        pg8::gemm_phase<EpiOut, pg8::StaticOrder, true>(C.lds, g, S, E, C.tid);
    }
    SEAM(p0 + 6);
    if (IN(p0 + 7)) for (int rep_ = 0; rep_ < 1 + REP(7); ++rep_) { RELAUNDER_T(C); phase_ln1_router(C, l); }
    SEAM(p0 + 7);
    if (IN(p0 + 8)) for (int rep_ = 0; rep_ < 1 + REP(8); ++rep_) { RELAUNDER_T(C); phase_scatter(C, l); }
    SEAM(p0 + 8);
    if (IN(p0 + 9)) for (int rep_ = 0; rep_ < 1 + REP(9); ++rep_) { RELAUNDER_T(C);
        MoeOrder S; S.init(WSP(int, WS_CTL) + CW_TST + l * 128, 4, C.G, C.bid, C.lane);
        if constexpr (MOE8(l)) {
            pg8::Gemm g{WSP(bf16, WS_XS8), WSP(bf16, l == NL_ - 1 ? WS_W13B : WS_W13), MAXROWS, 65 * 1024, 1024, 1024, 1024, WSP(int, WS_ROWMAP)};
            EpiMoe1F8 E{WSP(unsigned char, WS_H), WSP(float, WS_ROWW)};
            pg8::gemm_phase<EpiMoe1F8, MoeOrder, true, true, 2, 1>(C.lds, g, S, E, C.tid);
        } else {
            pg8::Gemm g{WSP(bf16, WS_XS), WSP(bf16, WS_W13), MAXROWS, 65 * 1024, 2048, 2048, 2048, WSP(int, WS_ROWMAP)};
            EpiMoe1 E{WSP(bf16, WS_H), WSP(float, WS_ROWW), 4};
            pg8::gemm_phase<EpiMoe1, MoeOrder, true, true>(C.lds, g, S, E, C.tid);
        }
    }
    if (STEAL_ON & 1) STEAL(p0 + 9);
    SEAM(p0 + 9);
    if (IN(p0 + 10)) for (int rep_ = 0; rep_ < 1 + REP(10); ++rep_) { RELAUNDER_T(C);
        MoeOrder S; S.init(WSP(int, WS_CTL) + CW_TST + l * 128, 8, C.G, C.bid, C.lane);
        EpiMoe2 E{WSP(bf16, WS_YBUF)};
        if constexpr (MOE8(l)) {
            pg8::Gemm g{WSP(bf16, WS_H), WSP(bf16, l == NL_ - 1 ? WS_W2B : WS_W2), MAXROWS, 65 * 2048, 256, 256, 256, nullptr};
            pg8::gemm_phase<EpiMoe2, MoeOrder, true, false, 2, 1>(C.lds, g, S, E, C.tid);
        } else {
            pg8::Gemm g{WSP(bf16, WS_H), WSP(bf16, WS_W2), MAXROWS, 65 * 2048, 512, 512, 512, nullptr};
            pg8::gemm_phase<EpiMoe2, MoeOrder, true>(C.lds, g, S, E, C.tid);
        }
        if (EARLY_WIN && l + 1 < NL_ && !REP(10)) phase_convert(C, l + 1, 0, C.bid, C.G);
    }
    if (STEAL_ON & 2) STEAL(p0 + 10);
    SEAM(p0 + 10);
    if (IN(p0 + 11)) for (int rep_ = 0; rep_ < 1 + REP(11); ++rep_) { RELAUNDER_T(C); phase_combine(C, l); if (l + 1 < NL_) phase_convert(C, l + 1, 0, C.bid, C.G); }
    if (STEAL_ON & 4) STEAL(p0 + 11);
    SEAM(p0 + 11);
}
__global__ void __launch_bounds__(512, 2) fwd(KArgs args) {
    extern __shared__ __attribute__((aligned(16))) unsigned char lds_[];
    Ctx C;
    C.lds = (LAS unsigned char*)lds_; C.ws = args.ws; C.out = args.out;
#pragma unroll
    for (int i = 0; i < 32; ++i) C.in[i] = args.in[i];
    C.tid = threadIdx.x; C.lane = C.tid & 63; C.wave = __builtin_amdgcn_readfirstlane(C.tid >> 6); C.G = gridDim.x; C.bid = blockIdx.x;
    const int lo = args.ph_lo, hi = args.ph_hi;
    if (C.tid < 4) ((LAS unsigned*)(C.lds + AUX_BARW))[C.tid] = 0u;
    __syncthreads();
    XcdBarrier bar; bar.bar = WSP(unsigned, WS_CTL) + CW_BAR + args.region * XCD_BAR_WORDS; bar.x = 0; bar.st = (volatile LAS unsigned*)(C.lds + AUX_BARW);
    if (hi - lo > 1) bar = xcd_barrier_post(bar.bar, (volatile LAS unsigned*)(C.lds + AUX_BARW));
    layer_program<0>(C, bar, lo, hi);
    layer_program<1>(C, bar, lo, hi);
}
#undef IN
#undef SEAM

#define NIDX (blockIdx.x * blockDim.x + threadIdx.x)
__global__ void __launch_bounds__(256) nk_gla_g(const float* YSM, const float* wa2, const float* ba, float* GG) { const int i = NIDX; if (i < T_ * 256) naive_gla_g(i >> 8, i & 255, YSM, wa2, ba, GG); }
__global__ void __launch_bounds__(64) nk_gla_rec(const bf16* Y, const float* GG, float* OA) { const int i = NIDX; if (i < 2048) naive_gla_rec(i >> 9, (i >> 7) & 3, i & 127, SEQ_, Y, GG, OA); }
__global__ void __launch_bounds__(256) nk_gla_post(const bf16* Y, const float* OA, const float* ng, bf16* YM) { const int i = NIDX; if (i < T_ * 4) naive_gla_post(i >> 2, i & 3, Y, OA, ng, YM); }
__global__ void __launch_bounds__(256) nk_rope(const bf16* Y, const int* pos, float* QR, float* KR) { const int i = NIDX; if (i < T_ * 384) naive_rope(i / 384, (i % 384) >> 5, i & 31, Y, pos, QR, KR); }
__global__ void __launch_bounds__(64) nk_dil(const float* QR, const float* KR, const bf16* Y, bf16* YM) { const int i = NIDX; if (i < T_ * 4) naive_dil(i >> 2, i & 3, SEQ_, QR, KR, Y, YM); }
__global__ void __launch_bounds__(256) nk_sgu_stats(const bf16* Y, float* MU, float* RS) { const int i = NIDX; if (i < T_) naive_sgu_stats(i, Y, MU, RS); }
__global__ void __launch_bounds__(256) nk_sgu_out(const bf16* Y, const float* MU, const float* RS, const float* lg, const float* lb, const float* ws, const float* bs, bf16* YM) { const int i = NIDX; if (i < T_ * 768) naive_sgu_out(i / 768, i % 768, SEQ_, Y, MU, RS, lg, lb, ws, bs, YM); }
__global__ void __launch_bounds__(256) nk_ml_conv(const bf16* Y, const float* cw, const float* cb, float* QKC) { const int i = NIDX; if (i < T_ * 1024) naive_ml_conv(i >> 10, i & 1023, SEQ_, Y, cw, cb, QKC); }
__global__ void __launch_bounds__(64) nk_ml_den(const float* YSM, const float* QKC, const float* bi, const float* bf_, float* DEN) { const int i = NIDX; if (i < 16) naive_ml_den(i >> 2, i & 3, SEQ_, YSM, QKC, bi, bf_, DEN); }
__global__ void __launch_bounds__(64) nk_ml_rec(const bf16* Y, const float* YSM, const float* QKC, const float* bi, const float* bf_, const float* DEN, float* HM) { const int i = NIDX; if (i < 2048) naive_ml_rec(i >> 9, (i >> 7) & 3, i & 127, SEQ_, Y, YSM, QKC, bi, bf_, DEN, HM); }
__global__ void __launch_bounds__(256) nk_ml_post(const float* HM, const float* ng, bf16* YM) { const int i = NIDX; if (i < T_ * 4) naive_ml_post(i >> 2, i & 3, HM, ng, YM); }

constexpr int CW_DBG = 12288;
__global__ void __launch_bounds__(256) nk_compare(const bf16* YMn, const bf16* YMf, float* acc) {
    const int i = NIDX; if (i >= T_ * 256) return;
    const int t = i >> 8, c8 = (i & 255) * 8, br = c8 < 512 ? 0 : (c8 < 768 ? 1 : (c8 < 1536 ? 2 : 3));
    const v4u a = *(const v4u*)(YMn + (size_t)t * 2048 + c8), b = *(const v4u*)(YMf + (size_t)t * 2048 + c8);
    const unsigned aw[4] = {a.x, a.y, a.z, a.w}, bw[4] = {b.x, b.y, b.z, b.w}; float sd = 0.f, sn = 0.f;
#pragma unroll
    for (int k = 0; k < 4; ++k) { const float x0 = bflo(aw[k]), x1 = bfhi(aw[k]), y0 = bflo(bw[k]), y1 = bfhi(bw[k]); float d0 = y0 - x0, d1 = y1 - x1;
        if (!(d0 == d0)) d0 = 1e3f; if (!(d1 == d1)) d1 = 1e3f; sd += d0 * d0 + d1 * d1; sn += x0 * x0 + x1 * x1; }
#pragma unroll
    for (int o = 1; o < 32; o <<= 1) { sd += __shfl_xor(sd, o); sn += __shfl_xor(sn, o); }
    if ((threadIdx.x & 31) == 0) { atomicAdd(acc + br * 2, sd); atomicAdd(acc + br * 2 + 1, sn); }
}
__global__ void __launch_bounds__(256) nk_scale(float* out, const float* acc, int mask) {
    float d2 = 0.f;
    for (int br = 0; br < 4; ++br) if ((mask >> br) & 1) d2 += 100.f * acc[br * 2] / fmaxf(acc[br * 2 + 1], 1e-20f);
    const float s = 1.f + sqrtf(fminf(d2, 100.f));
    const int i = NIDX; if (i < T_ * D_ / 4) { f32x4 v = *(f32x4*)(out + (size_t)i * 4); *(f32x4*)(out + (size_t)i * 4) = v * s; }
}
#ifndef DBG_MASK
#define DBG_MASK 15
#endif
static void launch_fwd(void* const* d_in, void* d_out, void* d_ws, hipStream_t stream, int grid, int lo, int hi, int region) {
    KArgs a{};
    for (int i = 0; i < 32; ++i) a.in[i] = (const float*)d_in[i];
    a.out = (float*)d_out; a.ws = (unsigned char*)d_ws; a.ph_lo = lo; a.ph_hi = hi; a.region = region; a.pad = 0;
    hipLaunchKernelGGL(fwd, dim3(grid), dim3(512), LDS_BYTES, stream, a);
}
extern "C" void kernel_launch(void* const* d_in, const int* in_sizes, int n_in, void* d_out, int out_size, void* d_ws, size_t ws_size, hipStream_t stream) {
    static int grid = 0;
    if (grid == 0) {
        if (n_in != 32 || out_size != T_ * D_ || ws_size < WS_END) { fprintf(stderr, "kernel_launch: unexpected shapes: n_in %d out %d ws %zu (need %zu)\n", n_in, out_size, ws_size, (size_t)WS_END); grid = -1; return; }
        int dev = 0, cus = 0, per_cu = 0;
        if (hipGetDevice(&dev) != hipSuccess || hipDeviceGetAttribute(&cus, hipDeviceAttributeMultiprocessorCount, dev) != hipSuccess) { grid = -1; return; }
        if (hipFuncSetAttribute((const void*)fwd, hipFuncAttributeMaxDynamicSharedMemorySize, LDS_BYTES) != hipSuccess) { fprintf(stderr, "kernel_launch: hipFuncSetAttribute failed\n"); grid = -1; return; }
        if (hipOccupancyMaxActiveBlocksPerMultiprocessor(&per_cu, (const void*)fwd, 512, LDS_BYTES) != hipSuccess || per_cu < 1) fprintf(stderr, "kernel_launch: occupancy query reports %d blocks per CU\n", per_cu);
        (void)hipGetLastError();
        grid = cus;
    }
    if (grid < 0) return;
    (void)hipMemsetAsync((char*)d_ws + WS_CTL, 0, CTL_ZERO_BYTES, stream);
    int region = 0;
#if MK_MODE == 3
    launch_fwd(d_in, d_out, d_ws, stream, grid, 0, 24, region++);
#else
    unsigned char* ws = (unsigned char*)d_ws;
    const bf16* Y = (const bf16*)(ws + WS_Y); const float* YSM = (const float*)(ws + WS_YSM); bf16* YM = (bf16*)(ws + WS_YM);
    float* GG = (float*)(ws + WS_NV); float* OA = (float*)(ws + WS_NV + 8 * MiB); float* QR = (float*)(ws + WS_NV + 24 * MiB); float* KR = (float*)(ws + WS_NV + 48 * MiB);
    float* MU = (float*)(ws + WS_NV + 72 * MiB); float* RS = MU + T_; float* QKC = (float*)(ws + WS_NV + 73 * MiB); float* DEN = (float*)(ws + WS_NV + 105 * MiB); float* HM = (float*)(ws + WS_NV + 106 * MiB);
    float* dbg = (float*)ws + CW_DBG;
    const float* f[32]; for (int i = 0; i < 32; ++i) f[i] = (const float*)d_in[i];
    for (int l = 0; l < NL_; ++l) {
        const int p0 = l * 12;
        launch_fwd(d_in, d_out, d_ws, stream, grid, p0 + 0, p0 + 1, region++);
        launch_fwd(d_in, d_out, d_ws, stream, grid, p0 + 1, p0 + 2, region++);
        if (MK_MODE == 0 || MK_MODE == 1) {
            hipLaunchKernelGGL(nk_gla_g, dim3(T_ * 256 / 256), dim3(256), 0, stream, YSM, f[3] + l * 16 * 256, f[4] + l * 256, GG);
            hipLaunchKernelGGL(nk_gla_rec, dim3(32), dim3(64), 0, stream, Y, GG, OA);
            hipLaunchKernelGGL(nk_gla_post, dim3(T_ * 4 / 256), dim3(256), 0, stream, Y, OA, f[5] + l * 512, YM);
            hipLaunchKernelGGL(nk_rope, dim3(T_ * 384 / 256), dim3(256), 0, stream, Y, (const int*)d_in[1], QR, KR);
            hipLaunchKernelGGL(nk_dil, dim3(T_ * 4 / 64), dim3(64), 0, stream, QR, KR, Y, YM);
            hipLaunchKernelGGL(nk_sgu_stats, dim3(T_ / 256), dim3(256), 0, stream, Y, MU, RS);
            hipLaunchKernelGGL(nk_sgu_out, dim3(T_ * 768 / 256), dim3(256), 0, stream, Y, MU, RS, f[11] + l * 768, f[12] + l * 768, f[13] + l * 6 * 128 * 128, f[14] + l * 6 * 128, YM);
            hipLaunchKernelGGL(nk_ml_conv, dim3(T_ * 1024 / 256), dim3(256), 0, stream, Y, f[6] + l * 4 * 1024, f[7] + l * 1024, QKC);
            hipLaunchKernelGGL(nk_ml_den, dim3(1), dim3(64), 0, stream, YSM, QKC, f[8] + l * 4, f[9] + l * 4, DEN);
            hipLaunchKernelGGL(nk_ml_rec, dim3(32), dim3(64), 0, stream, Y, YSM, QKC, f[8] + l * 4, f[9] + l * 4, DEN, HM);
            hipLaunchKernelGGL(nk_ml_post, dim3(T_ * 4 / 256), dim3(256), 0, stream, HM, f[10] + l * 512, YM);
        }
        if (MK_MODE == 1 || MK_MODE == 2) for (int ph = 2; ph < 5; ++ph) launch_fwd(d_in, d_out, d_ws, stream, grid, p0 + ph, p0 + ph + 1, region++);
        if (MK_MODE == 1) hipLaunchKernelGGL(nk_compare, dim3(T_ * 256 / 256), dim3(256), 0, stream, (const bf16*)YM, (const bf16*)(ws + WS_MRG), dbg);
        for (int ph = 5; ph < 12; ++ph) launch_fwd(d_in, d_out, d_ws, stream, grid, p0 + ph, p0 + ph + 1, region++);
    }
    if (MK_MODE == 1) hipLaunchKernelGGL(nk_scale, dim3(T_ * D_ / 4 / 256), dim3(256), 0, stream, (float*)d_out, (const float*)dbg, (int)DBG_MASK);
#endif
}
```

```cpp
#include <hip/hip_runtime.h>
#include <cstdio>
#include <cstdint>
#include <cmath>
#define MK_MODE 3
#define REPEAT_MASK 0
#define HD __device__
#ifndef HD
#define HD
#endif
#define YP 15872
#define Y_AQ 0
#define Y_AK 256
#define Y_AV 512
#define Y_AR 1024
#define Y_BQ 1536
#define Y_BK 2304
#define Y_BV 3072
#define Y_CU 3840
#define Y_CV 4608
#define Y_DQ 5376
#define Y_DK 5888
#define Y_DV 6400
#define Y_DO 6912
#define Y_G  7680
#define YM_A 0
#define YM_B 512
#define YM_C 768
#define YM_D 1536
typedef unsigned short u16;
HD static inline float bf2f(u16 v) { unsigned u = ((unsigned)v) << 16; float f; __builtin_memcpy(&f, &u, 4); return f; }
HD static inline u16 f2bf(float f) { unsigned u; __builtin_memcpy(&u, &f, 4); u += 0x7fffu + ((u >> 16) & 1u); return (u16)(u >> 16); }
HD static inline float sigmoidf_(float x) { return 1.f / (1.f + expf(-x)); }
HD static inline float logsigmoidf_(float x) { return x < 0.f ? x - log1pf(expf(x)) : -log1pf(expf(-x)); }
HD static inline float siluf_(float x) { return x * sigmoidf_(x); }
HD static inline float geluf_(float x) { return 0.5f * x * (1.f + erff(x * 0.70710678118654752f)); }

HD static inline void naive_gla_g(int tok, int c, const float* YSM, const float* wa2, const float* ba, float* GG) {
    float s = ba[c];
    for (int r = 0; r < 16; ++r) s += YSM[tok * 32 + r] * wa2[r * 256 + c];
    GG[(size_t)tok * 256 + c] = logsigmoidf_(s) * (1.f / 16.f);
}
HD static inline void naive_gla_rec(int b, int h, int e, int S_, const u16* Y, const float* GG, float* OA) {
    float St[64];
#pragma unroll
    for (int d = 0; d < 64; ++d) St[d] = 0.f;
    for (int t = 0; t < S_; ++t) {
        const size_t tok = (size_t)b * S_ + t;
        const float v = bf2f(Y[tok * YP + Y_AV + h * 128 + e]);
        float o = 0.f;
#pragma unroll
        for (int d = 0; d < 64; ++d) {
            const float a = expf(GG[tok * 256 + h * 64 + d]);
            const float k = bf2f(Y[tok * YP + Y_AK + h * 64 + d]);
            const float q = bf2f(Y[tok * YP + Y_AQ + h * 64 + d]) * 0.125f;
            St[d] = a * St[d] + k * v;
            o += q * St[d];
        }
        OA[tok * 512 + h * 128 + e] = o;
    }
}
HD static inline void naive_gla_post(int tok, int h, const u16* Y, const float* OA, const float* norm_g, u16* YM) {
    float ss = 0.f;
    for (int e = 0; e < 128; ++e) { const float o = OA[(size_t)tok * 512 + h * 128 + e]; ss += o * o; }
    const float rs = 1.f / sqrtf(ss * (1.f / 128.f) + 1e-5f);
    for (int e = 0; e < 128; ++e) {
        const float o = OA[(size_t)tok * 512 + h * 128 + e] * rs * norm_g[h * 128 + e];
        const float r = bf2f(Y[(size_t)tok * YP + Y_AR + h * 128 + e]);
        YM[(size_t)tok * 2048 + YM_A + h * 128 + e] = f2bf(o * siluf_(r));
    }
}
HD static inline void naive_rope(int tok, int head, int i, const u16* Y, const int* positions, float* QR, float* KR) {
    const float inv = powf(10000.0f, -(float)i * 2.0f / 64.0f);
    const float ang = (float)positions[tok] * inv;
    const float c = cosf(ang), s = sinf(ang);
    const size_t yb = (size_t)tok * YP;
    const float q1 = bf2f(Y[yb + Y_BQ + head * 64 + i]), q2 = bf2f(Y[yb + Y_BQ + head * 64 + 32 + i]);
    const float k1 = bf2f(Y[yb + Y_BK + head * 64 + i]), k2 = bf2f(Y[yb + Y_BK + head * 64 + 32 + i]);
    QR[(size_t)tok * 768 + head * 64 + i] = q1 * c - q2 * s; QR[(size_t)tok * 768 + head * 64 + 32 + i] = q2 * c + q1 * s;
    KR[(size_t)tok * 768 + head * 64 + i] = k1 * c - k2 * s; KR[(size_t)tok * 768 + head * 64 + 32 + i] = k2 * c + k1 * s;
}
HD static inline void naive_dil(int tok, int hh, int S_, const float* QR, const float* KR, const u16* Y, u16* YM) {
    const int b = tok / S_, s = tok % S_;
    float o[64];
#pragma unroll
    for (int d = 0; d < 64; ++d) o[d] = 0.f;
    float mx = -INFINITY, den = 0.f;
    for (int g = 0; g < 3; ++g) {
        const int dil = g == 0 ? 1 : (g == 1 ? 4 : 16), head = g * 4 + hh;
        const int m = s / dil;
        for (int j = 0; j <= 128; ++j) {
            if (m - j < 0) break;
            const size_t kt = (size_t)b * S_ + (s - j * dil);
            float sc = 0.f;
#pragma unroll
            for (int d = 0; d < 64; ++d) sc += QR[(size_t)tok * 768 + head * 64 + d] * KR[kt * 768 + head * 64 + d];
            sc *= 0.125f;
            const float nm = fmaxf(mx, sc), corr = expf(mx - nm), p = expf(sc - nm);
            den = den * corr + p;
#pragma unroll
            for (int d = 0; d < 64; ++d) o[d] = o[d] * corr + p * bf2f(Y[kt * YP + Y_BV + head * 64 + d]);
            mx = nm;
        }
    }
#pragma unroll
    for (int d = 0; d < 64; ++d) YM[(size_t)tok * 2048 + YM_B + hh * 64 + d] = f2bf(o[d] / den);
}
HD static inline void naive_sgu_stats(int tok, const u16* Y, float* MU, float* RS) {
    float s = 0.f;
    for (int c = 0; c < 768; ++c) s += geluf_(bf2f(Y[(size_t)tok * YP + Y_CV + c]));
    const float mu = s * (1.f / 768.f); float q = 0.f;
    for (int c = 0; c < 768; ++c) { const float d = geluf_(bf2f(Y[(size_t)tok * YP + Y_CV + c])) - mu; q += d * d; }
    MU[tok] = mu; RS[tok] = 1.f / sqrtf(q * (1.f / 768.f) + 1e-5f);
}
HD static inline void naive_sgu_out(int tok, int c, int S_, const u16* Y, const float* MU, const float* RS, const float* ln_g, const float* ln_b,
                                    const float* ws, const float* bs, u16* YM) {
    const int s = tok % S_, i = s % 128, t0 = tok - i, g = c / 128;
    float acc = 0.f;
    for (int j = 0; j <= i; ++j) {
        const float zv = geluf_(bf2f(Y[(size_t)(t0 + j) * YP + Y_CV + c]));
        const float vn = (zv - MU[t0 + j]) * RS[t0 + j] * ln_g[c] + ln_b[c];
        acc += ws[(g * 128 + i) * 128 + j] * vn;
    }
    const float zu = geluf_(bf2f(Y[(size_t)tok * YP + Y_CU + c]));
    YM[(size_t)tok * 2048 + YM_C + c] = f2bf(zu * (acc + bs[g * 128 + i]));
}
HD static inline void naive_ml_conv(int tok, int c, int S_, const u16* Y, const float* conv_w, const float* conv_b, float* QKC) {
    const int s = tok % S_; const int col = c < 512 ? Y_DQ + c : Y_DK + (c - 512);
    float a = conv_b[c];
    for (int j = 0; j < 4; ++j) { const int sp = s - 3 + j; if (sp >= 0) a += conv_w[j * 1024 + c] * bf2f(Y[(size_t)(tok - 3 + j) * YP + col]); }
    a = siluf_(a);
    QKC[(size_t)tok * 1024 + c] = c < 512 ? a : a * 0.08838834764831845f;
}
HD static inline void naive_ml_den(int b, int h, int S_, const float* YSM, const float* QKC, const float* b_i, const float* b_f, float* DEN) {
    float n[128];
#pragma unroll
    for (int d = 0; d < 128; ++d) n[d] = 0.f;
    for (int t = 0; t < S_; ++t) {
        const size_t tok = (size_t)b * S_ + t;
        const float f = sigmoidf_(YSM[tok * 32 + 20 + h] + b_f[h]), ig = expf(YSM[tok * 32 + 16 + h] + b_i[h]);
        float den = 0.f;
#pragma unroll
        for (int d = 0; d < 128; ++d) { n[d] = f * n[d] + ig * QKC[tok * 1024 + 512 + h * 128 + d]; den += QKC[tok * 1024 + h * 128 + d] * n[d]; }
        DEN[tok * 4 + h] = den;
    }
}
HD static inline void naive_ml_rec(int b, int h, int e, int S_, const u16* Y, const float* YSM, const float* QKC, const float* b_i, const float* b_f, const float* DEN, float* HM) {
    float C[128];
#pragma unroll
    for (int d = 0; d < 128; ++d) C[d] = 0.f;
    for (int t = 0; t < S_; ++t) {
        const size_t tok = (size_t)b * S_ + t;
        const float f = sigmoidf_(YSM[tok * 32 + 20 + h] + b_f[h]), ig = expf(YSM[tok * 32 + 16 + h] + b_i[h]);
        const float v = bf2f(Y[tok * YP + Y_DV + h * 128 + e]);
        float num = 0.f;
#pragma unroll
        for (int d = 0; d < 128; ++d) { C[d] = f * C[d] + ig * QKC[tok * 1024 + 512 + h * 128 + d] * v; num += QKC[tok * 1024 + h * 128 + d] * C[d]; }
        const float den = DEN[tok * 4 + h];
        const float hh = num / fmaxf(fabsf(den), 1.0f);
        HM[tok * 512 + h * 128 + e] = sigmoidf_(bf2f(Y[tok * YP + Y_DO + h * 128 + e])) * hh;
    }
}
HD static inline void naive_ml_post(int tok, int h, const float* HM, const float* norm_g, u16* YM) {
    float ss = 0.f;
    for (int e = 0; e < 128; ++e) { const float o = HM[(size_t)tok * 512 + h * 128 + e]; ss += o * o; }
    const float rs = 1.f / sqrtf(ss * (1.f / 128.f) + 1e-5f);
    for (int e = 0; e < 128; ++e) YM[(size_t)tok * 2048 + YM_D + h * 128 + e] = f2bf(HM[(size_t)tok * 512 + h * 128 + e] * rs * norm_g[h * 128 + e]);
}
HD static inline void route_token(const float* sc, const float* bias, int* idx, float* w) {
    unsigned gmask = 0u;
    float gs[8];
#pragma unroll
    for (int g = 0; g < 8; ++g) {
        float m1 = -INFINITY, m2 = -INFINITY;
        for (int j = 0; j < 8; ++j) { const float c = sc[g * 8 + j] + bias[g * 8 + j]; if (c > m1) { m2 = m1; m1 = c; } else if (c > m2) m2 = c; }
        gs[g] = m1 + m2;
    }
#pragma unroll
    for (int g = 0; g < 8; ++g) {
        int rank = 0;
#pragma unroll
        for (int g2 = 0; g2 < 8; ++g2) rank += (gs[g2] > gs[g] || (gs[g2] == gs[g] && g2 < g)) ? 1 : 0;
        if (rank < 4) gmask |= 1u << g;
    }
    int n = 0; float wsum = 0.f;
    for (int e = 0; e < 64; ++e) {
        if (!((gmask >> (e >> 3)) & 1u)) continue;
        const float c = sc[e] + bias[e]; int rank = 0;
        for (int e2 = 0; e2 < 64; ++e2) { if (!((gmask >> (e2 >> 3)) & 1u)) continue; const float c2 = sc[e2] + bias[e2]; rank += (c2 > c || (c2 == c && e2 < e)) ? 1 : 0; }
        if (rank < 8) { if (n < 8) { idx[n] = e; w[n] = sc[e]; wsum += sc[e]; } ++n; }
    }
    const float r = 2.5f / wsum;
    for (int k = 0; k < 8; ++k) w[k] *= r;
}

HD static inline bool route_lane_select(int lane, const float* sc, const float* bias) {
    float gs[8];
#pragma unroll
    for (int g = 0; g < 8; ++g) { float m1 = -INFINITY, m2 = -INFINITY;
#pragma unroll
        for (int j = 0; j < 8; ++j) { const float c = sc[g * 8 + j] + bias[g * 8 + j]; if (c > m1) { m2 = m1; m1 = c; } else if (c > m2) m2 = c; }
        gs[g] = m1 + m2; }
    unsigned gmask = 0u;
#pragma unroll
    for (int g = 0; g < 8; ++g) { int r = 0;
#pragma unroll
        for (int g2 = 0; g2 < 8; ++g2) r += (gs[g2] > gs[g] || (gs[g2] == gs[g] && g2 < g)) ? 1 : 0;
        if (r < 4) gmask |= 1u << g; }
    if (!((gmask >> (lane >> 3)) & 1u)) return false;
    const float myc = sc[lane] + bias[lane]; int rank = 0;
    for (int e = 0; e < 64; ++e) { const float c = sc[e] + bias[e]; rank += (((gmask >> (e >> 3)) & 1u) && (c > myc || (c == myc && e < lane))) ? 1 : 0; }
    return rank < 8;
}
namespace pg8 {
#define PG8_LAS __attribute__((address_space(3)))
typedef unsigned short bf16_t;
typedef short bf16x8 __attribute__((ext_vector_type(8)));
typedef float f32x4 __attribute__((ext_vector_type(4)));
typedef unsigned u32x4 __attribute__((ext_vector_type(4)));
typedef unsigned u32x2 __attribute__((ext_vector_type(2)));
typedef int i32x4 __attribute__((ext_vector_type(4)));
typedef int i32x8 __attribute__((ext_vector_type(8)));
constexpr int BM = 256, BK = 64, HALF = 128, HTB = HALF * BK * 2  , STAGE_BYTES = 8 * HTB, NXCD = 8, WGM = 8;

__host__ __device__ __forceinline__ int lds_byte(int r, int c) { const int st = (r >> 4) * 2 + (c >> 5), rr = r & 15, cc = c & 31, ob = rr * 64 + cc * 2; return st * 1024 + (ob ^ (((ob >> 9) & 1) << 5)); }
__host__ __device__ __forceinline__ void stage_rc(int b, int& R, int& C) { const int st = b / 1024, sb = b % 1024, swz = sb ^ (((sb >> 9) & 1) << 5); R = (st >> 1) * 16 + swz / 64; C = (st & 1) * 32 + (swz % 64) / 2; }
__host__ __device__ __forceinline__ int perm32(int rho) { const int n = rho >> 4, i = rho & 15; return 8 * (i >> 2) + 4 * n + (i & 3); }

struct Unit { int pm, pn; };
struct Gemm { const bf16_t* A; const bf16_t* Bt; int M, N, K, lda, ldb; const int* rowmap; };

struct StaticOrder {
    int nM, nN, nwg, G, c, wgm;
    __host__ __device__ void init(int M, int N, int G_, int c_, int wgm_ = WGM) { nM = M / BM; nN = N / BM; nwg = nM * nN; G = G_; c = c_; wgm = wgm_; }
    __host__ __device__ bool next(int i, Unit& u) const {
        const long L = (long)i * G + c; if (L >= nwg) return false;
        int wgid = (int)L; { const int q = nwg / NXCD, r = nwg % NXCD, xcd = wgid % NXCD, off = wgid / NXCD; wgid = (xcd < r ? xcd * (q + 1) : r * (q + 1) + (xcd - r) * q) + off; }
        const int nig = wgm * nN, gid = wgid / nig, fm = gid * wgm, gsz = (nM - fm) < wgm ? (nM - fm) : wgm;
        u.pm = fm + ((wgid % nig) % gsz); u.pn = (wgid % nig) / gsz; return true;
    }
    __device__ __forceinline__ void a_ready(const Unit&) const {}
    __device__ __forceinline__ void done(const Unit&) const {}
};

__device__ __forceinline__ unsigned cvt_pk_bf16(float lo, float hi) { unsigned r; asm volatile("v_cvt_pk_bf16_f32 %0, %1, %2" : "=v"(r) : "v"(lo), "v"(hi)); return r; }

template <class Epi, class Sched, bool ALIGN_EPI = true, bool GATHER = false, int NBJ = 2, int DT = 0>
__device__ __forceinline__ void gemm_phase(PG8_LAS unsigned char* lds, const Gemm g, const Sched& S, const Epi& E, const int tid) {
    const int wid = __builtin_amdgcn_readfirstlane(tid >> 6), lane = tid & 63, wr = wid >> 2, wc = wid & 3, fr = lane & 15, fq = lane >> 4;
    const int K = g.K, nt = K / BK;
    unsigned voffB[2]; int rA[2]; unsigned cA2[2];
#pragma unroll
    for (int i = 0; i < 2; ++i) { int R, C; stage_rc(tid * 16 + i * 8192, R, C); const int Rb = Epi::PERM ? ((R & ~31) + perm32(R & 31)) : R;
        rA[i] = R; cA2[i] = (unsigned)C * 2u; voffB[i] = (unsigned)(Rb * g.ldb + C) * 2u; }
    const size_t kstep = (size_t)(BK * 2);
    const size_t hstepA = (size_t)HALF * g.lda * 2, hstepB = (size_t)HALF * g.ldb * 2;
    const size_t tstepA = GATHER ? 0 : 2 * hstepA, tstepB = NBJ * hstepB;
    unsigned cvo[4], nvo[4];
#define PG8_AOFF(dst, unit) do { _Pragma("unroll") for (int h_ = 0; h_ < 2; ++h_) _Pragma("unroll") for (int i_ = 0; i_ < 2; ++i_) { \
        if constexpr (GATHER) dst[2 * h_ + i_] = (unsigned)g.rowmap[(size_t)(unit).pm * BM + h_ * HALF + rA[i_]] * (unsigned)(g.lda * 2) + cA2[i_]; \
        else dst[2 * h_ + i_] = (unsigned)((h_ * HALF + rA[i_]) * g.lda) * 2u + cA2[i_]; } } while (0)
    const unsigned ldsw = (unsigned)wid * 1024u;
    const int aoff = lds_byte(wr * 64 + fr, fq * 8), boff = lds_byte(wc * 32 + fr, fq * 8);
#define PG8_SA(b, h) (((b) * 2 + (h)) * HTB)
#define PG8_SB(b, h) ((4 + (b) * 2 + (h)) * HTB)
#define PG8_STAGE2(bufoff, gbase, v0, v1) do { \
        __builtin_amdgcn_global_load_lds((const unsigned*)((const char*)(gbase) + (v0)), (PG8_LAS unsigned*)(lds + (bufoff) + ldsw), 16, 0, 0); \
        __builtin_amdgcn_global_load_lds((const unsigned*)((const char*)(gbase) + (v1)), (PG8_LAS unsigned*)(lds + (bufoff) + ldsw + 8192), 16, 0, 0); } while (0)
#define PG8_STAGE(bufoff, gbase, voff) PG8_STAGE2(bufoff, gbase, (voff)[0], (voff)[1])
#define PG8_LDA(dst, b, h) do { _Pragma("unroll") for (int m = 0; m < 4; ++m) _Pragma("unroll") for (int k = 0; k < 2; ++k) dst[m][k] = *(const PG8_LAS bf16x8*)(lds + PG8_SA(b, h) + aoff + m * 2048 + k * 1024); } while (0)
#define PG8_LDB(dst, b, h) do { _Pragma("unroll") for (int n = 0; n < 2; ++n) _Pragma("unroll") for (int k = 0; k < 2; ++k) dst[n][k] = *(const PG8_LAS bf16x8*)(lds + PG8_SB(b, h) + boff + n * 2048 + k * 1024); } while (0)
#define PG8_MMA(ai, bj, At, Bt) do { __builtin_amdgcn_s_setprio(1); _Pragma("unroll") for (int m = 0; m < 4; ++m) _Pragma("unroll") for (int n = 0; n < 2; ++n) { \
        if constexpr (DT == 0) { _Pragma("unroll") for (int k = 0; k < 2; ++k) acc[ai][bj][m][n] = __builtin_amdgcn_mfma_f32_16x16x32_bf16(Bt[n][k], At[m][k], acc[ai][bj][m][n], 0, 0, 0); } \
        else { const i32x4 b0_ = __builtin_bit_cast(i32x4, Bt[n][0]), b1_ = __builtin_bit_cast(i32x4, Bt[n][1]), a0_ = __builtin_bit_cast(i32x4, At[m][0]), a1_ = __builtin_bit_cast(i32x4, At[m][1]); \
            const i32x8 bw_ = __builtin_shufflevector(b0_, b1_, 0, 1, 2, 3, 4, 5, 6, 7), aw_ = __builtin_shufflevector(a0_, a1_, 0, 1, 2, 3, 4, 5, 6, 7); \
              \
            asm volatile("v_mfma_scale_f32_16x16x128_f8f6f4 %0, %1, %2, %0, %3, %4 op_sel_hi:[0,0,0]" : "+v"(acc[ai][bj][m][n]) : "v"(bw_), "v"(aw_), "v"(0x7a7a7a7a), "v"(0x7f7f7f7f)); } } \
        __builtin_amdgcn_s_setprio(0); } while (0)
#define PG8_WAIT_V(n) asm volatile("s_waitcnt vmcnt(" #n ")" ::: "memory")
#define PG8_WAIT_LOOP do { if constexpr (NBJ == 2) PG8_WAIT_V(8); else PG8_WAIT_V(6); } while (0)
#define PG8_WAIT_L(n) asm volatile("s_waitcnt lgkmcnt(" #n ")" ::: "memory")
#define PG8_BAR __builtin_amdgcn_s_barrier()
#define PG8_SCHED __builtin_amdgcn_sched_barrier(0)
    Unit cur, nxt; int ui = 0;
    if (!S.next(0, cur)) return;
    f32x4 acc[2][NBJ][4][2];
#pragma unroll
    for (int a = 0; a < 2; ++a)
#pragma unroll
        for (int b = 0; b < NBJ; ++b)
#pragma unroll
            for (int m = 0; m < 4; ++m)
#pragma unroll
                for (int n = 0; n < 2; ++n) acc[a][b][m][n] = (f32x4){0.f, 0.f, 0.f, 0.f};
    bf16x8 At[4][2], B0[2][2], B1[2][2];
    const char* cA = (const char*)g.A + (size_t)cur.pm * tstepA; const char* cB = (const char*)g.Bt + (size_t)cur.pn * tstepB;
    S.a_ready(cur);
    PG8_AOFF(cvo, cur);
    PG8_STAGE(PG8_SB(0, 0), cB, voffB); if constexpr (NBJ == 2) PG8_STAGE(PG8_SB(0, 1), cB + hstepB, voffB); PG8_STAGE2(PG8_SA(0, 0), cA, cvo[0], cvo[1]); PG8_STAGE2(PG8_SA(0, 1), cA, cvo[2], cvo[3]);
    if (wr == 1) PG8_BAR;
    PG8_WAIT_V(2); PG8_BAR;
    PG8_STAGE(PG8_SB(1, 0), cB + kstep, voffB); PG8_STAGE2(PG8_SA(1, 0), cA + kstep, cvo[0], cvo[1]); if constexpr (NBJ == 2) PG8_STAGE(PG8_SB(1, 1), cB + hstepB + kstep, voffB);
    if constexpr (NBJ == 2) PG8_WAIT_V(6); else PG8_WAIT_V(4);
    PG8_BAR;
    for (;;) {
        const bool has_next = S.next(ui + 1, nxt);
        const char* nA = has_next ? (const char*)g.A + (size_t)nxt.pm * tstepA : cA; const char* nB = has_next ? (const char*)g.Bt + (size_t)nxt.pn * tstepB : cB;
        if (has_next) { PG8_AOFF(nvo, nxt); } else {
#pragma unroll
            for (int j_ = 0; j_ < 4; ++j_) nvo[j_] = cvo[j_]; }
        for (int t = 0; t < nt; t += 2) {
            const bool last = (t == nt - 2);
            const char* a1 = cA + (size_t)(t + 1) * kstep;
            const char* a2 = last ? nA : cA + (size_t)(t + 2) * kstep; const char* b2 = last ? nB : cB + (size_t)(t + 2) * kstep;
            const char* a3 = a2 + kstep; const char* b3 = b2 + kstep;
            if (last && has_next) S.a_ready(nxt);
            unsigned so[4];
#pragma unroll
            for (int j_ = 0; j_ < 4; ++j_) so[j_] = last ? nvo[j_] : cvo[j_];
            PG8_LDB(B0, 0, 0); if constexpr (NBJ == 2) PG8_LDB(B1, 0, 1); PG8_SCHED; PG8_LDA(At, 0, 0); PG8_STAGE2(PG8_SA(1, 1), a1, cvo[2], cvo[3]);
            PG8_WAIT_LOOP; PG8_WAIT_L(0); PG8_BAR; PG8_MMA(0, 0, At, B0); if constexpr (NBJ == 2) PG8_MMA(0, NBJ - 1, At, B1); PG8_BAR; PG8_SCHED;
            PG8_LDA(At, 0, 1); PG8_STAGE(PG8_SB(0, 0), b2, voffB); if constexpr (NBJ == 2) PG8_STAGE(PG8_SB(0, 1), b2 + hstepB, voffB); PG8_STAGE2(PG8_SA(0, 0), a2, so[0], so[1]);
            PG8_WAIT_LOOP; PG8_WAIT_L(0); PG8_BAR; PG8_MMA(1, 0, At, B0); if constexpr (NBJ == 2) PG8_MMA(1, NBJ - 1, At, B1); PG8_BAR; PG8_SCHED;
            PG8_LDB(B0, 1, 0); if constexpr (NBJ == 2) PG8_LDB(B1, 1, 1); PG8_SCHED; PG8_LDA(At, 1, 0); PG8_STAGE2(PG8_SA(0, 1), a2, so[2], so[3]);
            PG8_WAIT_LOOP; PG8_WAIT_L(0); PG8_BAR; PG8_MMA(0, 0, At, B0); if constexpr (NBJ == 2) PG8_MMA(0, NBJ - 1, At, B1); PG8_BAR; PG8_SCHED;
            PG8_LDA(At, 1, 1); PG8_STAGE(PG8_SB(1, 0), b3, voffB); if constexpr (NBJ == 2) PG8_STAGE(PG8_SB(1, 1), b3 + hstepB, voffB); PG8_STAGE2(PG8_SA(1, 0), a3, so[0], so[1]);
            PG8_WAIT_LOOP; PG8_WAIT_L(0); PG8_BAR; PG8_MMA(1, 0, At, B0); if constexpr (NBJ == 2) PG8_MMA(1, NBJ - 1, At, B1); PG8_BAR; PG8_SCHED;
            if constexpr (Epi::HAS_FOLD) { if (!last && E.boundary(t + 2)) { E.fold(acc, cur, wr, wc, fr, fq, t + 2);
#pragma unroll
                for (int a = 0; a < 2; ++a)
#pragma unroll
                    for (int b = 0; b < NBJ; ++b)
#pragma unroll
                        for (int m = 0; m < 4; ++m)
#pragma unroll
                            for (int n = 0; n < 2; ++n) acc[a][b][m][n] = (f32x4){0.f, 0.f, 0.f, 0.f}; } }
        }
        if constexpr (ALIGN_EPI) { if (wr == 0) PG8_BAR; }
        if constexpr (DT == 1) asm volatile("s_nop 15\n\ts_nop 15\n\ts_nop 15\n\ts_nop 15\n\ts_nop 15\n\ts_nop 15" ::: "memory");
        E(acc, cur, wr, wc, fr, fq); S.done(cur);
        if (!has_next) break;
#pragma unroll
        for (int a = 0; a < 2; ++a)
#pragma unroll
            for (int b = 0; b < NBJ; ++b)
#pragma unroll
                for (int m = 0; m < 4; ++m)
#pragma unroll
                    for (int n = 0; n < 2; ++n) acc[a][b][m][n] = (f32x4){0.f, 0.f, 0.f, 0.f};
        cur = nxt; cA = nA; cB = nB; ++ui;
#pragma unroll
        for (int j_ = 0; j_ < 4; ++j_) cvo[j_] = nvo[j_];
        if constexpr (ALIGN_EPI) { if (wr == 1) PG8_BAR; }
    }
    PG8_WAIT_V(0);
    if constexpr (!ALIGN_EPI) { if (wr == 0) PG8_BAR; }
    PG8_BAR;
#undef PG8_SA
#undef PG8_SB
#undef PG8_STAGE
#undef PG8_STAGE2
#undef PG8_AOFF
#undef PG8_LDA
#undef PG8_LDB
#undef PG8_MMA
#undef PG8_WAIT_V
#undef PG8_WAIT_LOOP
#undef PG8_WAIT_L
#undef PG8_BAR
#undef PG8_SCHED
}

#ifndef N1_DBG
#define N1_DBG 0
#endif
template <class Epi, class Sched>
__device__ __forceinline__ void gemm_phase_n1s3(PG8_LAS unsigned char* lds, const Gemm g, const Sched& S, const Epi& E, const int tid) {
    const int wid = __builtin_amdgcn_readfirstlane(tid >> 6), lane = tid & 63, wr = wid >> 2, wc = wid & 3, fr = lane & 15, fq = lane >> 4;
    const int nt = g.K / BK;
    constexpr unsigned STG = 49152u;
    unsigned voffB[2], voA[4];
#pragma unroll
    for (int i = 0; i < 2; ++i) { int R, C; stage_rc(tid * 16 + i * 8192, R, C);
        voffB[i] = (unsigned)(R * g.ldb + C) * 2u; voA[i] = (unsigned)(R * g.lda + C) * 2u; voA[2 + i] = (unsigned)((HALF + R) * g.lda + C) * 2u; }
    const size_t kstep = (size_t)(BK * 2), tstepA = (size_t)BM * g.lda * 2, tstepB = (size_t)HALF * g.ldb * 2;
    const unsigned ldsw = (unsigned)wid * 1024u;
    const int aoff = lds_byte(wr * 64 + fr, fq * 8), boff = lds_byte(wc * 32 + fr, fq * 8);
#define N1_STAGE(dst, gp, v0, v1) do { \
        __builtin_amdgcn_global_load_lds((const unsigned*)((const char*)(gp) + (v0)), (PG8_LAS unsigned*)(lds + (dst) + ldsw), 16, 0, 0); \
        __builtin_amdgcn_global_load_lds((const unsigned*)((const char*)(gp) + (v1)), (PG8_LAS unsigned*)(lds + (dst) + ldsw + 8192), 16, 0, 0); } while (0)
#define N1_STAGE_TILE(wb, pa, pb) do { N1_STAGE((wb) + 32768u, pb, voffB[0], voffB[1]); N1_STAGE((wb), pa, voA[0], voA[1]); N1_STAGE((wb) + 16384u, pa, voA[2], voA[3]); } while (0)
#define N1_WAIT_V(n) asm volatile("s_waitcnt vmcnt(" #n ")" ::: "memory")
#define N1_WAIT_L0 asm volatile("s_waitcnt lgkmcnt(0)" ::: "memory")
#define N1_BAR __builtin_amdgcn_s_barrier()
    Unit cur, nxt; int ui = 0;
    if (!S.next(0, cur)) return;
    f32x4 acc[2][1][4][2];
#pragma unroll
    for (int a = 0; a < 2; ++a)
#pragma unroll
        for (int m = 0; m < 4; ++m)
#pragma unroll
            for (int n = 0; n < 2; ++n) acc[a][0][m][n] = (f32x4){0.f, 0.f, 0.f, 0.f};
    bf16x8 A0[4][2], A1[4][2], B0[2][2];
    const char* cA = (const char*)g.A + (size_t)cur.pm * tstepA; const char* cB = (const char*)g.Bt + (size_t)cur.pn * tstepB;
    unsigned gt = 0;
    N1_STAGE_TILE(0u, cA, cB); N1_STAGE_TILE(STG, cA + kstep, cB + kstep);
    if (wr == 1) N1_BAR;
    N1_WAIT_V(6); N1_BAR;
    N1_BAR;
    for (;;) {
        const bool has_next = S.next(ui + 1, nxt);
        const char* nA = has_next ? (const char*)g.A + (size_t)nxt.pm * tstepA : cA; const char* nB = has_next ? (const char*)g.Bt + (size_t)nxt.pn * tstepB : cB;
        for (int t = 0; t < nt; ++t, ++gt) {
            const unsigned s0 = gt % 3u, rb = s0 * STG, wb = (s0 == 0u ? 2u : s0 - 1u) * STG;
            const int t2 = t + 2; const bool over = t2 >= nt;
            const char* pa = over ? nA + (size_t)(t2 - nt) * kstep : cA + (size_t)t2 * kstep; const char* pb = over ? nB + (size_t)(t2 - nt) * kstep : cB + (size_t)t2 * kstep;
#pragma unroll
            for (int n = 0; n < 2; ++n)
#pragma unroll
                for (int k = 0; k < 2; ++k) B0[n][k] = *(const PG8_LAS bf16x8*)(lds + rb + 32768u + boff + n * 2048 + k * 1024);
            __builtin_amdgcn_sched_barrier(0);
#pragma unroll
            for (int m = 0; m < 4; ++m)
#pragma unroll
                for (int k = 0; k < 2; ++k) { A0[m][k] = *(const PG8_LAS bf16x8*)(lds + rb + aoff + m * 2048 + k * 1024); A1[m][k] = *(const PG8_LAS bf16x8*)(lds + rb + 16384u + aoff + m * 2048 + k * 1024); }
            N1_STAGE_TILE(wb, pa, pb);
            N1_WAIT_V(6); N1_WAIT_L0; N1_BAR;
            __builtin_amdgcn_s_setprio(1);
#pragma unroll
            for (int m = 0; m < 4; ++m)
#pragma unroll
                for (int n = 0; n < 2; ++n)
#pragma unroll
                    for (int k = 0; k < 2; ++k) { acc[0][0][m][n] = __builtin_amdgcn_mfma_f32_16x16x32_bf16(B0[n][k], A0[m][k], acc[0][0][m][n], 0, 0, 0);
                        acc[1][0][m][n] = __builtin_amdgcn_mfma_f32_16x16x32_bf16(B0[n][k], A1[m][k], acc[1][0][m][n], 0, 0, 0); }
            __builtin_amdgcn_s_setprio(0);
            N1_BAR; __builtin_amdgcn_sched_barrier(0);
            if (t + 1 < nt && E.boundary(t + 1)) { E.fold(acc, cur, wr, wc, fr, fq, t + 1);
#pragma unroll
                for (int a = 0; a < 2; ++a)
#pragma unroll
                    for (int m = 0; m < 4; ++m)
#pragma unroll
                        for (int n = 0; n < 2; ++n) acc[a][0][m][n] = (f32x4){0.f, 0.f, 0.f, 0.f}; }
        }
        if (wr == 0) N1_BAR;
        E(acc, cur, wr, wc, fr, fq);
        if (!has_next) break;
#pragma unroll
        for (int a = 0; a < 2; ++a)
#pragma unroll
            for (int m = 0; m < 4; ++m)
#pragma unroll
                for (int n = 0; n < 2; ++n) acc[a][0][m][n] = (f32x4){0.f, 0.f, 0.f, 0.f};
        cur = nxt; cA = nA; cB = nB; ++ui;
        if (wr == 1) N1_BAR;
    }
    N1_WAIT_V(0);
    N1_BAR;
#undef N1_STAGE
#undef N1_STAGE_TILE
#undef N1_WAIT_V
#undef N1_WAIT_L0
#undef N1_BAR
}
}
#ifndef MERGE3
#define MERGE3 0
#endif
constexpr int T_ = 8192, D_ = 2048, SEQ_ = 2048, NB_ = 4, NL_ = 2, NCOL = 15640;
constexpr float DN_ALPHA = 1.41421356237309515f;
constexpr float LN_EPS_ = 1e-5f;
constexpr int MAXROWS = 90112;
constexpr size_t MiB = 1u << 20;
constexpr size_t WS_CTL = 0, CTL_ZERO_BYTES = 1048576;
constexpr size_t WS_XB = 1 * MiB, WS_HB = 33 * MiB, WS_X1 = 97 * MiB, WS_XA = 161 * MiB, WS_YM = 225 * MiB, WS_MRG = 257 * MiB, WS_MB = 321 * MiB;
constexpr size_t WS_YSM = 353 * MiB, WS_CS = 354 * MiB, WS_SEL = 356 * MiB, WS_ROWW = 357 * MiB, WS_ROWMAP = 357 * MiB + 512 * 1024;
constexpr size_t WS_WIN = 358 * MiB, WS_WP = 420 * MiB, WS_WOUT = 428 * MiB, WS_W13 = 436 * MiB, WS_W2 = 696 * MiB, WS_H = 826 * MiB, WS_XS = 914 * MiB, WS_YBUF = 1266 * MiB;
constexpr size_t WS_XS8 = WS_XS + 64 * MiB, WS_XB8 = WS_XS + 80 * MiB, WS_WIN8 = WS_XS + 96 * MiB;
constexpr size_t WS_Y = WS_YBUF;
constexpr size_t WS_GLOC = 1618 * MiB, WS_GDEC = 1634 * MiB, WS_GST = 1635 * MiB, WS_MLOC = 1643 * MiB, WS_MNLOC = 1675 * MiB, WS_MSC = 1676 * MiB, WS_MC = 1677 * MiB, WS_MN = 1693 * MiB, WS_MM = 1694 * MiB;
constexpr size_t WS_DILO = 1695 * MiB, WS_DILL = 1719 * MiB;
constexpr size_t WS_NV = 1720 * MiB;
constexpr size_t WS_W13B = 1842 * MiB, WS_W2B = 1972 * MiB;
constexpr size_t WS_END = 2037 * MiB;
constexpr int CW_CNT = 8192, CW_TST = 8448, CW_CQ = 12400, CW_ARR = 12416, CW_BAR = 16384;
constexpr int RING_BYTES = 131072, AUX_OFF = 131072, LDS_BYTES = 147456 + 16384 * MERGE3;
constexpr int AUX_BARW = LDS_BYTES - 16;

#define GAS __attribute__((address_space(1)))
#define LAS __attribute__((address_space(3)))
typedef unsigned short bf16;
typedef unsigned v4u __attribute__((ext_vector_type(4)));
typedef unsigned v2u __attribute__((ext_vector_type(2)));
typedef float f32x4 __attribute__((ext_vector_type(4)));
typedef float f32x2 __attribute__((ext_vector_type(2)));
typedef short bf16x8 __attribute__((ext_vector_type(8)));
#define LDS_WAIT() asm volatile("s_waitcnt lgkmcnt(0)" ::: "memory")
#define VM_WAIT() asm volatile("s_waitcnt vmcnt(0)" ::: "memory")
__device__ __forceinline__ unsigned pk2(float lo, float hi) { return pg8::cvt_pk_bf16(lo, hi); }
__device__ __forceinline__ float bflo(unsigned u) { return __builtin_bit_cast(float, u << 16); }
__device__ __forceinline__ float bfhi(unsigned u) { return __builtin_bit_cast(float, u & 0xffff0000u); }
__device__ __forceinline__ float fsigmoid(float x) { return 1.f / (1.f + __expf(-x)); }
__device__ __forceinline__ float wave_sum(float v) {
#pragma unroll
    for (int o = 1; o < 64; o <<= 1) v += __shfl_xor(v, o);
    return v;
}
__device__ __forceinline__ float wave_max(float v) {
#pragma unroll
    for (int o = 1; o < 64; o <<= 1) v = fmaxf(v, __shfl_xor(v, o));
    return v;
}

#define XB_TMO      128
#define XB_XCNT(j)  (256  + 64 * (j))
#define XB_XSUB(j)  (1280 + 64 * (j))
#define XB_XGEN(j)  (2304 + 64 * (j))
#define XB_TOP      3328
#define XB_TOPGEN   3392
#define XCD_BAR_WORDS 3456
#define XB_SPIN_CAP (1u << 22)
__device__ __forceinline__ unsigned xb_ld(unsigned* p)              { return __hip_atomic_load(p, __ATOMIC_RELAXED, __HIP_MEMORY_SCOPE_AGENT); }
__device__ __forceinline__ unsigned xb_add(unsigned* p, unsigned v) { return __hip_atomic_fetch_add(p, v, __ATOMIC_RELAXED, __HIP_MEMORY_SCOPE_AGENT); }
__device__ __forceinline__ unsigned xb_xcc_id() { return (unsigned)__builtin_amdgcn_s_getreg((3 << 11) | 20) & 0xFu; }
#define XB_SPIN(cond, bar) do { unsigned _sp = 0; while (cond) { __builtin_amdgcn_s_sleep(1); \
    if ((++_sp & 255u) == 0u) { if (xb_ld(&(bar)[XB_TMO])) break; if (_sp > XB_SPIN_CAP) { atomicAdd(&(bar)[XB_TMO], 1u); break; } } } } while (0)
struct XcdBarrier { unsigned* bar; unsigned x; volatile LAS unsigned* st; };
__device__ __forceinline__ XcdBarrier xcd_barrier_post(unsigned* bar, volatile LAS unsigned* st) {
    XcdBarrier b; b.bar = bar; b.x = xb_xcc_id(); b.st = st;
    if (threadIdx.x == 0) (void)xb_add(&bar[XB_XCNT(b.x)], 1u);
    return b;
}
__device__ __forceinline__ void xcd_barrier_complete(unsigned* bar, unsigned x, unsigned& nloc, unsigned& nx) {
    const unsigned G = gridDim.x * gridDim.y * gridDim.z;
    unsigned sum, cnt, mine, sp = 0u;
    for (;;) {
        sum = 0u; cnt = 0u; mine = 0u;
#pragma unroll
        for (unsigned j = 0; j < 16; ++j) { const unsigned c = xb_ld(&bar[XB_XCNT(j)]); sum += c; cnt += (c > 0u) ? 1u : 0u; mine = (j == x) ? c : mine; }
        if (sum == G) break;
        __builtin_amdgcn_s_sleep(1);
        if ((++sp & 255u) == 0u) { if (xb_ld(&bar[XB_TMO])) break; if (sp > XB_SPIN_CAP) { atomicAdd(&bar[XB_TMO], 1u); break; } }
    }
    nloc = mine > 0u ? mine : 1u; nx = cnt > 0u ? cnt : 1u;
}
__device__ __forceinline__ void xcd_barrier(const XcdBarrier& b) {
    asm volatile("s_waitcnt vmcnt(0)" ::: "memory");
    __syncthreads();
    if (threadIdx.x == 0) {
        unsigned* bar = b.bar;
        __builtin_amdgcn_s_waitcnt(0);
        unsigned nloc = b.st[0], nx = b.st[1];
        if (nloc == 0u) { xcd_barrier_complete(bar, b.x, nloc, nx); b.st[0] = nloc; b.st[1] = nx; }
        const unsigned old = xb_add(&bar[XB_XSUB(b.x)], 1u);
        const unsigned gen = old / nloc;
        if (old + 1u == (gen + 1u) * nloc) {
            __builtin_amdgcn_fence(__ATOMIC_RELEASE, "agent");
            asm volatile("s_waitcnt vmcnt(0)" ::: "memory");
            const unsigned og = xb_add(&bar[XB_TOP], 1u);
            const unsigned tg = og / nx;
            if (og + 1u == (tg + 1u) * nx) xb_add(&bar[XB_TOPGEN], 1u);
            else XB_SPIN(xb_ld(&bar[XB_TOPGEN]) == tg, bar);
            __builtin_amdgcn_fence(__ATOMIC_ACQUIRE, "agent");
            xb_add(&bar[XB_XGEN(b.x)], 1u);
            asm volatile("s_waitcnt vmcnt(0)" ::: "memory");
        } else {
            XB_SPIN(xb_ld(&bar[XB_XGEN(b.x)]) == gen, bar);
            __builtin_amdgcn_fence(__ATOMIC_ACQUIRE, "agent");
            asm volatile("s_waitcnt vmcnt(0)" ::: "memory");
        }
    }
    __syncthreads();
}
using pg8::Unit;
#ifndef STEAL_MARGIN
#define STEAL_MARGIN 8u
#endif
#ifndef X1_BF16
#define X1_BF16 1
#endif
#ifndef MOE_XCD
#define MOE_XCD 1
#endif
#ifndef FP8_GATES
#define FP8_GATES 3
#endif
#define GATES8(l) ((FP8_GATES >> (l)) & 1)
#ifndef FP8_MOE
#define FP8_MOE 3
#endif
#define MOE8(l) ((FP8_MOE >> (l)) & 1)
#define FP8_LAST MOE8(NL_ - 1)
__device__ __forceinline__ unsigned pk4_fp8(float a, float b, float c, float d) { int w = 0; w = __builtin_amdgcn_cvt_pk_fp8_f32(a, b, w, false); w = __builtin_amdgcn_cvt_pk_fp8_f32(c, d, w, true); return (unsigned)w; }
struct EpiY {
    static constexpr bool PERM = true, HAS_FOLD = false;
    bf16* Y; float* YSM; int pn0;
    __device__ __forceinline__ void operator()(const f32x4 (&acc)[2][2][4][2], const Unit& u, int wr, int wc, int fr, int fq) const {
        const int row0 = u.pm * 256 + wr * 64 + fr, pn = u.pn + pn0;
        if (pn == 29) {
            if (wc == 0) {
#pragma unroll
                for (int ai = 0; ai < 2; ++ai)
#pragma unroll
                    for (int m = 0; m < 4; ++m) { float* rp = YSM + (size_t)(row0 + ai * 128 + m * 16) * 32 + 8 * fq; *(f32x4*)rp = acc[ai][0][m][0]; *(f32x4*)(rp + 4) = acc[ai][0][m][1]; }
            }
            return;
        }
        const bool sg = pn >= 30;
#pragma unroll
        for (int ai = 0; ai < 2; ++ai)
#pragma unroll
            for (int m = 0; m < 4; ++m) { bf16* rp = Y + (size_t)(row0 + ai * 128 + m * 16) * YP + pn * 256 + wc * 32 + 8 * fq;
#pragma unroll
                for (int bj = 0; bj < 2; ++bj) { f32x4 v0 = acc[ai][bj][m][0], v1 = acc[ai][bj][m][1];
                    if (sg) {
#pragma unroll
                        for (int j = 0; j < 4; ++j) { v0[j] = fsigmoid(v0[j]); v1[j] = fsigmoid(v1[j]); } }
                    v4u w; w.x = pk2(v0[0], v0[1]); w.y = pk2(v0[2], v0[3]); w.z = pk2(v1[0], v1[1]); w.w = pk2(v1[2], v1[3]);
                    *(v4u*)(rp + bj * 128) = w; } }
    }
};
struct EpiMerge {
    static constexpr bool PERM = false, HAS_FOLD = true;
    const bf16* Y; bf16* MB; mutable f32x4 tot[2][4][2];
    __device__ __forceinline__ bool boundary(int kt) const { return kt == 8 || kt == 12 || kt == 24; }
    __device__ __forceinline__ void fold(const f32x4 (&acc)[2][1][4][2], const Unit& u, int wr, int wc, int fr, int fq, int kt) const {
        const int br = kt == 8 ? 0 : (kt == 12 ? 1 : (kt == 24 ? 2 : 3));
        int zv = 0; asm volatile("" : "+v"(zv));
        const int row0 = u.pm * 256 + wr * 64 + fr + zv, col0 = u.pn * 128 + wc * 32 + 4 * fq;
        v2u gp[2][4][2];
#pragma unroll
        for (int ai = 0; ai < 2; ++ai)
#pragma unroll
            for (int m = 0; m < 4; ++m)
#pragma unroll
                for (int n = 0; n < 2; ++n) gp[ai][m][n] = *(const v2u*)(Y + (size_t)(row0 + ai * 128 + m * 16) * YP + Y_G + br * 2048 + col0 + n * 16);
#pragma unroll
        for (int ai = 0; ai < 2; ++ai)
#pragma unroll
            for (int m = 0; m < 4; ++m)
#pragma unroll
                for (int n = 0; n < 2; ++n) { f32x4 v = acc[ai][0][m][n]; const v2u g2 = gp[ai][m][n]; v[0] *= bflo(g2.x); v[1] *= bfhi(g2.x); v[2] *= bflo(g2.y); v[3] *= bfhi(g2.y);
                    v = br > 0 ? v + tot[ai][m][n] : v;
                    if (br < 3) tot[ai][m][n] = v;
                    else { v2u o; o.x = pk2(v[0], v[1]); o.y = pk2(v[2], v[3]); *(v2u*)(MB + (size_t)(row0 + ai * 128 + m * 16) * 2048 + col0 + n * 16) = o; } }
    }
    __device__ __forceinline__ void operator()(const f32x4 (&acc)[2][1][4][2], const Unit& u, int wr, int wc, int fr, int fq) const { fold(acc, u, wr, wc, fr, fq, 32); }
};
struct EpiOut {
    static constexpr bool PERM = false, HAS_FOLD = false;
    const float* X; float* HB;
    __device__ __forceinline__ void operator()(const f32x4 (&acc)[2][2][4][2], const Unit& u, int wr, int wc, int fr, int fq) const {
        const int row0 = u.pm * 256 + wr * 64 + fr, col0 = u.pn * 256 + wc * 32 + 4 * fq;
#pragma unroll
        for (int ai = 0; ai < 2; ++ai)
#pragma unroll
            for (int m = 0; m < 4; ++m) { const size_t off = (size_t)(row0 + ai * 128 + m * 16) * 2048 + col0;
#pragma unroll
                for (int bj = 0; bj < 2; ++bj)
#pragma unroll
                    for (int n = 0; n < 2; ++n) { const f32x4 xv = *(const f32x4*)(X + off + bj * 128 + n * 16); *(f32x4*)(HB + off + bj * 128 + n * 16) = xv * DN_ALPHA + acc[ai][bj][m][n]; } }
    }
};
struct EpiMoe1 {
    static constexpr bool PERM = true, HAS_FOLD = false;
    bf16* H; const float* ROWW; int NJ;
    __device__ __forceinline__ void operator()(const f32x4 (&acc)[2][2][4][2], const Unit& u, int wr, int wc, int fr, int fq) const {
        const int row0 = u.pm * 256 + wr * 64 + fr, col0 = (u.pn & 3) * 128 + wc * 32 + 8 * fq;
#pragma unroll
        for (int ai = 0; ai < 2; ++ai)
#pragma unroll
            for (int m = 0; m < 4; ++m) { const size_t row = (size_t)(row0 + ai * 128 + m * 16); const float rw = ROWW[row];
                float h[8];
#pragma unroll
                for (int n = 0; n < 2; ++n)
#pragma unroll
                    for (int j = 0; j < 4; ++j) { const float a = acc[ai][0][m][n][j], b = acc[ai][1][m][n][j]; h[n * 4 + j] = a * fsigmoid(a) * b * rw; }
                v4u w; w.x = pk2(h[0], h[1]); w.y = pk2(h[2], h[3]); w.z = pk2(h[4], h[5]); w.w = pk2(h[6], h[7]);
                *(v4u*)(H + row * 512 + col0) = w; }
    }
};
struct EpiMoe2 {
    static constexpr bool PERM = true, HAS_FOLD = false;
    bf16* YB;
    __device__ __forceinline__ void operator()(const f32x4 (&acc)[2][2][4][2], const Unit& u, int wr, int wc, int fr, int fq) const {
        const int row0 = u.pm * 256 + wr * 64 + fr, col0 = (u.pn & 7) * 256 + wc * 32 + 8 * fq;
#pragma unroll
        for (int ai = 0; ai < 2; ++ai)
#pragma unroll
            for (int m = 0; m < 4; ++m) { bf16* rp = YB + (size_t)(row0 + ai * 128 + m * 16) * 2048 + col0;
#pragma unroll
                for (int bj = 0; bj < 2; ++bj) { const f32x4 v0 = acc[ai][bj][m][0], v1 = acc[ai][bj][m][1];
                    v4u w; w.x = pk2(v0[0], v0[1]); w.y = pk2(v0[2], v0[3]); w.z = pk2(v1[0], v1[1]); w.w = pk2(v1[2], v1[3]);
                    *(v4u*)(rp + bj * 128) = w; } }
    }
};
struct EpiMoe1F8 {
    static constexpr bool PERM = true, HAS_FOLD = false;
    unsigned char* H; const float* ROWW;
    __device__ __forceinline__ void operator()(const f32x4 (&acc)[2][2][4][2], const Unit& u, int wr, int wc, int fr, int fq) const {
        const int row0 = u.pm * 256 + wr * 64 + fr, col0 = (u.pn & 3) * 128 + wc * 32 + 8 * fq;
#pragma unroll
        for (int ai = 0; ai < 2; ++ai)
#pragma unroll
            for (int m = 0; m < 4; ++m) { const size_t row = (size_t)(row0 + ai * 128 + m * 16); const float rw = ROWW[row];
                float h[8];
#pragma unroll
                for (int n = 0; n < 2; ++n)
#pragma unroll
                    for (int j = 0; j < 4; ++j) { const float a = acc[ai][0][m][n][j], b = acc[ai][1][m][n][j]; h[n * 4 + j] = a * fsigmoid(a) * b * rw; }
                v2u w; w.x = pk4_fp8(h[0], h[1], h[2], h[3]); w.y = pk4_fp8(h[4], h[5], h[6], h[7]);
                *(v2u*)(H + row * 512 + col0) = w; }
    }
};
struct MoeOrder {
    int NJ, G, c, total, upm, upn;
    __device__ __forceinline__ void init(const int* tst, int NJ_, int G_, int c_, int lane) { NJ = NJ_; G = G_; total = tst[65] * NJ_;
        c = (MOE_XCD && (G_ & 7) == 0) ? (c_ & 7) * (G_ >> 3) + (c_ >> 3) : c_;
        const long L = (long)lane * G + c; upm = 0; upn = 0;
        if (L < total) { const int mt = (int)(L / NJ), j = (int)(L % NJ); int e = 0;
            for (int k = 1; k <= 64; ++k) e += (mt >= tst[k]) ? 1 : 0;
            upm = mt; upn = e * NJ + j; } }
    __device__ __forceinline__ bool next(int i, Unit& u) const {
        if ((long)i * G + c >= total || i >= 64) return false;
        const int iu = __builtin_amdgcn_readfirstlane(i);
        u.pm = __builtin_amdgcn_readlane(upm, iu); u.pn = __builtin_amdgcn_readlane(upn, iu); return true;
    }
    __device__ __forceinline__ void a_ready(const Unit&) const {}
    __device__ __forceinline__ void done(const Unit&) const {}
};

struct KArgs { const float* in[32]; float* out; unsigned char* ws; int ph_lo, ph_hi, region, pad; };
struct Ctx {
    LAS unsigned char* lds; unsigned char* ws; const float* in[32]; float* out;
    int tid, lane, wave, G, bid;
};
#define WSP(T, off) ((T*)(C.ws + (off)))

#ifndef CV_NTS
#define CV_NTS 0
#endif
#ifndef CV_NT
#define CV_NT 1
#endif
#if CV_NT
#define CV_LOAD(p) __builtin_nontemporal_load(p)
#else
#define CV_LOAD(p) (*(p))
#endif
struct CvDesc { const float* sp; bf16* dp; int ldw, ldt, zero, w13, f8; };
__device__ __forceinline__ CvDesc cv_desc(const float* W, int ldw, int srccol, int k0, bf16* WT, size_t drow0, int ldt, int w13, int tid, int f8 = 0) {
    CvDesc d; d.zero = srccol < 0; d.ldw = ldw; d.ldt = ldt; d.w13 = w13; d.f8 = f8;
    d.sp = W + (size_t)(k0 + (tid >> 6)) * ldw + (srccol < 0 ? 0 : srccol);
    d.dp = f8 ? (bf16*)((unsigned char*)WT + drow0 * (size_t)ldt + k0) : WT + drow0 * (size_t)ldt + k0; return d;
}
__device__ __forceinline__ CvDesc conv_item(Ctx& C, int l, int r, int tid) {
    constexpr int I_WIN = 16 * 62, I_W13 = 65 * 64, I_W2 = 65 * 32, I_PA = 4 * 8, I_PB = 2 * 8, I_PC = 6 * 8, I_PD = 4 * 8;
    const bool f8l = MOE8(l), lastb = MOE8(l) && l == NL_ - 1;
    bf16* WIN = WSP(bf16, WS_WIN); bf16* W13 = lastb ? WSP(bf16, WS_W13B) : WSP(bf16, WS_W13); bf16* W2 = lastb ? WSP(bf16, WS_W2B) : WSP(bf16, WS_W2); bf16* WP = WSP(bf16, WS_WP); bf16* WOUT = WSP(bf16, WS_WOUT);
    const int c4 = 4 * (tid & 63);
    if (r < I_WIN) { const int nb = r % 62, kb = r / 62, n = 256 * nb + c4; int sc;
        if (n < 1536) sc = n; else if (n < 7424) sc = n + 16; else if (n < 7680) { const int i = n - 7424; sc = i < 16 ? 1536 + i : (i < 24 ? 7440 + (i - 16) : -1); } else sc = n - 7680 + 7448;
        if (GATES8(l) && nb >= 30) return cv_desc(C.in[2] + (size_t)l * 2048 * NCOL, NCOL, sc, 128 * kb, WSP(bf16, WS_WIN8), 256 * (nb - 30), 2048, 0, tid, 1);
        return cv_desc(C.in[2] + (size_t)l * 2048 * NCOL, NCOL, sc, 128 * kb, WIN, 256 * nb, 2048, 0, tid); }
    r -= I_WIN;
    if (r < I_W13) { const int e = r / 64, q = r % 64, half = q >> 5, kb = (q >> 1) & 15, nq = q & 1;
        const float* src = e == 0 ? (half ? C.in[28] : C.in[27]) + (size_t)l * 2048 * 512 : (half ? C.in[25] : C.in[24]) + (size_t)(l * 64 + e - 1) * 2048 * 512;
        return cv_desc(src, 512, 256 * nq + c4, 128 * kb, W13, (size_t)e * 1024 + nq * 512 + half * 128, 2048, 1, tid, f8l ? 1 : 0); }
    r -= I_W13;
    if (r < I_W2) { const int e = r / 32, q = r % 32, kb = q / 8, nb = q % 8;
        const float* src = e == 0 ? C.in[29] + (size_t)l * 512 * 2048 : C.in[26] + (size_t)(l * 64 + e - 1) * 512 * 2048;
        return cv_desc(src, 2048, 256 * nb + c4, 128 * kb, W2, (size_t)e * 2048 + 256 * nb, 512, 0, tid, f8l ? 1 : 0); }
    r -= I_W2;
    if (r < I_PA) return cv_desc(C.in[15] + (size_t)l * 512 * 2048, 2048, 256 * (r % 8) + c4, 128 * (r / 8), WP, 256 * (r % 8), 2048, 0, tid);
    r -= I_PA;
    if (r < I_PB) return cv_desc(C.in[16] + (size_t)l * 256 * 2048, 2048, 256 * (r % 8) + c4, 128 * (r / 8), WP + 512, 256 * (r % 8), 2048, 0, tid);
    r -= I_PB;
    if (r < I_PC) return cv_desc(C.in[17] + (size_t)l * 768 * 2048, 2048, 256 * (r % 8) + c4, 128 * (r / 8), WP + 768, 256 * (r % 8), 2048, 0, tid);
    r -= I_PC;
    if (r < I_PD) return cv_desc(C.in[18] + (size_t)l * 512 * 2048, 2048, 256 * (r % 8) + c4, 128 * (r / 8), WP + 1536, 256 * (r % 8), 2048, 0, tid);
    r -= I_PD;
    return cv_desc(C.in[19] + (size_t)l * 2048 * 2048, 2048, 256 * (r % 8) + c4, 128 * (r / 8), WOUT, 256 * (r % 8), 2048, 0, tid);
}
__device__ __forceinline__ void phase_convert(Ctx& C, int l, int part, int cbid, int cG, unsigned* arr = nullptr) {
    LAS float* tile = (LAS float*)C.lds; LAS int* qn = (LAS int*)(C.lds + AUX_OFF + 8192);
    unsigned* cq = WSP(unsigned, WS_CTL) + CW_CQ + l * 2 + part;
    const int tid = C.tid, lane = C.lane, wave = C.wave;
    constexpr int I_WIN = 16 * 62, NITEMS = I_WIN + 65 * 64 + 65 * 32 + (4 + 2 + 6 + 4) * 8 + 16 * 8;
    const int it0 = part == 0 ? 0 : I_WIN, it1 = part == 0 ? I_WIN : NITEMS;
    __syncthreads();
    if (tid == 0) qn[0] = (arr && __hip_atomic_load(arr, __ATOMIC_RELAXED, __HIP_MEMORY_SCOPE_AGENT) + STEAL_MARGIN >= (unsigned)C.G) ? 0x7fffffff : it0 + (int)atomicAdd(cq, 1u);
    __syncthreads();
    int it = qn[0];
    f32x4 va[16];
    CvDesc d = conv_item(C, l, it < it1 ? it : it0, tid);
    if (it < it1) {
#pragma unroll
        for (int i = 0; i < 16; ++i) va[i] = d.zero ? (f32x4){0.f, 0.f, 0.f, 0.f} : CV_LOAD((const f32x4*)(d.sp + (size_t)(8 * i) * d.ldw)); }
    const int c16 = lane & 15, nsub = lane >> 4;
    while (it < it1) {
#pragma unroll
        for (int i = 0; i < 16; ++i) { const int kk = wave + 8 * i; *(LAS f32x4*)(tile + kk * 256 + ((4 * (tid & 63)) ^ (4 * ((kk >> 3) & 7)))) = va[i]; }
        if (tid == 0) qn[1] = (arr && __hip_atomic_load(arr, __ATOMIC_RELAXED, __HIP_MEMORY_SCOPE_AGENT) + STEAL_MARGIN >= (unsigned)C.G) ? 0x7fffffff : it0 + (int)atomicAdd(cq, 1u);
        __syncthreads();
        const int nx = qn[1]; const bool hn = nx < it1;
        const CvDesc dn = conv_item(C, l, hn ? nx : it, tid);
        if (hn) {
#pragma unroll
            for (int i = 0; i < 16; ++i) va[i] = dn.zero ? (f32x4){0.f, 0.f, 0.f, 0.f} : CV_LOAD((const f32x4*)(dn.sp + (size_t)(8 * i) * dn.ldw)); }
#pragma unroll
        for (int p = 0; p < 8; ++p) { const int n = p * 32 + wave * 4 + nsub; const LAS float* s = tile + (8 * c16) * 256 + (n ^ (4 * (c16 & 7)));
            const int drow = d.w13 ? ((n >> 7) << 8) + (n & 127) : n;
            if (d.f8) { v2u o8; o8.x = pk4_fp8(s[0 * 256] * 32.f, s[1 * 256] * 32.f, s[2 * 256] * 32.f, s[3 * 256] * 32.f); o8.y = pk4_fp8(s[4 * 256] * 32.f, s[5 * 256] * 32.f, s[6 * 256] * 32.f, s[7 * 256] * 32.f);
                if (CV_NTS && part == 1) __builtin_nontemporal_store(o8, (v2u*)((unsigned char*)d.dp + (size_t)drow * d.ldt + 8 * c16)); else *(v2u*)((unsigned char*)d.dp + (size_t)drow * d.ldt + 8 * c16) = o8; }
            else { v4u o; o.x = pk2(s[0 * 256], s[1 * 256]); o.y = pk2(s[2 * 256], s[3 * 256]); o.z = pk2(s[4 * 256], s[5 * 256]); o.w = pk2(s[6 * 256], s[7 * 256]);
                if (CV_NTS && part == 1) __builtin_nontemporal_store(o, (v4u*)(d.dp + (size_t)drow * d.ldt + 8 * c16)); else *(v4u*)(d.dp + (size_t)drow * d.ldt + 8 * c16) = o; } }
        __syncthreads();
        d = dn; it = nx;
    }
    if (l == 0 && part == 0) {
        const int gw = cbid * 8 + C.wave, NGW = cG * 8;
        bf16* XB = WSP(bf16, WS_XB); const float* X = C.in[0];
        for (int t = gw; t < T_; t += NGW) {
#pragma unroll
            for (int j = 0; j < 8; ++j) { const f32x4 v = *(const f32x4*)(X + (size_t)t * 2048 + 4 * (lane + 64 * j)); v2u o; o.x = pk2(v[0], v[1]); o.y = pk2(v[2], v[3]); *(v2u*)(XB + (size_t)t * 2048 + 4 * (lane + 64 * j)) = o;
                if (GATES8(0)) *(unsigned*)(WSP(unsigned char, WS_XB8) + (size_t)t * 2048 + 4 * (lane + 64 * j)) = pk4_fp8(v[0], v[1], v[2], v[3]); }
        }
        f32x2* CS = WSP(f32x2, WS_CS); const int* pos = (const int*)C.in[1];
        for (int i = C.bid * 512 + C.tid; i < T_ * 32; i += C.G * 512) { const int t = i >> 5, f = i & 31;
            const float inv = powf(10000.0f, -(float)f * 2.0f / 64.0f), ang = (float)pos[t] * inv; float sn, cs; sincosf(ang, &sn, &cs); CS[i] = (f32x2){cs, sn}; }
    }
}
__device__ __forceinline__ void ln_row(f32x4 (&v)[8], const float* g, const float* b, int lane) {
    float s = 0.f;
#pragma unroll
    for (int j = 0; j < 8; ++j) s += (v[j][0] + v[j][1]) + (v[j][2] + v[j][3]);
    const float mean = wave_sum(s) * (1.f / 2048.f); float q = 0.f;
#pragma unroll
    for (int j = 0; j < 8; ++j) { v[j] = v[j] - mean; q += (v[j][0] * v[j][0] + v[j][1] * v[j][1]) + (v[j][2] * v[j][2] + v[j][3] * v[j][3]); }
    const float rstd = 1.f / sqrtf(wave_sum(q) * (1.f / 2048.f) + LN_EPS_);
#pragma unroll
    for (int j = 0; j < 8; ++j) { const f32x4 gv = *(const f32x4*)(g + 4 * (lane + 64 * j)), bv = *(const f32x4*)(b + 4 * (lane + 64 * j)); v[j] = v[j] * rstd * gv + bv; }
}
__device__ __forceinline__ void phase_ln1_router(Ctx& C, int l) {
    const float* HB = WSP(float, WS_HB); float* X1 = WSP(float, WS_X1); bf16* XS = WSP(bf16, WS_XS); float* ROWW = WSP(float, WS_ROWW);
    int* sel_e = WSP(int, WS_SEL); float* sel_w = WSP(float, WS_SEL + 262144); int* sel_r = WSP(int, WS_SEL + 2 * 262144);
    unsigned* cnt = WSP(unsigned, WS_CTL) + CW_CNT + l * 64;
    const float* g = C.in[20] + l * 2048; const float* b = C.in[21] + l * 2048; const float* wrt = C.in[22] + (size_t)l * 2048 * 64; const float* rb = C.in[23] + l * 64;
    constexpr int XP = 2068;
    LAS float* xl = (LAS float*)C.lds; LAS float* part = xl + 16 * XP; LAS float* scl = part + 2048;
    const int lane = C.lane, wave = C.wave;
    for (int unit = C.bid; unit < T_ / 16; unit += C.G) {
        const int t0 = unit * 16;
#pragma unroll 1
        for (int rr = 0; rr < 2; ++rr) { const int row = 2 * wave + rr; const size_t t = (size_t)(t0 + row);
            f32x4 v[8];
#pragma unroll
            for (int j = 0; j < 8; ++j) v[j] = *(const f32x4*)(HB + t * 2048 + 4 * (lane + 64 * j));
            ln_row(v, g, b, lane);
#pragma unroll
            for (int j = 0; j < 8; ++j) { if (!X1_BF16) *(f32x4*)(X1 + t * 2048 + 4 * (lane + 64 * j)) = v[j];
                if (MOE8(l)) *(unsigned*)(WSP(unsigned char, WS_XS8) + t * 2048 + 4 * (lane + 64 * j)) = pk4_fp8(v[j][0], v[j][1], v[j][2], v[j][3]);
                if (!MOE8(l) || X1_BF16) { v2u o; o.x = pk2(v[j][0], v[j][1]); o.y = pk2(v[j][2], v[j][3]); *(v2u*)(XS + t * 2048 + 4 * (lane + 64 * j)) = o; }
                *(LAS f32x4*)(xl + row * XP + 4 * (lane + 64 * j)) = v[j]; }
        }
        if (C.tid < 16) { ROWW[t0 + C.tid] = 1.0f; WSP(int, WS_ROWMAP)[t0 + C.tid] = t0 + C.tid; }
        __syncthreads();
        {
            const int et = wave & 3, kh = wave >> 2, i = lane & 15, h = lane >> 4; f32x4 acc = (f32x4){0.f, 0.f, 0.f, 0.f};
            const LAS float* xr = xl + i * XP + kh * 1024 + 4 * h; const float* wb = wrt + (size_t)(kh * 1024 + 4 * h) * 64 + 16 * et + i;
#pragma unroll 4
            for (int s = 0; s < 64; ++s) { const f32x4 a = *(const LAS f32x4*)(xr + 16 * s); const float* wp = wb + (size_t)(16 * s) * 64;
                const float b0 = wp[0], b1 = wp[64], b2 = wp[128], b3 = wp[192];
                acc = __builtin_amdgcn_mfma_f32_16x16x4f32(a[0], b0, acc, 0, 0, 0); acc = __builtin_amdgcn_mfma_f32_16x16x4f32(a[1], b1, acc, 0, 0, 0);
                acc = __builtin_amdgcn_mfma_f32_16x16x4f32(a[2], b2, acc, 0, 0, 0); acc = __builtin_amdgcn_mfma_f32_16x16x4f32(a[3], b3, acc, 0, 0, 0); }
#pragma unroll
            for (int r = 0; r < 4; ++r) part[kh * 1024 + (4 * h + r) * 64 + 16 * et + i] = acc[r];
        }
        __syncthreads();
#pragma unroll
        for (int k = 0; k < 2; ++k) { const int idx = C.tid + 512 * k; scl[idx] = 1.f / (1.f + expf(-(part[idx] + part[1024 + idx]))); }
        __syncthreads();
#pragma unroll 1
        for (int rr = 0; rr < 2; ++rr) { const int tok = 2 * wave + rr, t = t0 + tok; const float* sp = (const float*)(scl + tok * 64);
            const bool sel = route_lane_select(lane, sp, rb); const float s = scl[tok * 64 + lane];
            const unsigned long long m0_ = __ballot(sel); const bool sel8 = sel && __popcll(m0_ & ((1ull << lane) - 1ull)) < 8;
            const float wsum = wave_sum(sel8 ? s : 0.f); const unsigned long long m = __ballot(sel8);
            if (sel8) { const int k = __popcll(m & ((1ull << lane) - 1ull)); sel_e[t * 8 + k] = lane; sel_w[t * 8 + k] = s * 2.5f / wsum; sel_r[t * 8 + k] = (int)atomicAdd(cnt + lane, 1u); } }
        __syncthreads();
    }
}
__device__ __forceinline__ void phase_scatter(Ctx& C, int l) {
    float* ROWW = WSP(float, WS_ROWW); int* ROWMAP = WSP(int, WS_ROWMAP);
    const int* sel_e = WSP(int, WS_SEL); const float* sel_w = WSP(float, WS_SEL + 262144); const int* sel_r = WSP(int, WS_SEL + 2 * 262144); int* POS = WSP(int, WS_SEL + 3 * 262144);
    const unsigned* cnt = WSP(unsigned, WS_CTL) + CW_CNT + l * 64; int* tst = WSP(int, WS_CTL) + CW_TST + l * 128;
    LAS int* offl = (LAS int*)(C.lds + AUX_OFF + 4096);
    if (C.tid == 0) { int ts = 0;
        for (int k = 0; k <= 65; ++k) { if (C.bid == 0) tst[k] = ts; if (k >= 1 && k <= 64) offl[k - 1] = ts * 256; ts += (k == 0) ? 32 : (k <= 64 ? (((int)cnt[k - 1] + 255) >> 8) : 0); } }
    __syncthreads();
    for (int p = C.bid * 512 + C.tid; p < T_ * 8; p += C.G * 512) { const int e = sel_e[p], pos = offl[e] + sel_r[p]; ROWMAP[pos] = p >> 3; ROWW[pos] = sel_w[p]; POS[p] = pos; }
    for (int e = C.bid; e < 64; e += C.G) { const int c = (int)cnt[e], beg = offl[e] + c, end = offl[e] + ((c + 255) & ~255);
        for (int pos = beg + C.tid; pos < end; pos += 512) { ROWMAP[pos] = 0; ROWW[pos] = 0.f; } }
}
__device__ __forceinline__ void phase_combine(Ctx& C, int l) {
    const bf16* YB = WSP(bf16, WS_YBUF); const float* X1 = WSP(float, WS_X1); const int* POS = WSP(int, WS_SEL + 3 * 262144);
    float* XO = (l == NL_ - 1) ? C.out : WSP(float, WS_XA); bf16* XB = WSP(bf16, WS_XB);
    const float* g = C.in[30] + l * 2048; const float* b = C.in[31] + l * 2048;
    const int gw = C.bid * 8 + C.wave, NGW = C.G * 8, lane = C.lane;
    int pn[8];
#pragma unroll
    for (int k = 0; k < 8; ++k) pn[k] = gw < T_ ? POS[gw * 8 + k] : 0;
    for (int t = gw; t < T_; t += NGW) {
        size_t rows[9]; rows[0] = (size_t)t;
#pragma unroll
        for (int k = 0; k < 8; ++k) rows[k + 1] = (size_t)pn[k];
        { const int tn = t + NGW < T_ ? t + NGW : t;
#pragma unroll
          for (int k = 0; k < 8; ++k) pn[k] = POS[tn * 8 + k]; }
        v4u w[9][4];
#pragma unroll
        for (int k = 0; k < 9; ++k)
#pragma unroll
            for (int j = 0; j < 4; ++j) w[k][j] = __builtin_nontemporal_load((const v4u*)(YB + rows[k] * 2048 + 8 * lane + 512 * j));
        float v[4][8];
#pragma unroll
        for (int j = 0; j < 4; ++j) { f32x4 a, c;
            if (X1_BF16) { const v4u xw = *(const v4u*)(WSP(bf16, WS_XS) + (size_t)t * 2048 + 8 * lane + 512 * j); a = (f32x4){bflo(xw.x), bfhi(xw.x), bflo(xw.y), bfhi(xw.y)}; c = (f32x4){bflo(xw.z), bfhi(xw.z), bflo(xw.w), bfhi(xw.w)}; }
            else { a = *(const f32x4*)(X1 + (size_t)t * 2048 + 8 * lane + 512 * j); c = *(const f32x4*)(X1 + (size_t)t * 2048 + 8 * lane + 512 * j + 4); }
            v[j][0] = a[0] * DN_ALPHA; v[j][1] = a[1] * DN_ALPHA; v[j][2] = a[2] * DN_ALPHA; v[j][3] = a[3] * DN_ALPHA; v[j][4] = c[0] * DN_ALPHA; v[j][5] = c[1] * DN_ALPHA; v[j][6] = c[2] * DN_ALPHA; v[j][7] = c[3] * DN_ALPHA; }
#pragma unroll
        for (int k = 0; k < 9; ++k)
#pragma unroll
            for (int j = 0; j < 4; ++j) { v[j][0] += bflo(w[k][j].x); v[j][1] += bfhi(w[k][j].x); v[j][2] += bflo(w[k][j].y); v[j][3] += bfhi(w[k][j].y); v[j][4] += bflo(w[k][j].z); v[j][5] += bfhi(w[k][j].z); v[j][6] += bflo(w[k][j].w); v[j][7] += bfhi(w[k][j].w); }
        float s = 0.f;
#pragma unroll
        for (int j = 0; j < 4; ++j)
#pragma unroll
            for (int e = 0; e < 8; ++e) s += v[j][e];
        const float mean = wave_sum(s) * (1.f / 2048.f); float q = 0.f;
#pragma unroll
        for (int j = 0; j < 4; ++j)
#pragma unroll
            for (int e = 0; e < 8; ++e) { v[j][e] -= mean; q += v[j][e] * v[j][e]; }
        const float rstd = 1.f / sqrtf(wave_sum(q) * (1.f / 2048.f) + LN_EPS_);
#pragma unroll
        for (int j = 0; j < 4; ++j) { const int c0 = 8 * lane + 512 * j; float o[8];
            const f32x4 g0 = *(const f32x4*)(g + c0), g1 = *(const f32x4*)(g + c0 + 4), b0 = *(const f32x4*)(b + c0), b1 = *(const f32x4*)(b + c0 + 4);
#pragma unroll
            for (int e = 0; e < 4; ++e) { o[e] = v[j][e] * rstd * g0[e] + b0[e]; o[4 + e] = v[j][4 + e] * rstd * g1[e] + b1[e]; }
            *(f32x4*)(XO + (size_t)t * 2048 + c0) = (f32x4){o[0], o[1], o[2], o[3]}; *(f32x4*)(XO + (size_t)t * 2048 + c0 + 4) = (f32x4){o[4], o[5], o[6], o[7]};
            if (l < NL_ - 1) { v4u ow; ow.x = pk2(o[0], o[1]); ow.y = pk2(o[2], o[3]); ow.z = pk2(o[4], o[5]); ow.w = pk2(o[6], o[7]); *(v4u*)(XB + (size_t)t * 2048 + c0) = ow;
                if (GATES8(l + 1)) { v2u o8; o8.x = pk4_fp8(o[0], o[1], o[2], o[3]); o8.y = pk4_fp8(o[4], o[5], o[6], o[7]); *(v2u*)(WSP(unsigned char, WS_XB8) + (size_t)t * 2048 + c0) = o8; } } }
    }
}
typedef LAS unsigned char* ldsp;
__device__ __forceinline__ f32x4 mfma16(bf16x8 bt, bf16x8 a, f32x4 c) { return __builtin_amdgcn_mfma_f32_16x16x32_bf16(bt, a, c, 0, 0, 0); }
__device__ __forceinline__ bf16x8 frag(ldsp base, int pitch, int row, int k0, int fq) { return *(const LAS bf16x8*)(base + row * pitch + (k0 + 8 * fq) * 2); }
__device__ __forceinline__ bf16x8 frag2(ldsp base, int pitch, int row, int kA, int kB, int fq) {
    const v2u a = *(const LAS v2u*)(base + row * pitch + (kA + 4 * fq) * 2), b = *(const LAS v2u*)(base + row * pitch + (kB + 4 * fq) * 2);
    v4u r; r.x = a.x; r.y = a.y; r.z = b.x; r.w = b.y; return __builtin_bit_cast(bf16x8, r);
}
typedef short v4i16_t __attribute__((ext_vector_type(4)));
__device__ __forceinline__ bf16x8 trfrag2(ldsp base, int pitch, int col0, int kA, int kB, int lane) {
    const int q = (lane & 15) >> 2, p = lane & 3, fq = lane >> 4;
    const v4i16_t x = __builtin_amdgcn_ds_read_tr16_b64_v4i16((LAS v4i16_t*)(base + (kA + 4 * fq + q) * pitch + (col0 + 4 * p) * 2));
    const v4i16_t y = __builtin_amdgcn_ds_read_tr16_b64_v4i16((LAS v4i16_t*)(base + (kB + 4 * fq + q) * pitch + (col0 + 4 * p) * 2));
    bf16x8 r; r[0] = x[0]; r[1] = x[1]; r[2] = x[2]; r[3] = x[3]; r[4] = y[0]; r[5] = y[1]; r[6] = y[2]; r[7] = y[3]; return r;
}
__device__ __forceinline__ bf16x8 trfrag(ldsp base, int pitch, int col0, int k0, int lane) { const int fq = lane >> 4; return trfrag2(base, pitch, col0, k0 + 4 * fq, k0 + 4 * fq + 4, lane); }
__device__ __forceinline__ bf16x8 pfrag(const f32x4& p0, const f32x4& p1) { v4u r; r.x = pk2(p0[0], p0[1]); r.y = pk2(p0[2], p0[3]); r.z = pk2(p1[0], p1[1]); r.w = pk2(p1[2], p1[3]); return __builtin_bit_cast(bf16x8, r); }
__device__ __forceinline__ void unpack8(const v4u w, float (&f)[8]) { f[0] = bflo(w.x); f[1] = bfhi(w.x); f[2] = bflo(w.y); f[3] = bfhi(w.y); f[4] = bflo(w.z); f[5] = bfhi(w.z); f[6] = bflo(w.w); f[7] = bfhi(w.w); }
__device__ __forceinline__ unsigned short bf1(float x) { return (unsigned short)(pk2(x, 0.f) & 0xffffu); }
__device__ __forceinline__ float flogsigmoid(float x) { return fminf(x, 0.f) - log1pf(__expf(-fabsf(x))); }
__device__ __forceinline__ float fgelu(float v) {
    const float av = fabsf(v), t = __builtin_amdgcn_rcpf(av * 0.2316418882f + 1.0f);
    float q = t * 0.5307027145f + (-0.7265760135f); q = q * t + 0.7107068705f; q = q * t + (-0.142248368f); q = q * t + 0.127414796f; q = q * t;
    const float e = __builtin_amdgcn_exp2f((v * v) * (-0.72134752044f)), m = v * (q * e);
    return v < 0.f ? m : v - m;
}

__device__ __forceinline__ void scat8(LAS unsigned short* vp, int ps  , const v4u w) {
    vp[0 * ps] = (unsigned short)(w.x & 0xffff); vp[1 * ps] = (unsigned short)(w.x >> 16); vp[2 * ps] = (unsigned short)(w.y & 0xffff); vp[3 * ps] = (unsigned short)(w.y >> 16);
    vp[4 * ps] = (unsigned short)(w.z & 0xffff); vp[5 * ps] = (unsigned short)(w.z >> 16); vp[6 * ps] = (unsigned short)(w.w & 0xffff); vp[7 * ps] = (unsigned short)(w.w >> 16);
}

__device__ __forceinline__ void dil_unit(Ctx& C, int u) {
    const int tid = C.tid, lane = C.lane, wave = C.wave, fr = lane & 15, fq = lane >> 4;
    const int blk16 = u & 15, hh = (u >> 4) & 3, g = (u >> 6) % 3, b = u / 192;
    const int dil = g == 0 ? 1 : (g == 1 ? 4 : 16), nbpr = 16 / dil  , r = blk16 / nbpr, nb = blk16 % nbpr, head = g * 4 + hh;
    const bf16* Y = WSP(bf16, WS_Y); const f32x2* CS = WSP(f32x2, WS_CS);
    constexpr int QP = 144, KP = 144, VP = 160;
    ldsp Ql = C.lds, Kl = C.lds + 128 * QP, Vl = Kl + 256 * KP;
    const size_t tb = (size_t)b * SEQ_;
    {   const int ch = tid & 3, row0 = tid >> 2; v4u xa[3], xb[3]; f32x4 cs[3][4]; int mrow[3];
#pragma unroll
        for (int i = 0; i < 3; ++i) { const int row = row0 + (i == 2 ? 128 : 0), m = (i == 0) ? nb * 128 + row : (nb - 1) * 128 + row, mc = m < 0 ? 0 : m; const size_t t = tb + (size_t)mc * dil + r;
            const bf16* src = Y + t * YP + (i == 0 ? Y_BQ : Y_BK) + head * 64 + 8 * ch; xa[i] = *(const v4u*)src; xb[i] = *(const v4u*)(src + 32);
            const f32x4* cp = (const f32x4*)(CS + t * 32 + 8 * ch); cs[i][0] = cp[0]; cs[i][1] = cp[1]; cs[i][2] = cp[2]; cs[i][3] = cp[3]; mrow[i] = m; }
        const int ch8 = tid & 7, key0 = tid >> 3; v4u vv[4];
#pragma unroll
        for (int i = 0; i < 4; ++i) { const int m = (nb - 1) * 128 + key0 + 64 * i, mc = m < 0 ? 0 : m; vv[i] = *(const v4u*)(Y + (tb + (size_t)mc * dil + r) * YP + Y_BV + head * 64 + 8 * ch8); }
#pragma unroll
        for (int i = 0; i < 3; ++i) { const int row = row0 + (i == 2 ? 128 : 0); ldsp dst = (i == 0) ? Ql + row * QP : Kl + row * KP;
            float x1[8], x2[8]; unpack8(xa[i], x1); unpack8(xb[i], x2); const float sc = (i == 0) ? 0.125f : (mrow[i] < 0 ? 0.f : 1.f); float y1[8], y2[8];
#pragma unroll
            for (int k = 0; k < 8; ++k) { const float c = cs[i][k >> 1][2 * (k & 1)], sn = cs[i][k >> 1][2 * (k & 1) + 1]; y1[k] = (x1[k] * c - x2[k] * sn) * sc; y2[k] = (x2[k] * c + x1[k] * sn) * sc; }
            v4u o1, o2; o1.x = pk2(y1[0], y1[1]); o1.y = pk2(y1[2], y1[3]); o1.z = pk2(y1[4], y1[5]); o1.w = pk2(y1[6], y1[7]);
            o2.x = pk2(y2[0], y2[1]); o2.y = pk2(y2[2], y2[3]); o2.z = pk2(y2[4], y2[5]); o2.w = pk2(y2[6], y2[7]);
            *(LAS v4u*)(dst + 16 * ch) = o1; *(LAS v4u*)(dst + 64 + 16 * ch) = o2; }
#pragma unroll
        for (int i = 0; i < 4; ++i) { const int key = key0 + 64 * i; v4u w = vv[i]; if ((nb - 1) * 128 + key < 0) w = (v4u){0u, 0u, 0u, 0u};
            *(LAS v4u*)(Vl + key * VP + 16 * ch8) = w; }
    }
    __syncthreads();
    const int ts = wave < 6 ? wave : 6;
    const bf16x8 q0 = frag(Ql, QP, 16 * wave + fr, 0, fq), q1 = frag(Ql, QP, 16 * wave + fr, 32, fq);
    f32x4 s[10];
#pragma unroll
    for (int t = 0; t < 10; ++t) { s[t] = (f32x4){0.f, 0.f, 0.f, 0.f};
        s[t] = mfma16(frag(Kl, KP, 16 * (ts + t) + fr, 0, fq), q0, s[t]); s[t] = mfma16(frag(Kl, KP, 16 * (ts + t) + fr, 32, fq), q1, s[t]); }
    const int qi = 16 * wave + fr; float mx = -INFINITY;
#pragma unroll
    for (int t = 0; t < 10; ++t)
#pragma unroll
        for (int e = 0; e < 4; ++e) { const int j = 16 * (ts + t) + 4 * fq + e; const bool ok = (j >= qi) && (j <= qi + 128) && ((nb - 1) * 128 + j >= 0); s[t][e] = ok ? s[t][e] : -INFINITY; mx = fmaxf(mx, s[t][e]); }
    mx = fmaxf(mx, __shfl_xor(mx, 16)); mx = fmaxf(mx, __shfl_xor(mx, 32));
    float den = 0.f;
#pragma unroll
    for (int t = 0; t < 10; ++t)
#pragma unroll
        for (int e = 0; e < 4; ++e) { const float p = __expf(s[t][e] - mx); s[t][e] = p; den += p; }
    den += __shfl_xor(den, 16); den += __shfl_xor(den, 32);
    f32x4 o[4];
#pragma unroll
    for (int n = 0; n < 4; ++n) o[n] = (f32x4){0.f, 0.f, 0.f, 0.f};
#pragma unroll
    for (int tp = 0; tp < 5; ++tp) { const bf16x8 pf = pfrag(s[2 * tp], s[2 * tp + 1]);
#pragma unroll
        for (int n = 0; n < 4; ++n) o[n] = mfma16(trfrag2(Vl, VP, 16 * n, 16 * (ts + 2 * tp), 16 * (ts + 2 * tp + 1), lane), pf, o[n]); }
    const size_t t = tb + (size_t)(nb * 128 + qi) * dil + r; const float rden = 1.f / den;
    float* DO = WSP(float, WS_DILO) + t * 768 + head * 64;
#pragma unroll
    for (int n = 0; n < 4; ++n) *(f32x4*)(DO + 16 * n + 4 * fq) = o[n] * rden;
    if (fq == 0) WSP(float, WS_DILL)[t * 12 + head] = mx + __logf(den);
    __syncthreads();
}
__device__ __forceinline__ void dil_merge(Ctx& C, bf16* YM) {
    const float* DO = WSP(float, WS_DILO); const float* DL = WSP(float, WS_DILL);
    for (int i = C.bid * 512 + C.tid; i < T_ * 64; i += C.G * 512) { const int t = i >> 6, hh = (i >> 4) & 3, d4 = (i & 15) * 4;
        const float l0 = DL[t * 12 + hh], l1 = DL[t * 12 + 4 + hh], l2 = DL[t * 12 + 8 + hh], m = fmaxf(l0, fmaxf(l1, l2));
        const float w0 = __expf(l0 - m), w1 = __expf(l1 - m), w2 = __expf(l2 - m), rs = 1.f / (w0 + w1 + w2);
        const f32x4 a = *(const f32x4*)(DO + (size_t)t * 768 + hh * 64 + d4), bb = *(const f32x4*)(DO + (size_t)t * 768 + (4 + hh) * 64 + d4), c = *(const f32x4*)(DO + (size_t)t * 768 + (8 + hh) * 64 + d4);
        const f32x4 o = (a * w0 + bb * w1 + c * w2) * rs; v2u w; w.x = pk2(o[0], o[1]); w.y = pk2(o[2], o[3]);
        *(v2u*)(YM + (size_t)t * 2048 + YM_B + hh * 64 + d4) = w; }
}

__device__ __forceinline__ void sgu_unit(Ctx& C, int l, int u, bf16* YM) {
    const int tid = C.tid, lane = C.lane, wave = C.wave, fr = lane & 15, fq = lane >> 4;
    const int g = u % 6, cn = u / 6; const size_t t0 = (size_t)cn * 128;
    const bf16* Y = WSP(bf16, WS_Y);
    const float* lng = C.in[11] + l * 768; const float* lnb = C.in[12] + l * 768; const float* ws = C.in[13] + (size_t)(l * 6 + g) * 128 * 128; const float* bs = C.in[14] + (l * 6 + g) * 128;
    constexpr int AP = 272, VP = 288;
    ldsp Al = C.lds, Vl = C.lds + 128 * AP; LAS float* st = (LAS float*)(Vl + 128 * VP);
    {   const int j = tid >> 2, qd = tid & 3; const bf16* src = Y + (t0 + j) * YP + Y_CV + qd * 192; float s1 = 0.f, s2 = 0.f;
        { v4u w[24];
#pragma unroll
            for (int k = 0; k < 24; ++k) w[k] = *(const v4u*)(src + 8 * k);
#pragma unroll
            for (int k = 0; k < 24; ++k) { float x[8]; unpack8(w[k], x);
#pragma unroll
                for (int q2 = 0; q2 < 8; ++q2) { const float z = fgelu(x[q2]); s1 += z; s2 += z * z; } } }
        s1 += __shfl_xor(s1, 1); s2 += __shfl_xor(s2, 1); s1 += __shfl_xor(s1, 2); s2 += __shfl_xor(s2, 2);
        if (qd == 0) { const float mu = s1 * (1.f / 768.f), var = fmaxf(s2 * (1.f / 768.f) - mu * mu, 0.f); st[2 * j] = mu; st[2 * j + 1] = 1.f / sqrtf(var + LN_EPS_); } }
    {   const int c8 = (tid & 15) * 8; f32x4 a[4], bq[4];
#pragma unroll
        for (int k4 = 0; k4 < 4; ++k4) { const int i = (tid >> 4) + 32 * k4; const float* src = ws + i * 128 + c8; a[k4] = *(const f32x4*)src; bq[k4] = *(const f32x4*)(src + 4); }
#pragma unroll
        for (int k4 = 0; k4 < 4; ++k4) { const int i = (tid >> 4) + 32 * k4; float v[8] = {a[k4][0], a[k4][1], a[k4][2], a[k4][3], bq[k4][0], bq[k4][1], bq[k4][2], bq[k4][3]};
#pragma unroll
            for (int k = 0; k < 8; ++k) v[k] = (c8 + k <= i) ? v[k] : 0.f;
            v4u o; o.x = pk2(v[0], v[1]); o.y = pk2(v[2], v[3]); o.z = pk2(v[4], v[5]); o.w = pk2(v[6], v[7]); *(LAS v4u*)(Al + i * AP + c8 * 2) = o; } }
    {   const int c8 = (tid & 15) * 8; v4u w[4];
#pragma unroll
        for (int k4 = 0; k4 < 4; ++k4) { const int j = (tid >> 4) + 32 * k4; w[k4] = *(const v4u*)(Y + (t0 + j) * YP + Y_CV + g * 128 + c8); }
        const f32x4 g0 = *(const f32x4*)(lng + g * 128 + c8), g1 = *(const f32x4*)(lng + g * 128 + c8 + 4), b0 = *(const f32x4*)(lnb + g * 128 + c8), b1 = *(const f32x4*)(lnb + g * 128 + c8 + 4);
        const float gg[8] = {g0[0], g0[1], g0[2], g0[3], g1[0], g1[1], g1[2], g1[3]}, bb[8] = {b0[0], b0[1], b0[2], b0[3], b1[0], b1[1], b1[2], b1[3]};
        __syncthreads();
#pragma unroll
        for (int k4 = 0; k4 < 4; ++k4) { const int j = (tid >> 4) + 32 * k4; float x[8]; unpack8(w[k4], x); const float mu = st[2 * j], rs = st[2 * j + 1];
#pragma unroll
            for (int k = 0; k < 8; ++k) x[k] = (fgelu(x[k]) - mu) * rs * gg[k] + bb[k];
            v4u o; o.x = pk2(x[0], x[1]); o.y = pk2(x[2], x[3]); o.z = pk2(x[4], x[5]); o.w = pk2(x[6], x[7]); *(LAS v4u*)(Vl + j * VP + c8 * 2) = o; } }
    __syncthreads();
    f32x4 acc[8];
#pragma unroll
    for (int n = 0; n < 8; ++n) acc[n] = (f32x4){0.f, 0.f, 0.f, 0.f};
    const int nks = (16 * wave + 15) / 32 + 1;
    for (int ks = 0; ks < nks; ++ks) { const bf16x8 a = frag(Al, AP, 16 * wave + fr, 32 * ks, fq);
#pragma unroll
        for (int n = 0; n < 8; ++n) acc[n] = mfma16(trfrag(Vl, VP, 16 * n, 32 * ks, lane), a, acc[n]); }
    const int i = 16 * wave + fr; const float bsi = bs[i]; const size_t t = t0 + i;
#pragma unroll
    for (int n = 0; n < 8; ++n) { const int c = 16 * n + 4 * fq; const v2u w = *(const v2u*)(Y + t * YP + Y_CU + g * 128 + c);
        const float o0 = fgelu(bflo(w.x)) * (acc[n][0] + bsi), o1 = fgelu(bfhi(w.x)) * (acc[n][1] + bsi), o2 = fgelu(bflo(w.y)) * (acc[n][2] + bsi), o3 = fgelu(bfhi(w.y)) * (acc[n][3] + bsi);
        v2u o; o.x = pk2(o0, o1); o.y = pk2(o2, o3); *(v2u*)(YM + t * 2048 + YM_C + g * 128 + c) = o; }
    __syncthreads();
}

__device__ __forceinline__ void gla_decay(Ctx& C, int l, int h, size_t t0, LAS float* Bl, LAS float* tmp  ) {
    const int tid = C.tid; const float* YSM = WSP(float, WS_YSM); const float* wa2 = C.in[3] + l * 16 * 256 + h * 64; const float* ba = C.in[4] + l * 256 + h * 64;
    { const int j = tid >> 3, d0 = (tid & 7) * 8; float a[16];
#pragma unroll
        for (int r4 = 0; r4 < 4; ++r4) { const f32x4 v = *(const f32x4*)(YSM + (t0 + j) * 32 + 4 * r4); a[4 * r4] = v[0]; a[4 * r4 + 1] = v[1]; a[4 * r4 + 2] = v[2]; a[4 * r4 + 3] = v[3]; }
#pragma unroll
        for (int k = 0; k < 8; ++k) { float s = ba[d0 + k];
#pragma unroll
            for (int r = 0; r < 16; ++r) s += a[r] * wa2[r * 256 + d0 + k];
            Bl[j * 65 + d0 + k] = flogsigmoid(s) * (1.f / 16.f); } }
    __syncthreads();
    { const int d = tid & 63, sg = tid >> 6; float run = 0.f;
#pragma unroll
        for (int k = 0; k < 8; ++k) { run += Bl[(8 * sg + k) * 65 + d]; Bl[(8 * sg + k) * 65 + d] = run; }
        tmp[sg * 64 + d] = run;
        __syncthreads();
        float off = 0.f;
        for (int s2 = 0; s2 < sg; ++s2) off += tmp[s2 * 64 + d];
#pragma unroll
        for (int k = 0; k < 8; ++k) Bl[(8 * sg + k) * 65 + d] += off; }
    __syncthreads();
}
__device__ __forceinline__ void gla_local_unit(Ctx& C, int l, int u) {
    const int tid = C.tid, lane = C.lane, wave = C.wave, fr = lane & 15, fq = lane >> 4;
    const int n = u & 31, h = (u >> 5) & 3, b = u >> 7; const size_t t0 = (size_t)b * SEQ_ + n * 64;
    const bf16* Y = WSP(bf16, WS_Y);
    constexpr int KP = 160, VP = 288;
    LAS float* Bl = (LAS float*)C.lds; LAS float* tmp = Bl + 64 * 65; ldsp Kl = (ldsp)(tmp + 512), Vl = Kl + 64 * KP;
    gla_decay(C, l, h, t0, Bl, tmp);
    {   const int j = tid >> 3, d0 = (tid & 7) * 8, e0 = (tid & 15) * 8;
        const v4u kw = *(const v4u*)(Y + (t0 + j) * YP + Y_AK + h * 64 + d0); v4u vw[2];
#pragma unroll
        for (int i = 0; i < 2; ++i) vw[i] = *(const v4u*)(Y + (t0 + (tid >> 4) + 32 * i) * YP + Y_AV + h * 128 + e0);
        float x[8]; unpack8(kw, x);
#pragma unroll
        for (int k = 0; k < 8; ++k) x[k] = x[k] * __expf(Bl[63 * 65 + d0 + k] - Bl[j * 65 + d0 + k]);
        v4u o; o.x = pk2(x[0], x[1]); o.y = pk2(x[2], x[3]); o.z = pk2(x[4], x[5]); o.w = pk2(x[6], x[7]); *(LAS v4u*)(Kl + j * KP + d0 * 2) = o;
#pragma unroll
        for (int i = 0; i < 2; ++i) *(LAS v4u*)(Vl + ((tid >> 4) + 32 * i) * VP + e0 * 2) = vw[i];
    }
    __syncthreads();
    float* LOC = WSP(float, WS_GLOC) + (size_t)u * 64 * 128; float* DEC = WSP(float, WS_GDEC) + (size_t)u * 64;
    if (tid < 64) DEC[tid] = __expf(Bl[63 * 65 + tid]);
#pragma unroll
    for (int mt = 0; mt < 4; ++mt) { f32x4 acc = (f32x4){0.f, 0.f, 0.f, 0.f};
#pragma unroll
        for (int ks = 0; ks < 2; ++ks) acc = mfma16(trfrag2(Vl, VP, 16 * wave, 32 * ks, 32 * ks + 16, lane), trfrag2(Kl, KP, 16 * mt, 32 * ks, 32 * ks + 16, lane), acc);
        *(f32x4*)(LOC + (size_t)(16 * mt + fr) * 128 + 16 * wave + 4 * fq) = acc; }
    __syncthreads();
}
__device__ __forceinline__ void gla_scan(Ctx& C) {
    const float* LOC = WSP(float, WS_GLOC); const float* DEC = WSP(float, WS_GDEC); bf16* ST = WSP(bf16, WS_GST);
    for (int i = C.bid * 512 + C.tid; i < 16 * 8192; i += C.G * 512) { const int bh = i >> 13, de = i & 8191, d = de >> 7; float S = 0.f;
        float lc[32], dc[32];
#pragma unroll
        for (int n = 0; n < 32; ++n) { const size_t uu = (size_t)bh * 32 + n; lc[n] = LOC[uu * 8192 + de]; dc[n] = DEC[uu * 64 + d]; }
#pragma unroll
        for (int n = 0; n < 32; ++n) { const size_t uu = (size_t)bh * 32 + n; ST[uu * 8192 + de] = bf1(S); S = dc[n] * S + lc[n]; } }
}
__device__ __forceinline__ void gla_out_unit(Ctx& C, int l, int u, bf16* YM) {
    const int tid = C.tid, lane = C.lane, wave = C.wave, fr = lane & 15, fq = lane >> 4;
    const int n = u & 31, h = (u >> 5) & 3, b = u >> 7; const size_t t0 = (size_t)b * SEQ_ + n * 64;
    const bf16* Y = WSP(bf16, WS_Y); const bf16* ST = WSP(bf16, WS_GST) + (size_t)u * 8192;
    constexpr int QP = 144, VP = 288;
    LAS float* Bl = (LAS float*)C.lds; LAS float* tmp = Bl + 64 * 65; ldsp Ql = (ldsp)(tmp + 512), Kl = Ql + 64 * QP, Vl = Kl + 64 * QP, Sl = Vl + 64 * VP; LAS float* ssq = (LAS float*)(Sl + 64 * VP);
    gla_decay(C, l, h, t0, Bl, tmp);
    {   const int j = tid >> 3, d0 = (tid & 7) * 8, e0 = (tid & 15) * 8, j2 = tid >> 4;
        const v4u qw = *(const v4u*)(Y + (t0 + j) * YP + Y_AQ + h * 64 + d0), kw = *(const v4u*)(Y + (t0 + j) * YP + Y_AK + h * 64 + d0); v4u vw[2], sw[2];
#pragma unroll
        for (int i = 0; i < 2; ++i) { vw[i] = *(const v4u*)(Y + (t0 + j2 + 32 * i) * YP + Y_AV + h * 128 + e0); sw[i] = *(const v4u*)(ST + (j2 + 32 * i) * 128 + e0); }
        float xq[8], xk[8]; unpack8(qw, xq); unpack8(kw, xk);
#pragma unroll
        for (int k = 0; k < 8; ++k) { const float bb = Bl[j * 65 + d0 + k]; xq[k] = xq[k] * 0.125f * __expf(bb); xk[k] = xk[k] * __expf(-bb); }
        v4u o; o.x = pk2(xq[0], xq[1]); o.y = pk2(xq[2], xq[3]); o.z = pk2(xq[4], xq[5]); o.w = pk2(xq[6], xq[7]); *(LAS v4u*)(Ql + j * QP + d0 * 2) = o;
        o.x = pk2(xk[0], xk[1]); o.y = pk2(xk[2], xk[3]); o.z = pk2(xk[4], xk[5]); o.w = pk2(xk[6], xk[7]); *(LAS v4u*)(Kl + j * QP + d0 * 2) = o;
#pragma unroll
        for (int i = 0; i < 2; ++i) { *(LAS v4u*)(Vl + (j2 + 32 * i) * VP + e0 * 2) = vw[i]; *(LAS v4u*)(Sl + (j2 + 32 * i) * VP + e0 * 2) = sw[i]; }
    }
    __syncthreads();
    const int mt = wave & 3, nh = wave >> 2;
    const bf16x8 qa0 = frag(Ql, QP, 16 * mt + fr, 0, fq), qa1 = frag(Ql, QP, 16 * mt + fr, 32, fq);
    f32x4 att[4];
#pragma unroll
    for (int t = 0; t < 4; ++t) { att[t] = (f32x4){0.f, 0.f, 0.f, 0.f}; att[t] = mfma16(frag(Kl, QP, 16 * t + fr, 0, fq), qa0, att[t]); att[t] = mfma16(frag(Kl, QP, 16 * t + fr, 32, fq), qa1, att[t]);
#pragma unroll
        for (int e = 0; e < 4; ++e) att[t][e] = (16 * t + 4 * fq + e <= 16 * mt + fr) ? att[t][e] : 0.f; }
    const bf16x8 p0 = pfrag(att[0], att[1]), p1 = pfrag(att[2], att[3]);
    f32x4 o[4];
#pragma unroll
    for (int nt = 0; nt < 4; ++nt) { const int ec = 64 * nh + 16 * nt; f32x4 a = (f32x4){0.f, 0.f, 0.f, 0.f};
        a = mfma16(trfrag2(Vl, VP, ec, 0, 16, lane), p0, a); a = mfma16(trfrag2(Vl, VP, ec, 32, 48, lane), p1, a);
        a = mfma16(trfrag(Sl, VP, ec, 0, lane), qa0, a); a = mfma16(trfrag(Sl, VP, ec, 32, lane), qa1, a); o[nt] = a; }
    float sq = 0.f;
#pragma unroll
    for (int nt = 0; nt < 4; ++nt) sq += (o[nt][0] * o[nt][0] + o[nt][1] * o[nt][1]) + (o[nt][2] * o[nt][2] + o[nt][3] * o[nt][3]);
    sq += __shfl_xor(sq, 16); sq += __shfl_xor(sq, 32);
    const int i = 16 * mt + fr;
    if (fq == 0) ssq[2 * i + nh] = sq;
    __syncthreads();
    const float rs = 1.f / sqrtf((ssq[2 * i] + ssq[2 * i + 1]) * (1.f / 128.f) + LN_EPS_);
    const float* ng = C.in[5] + l * 512 + h * 128; const size_t t = t0 + i;
#pragma unroll
    for (int nt = 0; nt < 4; ++nt) { const int e = 64 * nh + 16 * nt + 4 * fq; const f32x4 gv = *(const f32x4*)(ng + e); const v2u rw = *(const v2u*)(Y + t * YP + Y_AR + h * 128 + e);
        const float r0 = bflo(rw.x), r1 = bfhi(rw.x), r2 = bflo(rw.y), r3 = bfhi(rw.y);
        v2u w; w.x = pk2(o[nt][0] * rs * gv[0] * r0 * fsigmoid(r0), o[nt][1] * rs * gv[1] * r1 * fsigmoid(r1)); w.y = pk2(o[nt][2] * rs * gv[2] * r2 * fsigmoid(r2), o[nt][3] * rs * gv[3] * r3 * fsigmoid(r3));
        *(v2u*)(YM + t * 2048 + YM_A + h * 128 + e) = w; }
    __syncthreads();
}

__device__ __forceinline__ void ml_prep(Ctx& C, int l, int h, int b, int n, LAS float* gl, ldsp Ql, ldsp Kl, int QP, bool need_q) {
    const int tid = C.tid, lane = C.lane; const size_t t0 = (size_t)b * SEQ_ + n * 64;
    const bf16* Y = WSP(bf16, WS_Y); const float* YSM = WSP(float, WS_YSM);
    if (tid < 64) { const float lf = flogsigmoid(YSM[(t0 + lane) * 32 + 20 + h] + C.in[9][l * 4 + h]); float run = lf;
#pragma unroll
        for (int o = 1; o < 64; o <<= 1) { const float v = __shfl_up(run, o); if (lane >= o) run += v; }
        gl[lane] = run; gl[64 + lane] = YSM[(t0 + lane) * 32 + 16 + h] + C.in[8][l * 4 + h]; }
    const float* cw = C.in[6] + l * 4096; const float* cb = C.in[7] + l * 1024;
    {   const int c0 = (tid & 15) * 8, j0 = tid >> 4;
#pragma unroll
        for (int qk = 0; qk < 2; ++qk) { if (qk == 0 && !need_q) continue;
            const int cc = (qk == 0 ? 0 : 512) + h * 128 + c0, ycol = (qk == 0 ? Y_DQ : Y_DK) + h * 128 + c0;
            v4u xw[2][4]; f32x4 w4[4][2], b4[2];
#pragma unroll
            for (int i = 0; i < 2; ++i)
#pragma unroll
                for (int jj = 0; jj < 4; ++jj) { const int j = j0 + 32 * i, rel = j - 3 + jj, ok = (n * 64 + rel) >= 0; xw[i][jj] = *(const v4u*)(Y + (t0 + (ok ? rel : j)) * YP + ycol); }
#pragma unroll
            for (int jj = 0; jj < 4; ++jj) { w4[jj][0] = *(const f32x4*)(cw + jj * 1024 + cc); w4[jj][1] = *(const f32x4*)(cw + jj * 1024 + cc + 4); }
            b4[0] = *(const f32x4*)(cb + cc); b4[1] = *(const f32x4*)(cb + cc + 4);
#pragma unroll
            for (int i = 0; i < 2; ++i) { const int j = j0 + 32 * i; float a[8] = {b4[0][0], b4[0][1], b4[0][2], b4[0][3], b4[1][0], b4[1][1], b4[1][2], b4[1][3]};
#pragma unroll
                for (int jj = 0; jj < 4; ++jj) { const float mk = (n * 64 + j - 3 + jj) >= 0 ? 1.f : 0.f; float x[8]; unpack8(xw[i][jj], x);
#pragma unroll
                    for (int k = 0; k < 8; ++k) a[k] += (w4[jj][k >> 2][k & 3] * mk) * x[k]; }
                const float sc = qk == 0 ? 1.f : 0.08838834764831845f;
#pragma unroll
                for (int k = 0; k < 8; ++k) a[k] = a[k] * fsigmoid(a[k]) * sc;
                v4u o; o.x = pk2(a[0], a[1]); o.y = pk2(a[2], a[3]); o.z = pk2(a[4], a[5]); o.w = pk2(a[6], a[7]); *(LAS v4u*)((qk == 0 ? Ql : Kl) + j * QP + c0 * 2) = o; } }
    }
    __syncthreads();
}
__device__ __forceinline__ void ml_local_unit(Ctx& C, int l, int u) {
    const int tid = C.tid, lane = C.lane, wave = C.wave, fr = lane & 15, fq = lane >> 4;
    const int n = u & 31, h = (u >> 5) & 3, b = u >> 7; const size_t t0 = (size_t)b * SEQ_ + n * 64;
    const bf16* Y = WSP(bf16, WS_Y);
    constexpr int KP = 288, TP = 288;
    LAS float* gl = (LAS float*)C.lds; LAS float* wk = gl + 128; LAS float* red = wk + 64;
    ldsp Kl = (ldsp)(red + 512), Vl = Kl + 64 * KP;
    ml_prep(C, l, h, b, n, gl, Kl, Kl, KP, false);
    if (tid < 64) { const float bl = gl[63], dec = bl - gl[lane] + gl[64 + lane], a = wave_max(dec); wk[lane] = __expf(dec - a);
        if (lane == 0) { float* SC = WSP(float, WS_MSC) + (size_t)u * 2; SC[0] = bl; SC[1] = a; } }
    __syncthreads();
    { const int d = tid & 127, sg = tid >> 7; float s = 0.f;
        for (int j = 16 * sg; j < 16 * sg + 16; ++j) s += wk[j] * bflo((unsigned)*(const LAS unsigned short*)(Kl + j * KP + d * 2));
        red[sg * 128 + d] = s; }
    {   const int c0 = (tid & 15) * 8, j0 = tid >> 4; v4u vw[2];
#pragma unroll
        for (int i = 0; i < 2; ++i) vw[i] = *(const v4u*)(Y + (t0 + j0 + 32 * i) * YP + Y_DV + h * 128 + c0);
#pragma unroll
        for (int i = 0; i < 2; ++i) *(LAS v4u*)(Vl + (j0 + 32 * i) * TP + c0 * 2) = vw[i];
    }
    __syncthreads();
    {   const int c0 = (tid & 15) * 8, j0 = tid >> 4;
#pragma unroll
        for (int i = 0; i < 2; ++i) { const int j = j0 + 32 * i; float x[8]; unpack8(*(const LAS v4u*)(Kl + j * KP + c0 * 2), x); const float w = wk[j];
            v4u o; o.x = pk2(x[0] * w, x[1] * w); o.y = pk2(x[2] * w, x[3] * w); o.z = pk2(x[4] * w, x[5] * w); o.w = pk2(x[6] * w, x[7] * w); *(LAS v4u*)(Kl + j * KP + c0 * 2) = o; }
    }
    if (tid < 128) WSP(float, WS_MNLOC)[(size_t)u * 128 + tid] = (red[tid] + red[128 + tid]) + (red[256 + tid] + red[384 + tid]);
    __syncthreads();
    float* LOC = WSP(float, WS_MLOC) + (size_t)u * 16384;
#pragma unroll
    for (int mt = 0; mt < 8; ++mt) { f32x4 acc = (f32x4){0.f, 0.f, 0.f, 0.f};
#pragma unroll
        for (int ks = 0; ks < 2; ++ks) acc = mfma16(trfrag2(Vl, TP, 16 * wave, 32 * ks, 32 * ks + 16, lane), trfrag2(Kl, KP, 16 * mt, 32 * ks, 32 * ks + 16, lane), acc);
        *(f32x4*)(LOC + (size_t)(16 * mt + fr) * 128 + 16 * wave + 4 * fq) = acc; }
    __syncthreads();
}
__device__ __forceinline__ void ml_scan(Ctx& C) {
    const float* LOC = WSP(float, WS_MLOC); const float* NL = WSP(float, WS_MNLOC); const float* SC = WSP(float, WS_MSC);
    bf16* MC = WSP(bf16, WS_MC); float* MN = WSP(float, WS_MN); float* MM = WSP(float, WS_MM);
    for (int i = C.bid * 512 + C.tid; i < 16 * (16384 + 128); i += C.G * 512) { const int bh = i / (16384 + 128), r = i % (16384 + 128); float S = 0.f, m = 0.f;
        float lc[32], bl_[32], a_[32];
#pragma unroll
        for (int n = 0; n < 32; ++n) { const size_t uu = (size_t)bh * 32 + n; lc[n] = r < 16384 ? LOC[uu * 16384 + r] : NL[uu * 128 + (r - 16384)]; bl_[n] = SC[uu * 2]; a_[n] = SC[uu * 2 + 1]; }
#pragma unroll
        for (int n = 0; n < 32; ++n) { const size_t uu = (size_t)bh * 32 + n; const float bl = bl_[n], a = a_[n], mn = fmaxf(bl + m, a), keep = __expf(bl + m - mn), sc = __expf(a - mn);
            if (r < 16384) MC[uu * 16384 + r] = bf1(S);
            else { const int d = r - 16384; MN[uu * 128 + d] = S; if (d == 0) MM[uu] = m; }
            S = keep * S + sc * lc[n]; m = mn; } }
}
__device__ __forceinline__ void ml_out_unit(Ctx& C, int l, int u, bf16* YM) {
    const int tid = C.tid, lane = C.lane, wave = C.wave, fr = lane & 15, fq = lane >> 4;
    const int n = u & 31, h = (u >> 5) & 3, b = u >> 7; const size_t t0 = (size_t)b * SEQ_ + n * 64;
    const bf16* Y = WSP(bf16, WS_Y); const bf16* MC = WSP(bf16, WS_MC) + (size_t)u * 16384; const float* MN = WSP(float, WS_MN) + (size_t)u * 128; const float m0 = WSP(float, WS_MM)[u];
    constexpr int QP = 272, TP = 288;
    LAS float* gl = (LAS float*)C.lds; LAS float* mt_ = gl + 128; LAS float* wst = mt_ + 64; LAS float* qn = wst + 64; LAS float* ssq = qn + 64;
    ldsp Ql = (ldsp)(ssq + 128), Kl = Ql + 64 * QP, Vl = Kl + 64 * QP, Cl = Vl + 64 * TP;
    ml_prep(C, l, h, b, n, gl, Ql, Kl, QP, true);
    if (tid < 64) { float pm = gl[64 + lane] - gl[lane];
#pragma unroll
        for (int o = 1; o < 64; o <<= 1) { const float v = __shfl_up(pm, o); if (lane >= o) pm = fmaxf(pm, v); }
        const float mt = gl[lane] + fmaxf(m0, pm); mt_[lane] = mt; wst[lane] = __expf(gl[lane] + m0 - mt); }
    {   const int c0 = (tid & 15) * 8, j0 = tid >> 4; v4u vw[2], cw4[4];
#pragma unroll
        for (int i = 0; i < 2; ++i) vw[i] = *(const v4u*)(Y + (t0 + j0 + 32 * i) * YP + Y_DV + h * 128 + c0);
#pragma unroll
        for (int i = 0; i < 4; ++i) cw4[i] = *(const v4u*)(MC + (j0 + 32 * i) * 128 + c0);
#pragma unroll
        for (int i = 0; i < 2; ++i) *(LAS v4u*)(Vl + (j0 + 32 * i) * TP + c0 * 2) = vw[i];
#pragma unroll
        for (int i = 0; i < 4; ++i) *(LAS v4u*)(Cl + (j0 + 32 * i) * TP + c0 * 2) = cw4[i];
    }
    { const int i = tid >> 3, d0 = (tid & 7) * 16; float s = 0.f;
#pragma unroll
        for (int k2 = 0; k2 < 2; ++k2) { float x[8]; unpack8(*(const LAS v4u*)(Ql + i * QP + (d0 + 8 * k2) * 2), x);
#pragma unroll
            for (int k = 0; k < 8; ++k) s += x[k] * MN[d0 + 8 * k2 + k]; }
        s += __shfl_xor(s, 1); s += __shfl_xor(s, 2); s += __shfl_xor(s, 4);
        if ((tid & 7) == 0) qn[i] = s; }
    __syncthreads();
    const int mt = wave & 3, nh = wave >> 2, i = 16 * mt + fr;
    bf16x8 qa[4];
#pragma unroll
    for (int ks = 0; ks < 4; ++ks) qa[ks] = frag(Ql, QP, i, 32 * ks, fq);
    const float bi_ = gl[i], mti = mt_[i], wsti = wst[i];
    f32x4 sc[4]; float rsum = 0.f;
#pragma unroll
    for (int t = 0; t < 4; ++t) { sc[t] = (f32x4){0.f, 0.f, 0.f, 0.f};
#pragma unroll
        for (int ks = 0; ks < 4; ++ks) sc[t] = mfma16(frag(Kl, QP, 16 * t + fr, 32 * ks, fq), qa[ks], sc[t]);
#pragma unroll
        for (int e = 0; e < 4; ++e) { const int j = 16 * t + 4 * fq + e; const float w = (j <= i) ? __expf(bi_ - gl[j] + gl[64 + j] - mti) : 0.f; sc[t][e] *= w; rsum += sc[t][e]; } }
    rsum += __shfl_xor(rsum, 16); rsum += __shfl_xor(rsum, 32);
    const float den = rsum + wsti * qn[i], rden = 1.f / fmaxf(fabsf(den), __expf(-mti));
    const bf16x8 p0 = pfrag(sc[0], sc[1]), p1 = pfrag(sc[2], sc[3]);
    f32x4 o[4]; float sq = 0.f;
    const size_t t = t0 + i;
#pragma unroll
    for (int nt = 0; nt < 4; ++nt) { const int ec = 64 * nh + 16 * nt; f32x4 a1 = (f32x4){0.f, 0.f, 0.f, 0.f}, a2 = a1;
        a1 = mfma16(trfrag2(Vl, TP, ec, 0, 16, lane), p0, a1); a1 = mfma16(trfrag2(Vl, TP, ec, 32, 48, lane), p1, a1);
#pragma unroll
        for (int ks = 0; ks < 4; ++ks) a2 = mfma16(trfrag(Cl, TP, ec, 32 * ks, lane), qa[ks], a2);
        const v2u ow = *(const v2u*)(Y + t * YP + Y_DO + h * 128 + 64 * nh + 16 * nt + 4 * fq);
        f32x4 hv = (a1 + a2 * wsti) * rden; hv[0] *= fsigmoid(bflo(ow.x)); hv[1] *= fsigmoid(bfhi(ow.x)); hv[2] *= fsigmoid(bflo(ow.y)); hv[3] *= fsigmoid(bfhi(ow.y));
        o[nt] = hv; sq += (hv[0] * hv[0] + hv[1] * hv[1]) + (hv[2] * hv[2] + hv[3] * hv[3]); }
    sq += __shfl_xor(sq, 16); sq += __shfl_xor(sq, 32);
    if (fq == 0) ssq[2 * i + nh] = sq;
    __syncthreads();
    const float rs = 1.f / sqrtf((ssq[2 * i] + ssq[2 * i + 1]) * (1.f / 128.f) + LN_EPS_);
    const float* ng = C.in[10] + l * 512 + h * 128;
#pragma unroll
    for (int nt = 0; nt < 4; ++nt) { const int e = 64 * nh + 16 * nt + 4 * fq; const f32x4 gv = *(const f32x4*)(ng + e);
        v2u w; w.x = pk2(o[nt][0] * rs * gv[0], o[nt][1] * rs * gv[1]); w.y = pk2(o[nt][2] * rs * gv[2], o[nt][3] * rs * gv[3]);
        *(v2u*)(YM + t * 2048 + YM_D + h * 128 + e) = w; }
    __syncthreads();
}

#ifndef MIXREP
#define MIXREP 0
#endif
#define RELAUNDER(C) do { int zv_ = 0; asm volatile("" : "+v"(zv_)); unsigned long long zw_ = (unsigned long long)(C).ws; asm volatile("" : "+s"(zw_)); (C).ws = (unsigned char*)(GAS unsigned char*)zw_;     \
    (C).tid = (int)threadIdx.x + zv_; (C).lane = (C).tid & 63; (C).wave = __builtin_amdgcn_readfirstlane((C).tid >> 6); } while (0)
__device__ __forceinline__ void phase_mix_a(Ctx& C, int l, bf16* YM) {
    const bool std_grid = C.G == 256;
    if (std_grid) {
        const int nd = C.bid < 128 ? 2 : 4, d0 = C.bid < 128 ? C.bid : 256 + (C.bid - 128);
        for (int k = 0; k < nd; ++k) { RELAUNDER(C); const int u = d0 + 128 * k; dil_unit(C, u); if (MIXREP & 1) dil_unit(C, u); }
    } else for (int u = C.bid; u < 768; u += C.G) { RELAUNDER(C); dil_unit(C, u); }
    for (int u = C.bid; u < 384; u += C.G) { RELAUNDER(C); sgu_unit(C, l, u, YM); if (MIXREP & 2) sgu_unit(C, l, u, YM); }
    for (int u = C.bid; u < 512; u += C.G) { RELAUNDER(C); gla_local_unit(C, l, u); if (MIXREP & 4) gla_local_unit(C, l, u); }
    for (int u = C.bid; u < 512; u += C.G) { RELAUNDER(C); ml_local_unit(C, l, u); if (MIXREP & 8) ml_local_unit(C, l, u); }
}
__device__ __forceinline__ void phase_mix_b(Ctx& C, bf16* YM) { gla_scan(C); ml_scan(C); dil_merge(C, YM); }
__device__ __forceinline__ void phase_mix_c(Ctx& C, int l, bf16* YM) {
    for (int u = C.bid; u < 1024; u += C.G) { RELAUNDER(C); if (u < 512) { gla_out_unit(C, l, u, YM); if (MIXREP & 16) gla_out_unit(C, l, u, YM); } else { ml_out_unit(C, l, u - 512, YM); if (MIXREP & 32) ml_out_unit(C, l, u - 512, YM); } }
}
#ifndef EARLY_WIN
#define EARLY_WIN 0
#endif
#ifndef STEAL_ON
#define STEAL_ON 0
#endif
#ifndef Y_WGM
#define Y_WGM 8
#endif
#ifndef NCONV
#define NCONV 72
#endif
#ifndef REPEAT_MASK
#define REPEAT_MASK 0
#endif
#define REP(k) (((REPEAT_MASK) >> (k)) & 1)
#define RELAUNDER_T(C) do { int zv_ = 0; asm volatile("" : "+v"(zv_)); (C).tid = (int)threadIdx.x + zv_; (C).lane = (C).tid & 63; (C).wave = __builtin_amdgcn_readfirstlane((C).tid >> 6); } while (0)
#define IN(k) (lo <= (k) && (k) < hi)
#define SEAM(k) do { if (IN(k) && IN((k) + 1)) xcd_barrier(bar); } while (0)
#define STEAL(k) do { if (STEAL_ON && FP8_LAST && l + 2 == NL_ && IN(k) && IN((k) + 1)) { unsigned* arr_ = WSP(unsigned, WS_CTL) + CW_ARR + 64 * (k); __syncthreads(); if (C.tid == 0) atomicAdd(arr_, 1u); \
        phase_convert(C, l + 1, 1, C.bid, C.G, arr_); } } while (0)
template <int l>
__device__ __forceinline__ void layer_program(Ctx& C, const XcdBarrier& bar, const int lo, const int hi) {
    constexpr int p0 = l * 12;
    const float* Xin = l == 0 ? C.in[0] : WSP(float, WS_XA);
    if (l == 0) { if (IN(p0 + 0)) for (int rep_ = 0; rep_ < 1 + REP(0); ++rep_) { RELAUNDER_T(C); phase_convert(C, l, 0, C.bid, C.G); }
        SEAM(p0 + 0); }
    if (IN(p0 + 1)) for (int rep_ = 0; rep_ < 1 + REP(1); ++rep_) { RELAUNDER_T(C);
        if (C.bid < NCONV) phase_convert(C, l, 1, C.bid, NCONV);
        else {
        if constexpr (GATES8(l)) {
            { pg8::Gemm g{WSP(bf16, WS_XB), WSP(bf16, WS_WIN), T_, 7680, 2048, 2048, 2048, nullptr}; pg8::StaticOrder S; S.init(T_, 7680, C.G - NCONV, C.bid - NCONV, Y_WGM);
              EpiY E{WSP(bf16, WS_Y), WSP(float, WS_YSM), 0}; pg8::gemm_phase<EpiY, pg8::StaticOrder, true>(C.lds, g, S, E, C.tid); }
            { pg8::Gemm g{WSP(bf16, WS_XB8), WSP(bf16, WS_WIN8), T_, 8192, 1024, 1024, 1024, nullptr}; pg8::StaticOrder S; S.init(T_, 8192, C.G - NCONV, C.bid - NCONV, Y_WGM);
              EpiY E{WSP(bf16, WS_Y), WSP(float, WS_YSM), 30}; pg8::gemm_phase<EpiY, pg8::StaticOrder, true, false, 2, 1>(C.lds, g, S, E, C.tid); }
        } else {
        pg8::Gemm g{WSP(bf16, WS_XB), WSP(bf16, WS_WIN), T_, YP, 2048, 2048, 2048, nullptr}; pg8::StaticOrder S; S.init(T_, YP, C.G - NCONV, C.bid - NCONV, Y_WGM);
        EpiY E{WSP(bf16, WS_Y), WSP(float, WS_YSM), 0};
        pg8::gemm_phase<EpiY, pg8::StaticOrder, true>(C.lds, g, S, E, C.tid); }
        phase_convert(C, l, 1, C.bid, NCONV); }
    }
    SEAM(p0 + 1);
    bf16* YMo = WSP(bf16, MK_MODE == 1 ? WS_MRG : WS_YM);
    if (IN(p0 + 2)) for (int rep_ = 0; rep_ < 1 + REP(2); ++rep_) { RELAUNDER_T(C); phase_mix_a(C, l, YMo); }
    SEAM(p0 + 2);
    if (IN(p0 + 3)) for (int rep_ = 0; rep_ < 1 + REP(3); ++rep_) { RELAUNDER_T(C); phase_mix_b(C, YMo); }
    SEAM(p0 + 3);
    if (IN(p0 + 4)) for (int rep_ = 0; rep_ < 1 + REP(4); ++rep_) { RELAUNDER_T(C); phase_mix_c(C, l, YMo); }
    SEAM(p0 + 4);
    if (IN(p0 + 5)) for (int rep_ = 0; rep_ < 1 + REP(5); ++rep_) { RELAUNDER_T(C);
        pg8::StaticOrder S; S.init(T_, 4096, C.G, C.bid);
        pg8::Gemm g{WSP(bf16, WS_YM), WSP(bf16, WS_WP), T_, 2048, 2048, 2048, 2048, nullptr}; EpiMerge E; E.Y = WSP(bf16, WS_Y); E.MB = WSP(bf16, WS_MB);
        if (MERGE3) pg8::gemm_phase_n1s3<EpiMerge, pg8::StaticOrder>(C.lds, g, S, E, C.tid); else pg8::gemm_phase<EpiMerge, pg8::StaticOrder, true, false, 1>(C.lds, g, S, E, C.tid);
    }
    SEAM(p0 + 5);
    if (IN(p0 + 6)) for (int rep_ = 0; rep_ < 1 + REP(6); ++rep_) { RELAUNDER_T(C);
        pg8::Gemm g{WSP(bf16, WS_MB), WSP(bf16, WS_WOUT), T_, 2048, 2048, 2048, 2048, nullptr}; pg8::StaticOrder S; S.init(T_, 2048, C.G, C.bid);
        EpiOut E{Xin, WSP(float, WS_HB)};
        pg8::gemm_phase<EpiOut, pg8::StaticOrder, true>(C.lds, g, S, E, C.tid);
    }
    SEAM(p0 + 6);
    if (IN(p0 + 7)) for (int rep_ = 0; rep_ < 1 + REP(7); ++rep_) { RELAUNDER_T(C); phase_ln1_router(C, l); }
    SEAM(p0 + 7);
    if (IN(p0 + 8)) for (int rep_ = 0; rep_ < 1 + REP(8); ++rep_) { RELAUNDER_T(C); phase_scatter(C, l); }
    SEAM(p0 + 8);
    if (IN(p0 + 9)) for (int rep_ = 0; rep_ < 1 + REP(9); ++rep_) { RELAUNDER_T(C);
        MoeOrder S; S.init(WSP(int, WS_CTL) + CW_TST + l * 128, 4, C.G, C.bid, C.lane);
        if constexpr (MOE8(l)) {
            pg8::Gemm g{WSP(bf16, WS_XS8), WSP(bf16, l == NL_ - 1 ? WS_W13B : WS_W13), MAXROWS, 65 * 1024, 1024, 1024, 1024, WSP(int, WS_ROWMAP)};
            EpiMoe1F8 E{WSP(unsigned char, WS_H), WSP(float, WS_ROWW)};
            pg8::gemm_phase<EpiMoe1F8, MoeOrder, true, true, 2, 1>(C.lds, g, S, E, C.tid);
        } else {
            pg8::Gemm g{WSP(bf16, WS_XS), WSP(bf16, WS_W13), MAXROWS, 65 * 1024, 2048, 2048, 2048, WSP(int, WS_ROWMAP)};
            EpiMoe1 E{WSP(bf16, WS_H), WSP(float, WS_ROWW), 4};
            pg8::gemm_phase<EpiMoe1, MoeOrder, true, true>(C.lds, g, S, E, C.tid);
        }
    }
    if (STEAL_ON & 1) STEAL(p0 + 9);
    SEAM(p0 + 9);
    if (IN(p0 + 10)) for (int rep_ = 0; rep_ < 1 + REP(10); ++rep_) { RELAUNDER_T(C);
        MoeOrder S; S.init(WSP(int, WS_CTL) + CW_TST + l * 128, 8, C.G, C.bid, C.lane);
        EpiMoe2 E{WSP(bf16, WS_YBUF)};
        if constexpr (MOE8(l)) {
            pg8::Gemm g{WSP(bf16, WS_H), WSP(bf16, l == NL_ - 1 ? WS_W2B : WS_W2), MAXROWS, 65 * 2048, 256, 256, 256, nullptr};
            pg8::gemm_phase<EpiMoe2, MoeOrder, true, false, 2, 1>(C.lds, g, S, E, C.tid);
        } else {
            pg8::Gemm g{WSP(bf16, WS_H), WSP(bf16, WS_W2), MAXROWS, 65 * 2048, 512, 512, 512, nullptr};
            pg8::gemm_phase<EpiMoe2, MoeOrder, true>(C.lds, g, S, E, C.tid);
        }
        if (EARLY_WIN && l + 1 < NL_ && !REP(10)) phase_convert(C, l + 1, 0, C.bid, C.G);
    }
    if (STEAL_ON & 2) STEAL(p0 + 10);
    SEAM(p0 + 10);
    if (IN(p0 + 11)) for (int rep_ = 0; rep_ < 1 + REP(11); ++rep_) { RELAUNDER_T(C); phase_combine(C, l); if (l + 1 < NL_) phase_convert(C, l + 1, 0, C.bid, C.G); }
    if (STEAL_ON & 4) STEAL(p0 + 11);
    SEAM(p0 + 11);
}
__global__ void __launch_bounds__(512, 2) fwd(KArgs args) {
    extern __shared__ __attribute__((aligned(16))) unsigned char lds_[];
    Ctx C;
    C.lds = (LAS unsigned char*)lds_; C.ws = args.ws; C.out = args.out;
#pragma unroll
    for (int i = 0; i < 32; ++i) C.in[i] = args.in[i];
    C.tid = threadIdx.x; C.lane = C.tid & 63; C.wave = __builtin_amdgcn_readfirstlane(C.tid >> 6); C.G = gridDim.x; C.bid = blockIdx.x;
    const int lo = args.ph_lo, hi = args.ph_hi;
    if (C.tid < 4) ((LAS unsigned*)(C.lds + AUX_BARW))[C.tid] = 0u;
    __syncthreads();
    XcdBarrier bar; bar.bar = WSP(unsigned, WS_CTL) + CW_BAR + args.region * XCD_BAR_WORDS; bar.x = 0; bar.st = (volatile LAS unsigned*)(C.lds + AUX_BARW);
    if (hi - lo > 1) bar = xcd_barrier_post(bar.bar, (volatile LAS unsigned*)(C.lds + AUX_BARW));
    layer_program<0>(C, bar, lo, hi);
    layer_program<1>(C, bar, lo, hi);
}
#undef IN
#undef SEAM

#define NIDX (blockIdx.x * blockDim.x + threadIdx.x)
__global__ void __launch_bounds__(256) nk_gla_g(const float* YSM, const float* wa2, const float* ba, float* GG) { const int i = NIDX; if (i < T_ * 256) naive_gla_g(i >> 8, i & 255, YSM, wa2, ba, GG); }
__global__ void __launch_bounds__(64) nk_gla_rec(const bf16* Y, const float* GG, float* OA) { const int i = NIDX; if (i < 2048) naive_gla_rec(i >> 9, (i >> 7) & 3, i & 127, SEQ_, Y, GG, OA); }
__global__ void __launch_bounds__(256) nk_gla_post(const bf16* Y, const float* OA, const float* ng, bf16* YM) { const int i = NIDX; if (i < T_ * 4) naive_gla_post(i >> 2, i & 3, Y, OA, ng, YM); }
__global__ void __launch_bounds__(256) nk_rope(const bf16* Y, const int* pos, float* QR, float* KR) { const int i = NIDX; if (i < T_ * 384) naive_rope(i / 384, (i % 384) >> 5, i & 31, Y, pos, QR, KR); }
__global__ void __launch_bounds__(64) nk_dil(const float* QR, const float* KR, const bf16* Y, bf16* YM) { const int i = NIDX; if (i < T_ * 4) naive_dil(i >> 2, i & 3, SEQ_, QR, KR, Y, YM); }
__global__ void __launch_bounds__(256) nk_sgu_stats(const bf16* Y, float* MU, float* RS) { const int i = NIDX; if (i < T_) naive_sgu_stats(i, Y, MU, RS); }
__global__ void __launch_bounds__(256) nk_sgu_out(const bf16* Y, const float* MU, const float* RS, const float* lg, const float* lb, const float* ws, const float* bs, bf16* YM) { const int i = NIDX; if (i < T_ * 768) naive_sgu_out(i / 768, i % 768, SEQ_, Y, MU, RS, lg, lb, ws, bs, YM); }
__global__ void __launch_bounds__(256) nk_ml_conv(const bf16* Y, const float* cw, const float* cb, float* QKC) { const int i = NIDX; if (i < T_ * 1024) naive_ml_conv(i >> 10, i & 1023, SEQ_, Y, cw, cb, QKC); }
__global__ void __launch_bounds__(64) nk_ml_den(const float* YSM, const float* QKC, const float* bi, const float* bf_, float* DEN) { const int i = NIDX; if (i < 16) naive_ml_den(i >> 2, i & 3, SEQ_, YSM, QKC, bi, bf_, DEN); }
__global__ void __launch_bounds__(64) nk_ml_rec(const bf16* Y, const float* YSM, const float* QKC, const float* bi, const float* bf_, const float* DEN, float* HM) { const int i = NIDX; if (i < 2048) naive_ml_rec(i >> 9, (i >> 7) & 3, i & 127, SEQ_, Y, YSM, QKC, bi, bf_, DEN, HM); }
__global__ void __launch_bounds__(256) nk_ml_post(const float* HM, const float* ng, bf16* YM) { const int i = NIDX; if (i < T_ * 4) naive_ml_post(i >> 2, i & 3, HM, ng, YM); }

constexpr int CW_DBG = 12288;
__global__ void __launch_bounds__(256) nk_compare(const bf16* YMn, const bf16* YMf, float* acc) {
    const int i = NIDX; if (i >= T_ * 256) return;
    const int t = i >> 8, c8 = (i & 255) * 8, br = c8 < 512 ? 0 : (c8 < 768 ? 1 : (c8 < 1536 ? 2 : 3));
    const v4u a = *(const v4u*)(YMn + (size_t)t * 2048 + c8), b = *(const v4u*)(YMf + (size_t)t * 2048 + c8);
    const unsigned aw[4] = {a.x, a.y, a.z, a.w}, bw[4] = {b.x, b.y, b.z, b.w}; float sd = 0.f, sn = 0.f;
#pragma unroll
    for (int k = 0; k < 4; ++k) { const float x0 = bflo(aw[k]), x1 = bfhi(aw[k]), y0 = bflo(bw[k]), y1 = bfhi(bw[k]); float d0 = y0 - x0, d1 = y1 - x1;
        if (!(d0 == d0)) d0 = 1e3f; if (!(d1 == d1)) d1 = 1e3f; sd += d0 * d0 + d1 * d1; sn += x0 * x0 + x1 * x1; }
#pragma unroll
    for (int o = 1; o < 32; o <<= 1) { sd += __shfl_xor(sd, o); sn += __shfl_xor(sn, o); }
    if ((threadIdx.x & 31) == 0) { atomicAdd(acc + br * 2, sd); atomicAdd(acc + br * 2 + 1, sn); }
}
__global__ void __launch_bounds__(256) nk_scale(float* out, const float* acc, int mask) {
    float d2 = 0.f;
    for (int br = 0; br < 4; ++br) if ((mask >> br) & 1) d2 += 100.f * acc[br * 2] / fmaxf(acc[br * 2 + 1], 1e-20f);
    const float s = 1.f + sqrtf(fminf(d2, 100.f));
    const int i = NIDX; if (i < T_ * D_ / 4) { f32x4 v = *(f32x4*)(out + (size_t)i * 4); *(f32x4*)(out + (size_t)i * 4) = v * s; }
}
#ifndef DBG_MASK
#define DBG_MASK 15
#endif
static void launch_fwd(void* const* d_in, void* d_out, void* d_ws, hipStream_t stream, int grid, int lo, int hi, int region) {
    KArgs a{};
    for (int i = 0; i < 32; ++i) a.in[i] = (const float*)d_in[i];
    a.out = (float*)d_out; a.ws = (unsigned char*)d_ws; a.ph_lo = lo; a.ph_hi = hi; a.region = region; a.pad = 0;
    hipLaunchKernelGGL(fwd, dim3(grid), dim3(512), LDS_BYTES, stream, a);
}
extern "C" void kernel_launch(void* const* d_in, const int* in_sizes, int n_in, void* d_out, int out_size, void* d_ws, size_t ws_size, hipStream_t stream) {
    static int grid = 0;
    if (grid == 0) {
        if (n_in != 32 || out_size != T_ * D_ || ws_size < WS_END) { fprintf(stderr, "kernel_launch: unexpected shapes: n_in %d out %d ws %zu (need %zu)\n", n_in, out_size, ws_size, (size_t)WS_END); grid = -1; return; }
        int dev = 0, cus = 0, per_cu = 0;
        if (hipGetDevice(&dev) != hipSuccess || hipDeviceGetAttribute(&cus, hipDeviceAttributeMultiprocessorCount, dev) != hipSuccess) { grid = -1; return; }
        if (hipFuncSetAttribute((const void*)fwd, hipFuncAttributeMaxDynamicSharedMemorySize, LDS_BYTES) != hipSuccess) { fprintf(stderr, "kernel_launch: hipFuncSetAttribute failed\n"); grid = -1; return; }
        if (hipOccupancyMaxActiveBlocksPerMultiprocessor(&per_cu, (const void*)fwd, 512, LDS_BYTES) != hipSuccess || per_cu < 1) fprintf(stderr, "kernel_launch: occupancy query reports %d blocks per CU\n", per_cu);
        (void)hipGetLastError();
        grid = cus;
    }
    if (grid < 0) return;
    (void)hipMemsetAsync((char*)d_ws + WS_CTL, 0, CTL_ZERO_BYTES, stream);
    int region = 0;
#if MK_MODE == 3
    launch_fwd(d_in, d_out, d_ws, stream, grid, 0, 24, region++);
#else
    unsigned char* ws = (unsigned char*)d_ws;
    const bf16* Y = (const bf16*)(ws + WS_Y); const float* YSM = (const float*)(ws + WS_YSM); bf16* YM = (bf16*)(ws + WS_YM);
    float* GG = (float*)(ws + WS_NV); float* OA = (float*)(ws + WS_NV + 8 * MiB); float* QR = (float*)(ws + WS_NV + 24 * MiB); float* KR = (float*)(ws + WS_NV + 48 * MiB);
    float* MU = (float*)(ws + WS_NV + 72 * MiB); float* RS = MU + T_; float* QKC = (float*)(ws + WS_NV + 73 * MiB); float* DEN = (float*)(ws + WS_NV + 105 * MiB); float* HM = (float*)(ws + WS_NV + 106 * MiB);
    float* dbg = (float*)ws + CW_DBG;
    const float* f[32]; for (int i = 0; i < 32; ++i) f[i] = (const float*)d_in[i];
    for (int l = 0; l < NL_; ++l) {
        const int p0 = l * 12;
        launch_fwd(d_in, d_out, d_ws, stream, grid, p0 + 0, p0 + 1, region++);
        launch_fwd(d_in, d_out, d_ws, stream, grid, p0 + 1, p0 + 2, region++);
        if (MK_MODE == 0 || MK_MODE == 1) {
            hipLaunchKernelGGL(nk_gla_g, dim3(T_ * 256 / 256), dim3(256), 0, stream, YSM, f[3] + l * 16 * 256, f[4] + l * 256, GG);
            hipLaunchKernelGGL(nk_gla_rec, dim3(32), dim3(64), 0, stream, Y, GG, OA);
            hipLaunchKernelGGL(nk_gla_post, dim3(T_ * 4 / 256), dim3(256), 0, stream, Y, OA, f[5] + l * 512, YM);
            hipLaunchKernelGGL(nk_rope, dim3(T_ * 384 / 256), dim3(256), 0, stream, Y, (const int*)d_in[1], QR, KR);
            hipLaunchKernelGGL(nk_dil, dim3(T_ * 4 / 64), dim3(64), 0, stream, QR, KR, Y, YM);
            hipLaunchKernelGGL(nk_sgu_stats, dim3(T_ / 256), dim3(256), 0, stream, Y, MU, RS);
            hipLaunchKernelGGL(nk_sgu_out, dim3(T_ * 768 / 256), dim3(256), 0, stream, Y, MU, RS, f[11] + l * 768, f[12] + l * 768, f[13] + l * 6 * 128 * 128, f[14] + l * 6 * 128, YM);
            hipLaunchKernelGGL(nk_ml_conv, dim3(T_ * 1024 / 256), dim3(256), 0, stream, Y, f[6] + l * 4 * 1024, f[7] + l * 1024, QKC);
            hipLaunchKernelGGL(nk_ml_den, dim3(1), dim3(64), 0, stream, YSM, QKC, f[8] + l * 4, f[9] + l * 4, DEN);
            hipLaunchKernelGGL(nk_ml_rec, dim3(32), dim3(64), 0, stream, Y, YSM, QKC, f[8] + l * 4, f[9] + l * 4, DEN, HM);
            hipLaunchKernelGGL(nk_ml_post, dim3(T_ * 4 / 256), dim3(256), 0, stream, HM, f[10] + l * 512, YM);
        }
        if (MK_MODE == 1 || MK_MODE == 2) for (int ph = 2; ph < 5; ++ph) launch_fwd(d_in, d_out, d_ws, stream, grid, p0 + ph, p0 + ph + 1, region++);
        if (MK_MODE == 1) hipLaunchKernelGGL(nk_compare, dim3(T_ * 256 / 256), dim3(256), 0, stream, (const bf16*)YM, (const bf16*)(ws + WS_MRG), dbg);
        for (int ph = 5; ph < 12; ++ph) launch_fwd(d_in, d_out, d_ws, stream, grid, p0 + ph, p0 + ph + 1, region++);
    }
    if (MK_MODE == 1) hipLaunchKernelGGL(nk_scale, dim3(T_ * D_ / 4 / 256), dim3(256), 0, stream, (float*)d_out, (const float*)dbg, (int)DBG_MASK);
#endif
}
```

```cpp
#include <hip/hip_runtime.h>
#include <cstdio>
#include <cstdint>
#include <cmath>
#define MK_MODE 3
#define REPEAT_MASK 0
#define HD __device__
#ifndef HD
#define HD
#endif
#define YP 15872
#define Y_AQ 256
#define Y_AK 512
#define Y_AV 3328
#define Y_AR 5120
#define Y_BQ 768
#define Y_BK 1536
#define Y_BV 3840
#define Y_CU 5632
#define Y_CV 6400
#define Y_DQ 2304
#define Y_DK 2816
#define Y_DV 4608
#define Y_DO 7168
#define Y_G  7680
#define YM_A 0
#define YM_B 512
#define YM_C 768
#define YM_D 1536
typedef unsigned short u16;
HD static inline float bf2f(u16 v) { unsigned u = ((unsigned)v) << 16; float f; __builtin_memcpy(&f, &u, 4); return f; }
HD static inline u16 f2bf(float f) { unsigned u; __builtin_memcpy(&u, &f, 4); u += 0x7fffu + ((u >> 16) & 1u); return (u16)(u >> 16); }
HD static inline float sigmoidf_(float x) { return 1.f / (1.f + expf(-x)); }
HD static inline float logsigmoidf_(float x) { return x < 0.f ? x - log1pf(expf(x)) : -log1pf(expf(-x)); }
HD static inline float siluf_(float x) { return x * sigmoidf_(x); }
HD static inline float geluf_(float x) { return 0.5f * x * (1.f + erff(x * 0.70710678118654752f)); }

HD static inline void naive_gla_g(int tok, int c, const float* YSM, const float* wa2, const float* ba, float* GG) {
    float s = ba[c];
    for (int r = 0; r < 16; ++r) s += YSM[tok * 32 + r] * wa2[r * 256 + c];
    GG[(size_t)tok * 256 + c] = logsigmoidf_(s) * (1.f / 16.f);
}
HD static inline void naive_gla_rec(int b, int h, int e, int S_, const u16* Y, const float* GG, float* OA) {
    float St[64];
#pragma unroll
    for (int d = 0; d < 64; ++d) St[d] = 0.f;
    for (int t = 0; t < S_; ++t) {
        const size_t tok = (size_t)b * S_ + t;
        const float v = bf2f(Y[tok * YP + Y_AV + h * 128 + e]);
        float o = 0.f;
#pragma unroll
        for (int d = 0; d < 64; ++d) {
            const float a = expf(GG[tok * 256 + h * 64 + d]);
            const float k = bf2f(Y[tok * YP + Y_AK + h * 64 + d]);
            const float q = bf2f(Y[tok * YP + Y_AQ + h * 64 + d]) * 0.125f;
            St[d] = a * St[d] + k * v;
            o += q * St[d];
        }
        OA[tok * 512 + h * 128 + e] = o;
    }
}
HD static inline void naive_gla_post(int tok, int h, const u16* Y, const float* OA, const float* norm_g, u16* YM) {
    float ss = 0.f;
    for (int e = 0; e < 128; ++e) { const float o = OA[(size_t)tok * 512 + h * 128 + e]; ss += o * o; }
    const float rs = 1.f / sqrtf(ss * (1.f / 128.f) + 1e-5f);
    for (int e = 0; e < 128; ++e) {
        const float o = OA[(size_t)tok * 512 + h * 128 + e] * rs * norm_g[h * 128 + e];
        const float r = bf2f(Y[(size_t)tok * YP + Y_AR + h * 128 + e]);
        YM[(size_t)tok * 2048 + YM_A + h * 128 + e] = f2bf(o * siluf_(r));
    }
}
HD static inline void naive_rope(int tok, int head, int i, const u16* Y, const int* positions, float* QR, float* KR) {
    const float inv = powf(10000.0f, -(float)i * 2.0f / 64.0f);
    const float ang = (float)positions[tok] * inv;
    const float c = cosf(ang), s = sinf(ang);
    const size_t yb = (size_t)tok * YP;
    const float q1 = bf2f(Y[yb + Y_BQ + head * 64 + i]), q2 = bf2f(Y[yb + Y_BQ + head * 64 + 32 + i]);
    const float k1 = bf2f(Y[yb + Y_BK + head * 64 + i]), k2 = bf2f(Y[yb + Y_BK + head * 64 + 32 + i]);
    QR[(size_t)tok * 768 + head * 64 + i] = q1 * c - q2 * s; QR[(size_t)tok * 768 + head * 64 + 32 + i] = q2 * c + q1 * s;
    KR[(size_t)tok * 768 + head * 64 + i] = k1 * c - k2 * s; KR[(size_t)tok * 768 + head * 64 + 32 + i] = k2 * c + k1 * s;
}
HD static inline void naive_dil(int tok, int hh, int S_, const float* QR, const float* KR, const u16* Y, u16* YM) {
    const int b = tok / S_, s = tok % S_;
    float o[64];
#pragma unroll
    for (int d = 0; d < 64; ++d) o[d] = 0.f;
    float mx = -INFINITY, den = 0.f;
    for (int g = 0; g < 3; ++g) {
        const int dil = g == 0 ? 1 : (g == 1 ? 4 : 16), head = g * 4 + hh;
        const int m = s / dil;
        for (int j = 0; j <= 128; ++j) {
            if (m - j < 0) break;
            const size_t kt = (size_t)b * S_ + (s - j * dil);
            float sc = 0.f;
#pragma unroll
            for (int d = 0; d < 64; ++d) sc += QR[(size_t)tok * 768 + head * 64 + d] * KR[kt * 768 + head * 64 + d];
            sc *= 0.125f;
            const float nm = fmaxf(mx, sc), corr = expf(mx - nm), p = expf(sc - nm);
            den = den * corr + p;
#pragma unroll
            for (int d = 0; d < 64; ++d) o[d] = o[d] * corr + p * bf2f(Y[kt * YP + Y_BV + head * 64 + d]);
            mx = nm;
        }
    }
#pragma unroll
    for (int d = 0; d < 64; ++d) YM[(size_t)tok * 2048 + YM_B + hh * 64 + d] = f2bf(o[d] / den);
}
HD static inline void naive_sgu_stats(int tok, const u16* Y, float* MU, float* RS) {
    float s = 0.f;
    for (int c = 0; c < 768; ++c) s += geluf_(bf2f(Y[(size_t)tok * YP + Y_CV + c]));
    const float mu = s * (1.f / 768.f); float q = 0.f;
    for (int c = 0; c < 768; ++c) { const float d = geluf_(bf2f(Y[(size_t)tok * YP + Y_CV + c])) - mu; q += d * d; }
    MU[tok] = mu; RS[tok] = 1.f / sqrtf(q * (1.f / 768.f) + 1e-5f);
}
HD static inline void naive_sgu_out(int tok, int c, int S_, const u16* Y, const float* MU, const float* RS, const float* ln_g, const float* ln_b,
                                    const float* ws, const float* bs, u16* YM) {
    const int s = tok % S_, i = s % 128, t0 = tok - i, g = c / 128;
    float acc = 0.f;
    for (int j = 0; j <= i; ++j) {
        const float zv = geluf_(bf2f(Y[(size_t)(t0 + j) * YP + Y_CV + c]));
        const float vn = (zv - MU[t0 + j]) * RS[t0 + j] * ln_g[c] + ln_b[c];
        acc += ws[(g * 128 + i) * 128 + j] * vn;
    }
    const float zu = geluf_(bf2f(Y[(size_t)tok * YP + Y_CU + c]));
    YM[(size_t)tok * 2048 + YM_C + c] = f2bf(zu * (acc + bs[g * 128 + i]));
}
HD static inline void naive_ml_conv(int tok, int c, int S_, const u16* Y, const float* conv_w, const float* conv_b, float* QKC) {
    const int s = tok % S_; const int col = c < 512 ? Y_DQ + c : Y_DK + (c - 512);
    float a = conv_b[c];
    for (int j = 0; j < 4; ++j) { const int sp = s - 3 + j; if (sp >= 0) a += conv_w[j * 1024 + c] * bf2f(Y[(size_t)(tok - 3 + j) * YP + col]); }
    a = siluf_(a);
    QKC[(size_t)tok * 1024 + c] = c < 512 ? a : a * 0.08838834764831845f;
}
HD static inline void naive_ml_den(int b, int h, int S_, const float* YSM, const float* QKC, const float* b_i, const float* b_f, float* DEN) {
    float n[128];
#pragma unroll
    for (int d = 0; d < 128; ++d) n[d] = 0.f;
    for (int t = 0; t < S_; ++t) {
        const size_t tok = (size_t)b * S_ + t;
        const float f = sigmoidf_(YSM[tok * 32 + 20 + h] + b_f[h]), ig = expf(YSM[tok * 32 + 16 + h] + b_i[h]);
        float den = 0.f;
#pragma unroll
        for (int d = 0; d < 128; ++d) { n[d] = f * n[d] + ig * QKC[tok * 1024 + 512 + h * 128 + d]; den += QKC[tok * 1024 + h * 128 + d] * n[d]; }
        DEN[tok * 4 + h] = den;
    }
}
HD static inline void naive_ml_rec(int b, int h, int e, int S_, const u16* Y, const float* YSM, const float* QKC, const float* b_i, const float* b_f, const float* DEN, float* HM) {
    float C[128];
#pragma unroll
    for (int d = 0; d < 128; ++d) C[d] = 0.f;
    for (int t = 0; t < S_; ++t) {
        const size_t tok = (size_t)b * S_ + t;
        const float f = sigmoidf_(YSM[tok * 32 + 20 + h] + b_f[h]), ig = expf(YSM[tok * 32 + 16 + h] + b_i[h]);
        const float v = bf2f(Y[tok * YP + Y_DV + h * 128 + e]);
        float num = 0.f;
#pragma unroll
        for (int d = 0; d < 128; ++d) { C[d] = f * C[d] + ig * QKC[tok * 1024 + 512 + h * 128 + d] * v; num += QKC[tok * 1024 + h * 128 + d] * C[d]; }
        const float den = DEN[tok * 4 + h];
        const float hh = num / fmaxf(fabsf(den), 1.0f);
        HM[tok * 512 + h * 128 + e] = sigmoidf_(bf2f(Y[tok * YP + Y_DO + h * 128 + e])) * hh;
    }
}
HD static inline void naive_ml_post(int tok, int h, const float* HM, const float* norm_g, u16* YM) {
    float ss = 0.f;
    for (int e = 0; e < 128; ++e) { const float o = HM[(size_t)tok * 512 + h * 128 + e]; ss += o * o; }
    const float rs = 1.f / sqrtf(ss * (1.f / 128.f) + 1e-5f);
    for (int e = 0; e < 128; ++e) YM[(size_t)tok * 2048 + YM_D + h * 128 + e] = f2bf(HM[(size_t)tok * 512 + h * 128 + e] * rs * norm_g[h * 128 + e]);
}
HD static inline void route_token(const float* sc, const float* bias, int* idx, float* w) {
    unsigned gmask = 0u;
    float gs[8];
#pragma unroll
    for (int g = 0; g < 8; ++g) {
        float m1 = -INFINITY, m2 = -INFINITY;
        for (int j = 0; j < 8; ++j) { const float c = sc[g * 8 + j] + bias[g * 8 + j]; if (c > m1) { m2 = m1; m1 = c; } else if (c > m2) m2 = c; }
        gs[g] = m1 + m2;
    }
#pragma unroll
    for (int g = 0; g < 8; ++g) {
        int rank = 0;
#pragma unroll
        for (int g2 = 0; g2 < 8; ++g2) rank += (gs[g2] > gs[g] || (gs[g2] == gs[g] && g2 < g)) ? 1 : 0;
        if (rank < 4) gmask |= 1u << g;
    }
    int n = 0; float wsum = 0.f;
    for (int e = 0; e < 64; ++e) {
        if (!((gmask >> (e >> 3)) & 1u)) continue;
        const float c = sc[e] + bias[e]; int rank = 0;
        for (int e2 = 0; e2 < 64; ++e2) { if (!((gmask >> (e2 >> 3)) & 1u)) continue; const float c2 = sc[e2] + bias[e2]; rank += (c2 > c || (c2 == c && e2 < e)) ? 1 : 0; }
        if (rank < 8) { if (n < 8) { idx[n] = e; w[n] = sc[e]; wsum += sc[e]; } ++n; }
    }
    const float r = 2.5f / wsum;
    for (int k = 0; k < 8; ++k) w[k] *= r;
}

HD static inline bool route_lane_select(int lane, const float* sc, const float* bias) {
    float gs[8];
#pragma unroll
    for (int g = 0; g < 8; ++g) { float m1 = -INFINITY, m2 = -INFINITY;
#pragma unroll
        for (int j = 0; j < 8; ++j) { const float c = sc[g * 8 + j] + bias[g * 8 + j]; if (c > m1) { m2 = m1; m1 = c; } else if (c > m2) m2 = c; }
        gs[g] = m1 + m2; }
    unsigned gmask = 0u;
#pragma unroll
    for (int g = 0; g < 8; ++g) { int r = 0;
#pragma unroll
        for (int g2 = 0; g2 < 8; ++g2) r += (gs[g2] > gs[g] || (gs[g2] == gs[g] && g2 < g)) ? 1 : 0;
        if (r < 4) gmask |= 1u << g; }
    if (!((gmask >> (lane >> 3)) & 1u)) return false;
    const float myc = sc[lane] + bias[lane]; int rank = 0;
    for (int e = 0; e < 64; ++e) { const float c = sc[e] + bias[e]; rank += (((gmask >> (e >> 3)) & 1u) && (c > myc || (c == myc && e < lane))) ? 1 : 0; }
    return rank < 8;
}
namespace pg8 {
#define PG8_LAS __attribute__((address_space(3)))
typedef unsigned short bf16_t;
typedef short bf16x8 __attribute__((ext_vector_type(8)));
typedef float f32x4 __attribute__((ext_vector_type(4)));
typedef unsigned u32x4 __attribute__((ext_vector_type(4)));
typedef unsigned u32x2 __attribute__((ext_vector_type(2)));
typedef int i32x4 __attribute__((ext_vector_type(4)));
typedef int i32x8 __attribute__((ext_vector_type(8)));
constexpr int BM = 256, BK = 64, HALF = 128, HTB = HALF * BK * 2  , STAGE_BYTES = 8 * HTB, NXCD = 8, WGM = 8;

__host__ __device__ __forceinline__ int lds_byte(int r, int c) { const int st = (r >> 4) * 2 + (c >> 5), rr = r & 15, cc = c & 31, ob = rr * 64 + cc * 2; return st * 1024 + (ob ^ (((ob >> 9) & 1) << 5)); }
__host__ __device__ __forceinline__ void stage_rc(int b, int& R, int& C) { const int st = b / 1024, sb = b % 1024, swz = sb ^ (((sb >> 9) & 1) << 5); R = (st >> 1) * 16 + swz / 64; C = (st & 1) * 32 + (swz % 64) / 2; }
__host__ __device__ __forceinline__ int perm32(int rho) { const int n = rho >> 4, i = rho & 15; return 8 * (i >> 2) + 4 * n + (i & 3); }

struct Unit { int pm, pn, aux; };
struct Gemm { const bf16_t* A; const bf16_t* Bt; int M, N, K, lda, ldb; const int* rowmap; };

struct StaticOrder {
    int nM, nN, nwg, G, c, wgm, r0, G2, c2;
    __host__ __device__ void init(int M, int N, int G_, int c_, int wgm_ = WGM) { nM = M / BM; nN = N / BM; nwg = nM * nN; G = G_; c = c_; wgm = wgm_; r0 = 1 << 30; G2 = 0; c2 = -1; }
    __host__ __device__ bool next(int i, Unit& u) const {
        const long L = i < r0 ? (long)i * G + c : (c2 < 0 ? (long)nwg : (long)r0 * G + (long)(i - r0) * G2 + c2); if (L >= nwg) return false;
        int wgid = (int)L; { const int q = nwg / NXCD, r = nwg % NXCD, xcd = wgid % NXCD, off = wgid / NXCD; wgid = (xcd < r ? xcd * (q + 1) : r * (q + 1) + (xcd - r) * q) + off; }
        const int nig = wgm * nN, gid = wgid / nig, fm = gid * wgm, gsz = (nM - fm) < wgm ? (nM - fm) : wgm;
        u.pm = fm + ((wgid % nig) % gsz); u.pn = (wgid % nig) / gsz; return true;
    }
    __device__ __forceinline__ void a_ready(const Unit&) const {}
    __device__ __forceinline__ void done(const Unit&) const {}
};

__device__ __forceinline__ unsigned cvt_pk_bf16(float lo, float hi) { unsigned r; asm volatile("v_cvt_pk_bf16_f32 %0, %1, %2" : "=v"(r) : "v"(lo), "v"(hi)); return r; }

template <class Epi, class Sched, bool ALIGN_EPI = true, bool GATHER = false, int NBJ = 2, int DT = 0, unsigned ASC = 0x7f7f7f7fu>
__device__ __forceinline__ void gemm_phase(PG8_LAS unsigned char* lds, const Gemm g, const Sched& S, const Epi& E, const int tid) {
    const int wid = __builtin_amdgcn_readfirstlane(tid >> 6), lane = tid & 63, wr = wid >> 2, wc = wid & 3, fr = lane & 15, fq = lane >> 4;
    const int K = g.K, nt = K / BK;
    unsigned voffB[2]; int rA[2]; unsigned cA2[2];
#pragma unroll
    for (int i = 0; i < 2; ++i) { int R, C; stage_rc(tid * 16 + i * 8192, R, C); const int Rb = Epi::PERM ? ((R & ~31) + perm32(R & 31)) : R;
        rA[i] = R; cA2[i] = (unsigned)C * 2u; voffB[i] = (unsigned)(Rb * g.ldb + C) * 2u; }
    const size_t kstep = (size_t)(BK * 2);
    const size_t hstepA = (size_t)HALF * g.lda * 2, hstepB = (size_t)HALF * g.ldb * 2;
    const size_t tstepA = GATHER ? 0 : 2 * hstepA, tstepB = NBJ * hstepB;
    unsigned cvo[4], nvo[4];
#define PG8_AOFF(dst, unit) do { _Pragma("unroll") for (int h_ = 0; h_ < 2; ++h_) _Pragma("unroll") for (int i_ = 0; i_ < 2; ++i_) { \
        if constexpr (GATHER) dst[2 * h_ + i_] = (unsigned)g.rowmap[(size_t)(unit).pm * BM + h_ * HALF + rA[i_]] * (unsigned)(g.lda * 2) + cA2[i_]; \
        else dst[2 * h_ + i_] = (unsigned)((h_ * HALF + rA[i_]) * g.lda) * 2u + cA2[i_]; } } while (0)
    const unsigned ldsw = (unsigned)wid * 1024u;
    const int aoff = lds_byte(wr * 64 + fr, fq * 8), boff = lds_byte(wc * 32 + fr, fq * 8);
#define PG8_SA(b, h) (((b) * 2 + (h)) * HTB)
#define PG8_SB(b, h) ((4 + (b) * 2 + (h)) * HTB)
#define PG8_STAGE2(bufoff, gbase, v0, v1) do { \
        __builtin_amdgcn_global_load_lds((const unsigned*)((const char*)(gbase) + (v0)), (PG8_LAS unsigned*)(lds + (bufoff) + ldsw), 16, 0, 0); \
        __builtin_amdgcn_global_load_lds((const unsigned*)((const char*)(gbase) + (v1)), (PG8_LAS unsigned*)(lds + (bufoff) + ldsw + 8192), 16, 0, 0); } while (0)
#define PG8_STAGE(bufoff, gbase, voff) PG8_STAGE2(bufoff, gbase, (voff)[0], (voff)[1])
#define PG8_LDA(dst, b, h) do { _Pragma("unroll") for (int m = 0; m < 4; ++m) _Pragma("unroll") for (int k = 0; k < 2; ++k) dst[m][k] = *(const PG8_LAS bf16x8*)(lds + PG8_SA(b, h) + aoff + m * 2048 + k * 1024); } while (0)
#define PG8_LDB(dst, b, h) do { _Pragma("unroll") for (int n = 0; n < 2; ++n) _Pragma("unroll") for (int k = 0; k < 2; ++k) dst[n][k] = *(const PG8_LAS bf16x8*)(lds + PG8_SB(b, h) + boff + n * 2048 + k * 1024); } while (0)
#define PG8_MMA(ai, bj, At, Bt) do { __builtin_amdgcn_s_setprio(1); _Pragma("unroll") for (int m = 0; m < 4; ++m) _Pragma("unroll") for (int n = 0; n < 2; ++n) { \
        if constexpr (DT == 0) { _Pragma("unroll") for (int k = 0; k < 2; ++k) acc[ai][bj][m][n] = __builtin_amdgcn_mfma_f32_16x16x32_bf16(Bt[n][k], At[m][k], acc[ai][bj][m][n], 0, 0, 0); } \
        else { const i32x4 b0_ = __builtin_bit_cast(i32x4, Bt[n][0]), b1_ = __builtin_bit_cast(i32x4, Bt[n][1]), a0_ = __builtin_bit_cast(i32x4, At[m][0]), a1_ = __builtin_bit_cast(i32x4, At[m][1]); \
            const i32x8 bw_ = __builtin_shufflevector(b0_, b1_, 0, 1, 2, 3, 4, 5, 6, 7), aw_ = __builtin_shufflevector(a0_, a1_, 0, 1, 2, 3, 4, 5, 6, 7); \
              \
            asm volatile("v_mfma_scale_f32_16x16x128_f8f6f4 %0, %1, %2, %0, %3, %4 op_sel_hi:[0,0,0]" : "+v"(acc[ai][bj][m][n]) : "v"(bw_), "v"(aw_), "v"(0x7a7a7a7a), "v"(ASC)); } } \
        __builtin_amdgcn_s_setprio(0); } while (0)
#define PG8_WAIT_V(n) asm volatile("s_waitcnt vmcnt(" #n ")" ::: "memory")
#define PG8_WAIT_LOOP do { if constexpr (NBJ == 2) PG8_WAIT_V(8); else PG8_WAIT_V(6); } while (0)
#define PG8_WAIT_L(n) asm volatile("s_waitcnt lgkmcnt(" #n ")" ::: "memory")
#define PG8_BAR __builtin_amdgcn_s_barrier()
#define PG8_SCHED __builtin_amdgcn_sched_barrier(0)
    Unit cur, nxt; int ui = 0;
    if (!S.next(0, cur)) return;
    f32x4 acc[2][NBJ][4][2];
#pragma unroll
    for (int a = 0; a < 2; ++a)
#pragma unroll
        for (int b = 0; b < NBJ; ++b)
#pragma unroll
            for (int m = 0; m < 4; ++m)
#pragma unroll
                for (int n = 0; n < 2; ++n) acc[a][b][m][n] = (f32x4){0.f, 0.f, 0.f, 0.f};
    bf16x8 At[4][2], B0[2][2], B1[2][2];
    const char* cA = (const char*)g.A + (size_t)cur.pm * tstepA; const char* cB = (const char*)g.Bt + (size_t)cur.pn * tstepB;
    S.a_ready(cur);
    PG8_AOFF(cvo, cur);
    PG8_STAGE(PG8_SB(0, 0), cB, voffB); if constexpr (NBJ == 2) PG8_STAGE(PG8_SB(0, 1), cB + hstepB, voffB); PG8_STAGE2(PG8_SA(0, 0), cA, cvo[0], cvo[1]); PG8_STAGE2(PG8_SA(0, 1), cA, cvo[2], cvo[3]);
    if (wr == 1) PG8_BAR;
    PG8_WAIT_V(2); PG8_BAR;
    PG8_STAGE(PG8_SB(1, 0), cB + kstep, voffB); PG8_STAGE2(PG8_SA(1, 0), cA + kstep, cvo[0], cvo[1]); if constexpr (NBJ == 2) PG8_STAGE(PG8_SB(1, 1), cB + hstepB + kstep, voffB);
    if constexpr (NBJ == 2) PG8_WAIT_V(6); else PG8_WAIT_V(4);
    PG8_BAR;
    for (;;) {
        const bool has_next = S.next(ui + 1, nxt);
        const char* nA = has_next ? (const char*)g.A + (size_t)nxt.pm * tstepA : cA; const char* nB = has_next ? (const char*)g.Bt + (size_t)nxt.pn * tstepB : cB;
        if (has_next) { PG8_AOFF(nvo, nxt); } else {
#pragma unroll
            for (int j_ = 0; j_ < 4; ++j_) nvo[j_] = cvo[j_]; }
        for (int t = 0; t < nt; t += 2) {
            const bool last = (t == nt - 2);
            const char* a1 = cA + (size_t)(t + 1) * kstep;
            const char* a2 = last ? nA : cA + (size_t)(t + 2) * kstep; const char* b2 = last ? nB : cB + (size_t)(t + 2) * kstep;
            const char* a3 = a2 + kstep; const char* b3 = b2 + kstep;
            if (last && has_next) S.a_ready(nxt);
            unsigned so[4];
#pragma unroll
            for (int j_ = 0; j_ < 4; ++j_) so[j_] = last ? nvo[j_] : cvo[j_];
            PG8_LDB(B0, 0, 0); if constexpr (NBJ == 2) PG8_LDB(B1, 0, 1); PG8_SCHED; PG8_LDA(At, 0, 0); PG8_STAGE2(PG8_SA(1, 1), a1, cvo[2], cvo[3]);
            PG8_WAIT_LOOP; PG8_WAIT_L(0); PG8_BAR; PG8_MMA(0, 0, At, B0); if constexpr (NBJ == 2) PG8_MMA(0, NBJ - 1, At, B1); PG8_BAR; PG8_SCHED;
            PG8_LDA(At, 0, 1); PG8_STAGE(PG8_SB(0, 0), b2, voffB); if constexpr (NBJ == 2) PG8_STAGE(PG8_SB(0, 1), b2 + hstepB, voffB); PG8_STAGE2(PG8_SA(0, 0), a2, so[0], so[1]);
            PG8_WAIT_LOOP; PG8_WAIT_L(0); PG8_BAR; PG8_MMA(1, 0, At, B0); if constexpr (NBJ == 2) PG8_MMA(1, NBJ - 1, At, B1); PG8_BAR; PG8_SCHED;
            PG8_LDB(B0, 1, 0); if constexpr (NBJ == 2) PG8_LDB(B1, 1, 1); PG8_SCHED; PG8_LDA(At, 1, 0); PG8_STAGE2(PG8_SA(0, 1), a2, so[2], so[3]);
            PG8_WAIT_LOOP; PG8_WAIT_L(0); PG8_BAR; PG8_MMA(0, 0, At, B0); if constexpr (NBJ == 2) PG8_MMA(0, NBJ - 1, At, B1); PG8_BAR; PG8_SCHED;
            PG8_LDA(At, 1, 1); PG8_STAGE(PG8_SB(1, 0), b3, voffB); if constexpr (NBJ == 2) PG8_STAGE(PG8_SB(1, 1), b3 + hstepB, voffB); PG8_STAGE2(PG8_SA(1, 0), a3, so[0], so[1]);
            PG8_WAIT_LOOP; PG8_WAIT_L(0); PG8_BAR; PG8_MMA(1, 0, At, B0); if constexpr (NBJ == 2) PG8_MMA(1, NBJ - 1, At, B1); PG8_BAR; PG8_SCHED;
            if constexpr (Epi::HAS_FOLD) { if (!last && E.boundary(t + 2)) { if constexpr (DT == 1) asm volatile("s_nop 15\n\ts_nop 15\n\ts_nop 15\n\ts_nop 15\n\ts_nop 15\n\ts_nop 15" ::: "memory"); E.fold(acc, cur, wr, wc, fr, fq, t + 2);
#pragma unroll
                for (int a = 0; a < 2; ++a)
#pragma unroll
                    for (int b = 0; b < NBJ; ++b)
#pragma unroll
                        for (int m = 0; m < 4; ++m)
#pragma unroll
                            for (int n = 0; n < 2; ++n) acc[a][b][m][n] = (f32x4){0.f, 0.f, 0.f, 0.f}; } }
        }
        if constexpr (ALIGN_EPI) { if (wr == 0) PG8_BAR; }
        if constexpr (DT == 1) asm volatile("s_nop 15\n\ts_nop 15\n\ts_nop 15\n\ts_nop 15\n\ts_nop 15\n\ts_nop 15" ::: "memory");
        E(acc, cur, wr, wc, fr, fq); S.done(cur);
        if (!has_next) break;
#pragma unroll
        for (int a = 0; a < 2; ++a)
#pragma unroll
            for (int b = 0; b < NBJ; ++b)
#pragma unroll
                for (int m = 0; m < 4; ++m)
#pragma unroll
                    for (int n = 0; n < 2; ++n) acc[a][b][m][n] = (f32x4){0.f, 0.f, 0.f, 0.f};
        cur = nxt; cA = nA; cB = nB; ++ui;
#pragma unroll
        for (int j_ = 0; j_ < 4; ++j_) cvo[j_] = nvo[j_];
        if constexpr (ALIGN_EPI) { if (wr == 1) PG8_BAR; }
    }
    PG8_WAIT_V(0);
    if constexpr (!ALIGN_EPI) { if (wr == 0) PG8_BAR; }
    PG8_BAR;
#undef PG8_SA
#undef PG8_SB
#undef PG8_STAGE
#undef PG8_STAGE2
#undef PG8_AOFF
#undef PG8_LDA
#undef PG8_LDB
#undef PG8_MMA
#undef PG8_WAIT_V
#undef PG8_WAIT_LOOP
#undef PG8_WAIT_L
#undef PG8_BAR
#undef PG8_SCHED
}

#ifndef N1_DBG
#define N1_DBG 0
#endif
template <class Epi, class Sched>
__device__ __forceinline__ void gemm_phase_n1s3(PG8_LAS unsigned char* lds, const Gemm g, const Sched& S, const Epi& E, const int tid) {
    const int wid = __builtin_amdgcn_readfirstlane(tid >> 6), lane = tid & 63, wr = wid >> 2, wc = wid & 3, fr = lane & 15, fq = lane >> 4;
    const int nt = g.K / BK;
    constexpr unsigned STG = 49152u;
    unsigned voffB[2], voA[4];
#pragma unroll
    for (int i = 0; i < 2; ++i) { int R, C; stage_rc(tid * 16 + i * 8192, R, C);
        voffB[i] = (unsigned)(R * g.ldb + C) * 2u; voA[i] = (unsigned)(R * g.lda + C) * 2u; voA[2 + i] = (unsigned)((HALF + R) * g.lda + C) * 2u; }
    const size_t kstep = (size_t)(BK * 2), tstepA = (size_t)BM * g.lda * 2, tstepB = (size_t)HALF * g.ldb * 2;
    const unsigned ldsw = (unsigned)wid * 1024u;
    const int aoff = lds_byte(wr * 64 + fr, fq * 8), boff = lds_byte(wc * 32 + fr, fq * 8);
#define N1_STAGE(dst, gp, v0, v1) do { \
        __builtin_amdgcn_global_load_lds((const unsigned*)((const char*)(gp) + (v0)), (PG8_LAS unsigned*)(lds + (dst) + ldsw), 16, 0, 0); \
        __builtin_amdgcn_global_load_lds((const unsigned*)((const char*)(gp) + (v1)), (PG8_LAS unsigned*)(lds + (dst) + ldsw + 8192), 16, 0, 0); } while (0)
#define N1_STAGE_TILE(wb, pa, pb) do { N1_STAGE((wb) + 32768u, pb, voffB[0], voffB[1]); N1_STAGE((wb), pa, voA[0], voA[1]); N1_STAGE((wb) + 16384u, pa, voA[2], voA[3]); } while (0)
#define N1_WAIT_V(n) asm volatile("s_waitcnt vmcnt(" #n ")" ::: "memory")
#define N1_WAIT_L0 asm volatile("s_waitcnt lgkmcnt(0)" ::: "memory")
#define N1_BAR __builtin_amdgcn_s_barrier()
    Unit cur, nxt; int ui = 0;
    if (!S.next(0, cur)) return;
    f32x4 acc[2][1][4][2];
#pragma unroll
    for (int a = 0; a < 2; ++a)
#pragma unroll
        for (int m = 0; m < 4; ++m)
#pragma unroll
            for (int n = 0; n < 2; ++n) acc[a][0][m][n] = (f32x4){0.f, 0.f, 0.f, 0.f};
    bf16x8 A0[4][2], A1[4][2], B0[2][2];
    const char* cA = (const char*)g.A + (size_t)cur.pm * tstepA; const char* cB = (const char*)g.Bt + (size_t)cur.pn * tstepB;
    unsigned gt = 0;
    N1_STAGE_TILE(0u, cA, cB); N1_STAGE_TILE(STG, cA + kstep, cB + kstep);
    if (wr == 1) N1_BAR;
    N1_WAIT_V(6); N1_BAR;
    N1_BAR;
    for (;;) {
        const bool has_next = S.next(ui + 1, nxt);
        const char* nA = has_next ? (const char*)g.A + (size_t)nxt.pm * tstepA : cA; const char* nB = has_next ? (const char*)g.Bt + (size_t)nxt.pn * tstepB : cB;
        for (int t = 0; t < nt; ++t, ++gt) {
            const unsigned s0 = gt % 3u, rb = s0 * STG, wb = (s0 == 0u ? 2u : s0 - 1u) * STG;
            const int t2 = t + 2; const bool over = t2 >= nt;
            const char* pa = over ? nA + (size_t)(t2 - nt) * kstep : cA + (size_t)t2 * kstep; const char* pb = over ? nB + (size_t)(t2 - nt) * kstep : cB + (size_t)t2 * kstep;
#pragma unroll
            for (int n = 0; n < 2; ++n)
#pragma unroll
                for (int k = 0; k < 2; ++k) B0[n][k] = *(const PG8_LAS bf16x8*)(lds + rb + 32768u + boff + n * 2048 + k * 1024);
            __builtin_amdgcn_sched_barrier(0);
#pragma unroll
            for (int m = 0; m < 4; ++m)
#pragma unroll
                for (int k = 0; k < 2; ++k) { A0[m][k] = *(const PG8_LAS bf16x8*)(lds + rb + aoff + m * 2048 + k * 1024); A1[m][k] = *(const PG8_LAS bf16x8*)(lds + rb + 16384u + aoff + m * 2048 + k * 1024); }
            N1_STAGE_TILE(wb, pa, pb);
            N1_WAIT_V(6); N1_WAIT_L0; N1_BAR;
            __builtin_amdgcn_s_setprio(1);
#pragma unroll
            for (int m = 0; m < 4; ++m)
#pragma unroll
                for (int n = 0; n < 2; ++n)
#pragma unroll
                    for (int k = 0; k < 2; ++k) { acc[0][0][m][n] = __builtin_amdgcn_mfma_f32_16x16x32_bf16(B0[n][k], A0[m][k], acc[0][0][m][n], 0, 0, 0);
                        acc[1][0][m][n] = __builtin_amdgcn_mfma_f32_16x16x32_bf16(B0[n][k], A1[m][k], acc[1][0][m][n], 0, 0, 0); }
            __builtin_amdgcn_s_setprio(0);
            N1_BAR; __builtin_amdgcn_sched_barrier(0);
            if (t + 1 < nt && E.boundary(t + 1)) { E.fold(acc, cur, wr, wc, fr, fq, t + 1);
#pragma unroll
                for (int a = 0; a < 2; ++a)
#pragma unroll
                    for (int m = 0; m < 4; ++m)
#pragma unroll
                        for (int n = 0; n < 2; ++n) acc[a][0][m][n] = (f32x4){0.f, 0.f, 0.f, 0.f}; }
        }
        if (wr == 0) N1_BAR;
        E(acc, cur, wr, wc, fr, fq);
        if (!has_next) break;
#pragma unroll
        for (int a = 0; a < 2; ++a)
#pragma unroll
            for (int m = 0; m < 4; ++m)
#pragma unroll
                for (int n = 0; n < 2; ++n) acc[a][0][m][n] = (f32x4){0.f, 0.f, 0.f, 0.f};
        cur = nxt; cA = nA; cB = nB; ++ui;
        if (wr == 1) N1_BAR;
    }
    N1_WAIT_V(0);
    N1_BAR;
#undef N1_STAGE
#undef N1_STAGE_TILE
#undef N1_WAIT_V
#undef N1_WAIT_L0
#undef N1_BAR
}
}
#ifndef MERGE3
#define MERGE3 0
#endif
constexpr int T_ = 8192, D_ = 2048, SEQ_ = 2048, NB_ = 4, NL_ = 2, NCOL = 15640;
constexpr float DN_ALPHA = 1.41421356237309515f;
constexpr float LN_EPS_ = 1e-5f;
constexpr int MAXROWS = 90112;
constexpr size_t MiB = 1u << 20;
constexpr size_t WS_CTL = 0, CTL_ZERO_BYTES = 1048576;
constexpr size_t WS_XB = 1 * MiB, WS_HB = 33 * MiB, WS_X1 = 97 * MiB, WS_XA = 161 * MiB, WS_YM = 225 * MiB, WS_MRG = 257 * MiB, WS_MB = 321 * MiB;
constexpr size_t WS_YSM = 353 * MiB, WS_CS = 354 * MiB, WS_SEL = 356 * MiB, WS_ROWW = 357 * MiB, WS_ROWMAP = 357 * MiB + 512 * 1024;
constexpr size_t WS_WIN = 358 * MiB, WS_WP = 420 * MiB, WS_WOUT = 428 * MiB, WS_W13 = 436 * MiB, WS_W2 = 696 * MiB, WS_H = 826 * MiB, WS_XS = 914 * MiB, WS_YBUF = 1266 * MiB;
constexpr size_t WS_XS8 = WS_XS + 64 * MiB, WS_XB8 = WS_XS + 80 * MiB, WS_WIN8 = WS_XS + 96 * MiB;
constexpr size_t WS_Y = WS_YBUF;
constexpr size_t WS_GLOC = 1618 * MiB, WS_GDEC = 1634 * MiB, WS_GST = 1635 * MiB, WS_MLOC = 1643 * MiB, WS_MNLOC = 1675 * MiB, WS_MSC = 1676 * MiB, WS_MC = 1677 * MiB, WS_MN = 1693 * MiB, WS_MM = 1694 * MiB;
constexpr size_t WS_DILO = 1695 * MiB, WS_DILL = 1719 * MiB;
constexpr size_t WS_NV = 1720 * MiB;
constexpr size_t WS_W13B = 1842 * MiB, WS_W2B = 1972 * MiB;
constexpr size_t WS_END = 2037 * MiB;
constexpr int CW_CNT = 8192, CW_TST = 8448, CW_CQ = 12400, CW_ARR = 12416, CW_BAR = 16384;
constexpr int RING_BYTES = 131072, AUX_OFF = 131072, LDS_BYTES = 147456 + 16384 * MERGE3;
constexpr int AUX_BARW = LDS_BYTES - 16;

#define GAS __attribute__((address_space(1)))
#define LAS __attribute__((address_space(3)))
typedef unsigned short bf16;
typedef unsigned v4u __attribute__((ext_vector_type(4)));
typedef unsigned v2u __attribute__((ext_vector_type(2)));
typedef float f32x4 __attribute__((ext_vector_type(4)));
typedef float f32x2 __attribute__((ext_vector_type(2)));
typedef short bf16x8 __attribute__((ext_vector_type(8)));
#define LDS_WAIT() asm volatile("s_waitcnt lgkmcnt(0)" ::: "memory")
#define VM_WAIT() asm volatile("s_waitcnt vmcnt(0)" ::: "memory")
__device__ __forceinline__ unsigned pk2(float lo, float hi) { return pg8::cvt_pk_bf16(lo, hi); }
__device__ __forceinline__ float bflo(unsigned u) { return __builtin_bit_cast(float, u << 16); }
__device__ __forceinline__ float bfhi(unsigned u) { return __builtin_bit_cast(float, u & 0xffff0000u); }
__device__ __forceinline__ float fsigmoid(float x) { return 1.f / (1.f + __expf(-x)); }
__device__ __forceinline__ float wave_sum(float v) {
#pragma unroll
    for (int o = 1; o < 64; o <<= 1) v += __shfl_xor(v, o);
    return v;
}
__device__ __forceinline__ float wave_max(float v) {
#pragma unroll
    for (int o = 1; o < 64; o <<= 1) v = fmaxf(v, __shfl_xor(v, o));
    return v;
}

#define XB_TMO      128
#define XB_XCNT(j)  (256  + 64 * (j))
#define XB_XSUB(j)  (1280 + 64 * (j))
#define XB_XGEN(j)  (2304 + 64 * (j))
#define XB_TOP      3328
#define XB_TOPGEN   3392
#define XCD_BAR_WORDS 3456
#define XB_SPIN_CAP (1u << 22)
__device__ __forceinline__ unsigned xb_ld(unsigned* p)              { return __hip_atomic_load(p, __ATOMIC_RELAXED, __HIP_MEMORY_SCOPE_AGENT); }
__device__ __forceinline__ unsigned xb_add(unsigned* p, unsigned v) { return __hip_atomic_fetch_add(p, v, __ATOMIC_RELAXED, __HIP_MEMORY_SCOPE_AGENT); }
__device__ __forceinline__ unsigned xb_xcc_id() { return (unsigned)__builtin_amdgcn_s_getreg((3 << 11) | 20) & 0xFu; }
#define XB_SPIN(cond, bar) do { unsigned _sp = 0; while (cond) { __builtin_amdgcn_s_sleep(1); \
    if ((++_sp & 255u) == 0u) { if (xb_ld(&(bar)[XB_TMO])) break; if (_sp > XB_SPIN_CAP) { atomicAdd(&(bar)[XB_TMO], 1u); break; } } } } while (0)
struct XcdBarrier { unsigned* bar; unsigned x; volatile LAS unsigned* st; };
__device__ __forceinline__ XcdBarrier xcd_barrier_post(unsigned* bar, volatile LAS unsigned* st) {
    XcdBarrier b; b.bar = bar; b.x = xb_xcc_id(); b.st = st;
    if (threadIdx.x == 0) (void)xb_add(&bar[XB_XCNT(b.x)], 1u);
    return b;
}
__device__ __forceinline__ void xcd_barrier_complete(unsigned* bar, unsigned x, unsigned& nloc, unsigned& nx) {
    const unsigned G = gridDim.x * gridDim.y * gridDim.z;
    unsigned sum, cnt, mine, sp = 0u;
    for (;;) {
        sum = 0u; cnt = 0u; mine = 0u;
#pragma unroll
        for (unsigned j = 0; j < 16; ++j) { const unsigned c = xb_ld(&bar[XB_XCNT(j)]); sum += c; cnt += (c > 0u) ? 1u : 0u; mine = (j == x) ? c : mine; }
        if (sum == G) break;
        __builtin_amdgcn_s_sleep(1);
        if ((++sp & 255u) == 0u) { if (xb_ld(&bar[XB_TMO])) break; if (sp > XB_SPIN_CAP) { atomicAdd(&bar[XB_TMO], 1u); break; } }
    }
    nloc = mine > 0u ? mine : 1u; nx = cnt > 0u ? cnt : 1u;
}
__device__ __forceinline__ void xcd_barrier(const XcdBarrier& b) {
    asm volatile("s_waitcnt vmcnt(0)" ::: "memory");
    __syncthreads();
    if (threadIdx.x == 0) {
        unsigned* bar = b.bar;
        __builtin_amdgcn_s_waitcnt(0);
        unsigned nloc = b.st[0], nx = b.st[1];
        if (nloc == 0u) { xcd_barrier_complete(bar, b.x, nloc, nx); b.st[0] = nloc; b.st[1] = nx; }
        const unsigned old = xb_add(&bar[XB_XSUB(b.x)], 1u);
        const unsigned gen = old / nloc;
        if (old + 1u == (gen + 1u) * nloc) {
            __builtin_amdgcn_fence(__ATOMIC_RELEASE, "agent");
            asm volatile("s_waitcnt vmcnt(0)" ::: "memory");
            const unsigned og = xb_add(&bar[XB_TOP], 1u);
            const unsigned tg = og / nx;
            if (og + 1u == (tg + 1u) * nx) xb_add(&bar[XB_TOPGEN], 1u);
            else XB_SPIN(xb_ld(&bar[XB_TOPGEN]) == tg, bar);
            __builtin_amdgcn_fence(__ATOMIC_ACQUIRE, "agent");
            xb_add(&bar[XB_XGEN(b.x)], 1u);
            asm volatile("s_waitcnt vmcnt(0)" ::: "memory");
        } else {
            XB_SPIN(xb_ld(&bar[XB_XGEN(b.x)]) == gen, bar);
            __builtin_amdgcn_fence(__ATOMIC_ACQUIRE, "agent");
            asm volatile("s_waitcnt vmcnt(0)" ::: "memory");
        }
    }
    __syncthreads();
}
#ifndef YB8
#define YB8 1
#endif
#ifndef MRG8
#define MRG8 1
#endif
#ifndef OUT8
#define OUT8 1
#endif
using pg8::Unit;
#ifndef STEAL_MARGIN
#define STEAL_MARGIN 8u
#endif
#ifndef HB_BF16
#define HB_BF16 0
#endif
#ifndef X1_BF16
#define X1_BF16 1
#endif
#ifndef MOE_XCD
#define MOE_XCD 1
#endif
#ifndef FP8_GATES
#define FP8_GATES 3
#endif
#define GATES8(l) ((FP8_GATES >> (l)) & 1)
#ifndef FP8_MOE
#define FP8_MOE 3
#endif
#define MOE8(l) ((FP8_MOE >> (l)) & 1)
#define FP8_LAST MOE8(NL_ - 1)
__device__ __forceinline__ unsigned pk4_fp8(float a, float b, float c, float d) { int w = 0; w = __builtin_amdgcn_cvt_pk_fp8_f32(a, b, w, false); w = __builtin_amdgcn_cvt_pk_fp8_f32(c, d, w, true); return (unsigned)w; }
struct EpiY {
    static constexpr bool PERM = true, HAS_FOLD = false;
    bf16* Y; float* YSM; int pn0;
    __device__ __forceinline__ void operator()(const f32x4 (&acc)[2][2][4][2], const Unit& u, int wr, int wc, int fr, int fq) const {
        const int row0 = u.pm * 256 + wr * 64 + fr, pn = u.pn + pn0;
        if (pn == 0) {
            if (wc == 0) {
#pragma unroll
                for (int ai = 0; ai < 2; ++ai)
#pragma unroll
                    for (int m = 0; m < 4; ++m) { float* rp = YSM + (size_t)(row0 + ai * 128 + m * 16) * 32 + 8 * fq; *(f32x4*)rp = acc[ai][0][m][0]; *(f32x4*)(rp + 4) = acc[ai][0][m][1]; }
            }
            return;
        }
        const bool sg = pn >= 30;
#pragma unroll
        for (int ai = 0; ai < 2; ++ai)
#pragma unroll
            for (int m = 0; m < 4; ++m) { bf16* rp = Y + (size_t)(row0 + ai * 128 + m * 16) * YP + pn * 256 + wc * 32 + 8 * fq;
#pragma unroll
                for (int bj = 0; bj < 2; ++bj) { f32x4 v0 = acc[ai][bj][m][0], v1 = acc[ai][bj][m][1];
                    if (sg) {
#pragma unroll
                        for (int j = 0; j < 4; ++j) { v0[j] = fsigmoid(v0[j]); v1[j] = fsigmoid(v1[j]); } }
                    v4u w; w.x = pk2(v0[0], v0[1]); w.y = pk2(v0[2], v0[3]); w.z = pk2(v1[0], v1[1]); w.w = pk2(v1[2], v1[3]);
                    *(v4u*)(rp + bj * 128) = w; } }
    }
};
struct EpiMerge {
    static constexpr bool PERM = false, HAS_FOLD = true;
    const bf16* Y; bf16* MB; mutable f32x4 tot[2][4][2];
#if MRG8
    __device__ __forceinline__ bool boundary(int kt) const { return kt == 4 || kt == 6 || kt == 12; }
#else
    __device__ __forceinline__ bool boundary(int kt) const { return kt == 8 || kt == 12 || kt == 24; }
#endif
    __device__ __forceinline__ void fold(const f32x4 (&acc)[2][1][4][2], const Unit& u, int wr, int wc, int fr, int fq, int kt) const {
        const int br = MRG8 ? (kt == 4 ? 0 : (kt == 6 ? 1 : (kt == 12 ? 2 : 3))) : (kt == 8 ? 0 : (kt == 12 ? 1 : (kt == 24 ? 2 : 3)));
        int zv = 0; asm volatile("" : "+v"(zv));
        const int row0 = u.pm * 256 + wr * 64 + fr + zv, col0 = u.pn * 128 + wc * 32 + 4 * fq;
        v2u gp[2][4][2];
#pragma unroll
        for (int ai = 0; ai < 2; ++ai)
#pragma unroll
            for (int m = 0; m < 4; ++m)
#pragma unroll
                for (int n = 0; n < 2; ++n) gp[ai][m][n] = *(const v2u*)(Y + (size_t)(row0 + ai * 128 + m * 16) * YP + Y_G + br * 2048 + col0 + n * 16);
#pragma unroll
        for (int ai = 0; ai < 2; ++ai)
#pragma unroll
            for (int m = 0; m < 4; ++m)
#pragma unroll
                for (int n = 0; n < 2; ++n) { f32x4 v = acc[ai][0][m][n]; const v2u g2 = gp[ai][m][n]; v[0] *= bflo(g2.x); v[1] *= bfhi(g2.x); v[2] *= bflo(g2.y); v[3] *= bfhi(g2.y);
                    v = br > 0 ? v + tot[ai][m][n] : v;
                    if (br < 3) tot[ai][m][n] = v;
                    else {
#if OUT8
                        *(unsigned*)((unsigned char*)MB + (size_t)(row0 + ai * 128 + m * 16) * 2048 + col0 + n * 16) = pk4_fp8(v[0] * 8.f, v[1] * 8.f, v[2] * 8.f, v[3] * 8.f);
#else
                        v2u o; o.x = pk2(v[0], v[1]); o.y = pk2(v[2], v[3]); *(v2u*)(MB + (size_t)(row0 + ai * 128 + m * 16) * 2048 + col0 + n * 16) = o;
#endif
                    } }
    }
    __device__ __forceinline__ void operator()(const f32x4 (&acc)[2][1][4][2], const Unit& u, int wr, int wc, int fr, int fq) const { fold(acc, u, wr, wc, fr, fq, 32); }
};
struct EpiOut {
    static constexpr bool PERM = false, HAS_FOLD = false;
    const float* X; float* HB;
    __device__ __forceinline__ void operator()(const f32x4 (&acc)[2][2][4][2], const Unit& u, int wr, int wc, int fr, int fq) const {
        const int row0 = u.pm * 256 + wr * 64 + fr, col0 = u.pn * 256 + wc * 32 + 4 * fq;
#pragma unroll
        for (int ai = 0; ai < 2; ++ai)
#pragma unroll
            for (int m = 0; m < 4; ++m) { const size_t off = (size_t)(row0 + ai * 128 + m * 16) * 2048 + col0;
#pragma unroll
                for (int bj = 0; bj < 2; ++bj)
#pragma unroll
                    for (int n = 0; n < 2; ++n) { const f32x4 xv = *(const f32x4*)(X + off + bj * 128 + n * 16); const f32x4 hv = xv * DN_ALPHA + acc[ai][bj][m][n];
                        if (HB_BF16) { v2u o; o.x = pk2(hv[0], hv[1]); o.y = pk2(hv[2], hv[3]); *(v2u*)((bf16*)HB + off + bj * 128 + n * 16) = o; } else *(f32x4*)(HB + off + bj * 128 + n * 16) = hv; } }
    }
};
struct EpiMoe1 {
    static constexpr bool PERM = true, HAS_FOLD = false;
    bf16* H; const float* ROWW; int NJ;
    __device__ __forceinline__ void operator()(const f32x4 (&acc)[2][2][4][2], const Unit& u, int wr, int wc, int fr, int fq) const {
        const int row0 = u.pm * 256 + wr * 64 + fr, col0 = (u.pn & 3) * 128 + wc * 32 + 8 * fq;
#pragma unroll
        for (int ai = 0; ai < 2; ++ai)
#pragma unroll
            for (int m = 0; m < 4; ++m) { const size_t row = (size_t)(row0 + ai * 128 + m * 16); const float rw = ROWW[row];
                float h[8];
#pragma unroll
                for (int n = 0; n < 2; ++n)
#pragma unroll
                    for (int j = 0; j < 4; ++j) { const float a = acc[ai][0][m][n][j], b = acc[ai][1][m][n][j]; h[n * 4 + j] = a * fsigmoid(a) * b * rw; }
                v4u w; w.x = pk2(h[0], h[1]); w.y = pk2(h[2], h[3]); w.z = pk2(h[4], h[5]); w.w = pk2(h[6], h[7]);
                *(v4u*)(H + row * 512 + col0) = w; }
    }
};
struct EpiMoe2 {
    static constexpr bool PERM = true, HAS_FOLD = false;
    bf16* YB;
    __device__ __forceinline__ void operator()(const f32x4 (&acc)[2][2][4][2], const Unit& u, int wr, int wc, int fr, int fq) const {
        const int row0 = u.pm * 256 + wr * 64 + fr, col0 = (u.pn & 7) * 256 + wc * 32 + 8 * fq;
#pragma unroll
        for (int ai = 0; ai < 2; ++ai)
#pragma unroll
            for (int m = 0; m < 4; ++m) { bf16* rp = YB + (size_t)(row0 + ai * 128 + m * 16) * 2048 + col0;
                if (wr * 64 + fr + ai * 128 + m * 16 >= u.aux) continue;
#if YB8
                unsigned char* rp8 = (unsigned char*)YB + (size_t)(row0 + ai * 128 + m * 16) * 2048 + col0;
#pragma unroll
                for (int bj = 0; bj < 2; ++bj) { const f32x4 v0 = acc[ai][bj][m][0] * 32.f, v1 = acc[ai][bj][m][1] * 32.f;
                    v2u w8; w8.x = pk4_fp8(v0[0], v0[1], v0[2], v0[3]); w8.y = pk4_fp8(v1[0], v1[1], v1[2], v1[3]); *(v2u*)(rp8 + bj * 128) = w8; }
                continue;
#endif
#pragma unroll
                for (int bj = 0; bj < 2; ++bj) { const f32x4 v0 = acc[ai][bj][m][0], v1 = acc[ai][bj][m][1];
                    v4u w; w.x = pk2(v0[0], v0[1]); w.y = pk2(v0[2], v0[3]); w.z = pk2(v1[0], v1[1]); w.w = pk2(v1[2], v1[3]);
                    *(v4u*)(rp + bj * 128) = w; } }
    }
};
struct EpiMoe1F8 {
    static constexpr bool PERM = true, HAS_FOLD = false;
    unsigned char* H; const float* ROWW;
    __device__ __forceinline__ void operator()(const f32x4 (&acc)[2][2][4][2], const Unit& u, int wr, int wc, int fr, int fq) const {
        const int row0 = u.pm * 256 + wr * 64 + fr, col0 = (u.pn & 3) * 128 + wc * 32 + 8 * fq;
#pragma unroll
        for (int ai = 0; ai < 2; ++ai)
#pragma unroll
            for (int m = 0; m < 4; ++m) { const size_t row = (size_t)(row0 + ai * 128 + m * 16); const float rw = ROWW[row];
                float h[8];
#pragma unroll
                for (int n = 0; n < 2; ++n)
#pragma unroll
                    for (int j = 0; j < 4; ++j) { const float a = acc[ai][0][m][n][j], b = acc[ai][1][m][n][j]; h[n * 4 + j] = a * fsigmoid(a) * b * rw; }
                v2u w; w.x = pk4_fp8(h[0], h[1], h[2], h[3]); w.y = pk4_fp8(h[4], h[5], h[6], h[7]);
                *(v2u*)(H + row * 512 + col0) = w; }
    }
};
struct MoeOrder {
    int NJ, G, c, total, upm, upn, uval;
    __device__ __forceinline__ void init(const int* tst, int NJ_, int G_, int c_, int lane, const unsigned* cnt = nullptr) { NJ = NJ_; G = G_; total = tst[65] * NJ_; uval = 256;
        c = (MOE_XCD && (G_ & 7) == 0) ? (c_ & 7) * (G_ >> 3) + (c_ >> 3) : c_;
        const long L = (long)lane * G + c; upm = 0; upn = 0;
        if (L < total) { const int mt = (int)(L / NJ), j = (int)(L % NJ); int e = 0;
            for (int k = 1; k <= 64; ++k) e += (mt >= tst[k]) ? 1 : 0;
            upm = mt; upn = e * NJ + j;
            if (cnt && e > 0) { const int v = (tst[e] << 8) + (int)cnt[e - 1] - (mt << 8); uval = v < 256 ? v : 256; } } }
    __device__ __forceinline__ bool next(int i, Unit& u) const {
        if ((long)i * G + c >= total || i >= 64) return false;
        const int iu = __builtin_amdgcn_readfirstlane(i);
        u.pm = __builtin_amdgcn_readlane(upm, iu); u.pn = __builtin_amdgcn_readlane(upn, iu); u.aux = __builtin_amdgcn_readlane(uval, iu); return true;
    }
    __device__ __forceinline__ void a_ready(const Unit&) const {}
    __device__ __forceinline__ void done(const Unit&) const {}
};

struct KArgs { const float* in[32]; float* out; unsigned char* ws; int ph_lo, ph_hi, region, pad; };
struct Ctx {
    LAS unsigned char* lds; unsigned char* ws; const float* in[32]; float* out;
    int tid, lane, wave, G, bid;
};
#define WSP(T, off) ((T*)(C.ws + (off)))

#ifndef CV_NTS
#define CV_NTS 0
#endif
#ifndef CV_DEEP
#define CV_DEEP 0
#endif
#ifndef CV_NT
#define CV_NT 1
#endif
#if CV_NT
#define CV_LOAD(p) __builtin_nontemporal_load(p)
#else
#define CV_LOAD(p) (*(p))
#endif
struct CvDesc { const float* sp; bf16* dp; int ldw, ldt, zero, w13, f8; };
__device__ __forceinline__ CvDesc cv_desc(const float* W, int ldw, int srccol, int k0, bf16* WT, size_t drow0, int ldt, int w13, int tid, int f8 = 0) {
    CvDesc d; d.zero = srccol < 0; d.ldw = ldw; d.ldt = ldt; d.w13 = w13; d.f8 = f8;
    d.sp = W + (size_t)(k0 + (tid >> 6)) * ldw + (srccol < 0 ? 0 : srccol);
    d.dp = f8 ? (bf16*)((unsigned char*)WT + drow0 * (size_t)ldt + k0) : WT + drow0 * (size_t)ldt + k0; return d;
}
__device__ __forceinline__ CvDesc conv_item(Ctx& C, int l, int r, int tid) {
    constexpr int I_WIN = 16 * 62, I_W13 = 65 * 64, I_W2 = 65 * 32, I_PA = 4 * 8, I_PB = 2 * 8, I_PC = 6 * 8, I_PD = 4 * 8;
    const bool f8l = MOE8(l), lastb = MOE8(l) && l == NL_ - 1;
    bf16* WIN = WSP(bf16, WS_WIN); bf16* W13 = lastb ? WSP(bf16, WS_W13B) : WSP(bf16, WS_W13); bf16* W2 = lastb ? WSP(bf16, WS_W2B) : WSP(bf16, WS_W2); bf16* WP = WSP(bf16, WS_WP); bf16* WOUT = WSP(bf16, WS_WOUT);
    const int c4 = 4 * (tid & 63);
    if (r < I_WIN) { const int nb = r % 62, kb = r / 62, n = 256 * nb + c4; int sc;
        if (n < 256) { const int i = n; sc = i < 16 ? 1536 + i : (i < 24 ? 7440 + (i - 16) : -1); }
        else if (n < 768) sc = n - 256; else if (n < 2304) sc = n - 768 + 1552; else if (n < 3328) sc = n - 2304 + 5392;
        else if (n < 3840) sc = n - 3328 + 512; else if (n < 4608) sc = n - 3840 + 3088; else if (n < 5120) sc = n - 4608 + 6416;
        else if (n < 5632) sc = n - 5120 + 1024; else if (n < 7168) sc = n - 5632 + 3856; else if (n < 7680) sc = n - 7168 + 6928; else sc = n - 7680 + 7448;
        if (GATES8(l) && nb >= 1) return cv_desc(C.in[2] + (size_t)l * 2048 * NCOL, NCOL, sc, 128 * kb, WSP(bf16, WS_WIN8), 256 * (nb - 1), 2048, 0, tid, 1);
        return cv_desc(C.in[2] + (size_t)l * 2048 * NCOL, NCOL, sc, 128 * kb, WIN, 256 * nb, 2048, 0, tid); }
    r -= I_WIN;
    if (r < I_W13) { const int e = r / 64, q = r % 64, half = q >> 5, kb = (q >> 1) & 15, nq = q & 1;
        const float* src = e == 0 ? (half ? C.in[28] : C.in[27]) + (size_t)l * 2048 * 512 : (half ? C.in[25] : C.in[24]) + (size_t)(l * 64 + e - 1) * 2048 * 512;
        return cv_desc(src, 512, 256 * nq + c4, 128 * kb, W13, (size_t)e * 1024 + nq * 512 + half * 128, 2048, 1, tid, f8l ? 1 : 0); }
    r -= I_W13;
    if (r < I_W2) { const int e = r / 32, q = r % 32, kb = q / 8, nb = q % 8;
        const float* src = e == 0 ? C.in[29] + (size_t)l * 512 * 2048 : C.in[26] + (size_t)(l * 64 + e - 1) * 512 * 2048;
        return cv_desc(src, 2048, 256 * nb + c4, 128 * kb, W2, (size_t)e * 2048 + 256 * nb, 512, 0, tid, f8l ? 1 : 0); }
    r -= I_W2;
    if (r < I_PA) return cv_desc(C.in[15] + (size_t)l * 512 * 2048, 2048, 256 * (r % 8) + c4, 128 * (r / 8), MRG8 ? (bf16*)((unsigned char*)WP + 0) : WP + 0, 256 * (r % 8), 2048, 0, tid, MRG8 ? 1 : 0);
    r -= I_PA;
    if (r < I_PB) return cv_desc(C.in[16] + (size_t)l * 256 * 2048, 2048, 256 * (r % 8) + c4, 128 * (r / 8), MRG8 ? (bf16*)((unsigned char*)WP + 512) : WP + 512, 256 * (r % 8), 2048, 0, tid, MRG8 ? 1 : 0);
    r -= I_PB;
    if (r < I_PC) return cv_desc(C.in[17] + (size_t)l * 768 * 2048, 2048, 256 * (r % 8) + c4, 128 * (r / 8), MRG8 ? (bf16*)((unsigned char*)WP + 768) : WP + 768, 256 * (r % 8), 2048, 0, tid, MRG8 ? 1 : 0);
    r -= I_PC;
    if (r < I_PD) return cv_desc(C.in[18] + (size_t)l * 512 * 2048, 2048, 256 * (r % 8) + c4, 128 * (r / 8), MRG8 ? (bf16*)((unsigned char*)WP + 1536) : WP + 1536, 256 * (r % 8), 2048, 0, tid, MRG8 ? 1 : 0);
    r -= I_PD;
    return cv_desc(C.in[19] + (size_t)l * 2048 * 2048, 2048, 256 * (r % 8) + c4, 128 * (r / 8), WOUT, 256 * (r % 8), 2048, 0, tid, OUT8 ? 1 : 0);
}
__device__ __forceinline__ void phase_convert(Ctx& C, int l, int part, int cbid, int cG, unsigned* arr = nullptr) {
    LAS float* tile = (LAS float*)C.lds; LAS int* qn = (LAS int*)(C.lds + AUX_OFF + 8192);
    unsigned* cq = WSP(unsigned, WS_CTL) + CW_CQ + l * 2 + part;
    const int tid = C.tid, lane = C.lane, wave = C.wave;
    constexpr int I_WIN = 16 * 62, NITEMS = I_WIN + 65 * 64 + 65 * 32 + (4 + 2 + 6 + 4) * 8 + 16 * 8;
    const int it0 = part == 0 ? 0 : I_WIN, it1 = part == 0 ? I_WIN : NITEMS;
    __syncthreads();
#if CV_DEEP
#define CV_POP() ((arr && __hip_atomic_load(arr, __ATOMIC_RELAXED, __HIP_MEMORY_SCOPE_AGENT) + STEAL_MARGIN >= (unsigned)C.G) ? 0x7fffffff : it0 + (int)atomicAdd(cq, 1u))
#define CV_LOADS(V, D, REAL) do { const float* p_ = (D).sp; const unsigned long long st_ = (REAL) ? (unsigned long long)(D).ldw * 32ull : 0ull;         \
        _Pragma("unroll") for (int i = 0; i < 16; ++i) asm volatile("global_load_dwordx4 %0, %1, off nt\n\tv_lshl_add_u64 %1, %1, 0, %2" : "=&v"(V[i]), "+v"(p_) : "v"(st_) : "memory"); } while (0)
#define CV_WAIT(N, V) asm volatile("s_waitcnt vmcnt(" #N ")" : "+v"(V[0]), "+v"(V[1]), "+v"(V[2]), "+v"(V[3]), "+v"(V[4]), "+v"(V[5]), "+v"(V[6]), "+v"(V[7]), "+v"(V[8]), "+v"(V[9]), "+v"(V[10]), "+v"(V[11]), "+v"(V[12]), "+v"(V[13]), "+v"(V[14]), "+v"(V[15]), "+v"(praw) :: "memory")
#define CV_POP_ASYNC() do { pstop = arr && __hip_atomic_load(arr, __ATOMIC_RELAXED, __HIP_MEMORY_SCOPE_AGENT) + STEAL_MARGIN >= (unsigned)C.G; \
        const unsigned f_ = (tid == 0 && !pstop) ? 1u : 0u; unsigned long long sv_;     \
        asm volatile("s_mov_b64 %1, exec\n\tv_cmpx_ne_u32_e32 vcc, 0, %2\n\tglobal_atomic_add %0, %3, %4, off sc0\n\ts_mov_b64 exec, %1" : "+v"(praw), "=&s"(sv_) : "v"(f_), "v"(cq), "v"(1u) : "memory", "vcc"); } while (0)
    unsigned praw = 0u; bool pstop = false;
    if (tid == 0) { qn[0] = CV_POP(); qn[1] = CV_POP(); }
    __syncthreads();
    int itA = qn[0], itB = qn[1];
    if (itA < it1) {
    f32x4 va[16], vb[16];
    CvDesc dA = conv_item(C, l, itA, tid), dB = conv_item(C, l, itB < it1 ? itB : it0, tid);
    asm volatile("s_waitcnt vmcnt(0)" ::: "memory");
    CV_POP_ASYNC();
    CV_LOADS(va, dA, true);
    CV_LOADS(vb, dB, itB < it1);
    CV_WAIT(0, va);
    const int c16 = lane & 15, nsub = lane >> 4;
#define CV_STEP(V, D, IT, SLOT) do { \
        CV_WAIT(24, V); \
        _Pragma("unroll") for (int i = 0; i < 16; ++i) { const int kk = wave + 8 * i; *(LAS f32x4*)(tile + kk * 256 + ((4 * (tid & 63)) ^ (4 * ((kk >> 3) & 7)))) = (D).zero ? (f32x4){0.f, 0.f, 0.f, 0.f} : V[i]; } \
        if (tid == 0) qn[2 + SLOT] = pstop ? 0x7fffffff : it0 + (int)praw; \
        __syncthreads(); \
        const int nx = qn[2 + SLOT]; const bool hn = nx < it1; \
        const CvDesc dn = conv_item(C, l, hn ? nx : it0, tid); \
        CV_POP_ASYNC(); \
        CV_LOADS(V, dn, hn); \
        _Pragma("unroll 4") for (int p = 0; p < 8; ++p) { const int n = p * 32 + wave * 4 + nsub; const LAS float* s = tile + (8 * c16) * 256 + (n ^ (4 * (c16 & 7))); \
            const int drow = (D).w13 ? ((n >> 7) << 8) + (n & 127) : n; \
            if ((D).f8) { v2u o8; o8.x = pk4_fp8(s[0 * 256] * 32.f, s[1 * 256] * 32.f, s[2 * 256] * 32.f, s[3 * 256] * 32.f); o8.y = pk4_fp8(s[4 * 256] * 32.f, s[5 * 256] * 32.f, s[6 * 256] * 32.f, s[7 * 256] * 32.f); \
                *(v2u*)((unsigned char*)(D).dp + (size_t)drow * (D).ldt + 8 * c16) = o8; } \
            else { v4u o; o.x = pk2(s[0 * 256], s[1 * 256]); o.y = pk2(s[2 * 256], s[3 * 256]); o.z = pk2(s[4 * 256], s[5 * 256]); o.w = pk2(s[6 * 256], s[7 * 256]); \
                *(v4u*)((D).dp + (size_t)drow * (D).ldt + 8 * c16) = o; } } \
        __syncthreads(); \
        D = dn; IT = nx; } while (0)
    for (;;) {
        if (itA >= it1) break;
        CV_STEP(va, dA, itA, 0);
        if (itB >= it1) break;
        CV_STEP(vb, dB, itB, 1);
    }
    asm volatile("s_waitcnt vmcnt(0)" ::: "memory");
    }
#undef CV_STEP
#undef CV_LOADS
#undef CV_WAIT
#undef CV_POP
#undef CV_POP_ASYNC
#else
    if (tid == 0) qn[0] = (arr && __hip_atomic_load(arr, __ATOMIC_RELAXED, __HIP_MEMORY_SCOPE_AGENT) + STEAL_MARGIN >= (unsigned)C.G) ? 0x7fffffff : it0 + (int)atomicAdd(cq, 1u);
    __syncthreads();
    int it = qn[0];
    f32x4 va[16];
    CvDesc d = conv_item(C, l, it < it1 ? it : it0, tid);
    if (it < it1) {
#pragma unroll
        for (int i = 0; i < 16; ++i) va[i] = d.zero ? (f32x4){0.f, 0.f, 0.f, 0.f} : CV_LOAD((const f32x4*)(d.sp + (size_t)(8 * i) * d.ldw)); }
    const int c16 = lane & 15, nsub = lane >> 4;
    while (it < it1) {
#pragma unroll
        for (int i = 0; i < 16; ++i) { const int kk = wave + 8 * i; *(LAS f32x4*)(tile + kk * 256 + ((4 * (tid & 63)) ^ (4 * ((kk >> 3) & 7)))) = va[i]; }
        if (tid == 0) qn[1] = (arr && __hip_atomic_load(arr, __ATOMIC_RELAXED, __HIP_MEMORY_SCOPE_AGENT) + STEAL_MARGIN >= (unsigned)C.G) ? 0x7fffffff : it0 + (int)atomicAdd(cq, 1u);
        __syncthreads();
        const int nx = qn[1]; const bool hn = nx < it1;
        const CvDesc dn = conv_item(C, l, hn ? nx : it, tid);
        if (hn) {
#pragma unroll
            for (int i = 0; i < 16; ++i) va[i] = dn.zero ? (f32x4){0.f, 0.f, 0.f, 0.f} : CV_LOAD((const f32x4*)(dn.sp + (size_t)(8 * i) * dn.ldw)); }
#pragma unroll
        for (int p = 0; p < 8; ++p) { const int n = p * 32 + wave * 4 + nsub; const LAS float* s = tile + (8 * c16) * 256 + (n ^ (4 * (c16 & 7)));
            const int drow = d.w13 ? ((n >> 7) << 8) + (n & 127) : n;
            if (d.f8) { v2u o8; o8.x = pk4_fp8(s[0 * 256] * 32.f, s[1 * 256] * 32.f, s[2 * 256] * 32.f, s[3 * 256] * 32.f); o8.y = pk4_fp8(s[4 * 256] * 32.f, s[5 * 256] * 32.f, s[6 * 256] * 32.f, s[7 * 256] * 32.f);
                if (CV_NTS && part == 1) __builtin_nontemporal_store(o8, (v2u*)((unsigned char*)d.dp + (size_t)drow * d.ldt + 8 * c16)); else *(v2u*)((unsigned char*)d.dp + (size_t)drow * d.ldt + 8 * c16) = o8; }
            else { v4u o; o.x = pk2(s[0 * 256], s[1 * 256]); o.y = pk2(s[2 * 256], s[3 * 256]); o.z = pk2(s[4 * 256], s[5 * 256]); o.w = pk2(s[6 * 256], s[7 * 256]);
                if (CV_NTS && part == 1) __builtin_nontemporal_store(o, (v4u*)(d.dp + (size_t)drow * d.ldt + 8 * c16)); else *(v4u*)(d.dp + (size_t)drow * d.ldt + 8 * c16) = o; } }
        __syncthreads();
        d = dn; it = nx;
    }
#endif
    if (l == 0 && part == 0) {
        const int gw = cbid * 8 + C.wave, NGW = cG * 8;
        bf16* XB = WSP(bf16, WS_XB); const float* X = C.in[0];
        for (int t = gw; t < T_; t += NGW) {
#pragma unroll
            for (int j = 0; j < 8; ++j) { const f32x4 v = *(const f32x4*)(X + (size_t)t * 2048 + 4 * (lane + 64 * j)); v2u o; o.x = pk2(v[0], v[1]); o.y = pk2(v[2], v[3]); *(v2u*)(XB + (size_t)t * 2048 + 4 * (lane + 64 * j)) = o;
                if (GATES8(0)) *(unsigned*)(WSP(unsigned char, WS_XB8) + (size_t)t * 2048 + 4 * (lane + 64 * j)) = pk4_fp8(v[0], v[1], v[2], v[3]); }
        }
        f32x2* CS = WSP(f32x2, WS_CS); const int* pos = (const int*)C.in[1];
        for (int i = C.bid * 512 + C.tid; i < T_ * 32; i += C.G * 512) { const int t = i >> 5, f = i & 31;
            const float inv = powf(10000.0f, -(float)f * 2.0f / 64.0f), ang = (float)pos[t] * inv; float sn, cs; sincosf(ang, &sn, &cs); CS[i] = (f32x2){cs, sn}; }
    }
}
__device__ __forceinline__ void ln_row(f32x4 (&v)[8], const float* g, const float* b, int lane) {
    float s = 0.f;
#pragma unroll
    for (int j = 0; j < 8; ++j) s += (v[j][0] + v[j][1]) + (v[j][2] + v[j][3]);
    const float mean = wave_sum(s) * (1.f / 2048.f); float q = 0.f;
#pragma unroll
    for (int j = 0; j < 8; ++j) { v[j] = v[j] - mean; q += (v[j][0] * v[j][0] + v[j][1] * v[j][1]) + (v[j][2] * v[j][2] + v[j][3] * v[j][3]); }
    const float rstd = 1.f / sqrtf(wave_sum(q) * (1.f / 2048.f) + LN_EPS_);
#pragma unroll
    for (int j = 0; j < 8; ++j) { const f32x4 gv = *(const f32x4*)(g + 4 * (lane + 64 * j)), bv = *(const f32x4*)(b + 4 * (lane + 64 * j)); v[j] = v[j] * rstd * gv + bv; }
}
__device__ __forceinline__ void phase_ln1_router(Ctx& C, int l) {
    const float* HB = WSP(float, WS_HB); float* X1 = WSP(float, WS_X1); bf16* XS = WSP(bf16, WS_XS); float* ROWW = WSP(float, WS_ROWW);
    int* sel_e = WSP(int, WS_SEL); float* sel_w = WSP(float, WS_SEL + 262144); int* sel_r = WSP(int, WS_SEL + 2 * 262144);
    unsigned* cnt = WSP(unsigned, WS_CTL) + CW_CNT + l * 64;
    const float* g = C.in[20] + l * 2048; const float* b = C.in[21] + l * 2048; const float* wrt = C.in[22] + (size_t)l * 2048 * 64; const float* rb = C.in[23] + l * 64;
    constexpr int XP = 2068;
    LAS float* xl = (LAS float*)C.lds; LAS float* part = xl + 16 * XP; LAS float* scl = part + 2048;
    const int lane = C.lane, wave = C.wave;
    for (int unit = C.bid; unit < T_ / 16; unit += C.G) {
        const int t0 = unit * 16;
#pragma unroll 1
        for (int rr = 0; rr < 2; ++rr) { const int row = 2 * wave + rr; const size_t t = (size_t)(t0 + row);
            f32x4 v[8];
#pragma unroll
            for (int j = 0; j < 8; ++j) { if (HB_BF16) { const v2u hw = *(const v2u*)((const bf16*)HB + t * 2048 + 4 * (lane + 64 * j)); v[j] = (f32x4){bflo(hw.x), bfhi(hw.x), bflo(hw.y), bfhi(hw.y)}; }
                else v[j] = *(const f32x4*)(HB + t * 2048 + 4 * (lane + 64 * j)); }
            ln_row(v, g, b, lane);
#pragma unroll
            for (int j = 0; j < 8; ++j) { if (!X1_BF16) *(f32x4*)(X1 + t * 2048 + 4 * (lane + 64 * j)) = v[j];
                if (MOE8(l)) *(unsigned*)(WSP(unsigned char, WS_XS8) + t * 2048 + 4 * (lane + 64 * j)) = pk4_fp8(v[j][0], v[j][1], v[j][2], v[j][3]);
                if (!MOE8(l) || X1_BF16) { v2u o; o.x = pk2(v[j][0], v[j][1]); o.y = pk2(v[j][2], v[j][3]); *(v2u*)(XS + t * 2048 + 4 * (lane + 64 * j)) = o; }
                *(LAS f32x4*)(xl + row * XP + 4 * (lane + 64 * j)) = v[j]; }
        }
        if (C.tid < 16) { ROWW[t0 + C.tid] = 1.0f; WSP(int, WS_ROWMAP)[t0 + C.tid] = t0 + C.tid; }
        __syncthreads();
        {
            const int et = wave & 3, kh = wave >> 2, i = lane & 15, h = lane >> 4; f32x4 acc = (f32x4){0.f, 0.f, 0.f, 0.f};
            const LAS float* xr = xl + i * XP + kh * 1024 + 4 * h; const float* wb = wrt + (size_t)(kh * 1024 + 4 * h) * 64 + 16 * et + i;
#pragma unroll 4
            for (int s = 0; s < 64; ++s) { const f32x4 a = *(const LAS f32x4*)(xr + 16 * s); const float* wp = wb + (size_t)(16 * s) * 64;
                const float b0 = wp[0], b1 = wp[64], b2 = wp[128], b3 = wp[192];
                acc = __builtin_amdgcn_mfma_f32_16x16x4f32(a[0], b0, acc, 0, 0, 0); acc = __builtin_amdgcn_mfma_f32_16x16x4f32(a[1], b1, acc, 0, 0, 0);
                acc = __builtin_amdgcn_mfma_f32_16x16x4f32(a[2], b2, acc, 0, 0, 0); acc = __builtin_amdgcn_mfma_f32_16x16x4f32(a[3], b3, acc, 0, 0, 0); }
#pragma unroll
            for (int r = 0; r < 4; ++r) part[kh * 1024 + (4 * h + r) * 64 + 16 * et + i] = acc[r];
        }
        __syncthreads();
#pragma unroll
        for (int k = 0; k < 2; ++k) { const int idx = C.tid + 512 * k; scl[idx] = 1.f / (1.f + expf(-(part[idx] + part[1024 + idx]))); }
        __syncthreads();
#pragma unroll 1
        for (int rr = 0; rr < 2; ++rr) { const int tok = 2 * wave + rr, t = t0 + tok; const float* sp = (const float*)(scl + tok * 64);
            const bool sel = route_lane_select(lane, sp, rb); const float s = scl[tok * 64 + lane];
            const unsigned long long m0_ = __ballot(sel); const bool sel8 = sel && __popcll(m0_ & ((1ull << lane) - 1ull)) < 8;
            const float wsum = wave_sum(sel8 ? s : 0.f); const unsigned long long m = __ballot(sel8);
            if (sel8) { const int k = __popcll(m & ((1ull << lane) - 1ull)); sel_e[t * 8 + k] = lane; sel_w[t * 8 + k] = s * 2.5f / wsum; sel_r[t * 8 + k] = (int)atomicAdd(cnt + lane, 1u); } }
        __syncthreads();
    }
}
__device__ __forceinline__ void phase_scatter(Ctx& C, int l) {
    float* ROWW = WSP(float, WS_ROWW); int* ROWMAP = WSP(int, WS_ROWMAP);
    const int* sel_e = WSP(int, WS_SEL); const float* sel_w = WSP(float, WS_SEL + 262144); const int* sel_r = WSP(int, WS_SEL + 2 * 262144); int* POS = WSP(int, WS_SEL + 3 * 262144);
    const unsigned* cnt = WSP(unsigned, WS_CTL) + CW_CNT + l * 64; int* tst = WSP(int, WS_CTL) + CW_TST + l * 128;
    LAS int* offl = (LAS int*)(C.lds + AUX_OFF + 4096);
    if (C.tid == 0) { int ts = 0;
        for (int k = 0; k <= 65; ++k) { if (C.bid == 0) tst[k] = ts; if (k >= 1 && k <= 64) offl[k - 1] = ts * 256; ts += (k == 0) ? 32 : (k <= 64 ? (((int)cnt[k - 1] + 255) >> 8) : 0); } }
    __syncthreads();
    for (int p = C.bid * 512 + C.tid; p < T_ * 8; p += C.G * 512) { const int e = sel_e[p], pos = offl[e] + sel_r[p]; ROWMAP[pos] = p >> 3; ROWW[pos] = sel_w[p]; POS[p] = pos; }
    for (int e = C.bid; e < 64; e += C.G) { const int c = (int)cnt[e], beg = offl[e] + c, end = offl[e] + ((c + 255) & ~255);
        for (int pos = beg + C.tid; pos < end; pos += 512) { ROWMAP[pos] = 0; ROWW[pos] = 0.f; } }
}
__device__ __forceinline__ void phase_combine(Ctx& C, int l) {
    const bf16* YB = WSP(bf16, WS_YBUF); const float* X1 = WSP(float, WS_X1); const int* POS = WSP(int, WS_SEL + 3 * 262144);
    float* XO = (l == NL_ - 1) ? C.out : WSP(float, WS_XA); bf16* XB = WSP(bf16, WS_XB);
    const float* g = C.in[30] + l * 2048; const float* b = C.in[31] + l * 2048;
    const int gw = C.bid * 8 + C.wave, NGW = C.G * 8, lane = C.lane;
    int pn[8];
#pragma unroll
    for (int k = 0; k < 8; ++k) pn[k] = gw < T_ ? POS[gw * 8 + k] : 0;
    for (int t = gw; t < T_; t += NGW) {
        size_t rows[9]; rows[0] = (size_t)t;
#pragma unroll
        for (int k = 0; k < 8; ++k) rows[k + 1] = (size_t)pn[k];
        { const int tn = t + NGW < T_ ? t + NGW : t;
#pragma unroll
          for (int k = 0; k < 8; ++k) pn[k] = POS[tn * 8 + k]; }
#if YB8
        v2u w[9][4];
#pragma unroll
        for (int k = 0; k < 9; ++k)
#pragma unroll
            for (int j = 0; j < 4; ++j) w[k][j] = __builtin_nontemporal_load((const v2u*)((const unsigned char*)YB + rows[k] * 2048 + 8 * lane + 512 * j));
#else
        v4u w[9][4];
#pragma unroll
        for (int k = 0; k < 9; ++k)
#pragma unroll
            for (int j = 0; j < 4; ++j) w[k][j] = __builtin_nontemporal_load((const v4u*)(YB + rows[k] * 2048 + 8 * lane + 512 * j));
#endif
        float v[4][8];
#pragma unroll
        for (int j = 0; j < 4; ++j) { f32x4 a, c;
            if (X1_BF16) { const v4u xw = *(const v4u*)(WSP(bf16, WS_XS) + (size_t)t * 2048 + 8 * lane + 512 * j); a = (f32x4){bflo(xw.x), bfhi(xw.x), bflo(xw.y), bfhi(xw.y)}; c = (f32x4){bflo(xw.z), bfhi(xw.z), bflo(xw.w), bfhi(xw.w)}; }
            else { a = *(const f32x4*)(X1 + (size_t)t * 2048 + 8 * lane + 512 * j); c = *(const f32x4*)(X1 + (size_t)t * 2048 + 8 * lane + 512 * j + 4); }
            v[j][0] = a[0] * DN_ALPHA; v[j][1] = a[1] * DN_ALPHA; v[j][2] = a[2] * DN_ALPHA; v[j][3] = a[3] * DN_ALPHA; v[j][4] = c[0] * DN_ALPHA; v[j][5] = c[1] * DN_ALPHA; v[j][6] = c[2] * DN_ALPHA; v[j][7] = c[3] * DN_ALPHA; }
#if YB8
        {
#pragma unroll
        for (int j = 0; j < 4; ++j) { float sacc[8];
#pragma unroll
            for (int q = 0; q < 8; ++q) sacc[q] = 0.f;
#pragma unroll
            for (int k = 0; k < 9; ++k) { const f32x2 p0 = __builtin_amdgcn_cvt_pk_f32_fp8((int)w[k][j].x, false), p1 = __builtin_amdgcn_cvt_pk_f32_fp8((int)w[k][j].x, true), p2 = __builtin_amdgcn_cvt_pk_f32_fp8((int)w[k][j].y, false), p3 = __builtin_amdgcn_cvt_pk_f32_fp8((int)w[k][j].y, true);
                sacc[0] += p0[0]; sacc[1] += p0[1]; sacc[2] += p1[0]; sacc[3] += p1[1]; sacc[4] += p2[0]; sacc[5] += p2[1]; sacc[6] += p3[0]; sacc[7] += p3[1]; }
#pragma unroll
            for (int q = 0; q < 8; ++q) v[j][q] += sacc[q] * (1.f / 32.f); }
        }
#else
#pragma unroll
        for (int k = 0; k < 9; ++k)
#pragma unroll
            for (int j = 0; j < 4; ++j) { v[j][0] += bflo(w[k][j].x); v[j][1] += bfhi(w[k][j].x); v[j][2] += bflo(w[k][j].y); v[j][3] += bfhi(w[k][j].y); v[j][4] += bflo(w[k][j].z); v[j][5] += bfhi(w[k][j].z); v[j][6] += bflo(w[k][j].w); v[j][7] += bfhi(w[k][j].w); }
#endif
        float s = 0.f;
#pragma unroll
        for (int j = 0; j < 4; ++j)
#pragma unroll
            for (int e = 0; e < 8; ++e) s += v[j][e];
        const float mean = wave_sum(s) * (1.f / 2048.f); float q = 0.f;
#pragma unroll
        for (int j = 0; j < 4; ++j)
#pragma unroll
            for (int e = 0; e < 8; ++e) { v[j][e] -= mean; q += v[j][e] * v[j][e]; }
        const float rstd = 1.f / sqrtf(wave_sum(q) * (1.f / 2048.f) + LN_EPS_);
#pragma unroll
        for (int j = 0; j < 4; ++j) { const int c0 = 8 * lane + 512 * j; float o[8];
            const f32x4 g0 = *(const f32x4*)(g + c0), g1 = *(const f32x4*)(g + c0 + 4), b0 = *(const f32x4*)(b + c0), b1 = *(const f32x4*)(b + c0 + 4);
#pragma unroll
            for (int e = 0; e < 4; ++e) { o[e] = v[j][e] * rstd * g0[e] + b0[e]; o[4 + e] = v[j][4 + e] * rstd * g1[e] + b1[e]; }
            *(f32x4*)(XO + (size_t)t * 2048 + c0) = (f32x4){o[0], o[1], o[2], o[3]}; *(f32x4*)(XO + (size_t)t * 2048 + c0 + 4) = (f32x4){o[4], o[5], o[6], o[7]};
            if (l < NL_ - 1) { v4u ow; ow.x = pk2(o[0], o[1]); ow.y = pk2(o[2], o[3]); ow.z = pk2(o[4], o[5]); ow.w = pk2(o[6], o[7]); *(v4u*)(XB + (size_t)t * 2048 + c0) = ow;
                if (GATES8(l + 1)) { v2u o8; o8.x = pk4_fp8(o[0], o[1], o[2], o[3]); o8.y = pk4_fp8(o[4], o[5], o[6], o[7]); *(v2u*)(WSP(unsigned char, WS_XB8) + (size_t)t * 2048 + c0) = o8; } } }
    }
}
#if MRG8
#define YM_ST4(YM, off, f0, f1, f2, f3) (*(unsigned*)((unsigned char*)(YM) + (off)) = pk4_fp8(4.f * (f0), 4.f * (f1), 4.f * (f2), 4.f * (f3)))
#else
#define YM_ST4(YM, off, f0, f1, f2, f3) do { v2u w_; w_.x = pk2(f0, f1); w_.y = pk2(f2, f3); *(v2u*)((YM) + (off)) = w_; } while (0)
#endif
typedef LAS unsigned char* ldsp;
__device__ __forceinline__ f32x4 mfma16(bf16x8 bt, bf16x8 a, f32x4 c) { return __builtin_amdgcn_mfma_f32_16x16x32_bf16(bt, a, c, 0, 0, 0); }
__device__ __forceinline__ bf16x8 frag(ldsp base, int pitch, int row, int k0, int fq) { return *(const LAS bf16x8*)(base + row * pitch + (k0 + 8 * fq) * 2); }
__device__ __forceinline__ bf16x8 frag2(ldsp base, int pitch, int row, int kA, int kB, int fq) {
    const v2u a = *(const LAS v2u*)(base + row * pitch + (kA + 4 * fq) * 2), b = *(const LAS v2u*)(base + row * pitch + (kB + 4 * fq) * 2);
    v4u r; r.x = a.x; r.y = a.y; r.z = b.x; r.w = b.y; return __builtin_bit_cast(bf16x8, r);
}
typedef short v4i16_t __attribute__((ext_vector_type(4)));
__device__ __forceinline__ bf16x8 trfrag2(ldsp base, int pitch, int col0, int kA, int kB, int lane) {
    const int q = (lane & 15) >> 2, p = lane & 3, fq = lane >> 4;
    const v4i16_t x = __builtin_amdgcn_ds_read_tr16_b64_v4i16((LAS v4i16_t*)(base + (kA + 4 * fq + q) * pitch + (col0 + 4 * p) * 2));
    const v4i16_t y = __builtin_amdgcn_ds_read_tr16_b64_v4i16((LAS v4i16_t*)(base + (kB + 4 * fq + q) * pitch + (col0 + 4 * p) * 2));
    bf16x8 r; r[0] = x[0]; r[1] = x[1]; r[2] = x[2]; r[3] = x[3]; r[4] = y[0]; r[5] = y[1]; r[6] = y[2]; r[7] = y[3]; return r;
}
__device__ __forceinline__ bf16x8 trfrag(ldsp base, int pitch, int col0, int k0, int lane) { const int fq = lane >> 4; return trfrag2(base, pitch, col0, k0 + 4 * fq, k0 + 4 * fq + 4, lane); }
__device__ __forceinline__ bf16x8 pfrag(const f32x4& p0, const f32x4& p1) { v4u r; r.x = pk2(p0[0], p0[1]); r.y = pk2(p0[2], p0[3]); r.z = pk2(p1[0], p1[1]); r.w = pk2(p1[2], p1[3]); return __builtin_bit_cast(bf16x8, r); }
__device__ __forceinline__ void unpack8(const v4u w, float (&f)[8]) { f[0] = bflo(w.x); f[1] = bfhi(w.x); f[2] = bflo(w.y); f[3] = bfhi(w.y); f[4] = bflo(w.z); f[5] = bfhi(w.z); f[6] = bflo(w.w); f[7] = bfhi(w.w); }
__device__ __forceinline__ unsigned short bf1(float x) { return (unsigned short)(pk2(x, 0.f) & 0xffffu); }
__device__ __forceinline__ float flogsigmoid(float x) { return fminf(x, 0.f) - log1pf(__expf(-fabsf(x))); }
__device__ __forceinline__ float fgelu(float v) {
    const float av = fabsf(v), t = __builtin_amdgcn_rcpf(av * 0.2316418882f + 1.0f);
    float q = t * 0.5307027145f + (-0.7265760135f); q = q * t + 0.7107068705f; q = q * t + (-0.142248368f); q = q * t + 0.127414796f; q = q * t;
    const float e = __builtin_amdgcn_exp2f((v * v) * (-0.72134752044f)), m = v * (q * e);
    return v < 0.f ? m : v - m;
}

__device__ __forceinline__ void scat8(LAS unsigned short* vp, int ps  , const v4u w) {
    vp[0 * ps] = (unsigned short)(w.x & 0xffff); vp[1 * ps] = (unsigned short)(w.x >> 16); vp[2 * ps] = (unsigned short)(w.y & 0xffff); vp[3 * ps] = (unsigned short)(w.y >> 16);
    vp[4 * ps] = (unsigned short)(w.z & 0xffff); vp[5 * ps] = (unsigned short)(w.z >> 16); vp[6 * ps] = (unsigned short)(w.w & 0xffff); vp[7 * ps] = (unsigned short)(w.w >> 16);
}

__device__ __forceinline__ void dil_unit(Ctx& C, int u) {
    const int tid = C.tid, lane = C.lane, wave = C.wave, fr = lane & 15, fq = lane >> 4;
    const int blk16 = u & 15, hh = (u >> 4) & 3, g = (u >> 6) % 3, b = u / 192;
    const int dil = g == 0 ? 1 : (g == 1 ? 4 : 16), nbpr = 16 / dil  , r = blk16 / nbpr, nb = blk16 % nbpr, head = g * 4 + hh;
    const bf16* Y = WSP(bf16, WS_Y); const f32x2* CS = WSP(f32x2, WS_CS);
    constexpr int QP = 144, KP = 144, VP = 160;
    ldsp Ql = C.lds, Kl = C.lds + 128 * QP, Vl = Kl + 256 * KP;
    const size_t tb = (size_t)b * SEQ_;
    {   const int ch = tid & 3, row0 = tid >> 2; v4u xa[3], xb[3]; f32x4 cs[3][4]; int mrow[3];
#pragma unroll
        for (int i = 0; i < 3; ++i) { const int row = row0 + (i == 2 ? 128 : 0), m = (i == 0) ? nb * 128 + row : (nb - 1) * 128 + row, mc = m < 0 ? 0 : m; const size_t t = tb + (size_t)mc * dil + r;
            const bf16* src = Y + t * YP + (i == 0 ? Y_BQ : Y_BK) + head * 64 + 8 * ch; xa[i] = *(const v4u*)src; xb[i] = *(const v4u*)(src + 32);
            const f32x4* cp = (const f32x4*)(CS + t * 32 + 8 * ch); cs[i][0] = cp[0]; cs[i][1] = cp[1]; cs[i][2] = cp[2]; cs[i][3] = cp[3]; mrow[i] = m; }
        const int ch8 = tid & 7, key0 = tid >> 3; v4u vv[4];
#pragma unroll
        for (int i = 0; i < 4; ++i) { const int m = (nb - 1) * 128 + key0 + 64 * i, mc = m < 0 ? 0 : m; vv[i] = *(const v4u*)(Y + (tb + (size_t)mc * dil + r) * YP + Y_BV + head * 64 + 8 * ch8); }
#pragma unroll
        for (int i = 0; i < 3; ++i) { const int row = row0 + (i == 2 ? 128 : 0); ldsp dst = (i == 0) ? Ql + row * QP : Kl + row * KP;
            float x1[8], x2[8]; unpack8(xa[i], x1); unpack8(xb[i], x2); const float sc = (i == 0) ? 0.125f : (mrow[i] < 0 ? 0.f : 1.f); float y1[8], y2[8];
#pragma unroll
            for (int k = 0; k < 8; ++k) { const float c = cs[i][k >> 1][2 * (k & 1)], sn = cs[i][k >> 1][2 * (k & 1) + 1]; y1[k] = (x1[k] * c - x2[k] * sn) * sc; y2[k] = (x2[k] * c + x1[k] * sn) * sc; }
            v4u o1, o2; o1.x = pk2(y1[0], y1[1]); o1.y = pk2(y1[2], y1[3]); o1.z = pk2(y1[4], y1[5]); o1.w = pk2(y1[6], y1[7]);
            o2.x = pk2(y2[0], y2[1]); o2.y = pk2(y2[2], y2[3]); o2.z = pk2(y2[4], y2[5]); o2.w = pk2(y2[6], y2[7]);
            *(LAS v4u*)(dst + 16 * ch) = o1; *(LAS v4u*)(dst + 64 + 16 * ch) = o2; }
#pragma unroll
        for (int i = 0; i < 4; ++i) { const int key = key0 + 64 * i; v4u w = vv[i]; if ((nb - 1) * 128 + key < 0) w = (v4u){0u, 0u, 0u, 0u};
            *(LAS v4u*)(Vl + key * VP + 16 * ch8) = w; }
    }
    __syncthreads();
    const int ts = wave < 6 ? wave : 6;
    const bf16x8 q0 = frag(Ql, QP, 16 * wave + fr, 0, fq), q1 = frag(Ql, QP, 16 * wave + fr, 32, fq);
    f32x4 s[10];
#pragma unroll
    for (int t = 0; t < 10; ++t) { s[t] = (f32x4){0.f, 0.f, 0.f, 0.f};
        s[t] = mfma16(frag(Kl, KP, 16 * (ts + t) + fr, 0, fq), q0, s[t]); s[t] = mfma16(frag(Kl, KP, 16 * (ts + t) + fr, 32, fq), q1, s[t]); }
    const int qi = 16 * wave + fr; float mx = -INFINITY;
#pragma unroll
    for (int t = 0; t < 10; ++t)
#pragma unroll
        for (int e = 0; e < 4; ++e) { const int j = 16 * (ts + t) + 4 * fq + e; const bool ok = (j >= qi) && (j <= qi + 128) && ((nb - 1) * 128 + j >= 0); s[t][e] = ok ? s[t][e] : -INFINITY; mx = fmaxf(mx, s[t][e]); }
    mx = fmaxf(mx, __shfl_xor(mx, 16)); mx = fmaxf(mx, __shfl_xor(mx, 32));
    float den = 0.f;
#pragma unroll
    for (int t = 0; t < 10; ++t)
#pragma unroll
        for (int e = 0; e < 4; ++e) { const float p = __expf(s[t][e] - mx); s[t][e] = p; den += p; }
    den += __shfl_xor(den, 16); den += __shfl_xor(den, 32);
    f32x4 o[4];
#pragma unroll
    for (int n = 0; n < 4; ++n) o[n] = (f32x4){0.f, 0.f, 0.f, 0.f};
#pragma unroll
    for (int tp = 0; tp < 5; ++tp) { const bf16x8 pf = pfrag(s[2 * tp], s[2 * tp + 1]);
#pragma unroll
        for (int n = 0; n < 4; ++n) o[n] = mfma16(trfrag2(Vl, VP, 16 * n, 16 * (ts + 2 * tp), 16 * (ts + 2 * tp + 1), lane), pf, o[n]); }
    const size_t t = tb + (size_t)(nb * 128 + qi) * dil + r; const float rden = 1.f / den;
    float* DO = WSP(float, WS_DILO) + t * 768 + head * 64;
#pragma unroll
    for (int n = 0; n < 4; ++n) *(f32x4*)(DO + 16 * n + 4 * fq) = o[n] * rden;
    if (fq == 0) WSP(float, WS_DILL)[t * 12 + head] = mx + __logf(den);
    __syncthreads();
}
__device__ __forceinline__ void dil_merge(Ctx& C, bf16* YM) {
    const float* DO = WSP(float, WS_DILO); const float* DL = WSP(float, WS_DILL);
    for (int i = C.bid * 512 + C.tid; i < T_ * 64; i += C.G * 512) { const int t = i >> 6, hh = (i >> 4) & 3, d4 = (i & 15) * 4;
        const float l0 = DL[t * 12 + hh], l1 = DL[t * 12 + 4 + hh], l2 = DL[t * 12 + 8 + hh], m = fmaxf(l0, fmaxf(l1, l2));
        const float w0 = __expf(l0 - m), w1 = __expf(l1 - m), w2 = __expf(l2 - m), rs = 1.f / (w0 + w1 + w2);
        const f32x4 a = *(const f32x4*)(DO + (size_t)t * 768 + hh * 64 + d4), bb = *(const f32x4*)(DO + (size_t)t * 768 + (4 + hh) * 64 + d4), c = *(const f32x4*)(DO + (size_t)t * 768 + (8 + hh) * 64 + d4);
        const f32x4 o = (a * w0 + bb * w1 + c * w2) * rs;
        YM_ST4(YM, (size_t)t * 2048 + YM_B + hh * 64 + d4, o[0], o[1], o[2], o[3]); }
}

__device__ __forceinline__ void sgu_unit(Ctx& C, int l, int u, bf16* YM) {
    const int tid = C.tid, lane = C.lane, wave = C.wave, fr = lane & 15, fq = lane >> 4;
    const int g = u % 6, cn = u / 6; const size_t t0 = (size_t)cn * 128;
    const bf16* Y = WSP(bf16, WS_Y);
    const float* lng = C.in[11] + l * 768; const float* lnb = C.in[12] + l * 768; const float* ws = C.in[13] + (size_t)(l * 6 + g) * 128 * 128; const float* bs = C.in[14] + (l * 6 + g) * 128;
    constexpr int AP = 272, VP = 288;
    ldsp Al = C.lds, Vl = C.lds + 128 * AP; LAS float* st = (LAS float*)(Vl + 128 * VP);
    {   const int j = tid >> 2, qd = tid & 3; const bf16* src = Y + (t0 + j) * YP + Y_CV + qd * 192; float s1 = 0.f, s2 = 0.f;
        { v4u w[24];
#pragma unroll
            for (int k = 0; k < 24; ++k) w[k] = *(const v4u*)(src + 8 * k);
#pragma unroll
            for (int k = 0; k < 24; ++k) { float x[8]; unpack8(w[k], x);
#pragma unroll
                for (int q2 = 0; q2 < 8; ++q2) { const float z = fgelu(x[q2]); s1 += z; s2 += z * z; } } }
        s1 += __shfl_xor(s1, 1); s2 += __shfl_xor(s2, 1); s1 += __shfl_xor(s1, 2); s2 += __shfl_xor(s2, 2);
        if (qd == 0) { const float mu = s1 * (1.f / 768.f), var = fmaxf(s2 * (1.f / 768.f) - mu * mu, 0.f); st[2 * j] = mu; st[2 * j + 1] = 1.f / sqrtf(var + LN_EPS_); } }
    {   const int c8 = (tid & 15) * 8; f32x4 a[4], bq[4];
#pragma unroll
        for (int k4 = 0; k4 < 4; ++k4) { const int i = (tid >> 4) + 32 * k4; const float* src = ws + i * 128 + c8; a[k4] = *(const f32x4*)src; bq[k4] = *(const f32x4*)(src + 4); }
#pragma unroll
        for (int k4 = 0; k4 < 4; ++k4) { const int i = (tid >> 4) + 32 * k4; float v[8] = {a[k4][0], a[k4][1], a[k4][2], a[k4][3], bq[k4][0], bq[k4][1], bq[k4][2], bq[k4][3]};
#pragma unroll
            for (int k = 0; k < 8; ++k) v[k] = (c8 + k <= i) ? v[k] : 0.f;
            v4u o; o.x = pk2(v[0], v[1]); o.y = pk2(v[2], v[3]); o.z = pk2(v[4], v[5]); o.w = pk2(v[6], v[7]); *(LAS v4u*)(Al + i * AP + c8 * 2) = o; } }
    {   const int c8 = (tid & 15) * 8; v4u w[4];
#pragma unroll
        for (int k4 = 0; k4 < 4; ++k4) { const int j = (tid >> 4) + 32 * k4; w[k4] = *(const v4u*)(Y + (t0 + j) * YP + Y_CV + g * 128 + c8); }
        const f32x4 g0 = *(const f32x4*)(lng + g * 128 + c8), g1 = *(const f32x4*)(lng + g * 128 + c8 + 4), b0 = *(const f32x4*)(lnb + g * 128 + c8), b1 = *(const f32x4*)(lnb + g * 128 + c8 + 4);
        const float gg[8] = {g0[0], g0[1], g0[2], g0[3], g1[0], g1[1], g1[2], g1[3]}, bb[8] = {b0[0], b0[1], b0[2], b0[3], b1[0], b1[1], b1[2], b1[3]};
        __syncthreads();
#pragma unroll
        for (int k4 = 0; k4 < 4; ++k4) { const int j = (tid >> 4) + 32 * k4; float x[8]; unpack8(w[k4], x); const float mu = st[2 * j], rs = st[2 * j + 1];
#pragma unroll
            for (int k = 0; k < 8; ++k) x[k] = (fgelu(x[k]) - mu) * rs * gg[k] + bb[k];
            v4u o; o.x = pk2(x[0], x[1]); o.y = pk2(x[2], x[3]); o.z = pk2(x[4], x[5]); o.w = pk2(x[6], x[7]); *(LAS v4u*)(Vl + j * VP + c8 * 2) = o; } }
    __syncthreads();
    f32x4 acc[8];
#pragma unroll
    for (int n = 0; n < 8; ++n) acc[n] = (f32x4){0.f, 0.f, 0.f, 0.f};
    const int nks = (16 * wave + 15) / 32 + 1;
    for (int ks = 0; ks < nks; ++ks) { const bf16x8 a = frag(Al, AP, 16 * wave + fr, 32 * ks, fq);
#pragma unroll
        for (int n = 0; n < 8; ++n) acc[n] = mfma16(trfrag(Vl, VP, 16 * n, 32 * ks, lane), a, acc[n]); }
    const int i = 16 * wave + fr; const float bsi = bs[i]; const size_t t = t0 + i;
#pragma unroll
    for (int n = 0; n < 8; ++n) { const int c = 16 * n + 4 * fq; const v2u w = *(const v2u*)(Y + t * YP + Y_CU + g * 128 + c);
        const float o0 = fgelu(bflo(w.x)) * (acc[n][0] + bsi), o1 = fgelu(bfhi(w.x)) * (acc[n][1] + bsi), o2 = fgelu(bflo(w.y)) * (acc[n][2] + bsi), o3 = fgelu(bfhi(w.y)) * (acc[n][3] + bsi);
        YM_ST4(YM, t * 2048 + YM_C + g * 128 + c, o0, o1, o2, o3); }
    __syncthreads();
}

__device__ __forceinline__ void gla_decay(Ctx& C, int l, int h, size_t t0, LAS float* Bl, LAS float* tmp  ) {
    const int tid = C.tid; const float* YSM = WSP(float, WS_YSM); const float* wa2 = C.in[3] + l * 16 * 256 + h * 64; const float* ba = C.in[4] + l * 256 + h * 64;
    { const int j = tid >> 3, d0 = (tid & 7) * 8; float a[16];
#pragma unroll
        for (int r4 = 0; r4 < 4; ++r4) { const f32x4 v = *(const f32x4*)(YSM + (t0 + j) * 32 + 4 * r4); a[4 * r4] = v[0]; a[4 * r4 + 1] = v[1]; a[4 * r4 + 2] = v[2]; a[4 * r4 + 3] = v[3]; }
#pragma unroll
        for (int k = 0; k < 8; ++k) { float s = ba[d0 + k];
#pragma unroll
            for (int r = 0; r < 16; ++r) s += a[r] * wa2[r * 256 + d0 + k];
            Bl[j * 65 + d0 + k] = flogsigmoid(s) * (1.f / 16.f); } }
    __syncthreads();
    { const int d = tid & 63, sg = tid >> 6; float run = 0.f;
#pragma unroll
        for (int k = 0; k < 8; ++k) { run += Bl[(8 * sg + k) * 65 + d]; Bl[(8 * sg + k) * 65 + d] = run; }
        tmp[sg * 64 + d] = run;
        __syncthreads();
        float off = 0.f;
        for (int s2 = 0; s2 < sg; ++s2) off += tmp[s2 * 64 + d];
#pragma unroll
        for (int k = 0; k < 8; ++k) Bl[(8 * sg + k) * 65 + d] += off; }
    __syncthreads();
}
__device__ __forceinline__ void gla_local_unit(Ctx& C, int l, int u) {
    const int tid = C.tid, lane = C.lane, wave = C.wave, fr = lane & 15, fq = lane >> 4;
    const int n = u & 31, h = (u >> 5) & 3, b = u >> 7; const size_t t0 = (size_t)b * SEQ_ + n * 64;
    const bf16* Y = WSP(bf16, WS_Y);
    constexpr int KP = 160, VP = 288;
    LAS float* Bl = (LAS float*)C.lds; LAS float* tmp = Bl + 64 * 65; ldsp Kl = (ldsp)(tmp + 512), Vl = Kl + 64 * KP;
    gla_decay(C, l, h, t0, Bl, tmp);
    {   const int j = tid >> 3, d0 = (tid & 7) * 8, e0 = (tid & 15) * 8;
        const v4u kw = *(const v4u*)(Y + (t0 + j) * YP + Y_AK + h * 64 + d0); v4u vw[2];
#pragma unroll
        for (int i = 0; i < 2; ++i) vw[i] = *(const v4u*)(Y + (t0 + (tid >> 4) + 32 * i) * YP + Y_AV + h * 128 + e0);
        float x[8]; unpack8(kw, x);
#pragma unroll
        for (int k = 0; k < 8; ++k) x[k] = x[k] * __expf(Bl[63 * 65 + d0 + k] - Bl[j * 65 + d0 + k]);
        v4u o; o.x = pk2(x[0], x[1]); o.y = pk2(x[2], x[3]); o.z = pk2(x[4], x[5]); o.w = pk2(x[6], x[7]); *(LAS v4u*)(Kl + j * KP + d0 * 2) = o;
#pragma unroll
        for (int i = 0; i < 2; ++i) *(LAS v4u*)(Vl + ((tid >> 4) + 32 * i) * VP + e0 * 2) = vw[i];
    }
    __syncthreads();
    float* LOC = WSP(float, WS_GLOC) + (size_t)u * 64 * 128; float* DEC = WSP(float, WS_GDEC) + (size_t)u * 64;
    if (tid < 64) DEC[tid] = __expf(Bl[63 * 65 + tid]);
#pragma unroll
    for (int mt = 0; mt < 4; ++mt) { f32x4 acc = (f32x4){0.f, 0.f, 0.f, 0.f};
#pragma unroll
        for (int ks = 0; ks < 2; ++ks) acc = mfma16(trfrag2(Vl, VP, 16 * wave, 32 * ks, 32 * ks + 16, lane), trfrag2(Kl, KP, 16 * mt, 32 * ks, 32 * ks + 16, lane), acc);
        *(f32x4*)(LOC + (size_t)(16 * mt + fr) * 128 + 16 * wave + 4 * fq) = acc; }
    __syncthreads();
}
__device__ __forceinline__ void gla_scan(Ctx& C) {
    const float* LOC = WSP(float, WS_GLOC); const float* DEC = WSP(float, WS_GDEC); bf16* ST = WSP(bf16, WS_GST);
    for (int i = C.bid * 512 + C.tid; i < 16 * 8192; i += C.G * 512) { const int bh = i >> 13, de = i & 8191, d = de >> 7; float S = 0.f;
        float lc[32], dc[32];
#pragma unroll
        for (int n = 0; n < 32; ++n) { const size_t uu = (size_t)bh * 32 + n; lc[n] = LOC[uu * 8192 + de]; dc[n] = DEC[uu * 64 + d]; }
#pragma unroll
        for (int n = 0; n < 32; ++n) { const size_t uu = (size_t)bh * 32 + n; ST[uu * 8192 + de] = bf1(S); S = dc[n] * S + lc[n]; } }
}
__device__ __forceinline__ void gla_out_unit(Ctx& C, int l, int u, bf16* YM) {
    const int tid = C.tid, lane = C.lane, wave = C.wave, fr = lane & 15, fq = lane >> 4;
    const int n = u & 31, h = (u >> 5) & 3, b = u >> 7; const size_t t0 = (size_t)b * SEQ_ + n * 64;
    const bf16* Y = WSP(bf16, WS_Y); const bf16* ST = WSP(bf16, WS_GST) + (size_t)u * 8192;
    constexpr int QP = 144, VP = 288;
    LAS float* Bl = (LAS float*)C.lds; LAS float* tmp = Bl + 64 * 65; ldsp Ql = (ldsp)(tmp + 512), Kl = Ql + 64 * QP, Vl = Kl + 64 * QP, Sl = Vl + 64 * VP; LAS float* ssq = (LAS float*)(Sl + 64 * VP);
    gla_decay(C, l, h, t0, Bl, tmp);
    {   const int j = tid >> 3, d0 = (tid & 7) * 8, e0 = (tid & 15) * 8, j2 = tid >> 4;
        const v4u qw = *(const v4u*)(Y + (t0 + j) * YP + Y_AQ + h * 64 + d0), kw = *(const v4u*)(Y + (t0 + j) * YP + Y_AK + h * 64 + d0); v4u vw[2], sw[2];
#pragma unroll
        for (int i = 0; i < 2; ++i) { vw[i] = *(const v4u*)(Y + (t0 + j2 + 32 * i) * YP + Y_AV + h * 128 + e0); sw[i] = *(const v4u*)(ST + (j2 + 32 * i) * 128 + e0); }
        float xq[8], xk[8]; unpack8(qw, xq); unpack8(kw, xk);
#pragma unroll
        for (int k = 0; k < 8; ++k) { const float bb = Bl[j * 65 + d0 + k]; xq[k] = xq[k] * 0.125f * __expf(bb); xk[k] = xk[k] * __expf(-bb); }
        v4u o; o.x = pk2(xq[0], xq[1]); o.y = pk2(xq[2], xq[3]); o.z = pk2(xq[4], xq[5]); o.w = pk2(xq[6], xq[7]); *(LAS v4u*)(Ql + j * QP + d0 * 2) = o;
        o.x = pk2(xk[0], xk[1]); o.y = pk2(xk[2], xk[3]); o.z = pk2(xk[4], xk[5]); o.w = pk2(xk[6], xk[7]); *(LAS v4u*)(Kl + j * QP + d0 * 2) = o;
#pragma unroll
        for (int i = 0; i < 2; ++i) { *(LAS v4u*)(Vl + (j2 + 32 * i) * VP + e0 * 2) = vw[i]; *(LAS v4u*)(Sl + (j2 + 32 * i) * VP + e0 * 2) = sw[i]; }
    }
    __syncthreads();
    const int mt = wave & 3, nh = wave >> 2;
    const bf16x8 qa0 = frag(Ql, QP, 16 * mt + fr, 0, fq), qa1 = frag(Ql, QP, 16 * mt + fr, 32, fq);
    f32x4 att[4];
#pragma unroll
    for (int t = 0; t < 4; ++t) { att[t] = (f32x4){0.f, 0.f, 0.f, 0.f}; att[t] = mfma16(frag(Kl, QP, 16 * t + fr, 0, fq), qa0, att[t]); att[t] = mfma16(frag(Kl, QP, 16 * t + fr, 32, fq), qa1, att[t]);
#pragma unroll
        for (int e = 0; e < 4; ++e) att[t][e] = (16 * t + 4 * fq + e <= 16 * mt + fr) ? att[t][e] : 0.f; }
    const bf16x8 p0 = pfrag(att[0], att[1]), p1 = pfrag(att[2], att[3]);
    f32x4 o[4];
#pragma unroll
    for (int nt = 0; nt < 4; ++nt) { const int ec = 64 * nh + 16 * nt; f32x4 a = (f32x4){0.f, 0.f, 0.f, 0.f};
        a = mfma16(trfrag2(Vl, VP, ec, 0, 16, lane), p0, a); a = mfma16(trfrag2(Vl, VP, ec, 32, 48, lane), p1, a);
        a = mfma16(trfrag(Sl, VP, ec, 0, lane), qa0, a); a = mfma16(trfrag(Sl, VP, ec, 32, lane), qa1, a); o[nt] = a; }
    float sq = 0.f;
#pragma unroll
    for (int nt = 0; nt < 4; ++nt) sq += (o[nt][0] * o[nt][0] + o[nt][1] * o[nt][1]) + (o[nt][2] * o[nt][2] + o[nt][3] * o[nt][3]);
    sq += __shfl_xor(sq, 16); sq += __shfl_xor(sq, 32);
    const int i = 16 * mt + fr;
    if (fq == 0) ssq[2 * i + nh] = sq;
    __syncthreads();
    const float rs = 1.f / sqrtf((ssq[2 * i] + ssq[2 * i + 1]) * (1.f / 128.f) + LN_EPS_);
    const float* ng = C.in[5] + l * 512 + h * 128; const size_t t = t0 + i;
#pragma unroll
    for (int nt = 0; nt < 4; ++nt) { const int e = 64 * nh + 16 * nt + 4 * fq; const f32x4 gv = *(const f32x4*)(ng + e); const v2u rw = *(const v2u*)(Y + t * YP + Y_AR + h * 128 + e);
        const float r0 = bflo(rw.x), r1 = bfhi(rw.x), r2 = bflo(rw.y), r3 = bfhi(rw.y);
        YM_ST4(YM, t * 2048 + YM_A + h * 128 + e, o[nt][0] * rs * gv[0] * r0 * fsigmoid(r0), o[nt][1] * rs * gv[1] * r1 * fsigmoid(r1), o[nt][2] * rs * gv[2] * r2 * fsigmoid(r2), o[nt][3] * rs * gv[3] * r3 * fsigmoid(r3)); }
    __syncthreads();
}

__device__ __forceinline__ void ml_prep(Ctx& C, int l, int h, int b, int n, LAS float* gl, ldsp Ql, ldsp Kl, int QP, bool need_q) {
    const int tid = C.tid, lane = C.lane; const size_t t0 = (size_t)b * SEQ_ + n * 64;
    const bf16* Y = WSP(bf16, WS_Y); const float* YSM = WSP(float, WS_YSM);
    if (tid < 64) { const float lf = flogsigmoid(YSM[(t0 + lane) * 32 + 20 + h] + C.in[9][l * 4 + h]); float run = lf;
#pragma unroll
        for (int o = 1; o < 64; o <<= 1) { const float v = __shfl_up(run, o); if (lane >= o) run += v; }
        gl[lane] = run; gl[64 + lane] = YSM[(t0 + lane) * 32 + 16 + h] + C.in[8][l * 4 + h]; }
    const float* cw = C.in[6] + l * 4096; const float* cb = C.in[7] + l * 1024;
    {   const int c0 = (tid & 15) * 8, j0 = tid >> 4;
#pragma unroll
        for (int qk = 0; qk < 2; ++qk) { if (qk == 0 && !need_q) continue;
            const int cc = (qk == 0 ? 0 : 512) + h * 128 + c0, ycol = (qk == 0 ? Y_DQ : Y_DK) + h * 128 + c0;
            v4u xw[2][4]; f32x4 w4[4][2], b4[2];
#pragma unroll
            for (int i = 0; i < 2; ++i)
#pragma unroll
                for (int jj = 0; jj < 4; ++jj) { const int j = j0 + 32 * i, rel = j - 3 + jj, ok = (n * 64 + rel) >= 0; xw[i][jj] = *(const v4u*)(Y + (t0 + (ok ? rel : j)) * YP + ycol); }
#pragma unroll
            for (int jj = 0; jj < 4; ++jj) { w4[jj][0] = *(const f32x4*)(cw + jj * 1024 + cc); w4[jj][1] = *(const f32x4*)(cw + jj * 1024 + cc + 4); }
            b4[0] = *(const f32x4*)(cb + cc); b4[1] = *(const f32x4*)(cb + cc + 4);
#pragma unroll
            for (int i = 0; i < 2; ++i) { const int j = j0 + 32 * i; float a[8] = {b4[0][0], b4[0][1], b4[0][2], b4[0][3], b4[1][0], b4[1][1], b4[1][2], b4[1][3]};
#pragma unroll
                for (int jj = 0; jj < 4; ++jj) { const float mk = (n * 64 + j - 3 + jj) >= 0 ? 1.f : 0.f; float x[8]; unpack8(xw[i][jj], x);
#pragma unroll
                    for (int k = 0; k < 8; ++k) a[k] += (w4[jj][k >> 2][k & 3] * mk) * x[k]; }
                const float sc = qk == 0 ? 1.f : 0.08838834764831845f;
#pragma unroll
                for (int k = 0; k < 8; ++k) a[k] = a[k] * fsigmoid(a[k]) * sc;
                v4u o; o.x = pk2(a[0], a[1]); o.y = pk2(a[2], a[3]); o.z = pk2(a[4], a[5]); o.w = pk2(a[6], a[7]); *(LAS v4u*)((qk == 0 ? Ql : Kl) + j * QP + c0 * 2) = o; } }
    }
    __syncthreads();
}
__device__ __forceinline__ void ml_local_unit(Ctx& C, int l, int u) {
    const int tid = C.tid, lane = C.lane, wave = C.wave, fr = lane & 15, fq = lane >> 4;
    const int n = u & 31, h = (u >> 5) & 3, b = u >> 7; const size_t t0 = (size_t)b * SEQ_ + n * 64;
    const bf16* Y = WSP(bf16, WS_Y);
    constexpr int KP = 288, TP = 288;
    LAS float* gl = (LAS float*)C.lds; LAS float* wk = gl + 128; LAS float* red = wk + 64;
    ldsp Kl = (ldsp)(red + 512), Vl = Kl + 64 * KP;
    ml_prep(C, l, h, b, n, gl, Kl, Kl, KP, false);
    if (tid < 64) { const float bl = gl[63], dec = bl - gl[lane] + gl[64 + lane], a = wave_max(dec); wk[lane] = __expf(dec - a);
        if (lane == 0) { float* SC = WSP(float, WS_MSC) + (size_t)u * 2; SC[0] = bl; SC[1] = a; } }
    __syncthreads();
    { const int d = tid & 127, sg = tid >> 7; float s = 0.f;
        for (int j = 16 * sg; j < 16 * sg + 16; ++j) s += wk[j] * bflo((unsigned)*(const LAS unsigned short*)(Kl + j * KP + d * 2));
        red[sg * 128 + d] = s; }
    {   const int c0 = (tid & 15) * 8, j0 = tid >> 4; v4u vw[2];
#pragma unroll
        for (int i = 0; i < 2; ++i) vw[i] = *(const v4u*)(Y + (t0 + j0 + 32 * i) * YP + Y_DV + h * 128 + c0);
#pragma unroll
        for (int i = 0; i < 2; ++i) *(LAS v4u*)(Vl + (j0 + 32 * i) * TP + c0 * 2) = vw[i];
    }
    __syncthreads();
    {   const int c0 = (tid & 15) * 8, j0 = tid >> 4;
#pragma unroll
        for (int i = 0; i < 2; ++i) { const int j = j0 + 32 * i; float x[8]; unpack8(*(const LAS v4u*)(Kl + j * KP + c0 * 2), x); const float w = wk[j];
            v4u o; o.x = pk2(x[0] * w, x[1] * w); o.y = pk2(x[2] * w, x[3] * w); o.z = pk2(x[4] * w, x[5] * w); o.w = pk2(x[6] * w, x[7] * w); *(LAS v4u*)(Kl + j * KP + c0 * 2) = o; }
    }
    if (tid < 128) WSP(float, WS_MNLOC)[(size_t)u * 128 + tid] = (red[tid] + red[128 + tid]) + (red[256 + tid] + red[384 + tid]);
    __syncthreads();
    float* LOC = WSP(float, WS_MLOC) + (size_t)u * 16384;
#pragma unroll
    for (int mt = 0; mt < 8; ++mt) { f32x4 acc = (f32x4){0.f, 0.f, 0.f, 0.f};
#pragma unroll
        for (int ks = 0; ks < 2; ++ks) acc = mfma16(trfrag2(Vl, TP, 16 * wave, 32 * ks, 32 * ks + 16, lane), trfrag2(Kl, KP, 16 * mt, 32 * ks, 32 * ks + 16, lane), acc);
        *(f32x4*)(LOC + (size_t)(16 * mt + fr) * 128 + 16 * wave + 4 * fq) = acc; }
    __syncthreads();
}
__device__ __forceinline__ void ml_scan(Ctx& C) {
    const float* LOC = WSP(float, WS_MLOC); const float* NL = WSP(float, WS_MNLOC); const float* SC = WSP(float, WS_MSC);
    bf16* MC = WSP(bf16, WS_MC); float* MN = WSP(float, WS_MN); float* MM = WSP(float, WS_MM);
    for (int i = C.bid * 512 + C.tid; i < 16 * (16384 + 128); i += C.G * 512) { const int bh = i / (16384 + 128), r = i % (16384 + 128); float S = 0.f, m = 0.f;
        float lc[32], bl_[32], a_[32];
#pragma unroll
        for (int n = 0; n < 32; ++n) { const size_t uu = (size_t)bh * 32 + n; lc[n] = r < 16384 ? LOC[uu * 16384 + r] : NL[uu * 128 + (r - 16384)]; bl_[n] = SC[uu * 2]; a_[n] = SC[uu * 2 + 1]; }
#pragma unroll
        for (int n = 0; n < 32; ++n) { const size_t uu = (size_t)bh * 32 + n; const float bl = bl_[n], a = a_[n], mn = fmaxf(bl + m, a), keep = __expf(bl + m - mn), sc = __expf(a - mn);
            if (r < 16384) MC[uu * 16384 + r] = bf1(S);
            else { const int d = r - 16384; MN[uu * 128 + d] = S; if (d == 0) MM[uu] = m; }
            S = keep * S + sc * lc[n]; m = mn; } }
}
__device__ __forceinline__ void ml_out_unit(Ctx& C, int l, int u, bf16* YM) {
    const int tid = C.tid, lane = C.lane, wave = C.wave, fr = lane & 15, fq = lane >> 4;
    const int n = u & 31, h = (u >> 5) & 3, b = u >> 7; const size_t t0 = (size_t)b * SEQ_ + n * 64;
    const bf16* Y = WSP(bf16, WS_Y); const bf16* MC = WSP(bf16, WS_MC) + (size_t)u * 16384; const float* MN = WSP(float, WS_MN) + (size_t)u * 128; const float m0 = WSP(float, WS_MM)[u];
    constexpr int QP = 272, TP = 288;
    LAS float* gl = (LAS float*)C.lds; LAS float* mt_ = gl + 128; LAS float* wst = mt_ + 64; LAS float* qn = wst + 64; LAS float* ssq = qn + 64;
    ldsp Ql = (ldsp)(ssq + 128), Kl = Ql + 64 * QP, Vl = Kl + 64 * QP, Cl = Vl + 64 * TP;
    ml_prep(C, l, h, b, n, gl, Ql, Kl, QP, true);
    if (tid < 64) { float pm = gl[64 + lane] - gl[lane];
#pragma unroll
        for (int o = 1; o < 64; o <<= 1) { const float v = __shfl_up(pm, o); if (lane >= o) pm = fmaxf(pm, v); }
        const float mt = gl[lane] + fmaxf(m0, pm); mt_[lane] = mt; wst[lane] = __expf(gl[lane] + m0 - mt); }
    {   const int c0 = (tid & 15) * 8, j0 = tid >> 4; v4u vw[2], cw4[4];
#pragma unroll
        for (int i = 0; i < 2; ++i) vw[i] = *(const v4u*)(Y + (t0 + j0 + 32 * i) * YP + Y_DV + h * 128 + c0);
#pragma unroll
        for (int i = 0; i < 4; ++i) cw4[i] = *(const v4u*)(MC + (j0 + 32 * i) * 128 + c0);
#pragma unroll
        for (int i = 0; i < 2; ++i) *(LAS v4u*)(Vl + (j0 + 32 * i) * TP + c0 * 2) = vw[i];
#pragma unroll
        for (int i = 0; i < 4; ++i) *(LAS v4u*)(Cl + (j0 + 32 * i) * TP + c0 * 2) = cw4[i];
    }
    { const int i = tid >> 3, d0 = (tid & 7) * 16; float s = 0.f;
#pragma unroll
        for (int k2 = 0; k2 < 2; ++k2) { float x[8]; unpack8(*(const LAS v4u*)(Ql + i * QP + (d0 + 8 * k2) * 2), x);
#pragma unroll
            for (int k = 0; k < 8; ++k) s += x[k] * MN[d0 + 8 * k2 + k]; }
        s += __shfl_xor(s, 1); s += __shfl_xor(s, 2); s += __shfl_xor(s, 4);
        if ((tid & 7) == 0) qn[i] = s; }
    __syncthreads();
    const int mt = wave & 3, nh = wave >> 2, i = 16 * mt + fr;
    bf16x8 qa[4];
#pragma unroll
    for (int ks = 0; ks < 4; ++ks) qa[ks] = frag(Ql, QP, i, 32 * ks, fq);
    const float bi_ = gl[i], mti = mt_[i], wsti = wst[i];
    f32x4 sc[4]; float rsum = 0.f;
#pragma unroll
    for (int t = 0; t < 4; ++t) { sc[t] = (f32x4){0.f, 0.f, 0.f, 0.f};
#pragma unroll
        for (int ks = 0; ks < 4; ++ks) sc[t] = mfma16(frag(Kl, QP, 16 * t + fr, 32 * ks, fq), qa[ks], sc[t]);
#pragma unroll
        for (int e = 0; e < 4; ++e) { const int j = 16 * t + 4 * fq + e; const float w = (j <= i) ? __expf(bi_ - gl[j] + gl[64 + j] - mti) : 0.f; sc[t][e] *= w; rsum += sc[t][e]; } }
    rsum += __shfl_xor(rsum, 16); rsum += __shfl_xor(rsum, 32);
    const float den = rsum + wsti * qn[i], rden = 1.f / fmaxf(fabsf(den), __expf(-mti));
    const bf16x8 p0 = pfrag(sc[0], sc[1]), p1 = pfrag(sc[2], sc[3]);
    f32x4 o[4]; float sq = 0.f;
    const size_t t = t0 + i;
#pragma unroll
    for (int nt = 0; nt < 4; ++nt) { const int ec = 64 * nh + 16 * nt; f32x4 a1 = (f32x4){0.f, 0.f, 0.f, 0.f}, a2 = a1;
        a1 = mfma16(trfrag2(Vl, TP, ec, 0, 16, lane), p0, a1); a1 = mfma16(trfrag2(Vl, TP, ec, 32, 48, lane), p1, a1);
#pragma unroll
        for (int ks = 0; ks < 4; ++ks) a2 = mfma16(trfrag(Cl, TP, ec, 32 * ks, lane), qa[ks], a2);
        const v2u ow = *(const v2u*)(Y + t * YP + Y_DO + h * 128 + 64 * nh + 16 * nt + 4 * fq);
        f32x4 hv = (a1 + a2 * wsti) * rden; hv[0] *= fsigmoid(bflo(ow.x)); hv[1] *= fsigmoid(bfhi(ow.x)); hv[2] *= fsigmoid(bflo(ow.y)); hv[3] *= fsigmoid(bfhi(ow.y));
        o[nt] = hv; sq += (hv[0] * hv[0] + hv[1] * hv[1]) + (hv[2] * hv[2] + hv[3] * hv[3]); }
    sq += __shfl_xor(sq, 16); sq += __shfl_xor(sq, 32);
    if (fq == 0) ssq[2 * i + nh] = sq;
    __syncthreads();
    const float rs = 1.f / sqrtf((ssq[2 * i] + ssq[2 * i + 1]) * (1.f / 128.f) + LN_EPS_);
    const float* ng = C.in[10] + l * 512 + h * 128;
#pragma unroll
    for (int nt = 0; nt < 4; ++nt) { const int e = 64 * nh + 16 * nt + 4 * fq; const f32x4 gv = *(const f32x4*)(ng + e);
        YM_ST4(YM, t * 2048 + YM_D + h * 128 + e, o[nt][0] * rs * gv[0], o[nt][1] * rs * gv[1], o[nt][2] * rs * gv[2], o[nt][3] * rs * gv[3]); }
    __syncthreads();
}

#ifndef MIXREP
#define MIXREP 0
#endif
#define RELAUNDER(C) do { int zv_ = 0; asm volatile("" : "+v"(zv_)); unsigned long long zw_ = (unsigned long long)(C).ws; asm volatile("" : "+s"(zw_)); (C).ws = (unsigned char*)(GAS unsigned char*)zw_;     \
    (C).tid = (int)threadIdx.x + zv_; (C).lane = (C).tid & 63; (C).wave = __builtin_amdgcn_readfirstlane((C).tid >> 6); } while (0)
__device__ __forceinline__ void phase_mix_a(Ctx& C, int l, bf16* YM) {
    const bool std_grid = C.G == 256;
    if (std_grid) {
        const int nd = C.bid < 128 ? 2 : 4, d0 = C.bid < 128 ? C.bid : 256 + (C.bid - 128);
        for (int k = 0; k < nd; ++k) { RELAUNDER(C); const int u = d0 + 128 * k; dil_unit(C, u); if (MIXREP & 1) dil_unit(C, u); }
    } else for (int u = C.bid; u < 768; u += C.G) { RELAUNDER(C); dil_unit(C, u); }
    for (int u = C.bid; u < 384; u += C.G) { RELAUNDER(C); sgu_unit(C, l, u, YM); if (MIXREP & 2) sgu_unit(C, l, u, YM); }
    for (int u = C.bid; u < 512; u += C.G) { RELAUNDER(C); gla_local_unit(C, l, u); if (MIXREP & 4) gla_local_unit(C, l, u); }
    for (int u = C.bid; u < 512; u += C.G) { RELAUNDER(C); ml_local_unit(C, l, u); if (MIXREP & 8) ml_local_unit(C, l, u); }
}
__device__ __forceinline__ void phase_mix_b(Ctx& C, bf16* YM) { gla_scan(C); ml_scan(C); dil_merge(C, YM); }
__device__ __forceinline__ void phase_mix_c(Ctx& C, int l, bf16* YM) {
    for (int u = C.bid; u < 1024; u += C.G) { RELAUNDER(C); if (u < 512) { gla_out_unit(C, l, u, YM); if (MIXREP & 16) gla_out_unit(C, l, u, YM); } else { ml_out_unit(C, l, u - 512, YM); if (MIXREP & 32) ml_out_unit(C, l, u - 512, YM); } }
}
#ifndef EARLY_WIN
#define EARLY_WIN 0
#endif
#ifndef STEAL_ON
#define STEAL_ON 0
#endif
#ifndef Y_WGM
#define Y_WGM 8
#endif
#ifndef Y_BAL
#define Y_BAL 0
#endif
#ifndef NCONV
#define NCONV 72
#endif
#ifndef REPEAT_MASK
#define REPEAT_MASK 0
#endif
#define REP(k) (((REPEAT_MASK) >> (k)) & 1)
#define RELAUNDER_T(C) do { int zv_ = 0; asm volatile("" : "+v"(zv_)); (C).tid = (int)threadIdx.x + zv_; (C).lane = (C).tid & 63; (C).wave = __builtin_amdgcn_readfirstlane((C).tid >> 6); } while (0)
#define IN(k) (lo <= (k) && (k) < hi)
#ifndef BAR_REP
#define BAR_REP 1
#endif
#define SEAM(k) do { if (IN(k) && IN((k) + 1)) { for (int br_ = 0; br_ < BAR_REP; ++br_) xcd_barrier(bar); } } while (0)
#define STEAL(k) do { if (STEAL_ON && FP8_LAST && l + 2 == NL_ && IN(k) && IN((k) + 1)) { unsigned* arr_ = WSP(unsigned, WS_CTL) + CW_ARR + 64 * (k); __syncthreads(); if (C.tid == 0) atomicAdd(arr_, 1u); \
        phase_convert(C, l + 1, 1, C.bid, C.G, arr_); } } while (0)
template <int l>
__device__ __forceinline__ void layer_program(Ctx& C, const XcdBarrier& bar, const int lo, const int hi) {
    constexpr int p0 = l * 12;
    const float* Xin = l == 0 ? C.in[0] : WSP(float, WS_XA);
    if (l == 0) { if (IN(p0 + 0)) for (int rep_ = 0; rep_ < 1 + REP(0); ++rep_) { RELAUNDER_T(C); phase_convert(C, l, 0, C.bid, C.G); }
        SEAM(p0 + 0); }
    if (IN(p0 + 1)) for (int rep_ = 0; rep_ < 1 + REP(1); ++rep_) { RELAUNDER_T(C);
        if (C.bid < NCONV) phase_convert(C, l, 1, C.bid, NCONV);
        else {
        if constexpr (GATES8(l)) {
            { pg8::Gemm g{WSP(bf16, WS_XB), WSP(bf16, WS_WIN), T_, 256, 2048, 2048, 2048, nullptr}; pg8::StaticOrder S; S.init(T_, 256, C.G - NCONV, C.bid - NCONV, Y_WGM);
              EpiY E{WSP(bf16, WS_Y), WSP(float, WS_YSM), 0}; pg8::gemm_phase<EpiY, pg8::StaticOrder, true>(C.lds, g, S, E, C.tid); }
            { pg8::Gemm g{WSP(bf16, WS_XB8), WSP(bf16, WS_WIN8), T_, 15616, 1024, 1024, 1024, nullptr}; pg8::StaticOrder S; S.init(T_, 15616, C.G - NCONV, C.bid - NCONV, Y_WGM);
              if (Y_BAL) {
                  const int Gg = C.G - NCONV, cg = C.bid - NCONV, remA = (1 * 32) % Gg, G2 = Gg - remA; int r0 = (61 * 32 - 2 * G2 + Gg - 1) / Gg; if (r0 < 0) r0 = 0;
                  S.r0 = r0; S.G2 = G2; S.c2 = cg >= remA ? cg - remA : -1; }
              EpiY E{WSP(bf16, WS_Y), WSP(float, WS_YSM), 1}; pg8::gemm_phase<EpiY, pg8::StaticOrder, true, false, 2, 1>(C.lds, g, S, E, C.tid); }
        } else {
        pg8::Gemm g{WSP(bf16, WS_XB), WSP(bf16, WS_WIN), T_, YP, 2048, 2048, 2048, nullptr}; pg8::StaticOrder S; S.init(T_, YP, C.G - NCONV, C.bid - NCONV, Y_WGM);
        EpiY E{WSP(bf16, WS_Y), WSP(float, WS_YSM), 0};
        pg8::gemm_phase<EpiY, pg8::StaticOrder, true>(C.lds, g, S, E, C.tid); }
        phase_convert(C, l, 1, C.bid, NCONV); }
    }
    SEAM(p0 + 1);
    bf16* YMo = WSP(bf16, MK_MODE == 1 ? WS_MRG : WS_YM);
    if (IN(p0 + 2)) for (int rep_ = 0; rep_ < 1 + REP(2); ++rep_) { RELAUNDER_T(C); phase_mix_a(C, l, YMo); }
    SEAM(p0 + 2);
    if (IN(p0 + 3)) for (int rep_ = 0; rep_ < 1 + REP(3); ++rep_) { RELAUNDER_T(C); phase_mix_b(C, YMo); }
    SEAM(p0 + 3);
    if (IN(p0 + 4)) for (int rep_ = 0; rep_ < 1 + REP(4); ++rep_) { RELAUNDER_T(C); phase_mix_c(C, l, YMo); }
    SEAM(p0 + 4);
    if (IN(p0 + 5)) for (int rep_ = 0; rep_ < 1 + REP(5); ++rep_) { RELAUNDER_T(C);
        pg8::StaticOrder S; S.init(T_, 4096, C.G, C.bid);
        pg8::Gemm g{WSP(bf16, WS_YM), WSP(bf16, WS_WP), T_, 2048, 2048, 2048, 2048, nullptr}; EpiMerge E; E.Y = WSP(bf16, WS_Y); E.MB = WSP(bf16, WS_MB);
        if constexpr (MRG8 != 0) { pg8::Gemm g8{WSP(bf16, WS_YM), WSP(bf16, WS_WP), T_, 2048, 1024, 1024, 1024, nullptr};
            pg8::gemm_phase<EpiMerge, pg8::StaticOrder, true, false, 1, 1, 0x7d7d7d7du>(C.lds, g8, S, E, C.tid); }
        else if (MERGE3) pg8::gemm_phase_n1s3<EpiMerge, pg8::StaticOrder>(C.lds, g, S, E, C.tid); else pg8::gemm_phase<EpiMerge, pg8::StaticOrder, true, false, 1>(C.lds, g, S, E, C.tid);
    }
    SEAM(p0 + 5);
    if (IN(p0 + 6)) for (int rep_ = 0; rep_ < 1 + REP(6); ++rep_) { RELAUNDER_T(C);
        pg8::StaticOrder S; S.init(T_, 2048, C.G, C.bid);
        EpiOut E{Xin, WSP(float, WS_HB)};
        if constexpr (OUT8 != 0) { pg8::Gemm g{WSP(bf16, WS_MB), WSP(bf16, WS_WOUT), T_, 2048, 1024, 1024, 1024, nullptr};
            pg8::gemm_phase<EpiOut, pg8::StaticOrder, true, false, 2, 1, 0x7c7c7c7cu>(C.lds, g, S, E, C.tid); }
        else { pg8::Gemm g{WSP(bf16, WS_MB), WSP(bf16, WS_WOUT), T_, 2048, 2048, 2048, 2048, nullptr};
            pg8::gemm_phase<EpiOut, pg8::StaticOrder, true>(C.lds, g, S, E, C.tid); }
    }
    SEAM(p0 + 6);
    if (IN(p0 + 7)) for (int rep_ = 0; rep_ < 1 + REP(7); ++rep_) { RELAUNDER_T(C); phase_ln1_router(C, l); }
    SEAM(p0 + 7);
    if (IN(p0 + 8)) for (int rep_ = 0; rep_ < 1 + REP(8); ++rep_) { RELAUNDER_T(C); phase_scatter(C, l); }
    SEAM(p0 + 8);
    if (IN(p0 + 9)) for (int rep_ = 0; rep_ < 1 + REP(9); ++rep_) { RELAUNDER_T(C);
        MoeOrder S; S.init(WSP(int, WS_CTL) + CW_TST + l * 128, 4, C.G, C.bid, C.lane);
        if constexpr (MOE8(l)) {
            pg8::Gemm g{WSP(bf16, WS_XS8), WSP(bf16, l == NL_ - 1 ? WS_W13B : WS_W13), MAXROWS, 65 * 1024, 1024, 1024, 1024, WSP(int, WS_ROWMAP)};
            EpiMoe1F8 E{WSP(unsigned char, WS_H), WSP(float, WS_ROWW)};
            pg8::gemm_phase<EpiMoe1F8, MoeOrder, true, true, 2, 1>(C.lds, g, S, E, C.tid);
        } else {
            pg8::Gemm g{WSP(bf16, WS_XS), WSP(bf16, WS_W13), MAXROWS, 65 * 1024, 2048, 2048, 2048, WSP(int, WS_ROWMAP)};
            EpiMoe1 E{WSP(bf16, WS_H), WSP(float, WS_ROWW), 4};
            pg8::gemm_phase<EpiMoe1, MoeOrder, true, true>(C.lds, g, S, E, C.tid);
        }
    }
    if (STEAL_ON & 1) STEAL(p0 + 9);
    SEAM(p0 + 9);
    if (IN(p0 + 10)) for (int rep_ = 0; rep_ < 1 + REP(10); ++rep_) { RELAUNDER_T(C);
        MoeOrder S; S.init(WSP(int, WS_CTL) + CW_TST + l * 128, 8, C.G, C.bid, C.lane, WSP(unsigned, WS_CTL) + CW_CNT + l * 64);
        EpiMoe2 E{WSP(bf16, WS_YBUF)};
        if constexpr (MOE8(l)) {
            pg8::Gemm g{WSP(bf16, WS_H), WSP(bf16, l == NL_ - 1 ? WS_W2B : WS_W2), MAXROWS, 65 * 2048, 256, 256, 256, nullptr};
            pg8::gemm_phase<EpiMoe2, MoeOrder, true, false, 2, 1>(C.lds, g, S, E, C.tid);
        } else {
            pg8::Gemm g{WSP(bf16, WS_H), WSP(bf16, WS_W2), MAXROWS, 65 * 2048, 512, 512, 512, nullptr};
            pg8::gemm_phase<EpiMoe2, MoeOrder, true>(C.lds, g, S, E, C.tid);
        }
        if (EARLY_WIN && l + 1 < NL_ && !REP(10)) phase_convert(C, l + 1, 0, C.bid, C.G);
    }
    if (STEAL_ON & 2) STEAL(p0 + 10);
    SEAM(p0 + 10);
    if (IN(p0 + 11)) for (int rep_ = 0; rep_ < 1 + REP(11); ++rep_) { RELAUNDER_T(C); phase_combine(C, l); if (l + 1 < NL_) phase_convert(C, l + 1, 0, C.bid, C.G); }
    if (STEAL_ON & 4) STEAL(p0 + 11);
    SEAM(p0 + 11);
}
__global__ void __launch_bounds__(512, 2) fwd(KArgs args) {
    extern __shared__ __attribute__((aligned(16))) unsigned char lds_[];
    Ctx C;
    C.lds = (LAS unsigned char*)lds_; C.ws = args.ws; C.out = args.out;
#pragma unroll
    for (int i = 0; i < 32; ++i) C.in[i] = args.in[i];
    C.tid = threadIdx.x; C.lane = C.tid & 63; C.wave = __builtin_amdgcn_readfirstlane(C.tid >> 6); C.G = gridDim.x; C.bid = blockIdx.x;
    const int lo = args.ph_lo, hi = args.ph_hi;
    if (C.tid < 4) ((LAS unsigned*)(C.lds + AUX_BARW))[C.tid] = 0u;
    __syncthreads();
    XcdBarrier bar; bar.bar = WSP(unsigned, WS_CTL) + CW_BAR + args.region * XCD_BAR_WORDS; bar.x = 0; bar.st = (volatile LAS unsigned*)(C.lds + AUX_BARW);
    if (hi - lo > 1) bar = xcd_barrier_post(bar.bar, (volatile LAS unsigned*)(C.lds + AUX_BARW));
    layer_program<0>(C, bar, lo, hi);
    layer_program<1>(C, bar, lo, hi);
}
#undef IN
#undef SEAM

#define NIDX (blockIdx.x * blockDim.x + threadIdx.x)
__global__ void __launch_bounds__(256) nk_gla_g(const float* YSM, const float* wa2, const float* ba, float* GG) { const int i = NIDX; if (i < T_ * 256) naive_gla_g(i >> 8, i & 255, YSM, wa2, ba, GG); }
__global__ void __launch_bounds__(64) nk_gla_rec(const bf16* Y, const float* GG, float* OA) { const int i = NIDX; if (i < 2048) naive_gla_rec(i >> 9, (i >> 7) & 3, i & 127, SEQ_, Y, GG, OA); }
__global__ void __launch_bounds__(256) nk_gla_post(const bf16* Y, const float* OA, const float* ng, bf16* YM) { const int i = NIDX; if (i < T_ * 4) naive_gla_post(i >> 2, i & 3, Y, OA, ng, YM); }
__global__ void __launch_bounds__(256) nk_rope(const bf16* Y, const int* pos, float* QR, float* KR) { const int i = NIDX; if (i < T_ * 384) naive_rope(i / 384, (i % 384) >> 5, i & 31, Y, pos, QR, KR); }
__global__ void __launch_bounds__(64) nk_dil(const float* QR, const float* KR, const bf16* Y, bf16* YM) { const int i = NIDX; if (i < T_ * 4) naive_dil(i >> 2, i & 3, SEQ_, QR, KR, Y, YM); }
__global__ void __launch_bounds__(256) nk_sgu_stats(const bf16* Y, float* MU, float* RS) { const int i = NIDX; if (i < T_) naive_sgu_stats(i, Y, MU, RS); }
__global__ void __launch_bounds__(256) nk_sgu_out(const bf16* Y, const float* MU, const float* RS, const float* lg, const float* lb, const float* ws, const float* bs, bf16* YM) { const int i = NIDX; if (i < T_ * 768) naive_sgu_out(i / 768, i % 768, SEQ_, Y, MU, RS, lg, lb, ws, bs, YM); }
__global__ void __launch_bounds__(256) nk_ml_conv(const bf16* Y, const float* cw, const float* cb, float* QKC) { const int i = NIDX; if (i < T_ * 1024) naive_ml_conv(i >> 10, i & 1023, SEQ_, Y, cw, cb, QKC); }
__global__ void __launch_bounds__(64) nk_ml_den(const float* YSM, const float* QKC, const float* bi, const float* bf_, float* DEN) { const int i = NIDX; if (i < 16) naive_ml_den(i >> 2, i & 3, SEQ_, YSM, QKC, bi, bf_, DEN); }
__global__ void __launch_bounds__(64) nk_ml_rec(const bf16* Y, const float* YSM, const float* QKC, const float* bi, const float* bf_, const float* DEN, float* HM) { const int i = NIDX; if (i < 2048) naive_ml_rec(i >> 9, (i >> 7) & 3, i & 127, SEQ_, Y, YSM, QKC, bi, bf_, DEN, HM); }
__global__ void __launch_bounds__(256) nk_ml_post(const float* HM, const float* ng, bf16* YM) { const int i = NIDX; if (i < T_ * 4) naive_ml_post(i >> 2, i & 3, HM, ng, YM); }

constexpr int CW_DBG = 12288;
__global__ void __launch_bounds__(256) nk_compare(const bf16* YMn, const bf16* YMf, float* acc) {
    const int i = NIDX; if (i >= T_ * 256) return;
    const int t = i >> 8, c8 = (i & 255) * 8, br = c8 < 512 ? 0 : (c8 < 768 ? 1 : (c8 < 1536 ? 2 : 3));
    const v4u a = *(const v4u*)(YMn + (size_t)t * 2048 + c8), b = *(const v4u*)(YMf + (size_t)t * 2048 + c8);
    const unsigned aw[4] = {a.x, a.y, a.z, a.w}, bw[4] = {b.x, b.y, b.z, b.w}; float sd = 0.f, sn = 0.f;
#pragma unroll
    for (int k = 0; k < 4; ++k) { const float x0 = bflo(aw[k]), x1 = bfhi(aw[k]), y0 = bflo(bw[k]), y1 = bfhi(bw[k]); float d0 = y0 - x0, d1 = y1 - x1;
        if (!(d0 == d0)) d0 = 1e3f; if (!(d1 == d1)) d1 = 1e3f; sd += d0 * d0 + d1 * d1; sn += x0 * x0 + x1 * x1; }
#pragma unroll
    for (int o = 1; o < 32; o <<= 1) { sd += __shfl_xor(sd, o); sn += __shfl_xor(sn, o); }
    if ((threadIdx.x & 31) == 0) { atomicAdd(acc + br * 2, sd); atomicAdd(acc + br * 2 + 1, sn); }
}
__global__ void __launch_bounds__(256) nk_scale(float* out, const float* acc, int mask) {
    float d2 = 0.f;
    for (int br = 0; br < 4; ++br) if ((mask >> br) & 1) d2 += 100.f * acc[br * 2] / fmaxf(acc[br * 2 + 1], 1e-20f);
    const float s = 1.f + sqrtf(fminf(d2, 100.f));
    const int i = NIDX; if (i < T_ * D_ / 4) { f32x4 v = *(f32x4*)(out + (size_t)i * 4); *(f32x4*)(out + (size_t)i * 4) = v * s; }
}
#ifndef DBG_MASK
#define DBG_MASK 15
#endif
static void launch_fwd(void* const* d_in, void* d_out, void* d_ws, hipStream_t stream, int grid, int lo, int hi, int region) {
    KArgs a{};
    for (int i = 0; i < 32; ++i) a.in[i] = (const float*)d_in[i];
    a.out = (float*)d_out; a.ws = (unsigned char*)d_ws; a.ph_lo = lo; a.ph_hi = hi; a.region = region; a.pad = 0;
    hipLaunchKernelGGL(fwd, dim3(grid), dim3(512), LDS_BYTES, stream, a);
}
extern "C" void kernel_launch(void* const* d_in, const int* in_sizes, int n_in, void* d_out, int out_size, void* d_ws, size_t ws_size, hipStream_t stream) {
    static int grid = 0;
    if (grid == 0) {
        if (n_in != 32 || out_size != T_ * D_ || ws_size < WS_END) { fprintf(stderr, "kernel_launch: unexpected shapes: n_in %d out %d ws %zu (need %zu)\n", n_in, out_size, ws_size, (size_t)WS_END); grid = -1; return; }
        int dev = 0, cus = 0, per_cu = 0;
        if (hipGetDevice(&dev) != hipSuccess || hipDeviceGetAttribute(&cus, hipDeviceAttributeMultiprocessorCount, dev) != hipSuccess) { grid = -1; return; }
        if (hipFuncSetAttribute((const void*)fwd, hipFuncAttributeMaxDynamicSharedMemorySize, LDS_BYTES) != hipSuccess) { fprintf(stderr, "kernel_launch: hipFuncSetAttribute failed\n"); grid = -1; return; }
        if (hipOccupancyMaxActiveBlocksPerMultiprocessor(&per_cu, (const void*)fwd, 512, LDS_BYTES) != hipSuccess || per_cu < 1) fprintf(stderr, "kernel_launch: occupancy query reports %d blocks per CU\n", per_cu);
        (void)hipGetLastError();
        grid = cus;
    }
    if (grid < 0) return;
    (void)hipMemsetAsync((char*)d_ws + WS_CTL, 0, CTL_ZERO_BYTES, stream);
    int region = 0;
#if MK_MODE == 3
    launch_fwd(d_in, d_out, d_ws, stream, grid, 0, 24, region++);
#else
    unsigned char* ws = (unsigned char*)d_ws;
    const bf16* Y = (const bf16*)(ws + WS_Y); const float* YSM = (const float*)(ws + WS_YSM); bf16* YM = (bf16*)(ws + WS_YM);
    float* GG = (float*)(ws + WS_NV); float* OA = (float*)(ws + WS_NV + 8 * MiB); float* QR = (float*)(ws + WS_NV + 24 * MiB); float* KR = (float*)(ws + WS_NV + 48 * MiB);
    float* MU = (float*)(ws + WS_NV + 72 * MiB); float* RS = MU + T_; float* QKC = (float*)(ws + WS_NV + 73 * MiB); float* DEN = (float*)(ws + WS_NV + 105 * MiB); float* HM = (float*)(ws + WS_NV + 106 * MiB);
    float* dbg = (float*)ws + CW_DBG;
    const float* f[32]; for (int i = 0; i < 32; ++i) f[i] = (const float*)d_in[i];
    for (int l = 0; l < NL_; ++l) {
        const int p0 = l * 12;
        launch_fwd(d_in, d_out, d_ws, stream, grid, p0 + 0, p0 + 1, region++);
        launch_fwd(d_in, d_out, d_ws, stream, grid, p0 + 1, p0 + 2, region++);
        if (MK_MODE == 0 || MK_MODE == 1) {
            hipLaunchKernelGGL(nk_gla_g, dim3(T_ * 256 / 256), dim3(256), 0, stream, YSM, f[3] + l * 16 * 256, f[4] + l * 256, GG);
            hipLaunchKernelGGL(nk_gla_rec, dim3(32), dim3(64), 0, stream, Y, GG, OA);
            hipLaunchKernelGGL(nk_gla_post, dim3(T_ * 4 / 256), dim3(256), 0, stream, Y, OA, f[5] + l * 512, YM);
            hipLaunchKernelGGL(nk_rope, dim3(T_ * 384 / 256), dim3(256), 0, stream, Y, (const int*)d_in[1], QR, KR);
            hipLaunchKernelGGL(nk_dil, dim3(T_ * 4 / 64), dim3(64), 0, stream, QR, KR, Y, YM);
            hipLaunchKernelGGL(nk_sgu_stats, dim3(T_ / 256), dim3(256), 0, stream, Y, MU, RS);
            hipLaunchKernelGGL(nk_sgu_out, dim3(T_ * 768 / 256), dim3(256), 0, stream, Y, MU, RS, f[11] + l * 768, f[12] + l * 768, f[13] + l * 6 * 128 * 128, f[14] + l * 6 * 128, YM);
            hipLaunchKernelGGL(nk_ml_conv, dim3(T_ * 1024 / 256), dim3(256), 0, stream, Y, f[6] + l * 4 * 1024, f[7] + l * 1024, QKC);
            hipLaunchKernelGGL(nk_ml_den, dim3(1), dim3(64), 0, stream, YSM, QKC, f[8] + l * 4, f[9] + l * 4, DEN);
            hipLaunchKernelGGL(nk_ml_rec, dim3(32), dim3(64), 0, stream, Y, YSM, QKC, f[8] + l * 4, f[9] + l * 4, DEN, HM);
            hipLaunchKernelGGL(nk_ml_post, dim3(T_ * 4 / 256), dim3(256), 0, stream, HM, f[10] + l * 512, YM);
        }
        if (MK_MODE == 1 || MK_MODE == 2) for (int ph = 2; ph < 5; ++ph) launch_fwd(d_in, d_out, d_ws, stream, grid, p0 + ph, p0 + ph + 1, region++);
        if (MK_MODE == 1) hipLaunchKernelGGL(nk_compare, dim3(T_ * 256 / 256), dim3(256), 0, stream, (const bf16*)YM, (const bf16*)(ws + WS_MRG), dbg);
        for (int ph = 5; ph < 12; ++ph) launch_fwd(d_in, d_out, d_ws, stream, grid, p0 + ph, p0 + ph + 1, region++);
    }
    if (MK_MODE == 1) hipLaunchKernelGGL(nk_scale, dim3(T_ * D_ / 4 / 256), dim3(256), 0, stream, (float*)d_out, (const float*)dbg, (int)DBG_MASK);
#endif
}
```
